# Optimizing an MI355X kernel written in HIP

```python
import math
import jax, jax.numpy as jnp
from jax import lax
import numpy as np

D_MODEL = 1024
BATCH = 8
SEQ = 8192
DEPTH = 1

ATTN_WIDTH = 512
N_HEADS = 8
HEAD_DIM = 64
N_KV_GROUPS = 2
HEADS_PER_GROUP = N_HEADS // N_KV_GROUPS
KV_WIDTH = N_KV_GROUPS * HEAD_DIM
CMP_LEN = 32
CMP_STRIDE = 16
CMP_HIDDEN = 256
SEL_BLOCK = 64
SEL_TOPN = 16
WINDOW = 512
Q_BLOCK = 64
N_BRANCH = 3
ROPE_THETA = 10000.0
SSM_WIDTH = D_MODEL - ATTN_WIDTH
SSM_GROUP = 16
SSM_GROUPS = SSM_WIDTH // SSM_GROUP
SSM_STATE = 64
SSM_CHUNK = 128
DT_MIN = 1e-3
DT_MAX = 1e-1
EPS = 1e-6
IN_WIDTH = ATTN_WIDTH + 6 * KV_WIDTH + ATTN_WIDTH + N_BRANCH * N_HEADS + 2 * SSM_WIDTH

kernel_name = "hymba_nsa_s5_hybrid"


def rms_norm(x, g):
    xf = x.astype(jnp.float32)
    y = xf * lax.rsqrt(jnp.mean(xf * xf, axis=-1, keepdims=True) + EPS)
    return (y * g.astype(jnp.float32)).astype(x.dtype)


def rope_tables(T, dtype):
    inv = 1.0 / (ROPE_THETA ** (jnp.arange(0, HEAD_DIM, 2, dtype=jnp.float32) / HEAD_DIM))
    ang = jnp.arange(T, dtype=jnp.float32)[:, None] * inv[None, :]
    return jnp.cos(ang).astype(dtype), jnp.sin(ang).astype(dtype)


def apply_rope(x, cos, sin):
    x1, x2 = jnp.split(x, 2, axis=-1)
    c = cos[None, :, None, :]
    s = sin[None, :, None, :]
    return jnp.concatenate([x1 * c - x2 * s, x2 * c + x1 * s], axis=-1)


def masked_softmax(s, mask):
    s = jnp.where(mask, s.astype(jnp.float32), -jnp.inf)
    m = jnp.max(s, axis=-1, keepdims=True)
    m = jnp.where(jnp.isfinite(m), m, 0.0)
    e = jnp.where(mask, jnp.exp(s - m), 0.0)
    return e / jnp.maximum(jnp.sum(e, axis=-1, keepdims=True), 1e-30)


def compress(kv_raw, pos, w1, w2):
    B, T = kv_raw.shape[0], kv_raw.shape[1]
    nc = (T - CMP_LEN) // CMP_STRIDE + 1
    idx = jnp.arange(nc)[:, None] * CMP_STRIDE + jnp.arange(CMP_LEN)[None, :]
    blocks = kv_raw[:, idx] + pos[None, None, :, None, :]
    blocks = blocks.transpose(0, 1, 3, 2, 4).reshape(B, nc, N_KV_GROUPS, CMP_LEN * HEAD_DIM)
    return jax.nn.gelu(blocks @ w1) @ w2


def block_importance(p_cmp, nsb):
    r = SEL_BLOCK // CMP_STRIDE
    ov = CMP_LEN // CMP_STRIDE
    nc = p_cmp.shape[-1]
    left = ov - 1
    right = r * nsb + r - nc
    pp = jnp.pad(p_cmp, [(0, 0)] * (p_cmp.ndim - 1) + [(left, right)])
    terms = []
    for m in range(r):
        for n in range(ov):
            start = m - n + left
            terms.append(pp[..., start:start + r * (nsb - 1) + 1:r])
    return sum(terms[1:], terms[0])


def nsa_attention(q, kc, vc, k_slc, v_slc, k_win, v_win, gates):
    B, T = q.shape[0], q.shape[1]
    cos, sin = rope_tables(T, q.dtype)
    q_r = apply_rope(q, cos, sin)
    k_slc = apply_rope(k_slc, cos, sin)
    k_win = apply_rope(k_win, cos, sin)
    q_g = q.reshape(B, T, N_KV_GROUPS, HEADS_PER_GROUP, HEAD_DIM)
    q_rg = q_r.reshape(B, T, N_KV_GROUPS, HEADS_PER_GROUP, HEAD_DIM)
    gates = gates.reshape(B, T, N_KV_GROUPS, HEADS_PER_GROUP, N_BRANCH)
    nsb = T // SEL_BLOCK
    n_sel = min(SEL_TOPN, nsb)
    nc = kc.shape[1]
    k_blocks = k_slc.reshape(B, nsb, SEL_BLOCK, N_KV_GROUPS, HEAD_DIM).transpose(0, 3, 1, 2, 4)
    v_blocks = v_slc.reshape(B, nsb, SEL_BLOCK, N_KV_GROUPS, HEAD_DIM).transpose(0, 3, 1, 2, 4)
    k_win_p = jnp.pad(k_win, ((0, 0), (WINDOW, 0), (0, 0), (0, 0)))
    v_win_p = jnp.pad(v_win, ((0, 0), (WINDOW, 0), (0, 0), (0, 0)))
    cmp_end = jnp.arange(nc) * CMP_STRIDE + CMP_LEN - 1
    blk = jnp.arange(nsb)
    scale = HEAD_DIM ** -0.5
    gather = jax.vmap(jax.vmap(lambda kb, ix: kb[ix]))
    n_keys = n_sel * SEL_BLOCK

    def block_fn(qb):
        t0 = qb * Q_BLOCK
        t = t0 + jnp.arange(Q_BLOCK)
        qc = lax.dynamic_slice_in_dim(q_g, t0, Q_BLOCK, 1)
        qr = lax.dynamic_slice_in_dim(q_rg, t0, Q_BLOCK, 1)
        g = lax.dynamic_slice_in_dim(gates, t0, Q_BLOCK, 1)
        s = jnp.einsum('bqghd,bngd->bghqn', qc, kc) * scale
        p = masked_softmax(s, cmp_end[None, :] <= t[:, None])
        o_cmp = jnp.einsum('bghqn,bngd->bqghd', p.astype(vc.dtype), vc)
        imp = block_importance(jnp.sum(p, axis=2), nsb)
        cur = t // SEL_BLOCK
        forced = (blk[None, :] == 0) | (blk[None, :] == cur[:, None]) | (blk[None, :] == cur[:, None] - 1)
        valid = blk[None, :] * SEL_BLOCK <= t[:, None]
        imp = jnp.where(forced, jnp.inf, jnp.where(valid, imp, -jnp.inf))
        _, idx = lax.top_k(imp, n_sel)
        ks = gather(k_blocks, idx).reshape(B, N_KV_GROUPS, Q_BLOCK, n_keys, HEAD_DIM)
        vs = gather(v_blocks, idx).reshape(B, N_KV_GROUPS, Q_BLOCK, n_keys, HEAD_DIM)
        kpos = (idx[..., None] * SEL_BLOCK + jnp.arange(SEL_BLOCK)).reshape(B, N_KV_GROUPS, Q_BLOCK, n_keys)
        s = jnp.einsum('bqghd,bgqkd->bghqk', qr, ks) * scale
        p = masked_softmax(s, (kpos <= t[:, None])[:, :, None])
        o_slc = jnp.einsum('bghqk,bgqkd->bqghd', p.astype(vs.dtype), vs)
        kw = lax.dynamic_slice_in_dim(k_win_p, t0, WINDOW + Q_BLOCK, 1)
        vw = lax.dynamic_slice_in_dim(v_win_p, t0, WINDOW + Q_BLOCK, 1)
        wpos = t0 - WINDOW + jnp.arange(WINDOW + Q_BLOCK)
        dist = t[:, None] - wpos[None, :]
        wmask = (dist >= 0) & (dist < WINDOW) & (wpos[None, :] >= 0)
        s = jnp.einsum('bqghd,bkgd->bghqk', qr, kw) * scale
        p = masked_softmax(s, wmask)
        o_win = jnp.einsum('bghqk,bkgd->bqghd', p.astype(vw.dtype), vw)
        return g[..., 0:1] * o_cmp + g[..., 1:2] * o_slc + g[..., 2:3] * o_win

    out = lax.map(block_fn, jnp.arange(T // Q_BLOCK))
    return out.transpose(1, 0, 2, 3, 4, 5).reshape(B, T, ATTN_WIDTH)


def s5_mixer(u, a_re, a_im, log_dt, b_re, b_im, c_re, c_im, d_skip):
    B, T = u.shape[0], u.shape[1]
    f32 = jnp.float32
    uf = u.astype(f32)
    lam = lax.complex(a_re.astype(f32), a_im.astype(f32))
    dt = jnp.exp(log_dt.astype(f32))[:, None]
    lam_bar = jnp.exp(lam * dt)
    b_bar = ((lam_bar - 1.0) / lam)[..., None] * lax.complex(b_re.astype(f32), b_im.astype(f32))
    c_mat = lax.complex(c_re.astype(f32), c_im.astype(f32))
    nch = T // SSM_CHUNK
    uc = uf.reshape(B, nch, SSM_CHUNK, SSM_GROUPS, SSM_GROUP).transpose(1, 0, 2, 3, 4)

    def binop(e1, e2):
        a1, b1 = e1
        a2, b2 = e2
        return a1 * a2, a2 * b1 + b2

    def step(carry, u_chunk):
        bu = jnp.einsum('btgc,gpc->btgp', u_chunk.astype(jnp.complex64), b_bar)
        a = jnp.broadcast_to(lam_bar, bu.shape)
        a_cum, b_cum = lax.associative_scan(binop, (a, bu), axis=1)
        s = a_cum * carry[:, None] + b_cum
        y = jnp.real(jnp.einsum('gcp,btgp->btgc', c_mat, s))
        return s[:, -1], y

    carry0 = jnp.zeros((B, SSM_GROUPS, SSM_STATE), jnp.complex64)
    _, y = lax.scan(step, carry0, uc)
    y = y.transpose(1, 0, 2, 3, 4).reshape(B, T, SSM_WIDTH)
    return y + d_skip.astype(f32) * uf


def hybrid_layer(x, c, w_ada, b_ada, norm_g, w_in, q_norm_g, k_cmp_norm_g, k_slc_norm_g, k_win_norm_g,
                 cmp_pos_k, cmp_pos_v, cmp_w1_k, cmp_w2_k, cmp_w1_v, cmp_w2_v,
                 ssm_a_re, ssm_a_im, ssm_log_dt, ssm_b_re, ssm_b_im, ssm_c_re, ssm_c_im, ssm_d,
                 glu_w, glu_b, w_out):
    B, T = x.shape[0], x.shape[1]
    mod = jax.nn.silu(c) @ w_ada + b_ada
    shift, scale, gate = jnp.split(mod, 3, axis=-1)
    h = rms_norm(x, norm_g) * (1 + scale[:, None, :]) + shift[:, None, :]
    proj = h @ w_in
    widths = [ATTN_WIDTH] + [KV_WIDTH] * 6 + [ATTN_WIDTH, N_BRANCH * N_HEADS, SSM_WIDTH, SSM_WIDTH]
    offs = [int(v) for v in np.cumsum(widths)[:-1]]
    q, kcr, vcr, ksl, vsl, kwn, vwn, z_a, g_br, u, z_s = jnp.split(proj, offs, axis=-1)

    def kv_heads(t):
        return t.reshape(B, T, N_KV_GROUPS, HEAD_DIM)

    q = rms_norm(q.reshape(B, T, N_HEADS, HEAD_DIM), q_norm_g)
    kc = rms_norm(compress(kv_heads(kcr), cmp_pos_k, cmp_w1_k, cmp_w2_k), k_cmp_norm_g)
    vc = compress(kv_heads(vcr), cmp_pos_v, cmp_w1_v, cmp_w2_v)
    k_slc = rms_norm(kv_heads(ksl), k_slc_norm_g)
    k_win = rms_norm(kv_heads(kwn), k_win_norm_g)
    gates = jax.nn.sigmoid(g_br).reshape(B, T, N_HEADS, N_BRANCH)
    attn = nsa_attention(q, kc, vc, k_slc, kv_heads(vsl), k_win, kv_heads(vwn), gates)
    attn = attn * jax.nn.silu(z_a)

    y = s5_mixer(u, ssm_a_re, ssm_a_im, ssm_log_dt, ssm_b_re, ssm_b_im, ssm_c_re, ssm_c_im, ssm_d)
    y = jax.nn.gelu(y)
    y = y * jax.nn.sigmoid(y @ glu_w.astype(jnp.float32) + glu_b.astype(jnp.float32))
    ssm = y.astype(x.dtype) * jax.nn.silu(z_s)

    mix = jnp.concatenate([attn, ssm], axis=-1) @ w_out
    return x + gate[:, None, :] * mix


def setup_inputs(seed: int = 0) -> dict:
    key = jax.random.key(seed)
    ks = jax.random.split(key, 32)
    f32 = jnp.float32

    def nrm(k, shape, s):
        return jax.random.normal(k, shape, f32) * s

    D = D_MODEL
    L = DEPTH
    ng, p, cg = SSM_GROUPS, SSM_STATE, SSM_GROUP
    return {
        "x": nrm(ks[0], (BATCH, SEQ, D), 1.0),
        "c": nrm(ks[1], (BATCH, D), 1.0),
        "w_ada": nrm(ks[2], (L, D, 3 * D), 0.5 * D ** -0.5),
        "b_ada": nrm(ks[3], (L, 3 * D), 0.01),
        "norm_g": 1.0 + nrm(ks[4], (L, D), 0.02),
        "w_in": nrm(ks[5], (L, D, IN_WIDTH), D ** -0.5),
        "q_norm_g": 1.0 + nrm(ks[6], (L, HEAD_DIM), 0.02),
        "k_cmp_norm_g": 1.0 + nrm(ks[7], (L, HEAD_DIM), 0.02),
        "k_slc_norm_g": 1.0 + nrm(ks[8], (L, HEAD_DIM), 0.02),
        "k_win_norm_g": 1.0 + nrm(ks[9], (L, HEAD_DIM), 0.02),
        "cmp_pos_k": nrm(ks[10], (L, CMP_LEN, HEAD_DIM), 0.1),
        "cmp_pos_v": nrm(ks[11], (L, CMP_LEN, HEAD_DIM), 0.1),
        "cmp_w1_k": nrm(ks[12], (L, CMP_LEN * HEAD_DIM, CMP_HIDDEN), (CMP_LEN * HEAD_DIM) ** -0.5),
        "cmp_w2_k": nrm(ks[13], (L, CMP_HIDDEN, HEAD_DIM), CMP_HIDDEN ** -0.5),
        "cmp_w1_v": nrm(ks[14], (L, CMP_LEN * HEAD_DIM, CMP_HIDDEN), (CMP_LEN * HEAD_DIM) ** -0.5),
        "cmp_w2_v": nrm(ks[15], (L, CMP_HIDDEN, HEAD_DIM), CMP_HIDDEN ** -0.5),
        "ssm_a_re": -0.5 + nrm(ks[16], (L, ng, p), 0.01),
        "ssm_a_im": math.pi * jnp.arange(p, dtype=f32)[None, None, :] + nrm(ks[17], (L, ng, p), 0.01),
        "ssm_log_dt": jax.random.uniform(ks[18], (L, ng), f32, math.log(DT_MIN), math.log(DT_MAX)),
        "ssm_b_re": nrm(ks[19], (L, ng, p, cg), (2 * cg) ** -0.5),
        "ssm_b_im": nrm(ks[20], (L, ng, p, cg), (2 * cg) ** -0.5),
        "ssm_c_re": nrm(ks[21], (L, ng, cg, p), p ** -0.5),
        "ssm_c_im": nrm(ks[22], (L, ng, cg, p), p ** -0.5),
        "ssm_d": nrm(ks[23], (L, SSM_WIDTH), 1.0),
        "glu_w": nrm(ks[24], (L, SSM_WIDTH, SSM_WIDTH), SSM_WIDTH ** -0.5),
        "glu_b": nrm(ks[25], (L, SSM_WIDTH), 0.01),
        "w_out": nrm(ks[26], (L, D, D), D ** -0.5),
    }


def reference(x, c, w_ada, b_ada, norm_g, w_in, q_norm_g, k_cmp_norm_g, k_slc_norm_g, k_win_norm_g,
              cmp_pos_k, cmp_pos_v, cmp_w1_k, cmp_w2_k, cmp_w1_v, cmp_w2_v,
              ssm_a_re, ssm_a_im, ssm_log_dt, ssm_b_re, ssm_b_im, ssm_c_re, ssm_c_im, ssm_d,
              glu_w, glu_b, w_out):
    for l in range(DEPTH):
        x = hybrid_layer(x, c, w_ada[l], b_ada[l], norm_g[l], w_in[l], q_norm_g[l], k_cmp_norm_g[l],
                         k_slc_norm_g[l], k_win_norm_g[l], cmp_pos_k[l], cmp_pos_v[l], cmp_w1_k[l],
                         cmp_w2_k[l], cmp_w1_v[l], cmp_w2_v[l], ssm_a_re[l], ssm_a_im[l], ssm_log_dt[l],
                         ssm_b_re[l], ssm_b_im[l], ssm_c_re[l], ssm_c_im[l], ssm_d[l], glu_w[l], glu_b[l],
                         w_out[l])
    return x
```

```cpp
#ifndef CPU_EMU
#include <hip/hip_runtime.h>
#endif
#include <cstdio>
#include <cstdint>
#include <cmath>

#ifndef BATCH_N
#define BATCH_N 8
#endif
#ifndef SEQ_LEN
#define SEQ_LEN 8192
#endif
#ifndef N_LAUNCH
#define N_LAUNCH 1
#endif
#define DEV __device__ __forceinline__

typedef unsigned short bf16_t;
typedef short bf16x8 __attribute__((ext_vector_type(8)));
typedef float f32x4 __attribute__((ext_vector_type(4)));
typedef float f32x2 __attribute__((ext_vector_type(2)));
typedef unsigned u32x4 __attribute__((ext_vector_type(4)));
typedef unsigned u32x2 __attribute__((ext_vector_type(2)));

constexpr int B_ = BATCH_N, T_ = SEQ_LEN, D_ = 1024, M_ = B_ * T_;
constexpr int NH = 8, HD = 64, NGRP = 2;
constexpr int NCMP = (T_ - 32) / 16 + 1;
constexpr int NCP = T_ / 16;
constexpr int NSB = T_ / 64;
constexpr int INW = 2840, INP = 3072;
constexpr int SSM_NG = 32, SSM_P = 64, SSM_C = 16, SSM_W = 512;
constexpr int SSM_L = 64;
constexpr int SSM_CG = 32;
constexpr int SSM_NCG = T_ / (SSM_L * SSM_CG);
constexpr float EPS_ = 1e-6f;
static_assert(T_ % 2048 == 0 && NSB <= 128, "shape assumptions");

enum { I_X = 0, I_C, I_WADA, I_BADA, I_NORMG, I_WIN, I_QNG, I_KCNG, I_KSNG, I_KWNG, I_POSK, I_POSV, I_W1K, I_W2K, I_W1V, I_W2V,
       I_ARE, I_AIM, I_LOGDT, I_BRE, I_BIM, I_CRE, I_CIM, I_SSMD, I_GLUW, I_GLUB, I_WOUT, N_IN };

constexpr size_t MiB = 1u << 20;
constexpr size_t al(size_t x) { return (x + MiB - 1) / MiB * MiB; }
constexpr size_t WS_CTL = 0, CTL_ZERO_BYTES = 64 * 1024;
constexpr size_t WS_MOD = 1 * MiB;
constexpr size_t WS_ROPE = WS_MOD + al((size_t)B_ * 3072 * 4);
constexpr size_t WS_CPOS = WS_ROPE + al((size_t)T_ * 64 * 4);
constexpr size_t WS_LAM64 = WS_CPOS + 4096;
constexpr size_t WS_KT = WS_CPOS + MiB;
constexpr size_t WS_WST = WS_KT + al((size_t)32 * 65 * 256 * 2);
constexpr size_t WS_WOUTS = WS_WST + al((size_t)32 * 128 * 1024 * 2);
constexpr size_t WS_WIN = WS_WOUTS + al((size_t)32 * 1024 * 128 * 2);
constexpr size_t WS_WO = WS_WIN + al((size_t)INP * 1024 * 2);
constexpr size_t WS_WGLU = WS_WO + al((size_t)1024 * 1024 * 2);
constexpr size_t WS_W1K = WS_WGLU + MiB, WS_W1V = WS_W1K + MiB;
constexpr size_t WS_W2K = WS_W1V + MiB, WS_W2V = WS_W2K + 64 * 1024;
constexpr size_t WS_KC = WS_W2K + MiB;
constexpr size_t WS_VC = WS_KC + al((size_t)B_ * NCP * 128 * 2);
constexpr size_t WS_G = WS_VC + al((size_t)B_ * NCP * 128 * 2);
constexpr size_t WS_HN = WS_G + al((size_t)M_ * 32 * 4);
constexpr size_t WS_Q = WS_HN + al((size_t)M_ * 1024 * 2);
constexpr size_t WS_QR = WS_Q + al((size_t)M_ * 512 * 2);
constexpr size_t WS_CR = WS_QR + al((size_t)M_ * 512 * 2);
constexpr size_t WS_SL = WS_CR + al((size_t)M_ * 256 * 2);
constexpr size_t WS_WN = WS_SL + al((size_t)M_ * 256 * 2);
constexpr size_t WS_ZA = WS_WN + al((size_t)M_ * 256 * 2);
constexpr size_t WS_U = WS_ZA + al((size_t)M_ * 512 * 2);
constexpr size_t WS_ZS = WS_U + al((size_t)M_ * 512 * 2);
constexpr size_t WS_YG = WS_ZS + al((size_t)M_ * 512 * 2);
constexpr size_t WS_MIX = WS_YG + al((size_t)M_ * 512 * 2);
constexpr size_t WS_END = WS_MIX + al((size_t)M_ * 1024 * 2);

constexpr int RING_BYTES = 131072;
constexpr int MISC_OFF = RING_BYTES;
constexpr int LDS_BYTES = 147456;

DEV unsigned f2bf(float f) { unsigned u = __builtin_bit_cast(unsigned, f); return (u + 0x7fffu + ((u >> 16) & 1u)) >> 16; }
DEV float bf2f(unsigned h) { return __builtin_bit_cast(float, h << 16); }
#ifdef CPU_EMU
DEV unsigned pk2(float lo, float hi) { return f2bf(lo) | (f2bf(hi) << 16); }
DEV float exp2_fast(float x) { return exp2f(x); }
DEV float rcp_fast(float x) { return 1.0f / x; }
DEV f32x4 mfma16(bf16x8 a, bf16x8 b, f32x4 c) { return emu_mfma16(a, b, c); }
#define WAVE_ID() ((int)(threadIdx.x >> 6))
#else
typedef __bf16 bf16x2_t __attribute__((ext_vector_type(2)));
DEV unsigned pk2(float lo, float hi) { f32x2 v = {lo, hi}; bf16x2_t b = __builtin_convertvector(v, bf16x2_t); return __builtin_bit_cast(unsigned, b); }
DEV float exp2_fast(float x) { return __builtin_amdgcn_exp2f(x); }
DEV float rcp_fast(float x) { return __builtin_amdgcn_rcpf(x); }
DEV f32x4 mfma16(bf16x8 a, bf16x8 b, f32x4 c) { return __builtin_amdgcn_mfma_f32_16x16x32_bf16(a, b, c, 0, 0, 0); }
#define WAVE_ID() (__builtin_amdgcn_readfirstlane((int)(threadIdx.x >> 6)))
#endif
#ifdef CPU_EMU
#define EXPF(x) expf(x)
#else
#define EXPF(x) __expf(x)
#endif
DEV float silu_f(float v) { return v / (1.0f + EXPF(-v)); }
DEV float sigmoid_f(float v) { return 1.0f / (1.0f + EXPF(-v)); }
DEV float gelu_tanh_f(float v) { const float u = 0.7978845608028654f * (v + 0.044715f * v * v * v); const float e = EXPF(2.0f * u); return v * (1.0f - 1.0f / (e + 1.0f)); }
DEV float wave_sum(float v) {
#pragma unroll
    for (int o = 1; o < 64; o <<= 1) v += __shfl_xor(v, o);
    return v;
}
DEV float wave_max(float v) {
#pragma unroll
    for (int o = 1; o < 64; o <<= 1) v = fmaxf(v, __shfl_xor(v, o));
    return v;
}
DEV bf16x8 ld8(const bf16_t* p) { return *(const bf16x8*)p; }
namespace pg8 {
#define PG8_LAS __attribute__((address_space(3)))
typedef unsigned short bf16_t;
typedef short bf16x8 __attribute__((ext_vector_type(8)));
typedef float f32x4 __attribute__((ext_vector_type(4)));
typedef unsigned u32x4 __attribute__((ext_vector_type(4)));
constexpr int BM = 256, BK = 64, HALF = 128, HTB = HALF * BK * 2  , STAGE_BYTES = 8 * HTB, NXCD = 8, WGM = 8;

__host__ __device__ __forceinline__ int lds_byte(int r, int c) { const int st = (r >> 4) * 2 + (c >> 5), rr = r & 15, cc = c & 31, ob = rr * 64 + cc * 2; return st * 1024 + (ob ^ (((ob >> 9) & 1) << 5)); }
__host__ __device__ __forceinline__ void stage_rc(int b, int& R, int& C) { const int st = b / 1024, sb = b % 1024, swz = sb ^ (((sb >> 9) & 1) << 5); R = (st >> 1) * 16 + swz / 64; C = (st & 1) * 32 + (swz % 64) / 2; }
__host__ __device__ __forceinline__ int perm32(int rho) { const int n = rho >> 4, i = rho & 15; return 8 * (i >> 2) + 4 * n + (i & 3); }

struct Unit { int pm, pn; };
struct Gemm { const bf16_t* A; const bf16_t* Bt; int M, N, K; };

struct StaticOrder {
    int nM, nN, nwg, G, c;
    __host__ __device__ void init(int M, int N, int G_, int c_) { nM = M / BM; nN = N / BM; nwg = nM * nN; G = G_; c = c_; }
    __host__ __device__ bool next(int i, Unit& u) const {
        const long L = (long)i * G + c; if (L >= nwg) return false;
        int wgid = (int)L; { const int q = nwg / NXCD, r = nwg % NXCD, xcd = wgid % NXCD, off = wgid / NXCD; wgid = (xcd < r ? xcd * (q + 1) : r * (q + 1) + (xcd - r) * q) + off; }
        const int nig = WGM * nN, gid = wgid / nig, fm = gid * WGM, gsz = (nM - fm) < WGM ? (nM - fm) : WGM;
        u.pm = fm + ((wgid % nig) % gsz); u.pn = (wgid % nig) / gsz; return true;
    }
    __device__ __forceinline__ void a_ready(const Unit&) const {}
    __device__ __forceinline__ void done(const Unit&) const {}
};

#ifndef CPU_EMU
__device__ __forceinline__ unsigned cvt_pk_bf16(float lo, float hi) { unsigned r; asm volatile("v_cvt_pk_bf16_f32 %0, %1, %2" : "=v"(r) : "v"(lo), "v"(hi)); return r; }
template <class Epi, class Sched, bool ALIGN_EPI = false, bool SP2 = false>
__device__ __forceinline__ void gemm_phase(PG8_LAS unsigned char* lds, const Gemm g, const Sched& S, const Epi& E) {
    const int tid = threadIdx.x, wid = __builtin_amdgcn_readfirstlane(tid >> 6), lane = tid & 63, wr = wid >> 2, wc = wid & 3, fr = lane & 15, fq = lane >> 4;
    const int K = g.K, nt = K / BK;
    unsigned voffA[2], voffB[2];
#pragma unroll
    for (int i = 0; i < 2; ++i) { int R, C; stage_rc(tid * 16 + i * 8192, R, C); const int Rb = Epi::PERM ? ((R & ~31) + perm32(R & 31)) : R;
        voffA[i] = (unsigned)(R * K + C) * 2u; voffB[i] = (unsigned)(Rb * K + C) * 2u; }
    const size_t kstep = (size_t)(BK * 2);
    const size_t hstep = (size_t)HALF * K * 2;
    const size_t tstep = 2 * hstep;
    const unsigned ldsw = (unsigned)wid * 1024u;
    const int aoff = lds_byte(wr * 64 + fr, fq * 8), boff = lds_byte(wc * 32 + fr, fq * 8);
#define PG8_SA(b, h) (((b) * 2 + (h)) * HTB)
#define PG8_SB(b, h) ((4 + (b) * 2 + (h)) * HTB)
#define PG8_STAGE(bufoff, gbase, voff) do { _Pragma("unroll") for (int _i = 0; _i < 2; ++_i) \
        __builtin_amdgcn_global_load_lds((const unsigned*)((const char*)(gbase) + (voff)[_i]), (PG8_LAS unsigned*)(lds + (bufoff) + ldsw + _i * 8192), 16, 0, 0); } while (0)
#define PG8_LDA(dst, b, h) do { _Pragma("unroll") for (int m = 0; m < 4; ++m) _Pragma("unroll") for (int k = 0; k < 2; ++k) dst[m][k] = *(const PG8_LAS bf16x8*)(lds + PG8_SA(b, h) + aoff + m * 2048 + k * 1024); } while (0)
#define PG8_LDB(dst, b, h) do { _Pragma("unroll") for (int n = 0; n < 2; ++n) _Pragma("unroll") for (int k = 0; k < 2; ++k) dst[n][k] = *(const PG8_LAS bf16x8*)(lds + PG8_SB(b, h) + boff + n * 2048 + k * 1024); } while (0)
#define PG8_MMA(ai, bj, At, Bt) do { __builtin_amdgcn_s_setprio(1); _Pragma("unroll") for (int m = 0; m < 4; ++m) _Pragma("unroll") for (int n = 0; n < 2; ++n) _Pragma("unroll") for (int k = 0; k < 2; ++k) \
        acc[ai][bj][m][n] = __builtin_amdgcn_mfma_f32_16x16x32_bf16(Bt[n][k], At[m][k], acc[ai][bj][m][n], 0, 0, 0); __builtin_amdgcn_s_setprio(0); } while (0)
#define PG8_WAIT_V(n) asm volatile("s_waitcnt vmcnt(" #n ")" ::: "memory")
#define PG8_WAIT_L(n) asm volatile("s_waitcnt lgkmcnt(" #n ")" ::: "memory")
#define PG8_BAR __builtin_amdgcn_s_barrier()
#define PG8_SCHED __builtin_amdgcn_sched_barrier(0)
    Unit cur, nxt; int ui = 0;
    if (!S.next(0, cur)) return;
    f32x4 acc[2][2][4][2];
#pragma unroll
    for (int a = 0; a < 2; ++a)
#pragma unroll
        for (int b = 0; b < 2; ++b)
#pragma unroll
            for (int m = 0; m < 4; ++m)
#pragma unroll
                for (int n = 0; n < 2; ++n) acc[a][b][m][n] = (f32x4){0.f, 0.f, 0.f, 0.f};
    bf16x8 At[4][2], B0[2][2], B1[2][2];
    const char* cA = (const char*)g.A + (size_t)cur.pm * tstep; const char* cB = (const char*)g.Bt + (size_t)cur.pn * tstep;
    S.a_ready(cur);
    if constexpr (SP2) {
        PG8_STAGE(PG8_SB(0, 0), cB, voffB); PG8_STAGE(PG8_SB(0, 1), cB + hstep, voffB); PG8_STAGE(PG8_SA(0, 0), cA, voffA); PG8_STAGE(PG8_SA(0, 1), cA + hstep, voffA);
        if (wr == 1) PG8_BAR;
        PG8_WAIT_V(2); PG8_BAR;
        PG8_STAGE(PG8_SB(1, 0), cB + kstep, voffB); PG8_STAGE(PG8_SA(1, 0), cA + kstep, voffA); PG8_STAGE(PG8_SB(1, 1), cB + hstep + kstep, voffB);
        PG8_WAIT_V(6); PG8_BAR;
    } else {
        PG8_STAGE(PG8_SB(0, 0), cB, voffB); PG8_STAGE(PG8_SA(0, 0), cA, voffA); PG8_STAGE(PG8_SB(0, 1), cB + hstep, voffB); PG8_STAGE(PG8_SA(0, 1), cA + hstep, voffA);
        if (wr == 1) PG8_BAR;
        PG8_WAIT_V(4); PG8_BAR;
        PG8_STAGE(PG8_SB(1, 0), cB + kstep, voffB); PG8_STAGE(PG8_SA(1, 0), cA + kstep, voffA); PG8_STAGE(PG8_SB(1, 1), cB + hstep + kstep, voffB);
        PG8_WAIT_V(6); PG8_BAR;
    }
    for (;;) {
        const bool has_next = S.next(ui + 1, nxt);
        const char* nA = has_next ? (const char*)g.A + (size_t)nxt.pm * tstep : cA; const char* nB = has_next ? (const char*)g.Bt + (size_t)nxt.pn * tstep : cB;
        for (int t = 0; t < nt; t += 2) {
            const bool last = (t == nt - 2);
            const char* a1 = cA + (size_t)(t + 1) * kstep;
            const char* a2 = last ? nA : cA + (size_t)(t + 2) * kstep; const char* b2 = last ? nB : cB + (size_t)(t + 2) * kstep;
            const char* a3 = a2 + kstep; const char* b3 = b2 + kstep;
            if (last && has_next) S.a_ready(nxt);
            if constexpr (SP2) {
            PG8_LDB(B0, 0, 0); PG8_LDB(B1, 0, 1); PG8_SCHED; PG8_LDA(At, 0, 0); PG8_STAGE(PG8_SA(1, 1), a1 + hstep, voffA);
            PG8_WAIT_V(8); PG8_WAIT_L(0); PG8_BAR; PG8_MMA(0, 0, At, B0); PG8_MMA(0, 1, At, B1); PG8_BAR; PG8_SCHED;
            PG8_LDA(At, 0, 1); PG8_STAGE(PG8_SB(0, 0), b2, voffB); PG8_STAGE(PG8_SB(0, 1), b2 + hstep, voffB); PG8_STAGE(PG8_SA(0, 0), a2, voffA);
            PG8_WAIT_V(8); PG8_WAIT_L(0); PG8_BAR; PG8_MMA(1, 0, At, B0); PG8_MMA(1, 1, At, B1); PG8_BAR; PG8_SCHED;
            PG8_LDB(B0, 1, 0); PG8_LDB(B1, 1, 1); PG8_SCHED; PG8_LDA(At, 1, 0); PG8_STAGE(PG8_SA(0, 1), a2 + hstep, voffA);
            PG8_WAIT_V(8); PG8_WAIT_L(0); PG8_BAR; PG8_MMA(0, 0, At, B0); PG8_MMA(0, 1, At, B1); PG8_BAR; PG8_SCHED;
            PG8_LDA(At, 1, 1); PG8_STAGE(PG8_SB(1, 0), b3, voffB); PG8_STAGE(PG8_SB(1, 1), b3 + hstep, voffB); PG8_STAGE(PG8_SA(1, 0), a3, voffA);
            PG8_WAIT_V(8); PG8_WAIT_L(0); PG8_BAR; PG8_MMA(1, 0, At, B0); PG8_MMA(1, 1, At, B1); PG8_BAR; PG8_SCHED;
            } else {
            PG8_LDB(B0, 0, 0); PG8_SCHED; PG8_LDA(At, 0, 0); PG8_STAGE(PG8_SA(1, 1), a1 + hstep, voffA);
            PG8_WAIT_L(8); PG8_BAR; PG8_WAIT_L(0); PG8_MMA(0, 0, At, B0); PG8_BAR; PG8_SCHED;
            PG8_LDB(B1, 0, 1); PG8_STAGE(PG8_SB(0, 0), b2, voffB);
            PG8_BAR; PG8_WAIT_L(0); PG8_MMA(0, 1, At, B1); PG8_BAR;
            PG8_LDA(At, 0, 1); PG8_STAGE(PG8_SA(0, 0), a2, voffA);
            PG8_BAR; PG8_WAIT_L(0); PG8_MMA(1, 0, At, B0); PG8_BAR; PG8_SCHED;
            PG8_STAGE(PG8_SB(0, 1), b2 + hstep, voffB);
            PG8_WAIT_V(6); PG8_BAR; PG8_MMA(1, 1, At, B1); PG8_BAR;
            PG8_LDB(B0, 1, 0); PG8_SCHED; PG8_LDA(At, 1, 0); PG8_STAGE(PG8_SA(0, 1), a2 + hstep, voffA);
            PG8_WAIT_L(8); PG8_BAR; PG8_WAIT_L(0); PG8_MMA(0, 0, At, B0); PG8_BAR; PG8_SCHED;
            PG8_LDB(B1, 1, 1); PG8_STAGE(PG8_SB(1, 0), b3, voffB);
            PG8_BAR; PG8_WAIT_L(0); PG8_MMA(0, 1, At, B1); PG8_BAR;
            PG8_LDA(At, 1, 1); PG8_STAGE(PG8_SA(1, 0), a3, voffA);
            PG8_BAR; PG8_WAIT_L(0); PG8_MMA(1, 0, At, B0); PG8_BAR; PG8_SCHED;
            PG8_STAGE(PG8_SB(1, 1), b3 + hstep, voffB);
            PG8_WAIT_V(6); PG8_BAR; PG8_MMA(1, 1, At, B1); PG8_BAR;
            }
        }
        if constexpr (ALIGN_EPI) { if (wr == 0) PG8_BAR; }
        if constexpr (!Epi::AFTER_DRAIN) { E(acc, cur, wr, wc, fr, fq); S.done(cur); }
        if (!has_next) break;
#pragma unroll
        for (int a = 0; a < 2; ++a)
#pragma unroll
            for (int b = 0; b < 2; ++b)
#pragma unroll
                for (int m = 0; m < 4; ++m)
#pragma unroll
                    for (int n = 0; n < 2; ++n) acc[a][b][m][n] = (f32x4){0.f, 0.f, 0.f, 0.f};
        cur = nxt; cA = nA; cB = nB; ++ui;
        if constexpr (ALIGN_EPI) { if (wr == 1) PG8_BAR; }
    }
    PG8_WAIT_V(0);
    if constexpr (!ALIGN_EPI) { if (wr == 0) PG8_BAR; }
    PG8_BAR;
    if constexpr (Epi::AFTER_DRAIN) { E.fused(acc, cur, wr, wc, fr, fq, lds, wid, lane); S.done(cur); }
#undef PG8_SA
#undef PG8_SB
#undef PG8_STAGE
#undef PG8_LDA
#undef PG8_LDB
#undef PG8_MMA
#undef PG8_WAIT_V
#undef PG8_WAIT_L
#undef PG8_BAR
#undef PG8_SCHED
}
}
#define PG8_PTR(x) ((__attribute__((address_space(3))) unsigned char*)(x))
#else
template <class Epi, class Sched, bool ALIGN_EPI = false, bool SP2 = false>
inline void gemm_phase(unsigned char* lds, const Gemm g, const Sched& S, const Epi& E) {
    const int tid = threadIdx.x, wid = tid >> 6, lane = tid & 63, wr = wid >> 2, wc = wid & 3, fr = lane & 15, fq = lane >> 4;
    Unit cur;
    for (int ui = 0; S.next(ui, cur); ++ui) {
        f32x4 acc[2][2][4][2];
        for (int ai = 0; ai < 2; ++ai) for (int bj = 0; bj < 2; ++bj) for (int m = 0; m < 4; ++m) for (int n = 0; n < 2; ++n) for (int i = 0; i < 4; ++i) {
            const int row = 256 * cur.pm + 128 * ai + 64 * wr + 16 * m + fr;
            const int col = 256 * cur.pn + 128 * bj + 32 * wc + (Epi::PERM ? 8 * fq + 4 * n + i : 16 * n + 4 * fq + i);
            const bf16_t* a = g.A + (size_t)row * g.K; const bf16_t* b = g.Bt + (size_t)col * g.K; float s = 0.f;
            for (int k = 0; k < g.K; ++k) s += emu_bf2f(a[k]) * emu_bf2f(b[k]);
            acc[ai][bj][m][n][i] = s; }
        E(acc, cur, wr, wc, fr, fq);
    }
}
}
#define PG8_PTR(x) (x)
#endif
#ifdef CPU_EMU
#define WAVE_SYNC() emu_wave_sync()
#define SCHED_FENCE() do { } while (0)
#define LAUNDER_V(x) do { } while (0)
#else
#define LAUNDER_V(x) asm volatile("" : "+v"(x))
#define WAVE_SYNC() asm volatile("s_waitcnt lgkmcnt(0)" ::: "memory")
#define SCHED_FENCE() __builtin_amdgcn_sched_barrier(0)
#endif

struct Params { const float* in[N_IN]; float* out; unsigned char* ws; int ph_lo, ph_hi, li, pad; };

struct EpiInProj {
    static constexpr bool PERM = true, AFTER_DRAIN = false;
    unsigned char* ws; const float* qng; const float* ksng; const float* kwng;
    DEV void operator()(const f32x4 (&acc)[2][2][4][2], const pg8::Unit& u, int wr, int wc, int fr, int fq) const {
        const int pn = u.pn; const int row0 = u.pm * 256 + wr * 64 + fr;
        int kind; bf16_t* dst = nullptr; bf16_t* dst2 = nullptr; int pitch = 512, colb = 0; const float* gv = nullptr;
        if (pn < 2) { kind = 2; dst = (bf16_t*)(ws + WS_Q); dst2 = (bf16_t*)(ws + WS_QR); colb = (4 * pn + wc) * 64; gv = qng; }
        else if (pn == 2) { kind = 0; dst = (bf16_t*)(ws + WS_CR); pitch = 256; colb = wc * 64; }
        else if (pn == 3) { kind = wc < 2 ? 1 : 0; dst = (bf16_t*)(ws + WS_SL); pitch = 256; colb = wc * 64; gv = ksng; }
        else if (pn == 4) { kind = wc < 2 ? 1 : 0; dst = (bf16_t*)(ws + WS_WN); pitch = 256; colb = wc * 64; gv = kwng; }
        else if (pn < 7) { kind = 3; dst = (bf16_t*)(ws + WS_ZA); colb = (4 * (pn - 5) + wc) * 64; }
        else if (pn < 9) { kind = 0; dst = (bf16_t*)(ws + WS_U); colb = (4 * (pn - 7) + wc) * 64; }
        else if (pn < 11) { kind = 3; dst = (bf16_t*)(ws + WS_ZS); colb = (4 * (pn - 9) + wc) * 64; }
        else { kind = (wc == 0) ? 4 : 5; }
        if (kind == 5) return;
        float g1[8], g2[8];
        if (kind == 1 || kind == 2) {
#pragma unroll
            for (int i = 0; i < 8; ++i) { g1[i] = gv[8 * fq + i]; g2[i] = gv[32 + 8 * fq + i]; }
        }
        const float* rope = (const float*)(ws + WS_ROPE);
#pragma unroll
        for (int ai = 0; ai < 2; ++ai)
#pragma unroll
            for (int m = 0; m < 4; ++m) {
                const int row = row0 + ai * 128 + m * 16;
                float x1[8], x2[8];
#pragma unroll
                for (int i = 0; i < 4; ++i) { x1[i] = acc[ai][0][m][0][i]; x1[4 + i] = acc[ai][0][m][1][i]; x2[i] = acc[ai][1][m][0][i]; x2[4 + i] = acc[ai][1][m][1][i]; }
                if (kind == 4) {
                    float* G = (float*)(ws + WS_G) + (size_t)row * 32 + 8 * fq;
                    f32x4 o0, o1;
#pragma unroll
                    for (int i = 0; i < 4; ++i) { o0[i] = sigmoid_f(x1[i]); o1[i] = sigmoid_f(x1[4 + i]); }
                    *(f32x4*)G = o0; *(f32x4*)(G + 4) = o1;
                    continue;
                }
                if (kind == 1 || kind == 2) {
                    float ss = 0.f;
#pragma unroll
                    for (int i = 0; i < 8; ++i) ss += x1[i] * x1[i] + x2[i] * x2[i];
                    ss += __shfl_xor(ss, 16); ss += __shfl_xor(ss, 32);
                    const float rinv = rsqrtf(ss * (1.0f / 64.0f) + EPS_);
#pragma unroll
                    for (int i = 0; i < 8; ++i) { x1[i] = x1[i] * rinv * g1[i]; x2[i] = x2[i] * rinv * g2[i]; }
                    if (kind == 2) {
                        bf16_t* o = dst + (size_t)row * pitch + colb + 8 * fq;
                        *(u32x4*)o = (u32x4){pk2(x1[0], x1[1]), pk2(x1[2], x1[3]), pk2(x1[4], x1[5]), pk2(x1[6], x1[7])};
                        *(u32x4*)(o + 32) = (u32x4){pk2(x2[0], x2[1]), pk2(x2[2], x2[3]), pk2(x2[4], x2[5]), pk2(x2[6], x2[7])};
                    }
                    const int t = row % T_;
                    const float* cs = rope + (size_t)t * 32 + 8 * fq; const float* sn = cs + (size_t)T_ * 32;
                    const f32x4 c0 = *(const f32x4*)cs, c1 = *(const f32x4*)(cs + 4), s0 = *(const f32x4*)sn, s1 = *(const f32x4*)(sn + 4);
#pragma unroll
                    for (int i = 0; i < 8; ++i) { const float c = i < 4 ? c0[i & 3] : c1[i & 3], s = i < 4 ? s0[i & 3] : s1[i & 3]; const float a = x1[i], b = x2[i]; x1[i] = a * c - b * s; x2[i] = b * c + a * s; }
                } else if (kind == 3) {
#pragma unroll
                    for (int i = 0; i < 8; ++i) { x1[i] = silu_f(x1[i]); x2[i] = silu_f(x2[i]); }
                }
                bf16_t* o = (kind == 2 ? dst2 : dst) + (size_t)row * pitch + colb + 8 * fq;
                *(u32x4*)o = (u32x4){pk2(x1[0], x1[1]), pk2(x1[2], x1[3]), pk2(x1[4], x1[5]), pk2(x1[6], x1[7])};
                *(u32x4*)(o + 32) = (u32x4){pk2(x2[0], x2[1]), pk2(x2[2], x2[3]), pk2(x2[4], x2[5]), pk2(x2[6], x2[7])};
            }
    }
};

struct EpiGlu {
    static constexpr bool PERM = true, AFTER_DRAIN = false;
    const bf16_t* YG; const bf16_t* ZS; bf16_t* MIX; const float* glub;
    DEV void operator()(const f32x4 (&acc)[2][2][4][2], const pg8::Unit& u, int wr, int wc, int fr, int fq) const {
        const int row0 = u.pm * 256 + wr * 64 + fr, col0 = u.pn * 256 + wc * 32 + 8 * fq;
#pragma unroll
        for (int bj = 0; bj < 2; ++bj) {
            const int col = col0 + bj * 128;
            const f32x4 b0 = *(const f32x4*)(glub + col), b1 = *(const f32x4*)(glub + col + 4);
#pragma unroll
            for (int ai = 0; ai < 2; ++ai)
#pragma unroll
                for (int m = 0; m < 4; ++m) {
                    const int row = row0 + ai * 128 + m * 16;
                    const u32x4 yv = *(const u32x4*)(YG + (size_t)row * 512 + col), zv = *(const u32x4*)(ZS + (size_t)row * 512 + col);
                    float o[8];
#pragma unroll
                    for (int i = 0; i < 8; ++i) {
                        const float a = (i < 4 ? acc[ai][bj][m][0][i & 3] : acc[ai][bj][m][1][i & 3]) + (i < 4 ? b0[i & 3] : b1[i & 3]);
                        const unsigned yw = yv[i >> 1], zw = zv[i >> 1];
                        const float y = bf2f((i & 1) ? (yw >> 16) : (yw & 0xffffu)), z = bf2f((i & 1) ? (zw >> 16) : (zw & 0xffffu));
                        o[i] = y * sigmoid_f(a) * z;
                    }
                    *(u32x4*)(MIX + (size_t)row * 1024 + 512 + col) = (u32x4){pk2(o[0], o[1]), pk2(o[2], o[3]), pk2(o[4], o[5]), pk2(o[6], o[7])};
                }
        }
    }
};

struct EpiOut {
    static constexpr bool PERM = true, AFTER_DRAIN = false;
    const float* x; float* out; const float* mod;
    DEV void operator()(const f32x4 (&acc)[2][2][4][2], const pg8::Unit& u, int wr, int wc, int fr, int fq) const {
        const int row0 = u.pm * 256 + wr * 64 + fr, col0 = u.pn * 256 + wc * 32 + 8 * fq; const int b = (u.pm * 256) / T_;
#pragma unroll
        for (int bj = 0; bj < 2; ++bj) {
            const int col = col0 + bj * 128;
            const f32x4 g0 = *(const f32x4*)(mod + (size_t)b * 3072 + 2048 + col), g1 = *(const f32x4*)(mod + (size_t)b * 3072 + 2048 + col + 4);
#pragma unroll
            for (int ai = 0; ai < 2; ++ai)
#pragma unroll
                for (int m = 0; m < 4; ++m) {
                    const size_t off = (size_t)(row0 + ai * 128 + m * 16) * 1024 + col;
                    const f32x4 x0 = *(const f32x4*)(x + off), x1 = *(const f32x4*)(x + off + 4);
                    *(f32x4*)(out + off) = x0 + g0 * acc[ai][bj][m][0];
                    *(f32x4*)(out + off + 4) = x1 + g1 * acc[ai][bj][m][1];
                }
        }
    }
};

DEV void tr_item(const float* W, int Nsrc, int K, int k0, int col0, int nvalid, bf16_t* WT, int drow0, float* scr, int lane) {
    const int c = lane & 31;
#pragma unroll 8
    for (int i = 0; i < 32; ++i) { const int kk = 2 * i + (lane >> 5); scr[kk * 33 + c] = (c < nvalid) ? W[(size_t)(k0 + kk) * Nsrc + col0 + c] : 0.f; }
    WAVE_SYNC();
    const int c8 = lane & 7;
#pragma unroll
    for (int j = 0; j < 4; ++j) { const int n = (lane >> 3) + 8 * j; const float* s = scr + (8 * c8) * 33 + n;
        u32x4 o; o.x = pk2(s[0 * 33], s[1 * 33]); o.y = pk2(s[2 * 33], s[3 * 33]); o.z = pk2(s[4 * 33], s[5 * 33]); o.w = pk2(s[6 * 33], s[7 * 33]);
        *(u32x4*)(WT + (size_t)(drow0 + n) * K + k0 + 8 * c8) = o; }
    WAVE_SYNC();
}

DEV void p0_prologue(const Params& p, unsigned char* lds, int vcu, int G, int tid, int wave, int lane) {
    unsigned char* ws = p.ws;
    {
        const float* c = p.in[I_C]; const float* w = p.in[I_WADA]; const float* ba = p.in[I_BADA]; float* mod = (float*)(ws + WS_MOD);
        for (int cb = vcu; cb < 256; cb += G)
            for (int b = wave; b < B_; b += 8) {
                float a[12];
#pragma unroll
                for (int j = 0; j < 12; ++j) a[j] = 0.f;
                for (int i = 0; i < 16; ++i) {
                    const int k = lane + 64 * i; const float s = silu_f(c[b * 1024 + k]);
                    const f32x4* wp = (const f32x4*)(w + (size_t)k * 3072 + 12 * cb); const f32x4 w0 = wp[0], w1 = wp[1], w2 = wp[2];
#pragma unroll
                    for (int j = 0; j < 4; ++j) { a[j] += s * w0[j]; a[4 + j] += s * w1[j]; a[8 + j] += s * w2[j]; }
                }
#pragma unroll
                for (int j = 0; j < 12; ++j) a[j] = wave_sum(a[j]);
                if (lane == 0) {
#pragma unroll
                    for (int j = 0; j < 12; ++j) mod[b * 3072 + 12 * cb + j] = a[j] + ba[12 * cb + j];
                }
            }
    }
    {
        float* scr = (float*)(lds + wave * 16384);
        const int gw = vcu * 8 + wave, NGW = G * 8;
        constexpr int I_IN = 96 * 16, I_O = 32 * 16, I_GL = 16 * 8, I_W1 = 8 * 32, I_W2 = 2 * 4;
        constexpr int NIT = I_IN + I_O + I_GL + 2 * I_W1 + 2 * I_W2;
        for (int it = gw; it < NIT; it += NGW) {
            int r = it;
            if (r < I_IN) {
                const int ci = r / 16, kb = r % 16, n0 = 32 * ci, pn = n0 >> 8, bj = (n0 >> 7) & 1, wc = (n0 >> 5) & 3, L0 = 256 * pn + 64 * wc + 32 * bj;
                int oc, nv; if (L0 < 1792) { oc = L0; nv = 32; } else if (L0 < 2816) { oc = L0 + 24; nv = 32; } else if (L0 == 2816) { oc = 1792; nv = 24; } else { oc = 0; nv = 0; }
                tr_item(p.in[I_WIN], INW, 1024, 64 * kb, oc, nv, (bf16_t*)(ws + WS_WIN), n0, scr, lane); continue; }
            r -= I_IN;
            if (r < I_O) { tr_item(p.in[I_WOUT], 1024, 1024, 64 * (r % 16), 32 * (r / 16), 32, (bf16_t*)(ws + WS_WO), 32 * (r / 16), scr, lane); continue; }
            r -= I_O;
            if (r < I_GL) { tr_item(p.in[I_GLUW], 512, 512, 64 * (r % 8), 32 * (r / 8), 32, (bf16_t*)(ws + WS_WGLU), 32 * (r / 8), scr, lane); continue; }
            r -= I_GL;
            if (r < I_W1) { tr_item(p.in[I_W1K], 256, 2048, 64 * (r % 32), 32 * (r / 32), 32, (bf16_t*)(ws + WS_W1K), 32 * (r / 32), scr, lane); continue; }
            r -= I_W1;
            if (r < I_W1) { tr_item(p.in[I_W1V], 256, 2048, 64 * (r % 32), 32 * (r / 32), 32, (bf16_t*)(ws + WS_W1V), 32 * (r / 32), scr, lane); continue; }
            r -= I_W1;
            if (r < I_W2) { tr_item(p.in[I_W2K], 64, 256, 64 * (r % 4), 32 * (r / 4), 32, (bf16_t*)(ws + WS_W2K), 32 * (r / 4), scr, lane); continue; }
            r -= I_W2;
            tr_item(p.in[I_W2V], 64, 256, 64 * (r % 4), 32 * (r / 4), 32, (bf16_t*)(ws + WS_W2V), 32 * (r / 4), scr, lane);
        }
    }
    {
        float* rc = (float*)(ws + WS_ROPE); float* rs = rc + (size_t)T_ * 32;
        for (int i = vcu * 512 + tid; i < T_ * 32; i += G * 512) {
            const int t = i >> 5, d = i & 31;
            const float inv = (float)(1.0 / pow(10000.0, (double)d / 32.0));
            const float ang = (float)t * inv;
            rc[i] = (float)cos((double)ang); rs[i] = (float)sin((double)ang);
        }
    }
    __syncthreads();
    {
        f32x2* lp = (f32x2*)lds;
        f32x2* bb = lp + 64;
        f32x2* cc = bb + 1024;
        f32x2* ee = cc + 1024;
        for (int it = vcu; it < 32 * 65 + 2; it += G) {
            if (it >= 32 * 65) {
                const int kv = it - 32 * 65; const float* pos = p.in[kv ? I_POSV : I_POSK]; const float* w1 = p.in[kv ? I_W1V : I_W1K];
                if (tid < 256) { float a = 0.f; for (int i = 0; i < 2048; ++i) a += pos[i] * w1[(size_t)i * 256 + tid]; ((float*)(ws + WS_CPOS))[kv * 256 + tid] = a; }
                continue;
            }
            const int g = it / 65, n = it % 65;
            const double dt = exp((double)p.in[I_LOGDT][g]);
            if (tid < 64) {
                const double ar = p.in[I_ARE][g * 64 + tid], ai = p.in[I_AIM][g * 64 + tid];
                const double mag = exp(ar * dt * n), ang = ai * dt * n;
                lp[tid] = (f32x2){(float)(mag * cos(ang)), (float)(mag * sin(ang))};
            }
            for (int e = tid; e < 1024; e += 512) {
                const int pp = e >> 4, ci = e & 15;
                const double ar = p.in[I_ARE][g * 64 + pp], ai = p.in[I_AIM][g * 64 + pp];
                const double m1 = exp(ar * dt), lr = m1 * cos(ai * dt) - 1.0, li = m1 * sin(ai * dt);
                const double den = ar * ar + ai * ai, fr_ = (lr * ar + li * ai) / den, fi_ = (li * ar - lr * ai) / den;
                const double br = p.in[I_BRE][(g * 64 + pp) * 16 + ci], bi = p.in[I_BIM][(g * 64 + pp) * 16 + ci];
                bb[e] = (f32x2){(float)(fr_ * br - fi_ * bi), (float)(fr_ * bi + fi_ * br)};
                const int co = e >> 6, p2 = e & 63;
                cc[e] = (f32x2){p.in[I_CRE][(g * 16 + co) * 64 + p2], p.in[I_CIM][(g * 16 + co) * 64 + p2]};
            }
            __syncthreads();
            for (int e = tid; e < 1024; e += 512) { const f32x2 l = lp[e >> 4], b = bb[e]; ee[e] = (f32x2){l.x * b.x - l.y * b.y, l.x * b.y + l.y * b.x}; }
            __syncthreads();
            if (n < 64) {
                bf16_t* KT = (bf16_t*)(ws + WS_KT) + (size_t)g * 65 * 256;
                if (tid < 256) {
                    const int co = tid >> 4, ci = tid & 15; float a = 0.f;
                    for (int pp = 0; pp < 64; ++pp) { const f32x2 c = cc[co * 64 + pp], e = ee[pp * 16 + ci]; a += c.x * e.x - c.y * e.y; }
                    KT[(n + 1) * 256 + tid] = (bf16_t)f2bf(a);
                    if (n == 0) KT[tid] = 0;
                }
                bf16_t* WST = (bf16_t*)(ws + WS_WST) + (size_t)g * 128 * 1024; const int s = 63 - n;
                for (int e = tid; e < 1024; e += 512) { const int pp = e >> 4, ci = e & 15; const f32x2 v = ee[e];
                    WST[(size_t)pp * 1024 + s * 16 + ci] = (bf16_t)f2bf(v.x); WST[(size_t)(64 + pp) * 1024 + s * 16 + ci] = (bf16_t)f2bf(v.y); }
            }
            if (n >= 1) {
                bf16_t* WO = (bf16_t*)(ws + WS_WOUTS) + (size_t)g * 1024 * 128; const int t = n - 1;
                for (int e = tid; e < 1024; e += 512) { const int co = e >> 6, pp = e & 63; const f32x2 c = cc[e], l = lp[pp];
                    WO[(size_t)(t * 16 + co) * 128 + pp] = (bf16_t)f2bf(c.x * l.x - c.y * l.y); WO[(size_t)(t * 16 + co) * 128 + 64 + pp] = (bf16_t)f2bf(-(c.x * l.y + c.y * l.x)); }
            }
            if (n == 64 && tid < 64) ((f32x2*)(ws + WS_LAM64))[g * 64 + tid] = lp[tid];
            __syncthreads();
        }
    }
}

DEV void p1_norm(const Params& p, int vcu, int G, int wave, int lane) {
    const float* x = p.in[I_X]; const float* ng = p.in[I_NORMG]; const float* mod = (const float*)(p.ws + WS_MOD); bf16_t* HN = (bf16_t*)(p.ws + WS_HN);
    const int gw = vcu * 8 + wave, NGW = G * 8;
    constexpr int RB = 32;
    for (int it = gw; it < M_ / RB; it += NGW) {
        const int r0 = it * RB, b = r0 / T_;
        f32x4 cs[4], sh[4];
#pragma unroll
        for (int j = 0; j < 4; ++j) { const int k = 4 * lane + 256 * j; const f32x4 g = *(const f32x4*)(ng + k), sc = *(const f32x4*)(mod + (size_t)b * 3072 + 1024 + k);
            cs[j] = g * (sc + 1.0f); sh[j] = *(const f32x4*)(mod + (size_t)b * 3072 + k); }
        for (int r = r0; r < r0 + RB; ++r) {
            const f32x4* xr = (const f32x4*)(x + (size_t)r * 1024) + lane; f32x4 v[4]; float s = 0.f;
#pragma unroll
            for (int j = 0; j < 4; ++j) { v[j] = xr[64 * j]; s += (v[j].x * v[j].x + v[j].y * v[j].y) + (v[j].z * v[j].z + v[j].w * v[j].w); }
            const float rinv = rsqrtf(wave_sum(s) * (1.0f / 1024.0f) + EPS_);
            u32x2* o = (u32x2*)(HN + (size_t)r * 1024) + lane;
#pragma unroll
            for (int j = 0; j < 4; ++j) { const f32x4 h = v[j] * rinv * cs[j] + sh[j]; o[64 * j] = (u32x2){pk2(h.x, h.y), pk2(h.z, h.w)}; }
        }
    }
}

constexpr int UL_CH = 2064;
constexpr int SSM_UL = 0, SSM_KT = 32 * UL_CH, SSM_SLOC = SSM_KT + 65 * 256 * 2, SSM_CBT = SSM_SLOC + 128 * 32 * 4, SSM_END = SSM_CBT + 32 * 272;
static_assert(SSM_END <= RING_BYTES, "ssm lds");
DEV void ssm_unit(const Params& p, unsigned char* lds, int unit, int tid, int wave, int lane) {
    const int b = unit / SSM_NG, g = unit % SSM_NG; const int l16 = lane & 15, q4 = lane >> 4;
    unsigned char* ws = p.ws;
    const bf16_t* U = (const bf16_t*)(ws + WS_U); bf16_t* YG = (bf16_t*)(ws + WS_YG);
    const bf16_t* WST = (const bf16_t*)(ws + WS_WST) + (size_t)g * 128 * 1024; const bf16_t* WO = (const bf16_t*)(ws + WS_WOUTS) + (size_t)g * 1024 * 128;
    unsigned char* ul = lds + SSM_UL; bf16_t* ktl = (bf16_t*)(lds + SSM_KT); float* sloc = (float*)(lds + SSM_SLOC); bf16_t* cbt = (bf16_t*)(lds + SSM_CBT);
    { const u32x4* src = (const u32x4*)((const bf16_t*)(ws + WS_KT) + (size_t)g * 65 * 256); u32x4* dstv = (u32x4*)ktl; for (int i = tid; i < 65 * 256 * 2 / 16; i += 512) dstv[i] = src[i]; }
    float sre = 0.f, sim = 0.f; f32x2 lam = {0.f, 0.f};
    if (wave == 0) lam = ((const f32x2*)(ws + WS_LAM64))[g * 64 + lane];
    f32x4 dsk = *(const f32x4*)(p.in[I_SSMD] + 16 * g + 4 * q4);
    for (int cg = 0; cg < SSM_NCG; ++cg) {
        const size_t tokbase = (size_t)b * T_ + (size_t)cg * 2048;
#pragma unroll
        for (int i = 0; i < 8; ++i) { const int idx = tid + 512 * i, tok = idx >> 1, hf = idx & 1;
            *(u32x4*)(ul + (tok >> 6) * UL_CH + (tok & 63) * 32 + hf * 16) = *(const u32x4*)(U + (tokbase + tok) * 512 + 16 * g + 8 * hf); }
        __syncthreads();
        {
            f32x4 a1[2] = {(f32x4){0.f, 0.f, 0.f, 0.f}, (f32x4){0.f, 0.f, 0.f, 0.f}};
            const bf16_t* ap = WST + (size_t)(16 * wave + l16) * 1024 + 8 * q4;
            const unsigned char* bp = ul + l16 * UL_CH + (q4 >> 1) * 32 + (q4 & 1) * 16;
#pragma unroll 4
            for (int ks = 0; ks < 32; ++ks) {
                const bf16x8 a = ld8(ap + 32 * ks);
                const bf16x8 b0 = *(const bf16x8*)(bp + ks * 64), b1 = *(const bf16x8*)(bp + 16 * UL_CH + ks * 64);
                a1[0] = mfma16(a, b0, a1[0]); a1[1] = mfma16(a, b1, a1[1]);
            }
#pragma unroll
            for (int ct = 0; ct < 2; ++ct)
#pragma unroll
                for (int r = 0; r < 4; ++r) sloc[(16 * wave + 4 * q4 + r) * 32 + 16 * ct + l16] = a1[ct][r];
        }
        __syncthreads();
        if (wave == 0) {
            for (int c = 0; c < 32; ++c) {
                cbt[c * 136 + lane] = (bf16_t)f2bf(sre); cbt[c * 136 + 64 + lane] = (bf16_t)f2bf(sim);
                const float lr = sloc[lane * 32 + c], li = sloc[(64 + lane) * 32 + c];
                const float nr = lam.x * sre - lam.y * sim + lr, ni = lam.x * sim + lam.y * sre + li; sre = nr; sim = ni;
            }
        }
        __syncthreads();
        for (int i = 0; i < 8; ++i) {
            const int t = wave + 8 * i;
            f32x4 a3[2] = {(f32x4){0.f, 0.f, 0.f, 0.f}, (f32x4){0.f, 0.f, 0.f, 0.f}};
            const unsigned char* bp = ul + l16 * UL_CH + (q4 >> 1) * 32 + (q4 & 1) * 16;
            const bf16_t* kp = ktl + (t - (q4 >> 1) + 1) * 256 + l16 * 16 + 8 * (q4 & 1);
            const int nks = (t >> 1) + 1;
            for (int ks = 0; ks < nks; ++ks) {
                const bf16x8 a = ld8(kp - ks * 512);
                const bf16x8 b0 = *(const bf16x8*)(bp + ks * 64), b1 = *(const bf16x8*)(bp + 16 * UL_CH + ks * 64);
                a3[0] = mfma16(a, b0, a3[0]); a3[1] = mfma16(a, b1, a3[1]);
            }
            const bf16_t* wp = WO + (size_t)(t * 16 + l16) * 128 + 8 * q4;
#pragma unroll
            for (int ks = 0; ks < 4; ++ks) {
                const bf16x8 a = ld8(wp + 32 * ks);
                const bf16x8 b0 = ld8(cbt + l16 * 136 + 32 * ks + 8 * q4), b1 = ld8(cbt + (16 + l16) * 136 + 32 * ks + 8 * q4);
                a3[0] = mfma16(a, b0, a3[0]); a3[1] = mfma16(a, b1, a3[1]);
            }
#pragma unroll
            for (int ct = 0; ct < 2; ++ct) {
                const int chunk = 16 * ct + l16; const size_t tok = tokbase + (size_t)chunk * 64 + t;
                const u32x2 uv = *(const u32x2*)(ul + chunk * UL_CH + t * 32 + 8 * q4);
                float y[4];
#pragma unroll
                for (int r = 0; r < 4; ++r) { const unsigned w = uv[r >> 1]; const float uu = bf2f((r & 1) ? (w >> 16) : (w & 0xffffu)); y[r] = gelu_tanh_f(a3[ct][r] + dsk[r] * uu); }
                *(u32x2*)(YG + tok * 512 + 16 * g + 4 * q4) = (u32x2){pk2(y[0], y[1]), pk2(y[2], y[3])};
            }
        }
        __syncthreads();
    }
}

constexpr int CMP_TOK = 0, CMP_H = 528 * 128, CMP_OUT = CMP_H + 32 * 528, CMP_END = CMP_OUT + 32 * 64 * 4;
static_assert(CMP_END <= RING_BYTES, "cmp lds");
constexpr int CMP_UNITS = 2 * B_ * NGRP * (NCP / 32);
DEV void compress_unit(const Params& p, unsigned char* lds, int unit, int tid, int wave, int lane) {
    int r = unit; const int nb = r % (NCP / 32); r /= (NCP / 32); const int g = r % NGRP; r /= NGRP; const int b = r % B_; const int kv = r / B_;
    const int l16 = lane & 15, q4 = lane >> 4; unsigned char* ws = p.ws;
    const bf16_t* CR = (const bf16_t*)(ws + WS_CR); const bf16_t* w1t = (const bf16_t*)(ws + (kv ? WS_W1V : WS_W1K)); const bf16_t* w2t = (const bf16_t*)(ws + (kv ? WS_W2V : WS_W2K));
    const float* cpos = (const float*)(ws + WS_CPOS) + kv * 256;
    unsigned char* tokl = lds + CMP_TOK; bf16_t* hl = (bf16_t*)(lds + CMP_H); float* outl = (float*)(lds + CMP_OUT);
    const int n0 = 32 * nb, tk0 = 16 * n0;
    for (int idx = tid; idx < 528 * 8; idx += 512) {
        const int tl = idx >> 3, ch = idx & 7; const int tok = tk0 + tl;
        u32x4 v = (u32x4){0u, 0u, 0u, 0u};
        if (tok < T_) v = *(const u32x4*)(CR + ((size_t)b * T_ + tok) * 256 + kv * 128 + g * 64 + 8 * ch);
        *(u32x4*)(tokl + (tl * 8 + (ch ^ ((tl >> 4) & 7))) * 16) = v;
    }
    __syncthreads();
    f32x4 acc[2][2];
#pragma unroll
    for (int a = 0; a < 2; ++a)
#pragma unroll
        for (int c = 0; c < 2; ++c) acc[a][c] = (f32x4){0.f, 0.f, 0.f, 0.f};
    const bf16_t* bp0 = w1t + (size_t)(32 * wave + l16) * 2048 + 8 * q4; const bf16_t* bp1 = bp0 + (size_t)16 * 2048;
#pragma unroll 4
    for (int ks = 0; ks < 64; ++ks) {
        const int l = ks >> 1, chunk = 4 * (ks & 1) + q4;
        const int tl0 = 16 * l16 + l, tl1 = 16 * (16 + l16) + l;
        const bf16x8 a0 = *(const bf16x8*)(tokl + (tl0 * 8 + (chunk ^ ((tl0 >> 4) & 7))) * 16), a1 = *(const bf16x8*)(tokl + (tl1 * 8 + (chunk ^ ((tl1 >> 4) & 7))) * 16);
        const bf16x8 b0 = ld8(bp0 + 32 * ks), b1 = ld8(bp1 + 32 * ks);
        acc[0][0] = mfma16(a0, b0, acc[0][0]); acc[0][1] = mfma16(a0, b1, acc[0][1]); acc[1][0] = mfma16(a1, b0, acc[1][0]); acc[1][1] = mfma16(a1, b1, acc[1][1]);
    }
#pragma unroll
    for (int rt = 0; rt < 2; ++rt)
#pragma unroll
        for (int ct = 0; ct < 2; ++ct) { const int j = 32 * wave + 16 * ct + l16; const float cp = cpos[j];
#pragma unroll
            for (int rr = 0; rr < 4; ++rr) hl[(16 * rt + 4 * q4 + rr) * 264 + j] = (bf16_t)f2bf(gelu_tanh_f(acc[rt][ct][rr] + cp)); }
    __syncthreads();
    {
        const int rt = wave >> 2, ct = wave & 3; f32x4 a2 = (f32x4){0.f, 0.f, 0.f, 0.f};
#pragma unroll
        for (int ks = 0; ks < 8; ++ks) { const bf16x8 a = ld8(hl + (16 * rt + l16) * 264 + 32 * ks + 8 * q4), bq = ld8(w2t + (size_t)(16 * ct + l16) * 256 + 32 * ks + 8 * q4); a2 = mfma16(a, bq, a2); }
#pragma unroll
        for (int rr = 0; rr < 4; ++rr) outl[(16 * rt + 4 * q4 + rr) * 64 + 16 * ct + l16] = a2[rr];
    }
    __syncthreads();
    {
        const int row = tid >> 4, c4 = tid & 15; f32x4 v = *(const f32x4*)(outl + row * 64 + 4 * c4);
        if (kv == 0) {
            float ss = v.x * v.x + v.y * v.y + v.z * v.z + v.w * v.w;
            ss += __shfl_xor(ss, 1); ss += __shfl_xor(ss, 2); ss += __shfl_xor(ss, 4); ss += __shfl_xor(ss, 8);
            const float rinv = rsqrtf(ss * (1.0f / 64.0f) + EPS_); const f32x4 gk = *(const f32x4*)(p.in[I_KCNG] + 4 * c4);
            v = v * rinv * gk;
        }
        const int n = n0 + row; if (n >= NCMP) v = (f32x4){0.f, 0.f, 0.f, 0.f};
        bf16_t* dst = (bf16_t*)(ws + (kv ? WS_VC : WS_KC)) + (((size_t)b * NCP + n) * NGRP + g) * 64 + 4 * c4;
        *(u32x2*)dst = (u32x2){pk2(v.x, v.y), pk2(v.z, v.w)};
    }
    __syncthreads();
}

constexpr int AT_KB = 0, AT_VT = 2 * 9216, AT_IA = 4 * 9216, AT_IB = AT_IA + 64 * 128 * 4, AT_SEL = AT_IB + 64 * 128 * 4, AT_END = AT_SEL + 64 * 16;
static_assert(AT_END <= RING_BYTES, "attn lds");
constexpr int AT_UNITS = B_ * NGRP * NSB;
DEV int pi_key(int key) { return (key & 32) | (((key >> 2) & 3) << 3) | (((key >> 4) & 1) << 2) | (key & 3); }

template <int MODE>
DEV void attn_pass(const bf16_t* Kg, const bf16_t* Vg, int pitch, int jlo, int jhi, unsigned char* lds, const bf16x8 (&qf)[2][2], f32x4 (&oacc)[2][4], float (&lsum)[2], const float (&linv)[2],
                   float cexp, float m0l, const int (&ttok)[2], const unsigned long long (&slo)[2], const unsigned long long (&shi)[2], int tid, int wave, int lane_) {
    LAUNDER_V(tid); const int lane = tid & 63; (void)lane_;
    const int l16 = lane & 15, q4 = lane >> 4, hg = lane & 3, tau = l16 >> 2;
    const int key = tid >> 3, ch = tid & 7, pk = pi_key(key);
    float* impA = (float*)(lds + AT_IA); float* impB = (float*)(lds + AT_IB);
    u32x4 kreg, vreg = (u32x4){0u, 0u, 0u, 0u};
    kreg = *(const u32x4*)(Kg + (size_t)(64 * jlo + key) * pitch + 8 * ch);
    if (MODE != 0) vreg = *(const u32x4*)(Vg + (size_t)(64 * jlo + key) * pitch + 8 * ch);
    {
        *(u32x4*)(lds + AT_KB + (key * 72 + 8 * ch) * 2) = kreg;
        if (MODE != 0) { bf16_t* vt = (bf16_t*)(lds + AT_VT);
#pragma unroll
            for (int i = 0; i < 8; ++i) { const unsigned w = vreg[i >> 1]; vt[(8 * ch + i) * 72 + pk] = (bf16_t)((i & 1) ? (w >> 16) : (w & 0xffffu)); } }
    }
    __syncthreads();
    for (int jt = jlo; jt <= jhi; ++jt) {
        const int cb = (jt - jlo) & 1;
        if (jt < jhi) {
            kreg = *(const u32x4*)(Kg + (size_t)(64 * (jt + 1) + key) * pitch + 8 * ch);
            if (MODE != 0) vreg = *(const u32x4*)(Vg + (size_t)(64 * (jt + 1) + key) * pitch + 8 * ch);
        }
        const bf16_t* kb = (const bf16_t*)(lds + AT_KB + cb * 9216); const bf16_t* vt = (const bf16_t*)(lds + AT_VT + cb * 9216);
#pragma unroll
        for (int sl = 0; sl < 2; ++sl) {
            bool act = true; int selbit = 1;
            if (MODE == 2) { selbit = (int)((jt < 64 ? (slo[sl] >> jt) : (shi[sl] >> (jt - 64))) & 1ull); act = __any(selbit) != 0; }
            if (!act) continue;
            SCHED_FENCE();
            f32x4 s[4];
#pragma unroll
            for (int kt = 0; kt < 4; ++kt) { s[kt] = (f32x4){0.f, 0.f, 0.f, 0.f};
#pragma unroll
                for (int ks = 0; ks < 2; ++ks) { const bf16x8 a = ld8(kb + (16 * kt + l16) * 72 + 32 * ks + 8 * q4); s[kt] = mfma16(a, qf[sl][ks], s[kt]); } }
            const int t = ttok[sl]; float psum = 0.f;
#pragma unroll
            for (int kt = 0; kt < 4; ++kt)
#pragma unroll
                for (int r = 0; r < 4; ++r) {
                    const int kk = 64 * jt + 16 * kt + 4 * q4 + r; bool valid;
                    if (MODE <= 1) valid = (16 * kk + 31 <= t);
                    else if (MODE == 2) valid = selbit && (kk <= t);
                    else valid = (kk <= t) && (kk + 512 > t);
                    float pv = valid ? exp2_fast(s[kt][r] * cexp - m0l) : 0.f;
                    if (MODE == 1) pv *= linv[sl];
                    s[kt][r] = pv; psum += pv;
                }
            if (MODE != 1) lsum[sl] += psum;
            if (MODE == 1) {
#pragma unroll
                for (int kt = 0; kt < 4; ++kt) {
                    float a = 2.0f * (s[kt][0] + s[kt][1] + s[kt][2]) + s[kt][3], bq = s[kt][3];
                    a += __shfl_xor(a, 1); a += __shfl_xor(a, 2); bq += __shfl_xor(bq, 1); bq += __shfl_xor(bq, 2);
                    if (hg == 0) { const int j = 16 * jt + 4 * kt + q4; const int tl = 8 * wave + 4 * sl + tau; impA[tl * 128 + j] = a; impB[tl * 128 + j] = bq; }
                }
            }
            SCHED_FENCE();
            if (MODE != 0) {
#pragma unroll
                for (int a2 = 0; a2 < 2; ++a2) {
                    const u32x4 pw = (u32x4){pk2(s[2 * a2][0], s[2 * a2][1]), pk2(s[2 * a2][2], s[2 * a2][3]), pk2(s[2 * a2 + 1][0], s[2 * a2 + 1][1]), pk2(s[2 * a2 + 1][2], s[2 * a2 + 1][3])};
                    const bf16x8 pf = __builtin_bit_cast(bf16x8, pw);
#pragma unroll
                    for (int dt = 0; dt < 4; ++dt) { const bf16x8 a = ld8(vt + (16 * dt + l16) * 72 + 32 * a2 + 8 * q4); oacc[sl][dt] = mfma16(a, pf, oacc[sl][dt]); }
                }
            }
        }
        if (jt < jhi) {
            *(u32x4*)(lds + AT_KB + (cb ^ 1) * 9216 + (key * 72 + 8 * ch) * 2) = kreg;
            if (MODE != 0) { bf16_t* vtw = (bf16_t*)(lds + AT_VT + (cb ^ 1) * 9216);
#pragma unroll
                for (int i = 0; i < 8; ++i) { const unsigned w = vreg[i >> 1]; vtw[(8 * ch + i) * 72 + pk] = (bf16_t)((i & 1) ? (w >> 16) : (w & 0xffffu)); } }
        }
        __syncthreads();
    }
}

DEV void attn_unit(const Params& p, unsigned char* lds, int b, int g, int qb, float m0c, float m0s, float m0w, int tid, int wave, int lane_) {
    LAUNDER_V(tid); const int lane = tid & 63; (void)lane_;
    unsigned char* ws = p.ws;
    const int l16 = lane & 15, q4 = lane >> 4, hg = lane & 3, tau = l16 >> 2; const int t0 = 64 * qb;
    const bf16_t* Q = (const bf16_t*)(ws + WS_Q); const bf16_t* QR = (const bf16_t*)(ws + WS_QR);
    const bf16_t* KC = (const bf16_t*)(ws + WS_KC) + (size_t)b * NCP * 128 + g * 64; const bf16_t* VC = (const bf16_t*)(ws + WS_VC) + (size_t)b * NCP * 128 + g * 64;
    const bf16_t* SL = (const bf16_t*)(ws + WS_SL) + (size_t)b * T_ * 256 + g * 64; const bf16_t* WN = (const bf16_t*)(ws + WS_WN) + (size_t)b * T_ * 256 + g * 64;
    const float* G = (const float*)(ws + WS_G);
    constexpr float LOG2E = 1.4426950408889634f; const float cexp = 0.125f * LOG2E;
    int ttok[2]; size_t rowg[2];
#pragma unroll
    for (int sl = 0; sl < 2; ++sl) { ttok[sl] = t0 + 8 * wave + 4 * sl + tau; rowg[sl] = (size_t)b * T_ + ttok[sl]; }
    const int h = 4 * g + hg;
    bf16x8 qf[2][2]; f32x4 oacc[2][4], outa[2][4]; float lsum[2] = {0.f, 0.f}, linv[2] = {0.f, 0.f};
    unsigned long long slo[2] = {0ull, 0ull}, shi[2] = {0ull, 0ull};
#pragma unroll
    for (int sl = 0; sl < 2; ++sl)
#pragma unroll
        for (int dt = 0; dt < 4; ++dt) { oacc[sl][dt] = (f32x4){0.f, 0.f, 0.f, 0.f}; outa[sl][dt] = (f32x4){0.f, 0.f, 0.f, 0.f}; }
#pragma unroll
    for (int sl = 0; sl < 2; ++sl)
#pragma unroll
        for (int ks = 0; ks < 2; ++ks) qf[sl][ks] = ld8(Q + rowg[sl] * 512 + h * 64 + 32 * ks + 8 * q4);
    const int ncmp = 4 * qb + 3;
    const int jhc = (ncmp - 1) >> 6;
    attn_pass<0>(KC, VC, 128, 0, jhc, lds, qf, oacc, lsum, linv, cexp, m0c * LOG2E, ttok, slo, shi, tid, wave, lane);
#pragma unroll
    for (int sl = 0; sl < 2; ++sl) { float L = lsum[sl]; L += __shfl_xor(L, 16); L += __shfl_xor(L, 32); linv[sl] = L > 0.f ? 1.0f / L : 0.f; lsum[sl] = 0.f; }
    attn_pass<1>(KC, VC, 128, 0, jhc, lds, qf, oacc, lsum, linv, cexp, m0c * LOG2E, ttok, slo, shi, tid, wave, lane);
#pragma unroll
    for (int sl = 0; sl < 2; ++sl) { const float gt = G[rowg[sl] * 32 + 3 * h + 0];
#pragma unroll
        for (int dt = 0; dt < 4; ++dt) { outa[sl][dt] = oacc[sl][dt] * gt; oacc[sl][dt] = (f32x4){0.f, 0.f, 0.f, 0.f}; } }
    {
        const float* impA = (const float*)(lds + AT_IA); const float* impB = (const float*)(lds + AT_IB); unsigned long long* sel = (unsigned long long*)(lds + AT_SEL);
        const float NINF = -INFINITY, PINF = INFINITY;
        for (int tk = 0; tk < 8; ++tk) {
            const int tl = 8 * wave + tk; const float* ia = impA + tl * 128; const float* ib = impB + tl * 128;
            const int j0 = lane, j1 = lane + 64;
            float sc0 = NINF, sc1 = NINF;
            if (j0 <= qb) sc0 = (j0 == 0 || j0 == qb || j0 == qb - 1) ? PINF : ia[j0] + ib[j0 - 1];
            if (j1 <= qb) sc1 = (j1 == qb || j1 == qb - 1) ? PINF : ia[j1] + ib[j1 - 1];
            bool tk0 = false, tk1 = false;
            for (int it = 0; it < 16; ++it) {
                const float mx = wave_max(fmaxf(sc0, sc1));
                if (mx == NINF) break;
                const unsigned long long b0 = __ballot(sc0 == mx);
                if (b0) { const int l = __builtin_ctzll(b0); if (lane == l) { tk0 = true; sc0 = NINF; } }
                else { const unsigned long long b1 = __ballot(sc1 == mx); const int l = __builtin_ctzll(b1); if (lane == l) { tk1 = true; sc1 = NINF; } }
            }
            const unsigned long long m0 = __ballot(tk0), m1 = __ballot(tk1);
            if (lane == 0) { sel[tl * 2] = m0; sel[tl * 2 + 1] = m1; }
        }
    }
    __syncthreads();
    {
        const unsigned long long* sel = (const unsigned long long*)(lds + AT_SEL);
#pragma unroll
        for (int sl = 0; sl < 2; ++sl) { const int tl = 8 * wave + 4 * sl + tau; slo[sl] = sel[tl * 2]; shi[sl] = sel[tl * 2 + 1]; }
    }
    float* outl = (float*)(lds + AT_IA) + tid;
#pragma unroll
    for (int sl = 0; sl < 2; ++sl)
#pragma unroll
        for (int dt = 0; dt < 4; ++dt)
#pragma unroll
            for (int r = 0; r < 4; ++r) outl[(sl * 16 + dt * 4 + r) * 512] = outa[sl][dt][r];
#pragma unroll
    for (int sl = 0; sl < 2; ++sl)
#pragma unroll
        for (int ks = 0; ks < 2; ++ks) qf[sl][ks] = ld8(QR + rowg[sl] * 512 + h * 64 + 32 * ks + 8 * q4);
    attn_pass<2>(SL, SL + 128, 256, 0, qb, lds, qf, oacc, lsum, linv, cexp, m0s * LOG2E, ttok, slo, shi, tid, wave, lane);
#pragma unroll
    for (int sl = 0; sl < 2; ++sl) { float L = lsum[sl]; L += __shfl_xor(L, 16); L += __shfl_xor(L, 32); const float sc = (L > 0.f ? 1.0f / L : 0.f) * G[rowg[sl] * 32 + 3 * h + 1]; lsum[sl] = 0.f;
#pragma unroll
        for (int dt = 0; dt < 4; ++dt) {
#pragma unroll
            for (int r = 0; r < 4; ++r) outl[(sl * 16 + dt * 4 + r) * 512] += oacc[sl][dt][r] * sc;
            oacc[sl][dt] = (f32x4){0.f, 0.f, 0.f, 0.f}; } }
    attn_pass<3>(WN, WN + 128, 256, qb >= 8 ? qb - 8 : 0, qb, lds, qf, oacc, lsum, linv, cexp, m0w * LOG2E, ttok, slo, shi, tid, wave, lane);
#pragma unroll
    for (int sl = 0; sl < 2; ++sl) { float L = lsum[sl]; L += __shfl_xor(L, 16); L += __shfl_xor(L, 32); const float sc = (L > 0.f ? 1.0f / L : 0.f) * G[rowg[sl] * 32 + 3 * h + 2];
#pragma unroll
        for (int dt = 0; dt < 4; ++dt)
#pragma unroll
            for (int r = 0; r < 4; ++r) outa[sl][dt][r] = outl[(sl * 16 + dt * 4 + r) * 512] + oacc[sl][dt][r] * sc; }
    const bf16_t* ZA = (const bf16_t*)(ws + WS_ZA); bf16_t* MIX = (bf16_t*)(ws + WS_MIX);
#pragma unroll
    for (int sl = 0; sl < 2; ++sl)
#pragma unroll
        for (int dt = 0; dt < 4; ++dt) {
            const int col = h * 64 + 16 * dt + 4 * q4; const u32x2 zv = *(const u32x2*)(ZA + rowg[sl] * 512 + col);
            float o[4];
#pragma unroll
            for (int r = 0; r < 4; ++r) { const unsigned w = zv[r >> 1]; o[r] = outa[sl][dt][r] * bf2f((r & 1) ? (w >> 16) : (w & 0xffffu)); }
            *(u32x2*)(MIX + rowg[sl] * 1024 + col) = (u32x2){pk2(o[0], o[1]), pk2(o[2], o[3])};
        }
    __syncthreads();
}

DEV void p4_attention(const Params& p, unsigned char* lds, int vcu, int G, int tid, int wave, int lane) {
    const float gq = wave_max(fabsf(p.in[I_QNG][lane])), gc = wave_max(fabsf(p.in[I_KCNG][lane])), gs = wave_max(fabsf(p.in[I_KSNG][lane])), gw = wave_max(fabsf(p.in[I_KWNG][lane]));
    const float m0c = 8.2f * gq * gc, m0s = 8.2f * gq * gs, m0w = 8.2f * gq * gw;
    for (int i = 0;; ++i) {
        const long L = (long)i * G + vcu; if (L >= AT_UNITS) break;
        const int per = B_ * NGRP * 16;
        const int k = (int)(L / per), v = (int)(L % per), bg = v >> 4, s = v & 15;
        const int nrounds = NSB / 16;
        const int qb = 32 * (k >> 1) + ((k & 1) ? 31 - s : s);
        (void)nrounds;
        attn_unit(p, lds, bg / NGRP, bg % NGRP, qb, m0c, m0s, m0w, tid, wave, lane);
    }
}

#ifndef CPU_EMU
#define GAS __attribute__((address_space(1)))
#define LAS __attribute__((address_space(3)))
#define XB_TMO      128
#define XB_XCNT(j)  (256  + 64 * (j))
#define XB_XSUB(j)  (1280 + 64 * (j))
#define XB_XGEN(j)  (2304 + 64 * (j))
#define XB_TOP      3328
#define XB_TOPGEN   3392
#define XCD_BAR_WORDS 3456
#define XB_SPIN_CAP (1u << 20)
__device__ __forceinline__ unsigned xb_ld(unsigned* p)              { return __hip_atomic_load(p, __ATOMIC_RELAXED, __HIP_MEMORY_SCOPE_AGENT); }
__device__ __forceinline__ unsigned xb_add(unsigned* p, unsigned v) { return __hip_atomic_fetch_add(p, v, __ATOMIC_RELAXED, __HIP_MEMORY_SCOPE_AGENT); }
__device__ __forceinline__ unsigned xb_xcc_id() { return (unsigned)__builtin_amdgcn_s_getreg((3 << 11) | 20) & 0xFu; }
#define XB_SPIN(cond, bar) do { unsigned _sp = 0; while (cond) { __builtin_amdgcn_s_sleep(1); \
    if ((++_sp & 255u) == 0u) { if (xb_ld(&(bar)[XB_TMO])) break; if (_sp > XB_SPIN_CAP) { atomicAdd(&(bar)[XB_TMO], 1u); break; } } } } while (0)
struct XcdBarrier { unsigned* bar; unsigned x; volatile LAS unsigned* st; };
__device__ __forceinline__ XcdBarrier xcd_barrier_post(unsigned* bar, volatile LAS unsigned* st) {
    XcdBarrier b; b.bar = bar; b.x = xb_xcc_id(); b.st = st;
    if (threadIdx.x == 0) (void)xb_add(&bar[XB_XCNT(b.x)], 1u);
    return b;
}
__device__ __forceinline__ void xcd_barrier_complete(unsigned* bar, unsigned x, unsigned& nloc, unsigned& nx) {
    const unsigned G = gridDim.x * gridDim.y * gridDim.z;
    unsigned sum, cnt, mine, sp = 0u;
    for (;;) {
        sum = 0u; cnt = 0u; mine = 0u;
#pragma unroll
        for (unsigned j = 0; j < 16; ++j) { const unsigned c = xb_ld(&bar[XB_XCNT(j)]); sum += c; cnt += (c > 0u) ? 1u : 0u; mine = (j == x) ? c : mine; }
        if (sum == G) break;
        __builtin_amdgcn_s_sleep(1);
        if ((++sp & 255u) == 0u) { if (xb_ld(&bar[XB_TMO])) break; if (sp > XB_SPIN_CAP) { atomicAdd(&bar[XB_TMO], 1u); break; } }
    }
    nloc = mine > 0u ? mine : 1u; nx = cnt > 0u ? cnt : 1u;
}
__device__ __forceinline__ void xcd_barrier(const XcdBarrier& b) {
    asm volatile("s_waitcnt vmcnt(0)" ::: "memory");
    __syncthreads();
    if (threadIdx.x == 0) {
        unsigned* bar = b.bar;
        __builtin_amdgcn_s_waitcnt(0);
        unsigned nloc = b.st[0], nx = b.st[1];
        if (nloc == 0u) { xcd_barrier_complete(bar, b.x, nloc, nx); b.st[0] = nloc; b.st[1] = nx; }
        const unsigned old = xb_add(&bar[XB_XSUB(b.x)], 1u);
        const unsigned gen = old / nloc;
        if (old + 1u == (gen + 1u) * nloc) {
            __builtin_amdgcn_fence(__ATOMIC_RELEASE, "agent");
            asm volatile("s_waitcnt vmcnt(0)" ::: "memory");
            const unsigned og = xb_add(&bar[XB_TOP], 1u);
            const unsigned tg = og / nx;
            if (og + 1u == (tg + 1u) * nx) xb_add(&bar[XB_TOPGEN], 1u);
            else XB_SPIN(xb_ld(&bar[XB_TOPGEN]) == tg, bar);
            __builtin_amdgcn_fence(__ATOMIC_ACQUIRE, "agent");
            xb_add(&bar[XB_XGEN(b.x)], 1u);
            asm volatile("s_waitcnt vmcnt(0)" ::: "memory");
        } else {
            XB_SPIN(xb_ld(&bar[XB_XGEN(b.x)]) == gen, bar);
            __builtin_amdgcn_fence(__ATOMIC_ACQUIRE, "agent");
            asm volatile("s_waitcnt vmcnt(0)" ::: "memory");
        }
    }
    __syncthreads();
}
#endif

constexpr int N_PHASES = 6;
__global__ void __launch_bounds__(512, 2) fwd_kernel(Params p) {
#ifdef CPU_EMU
    unsigned char* lds = emu_smem;
#else
    extern __shared__ __attribute__((aligned(16))) unsigned char lds[];
#endif
    const int tid = threadIdx.x, lane = tid & 63, wave = WAVE_ID();
    const int G = gridDim.x; const int bx = blockIdx.x; const int vcu = (G % 8 == 0) ? (bx % 8) * (G / 8) + bx / 8 : bx;
#ifndef CPU_EMU
    for (int u = tid; u < 64; u += 512) ((LAS unsigned*)(lds + MISC_OFF))[u] = 0u;
    __syncthreads();
    XcdBarrier bar; bar.bar = (unsigned*)(p.ws + WS_CTL) + 1024 + p.li * XCD_BAR_WORDS; bar.x = 0; bar.st = nullptr;
    if (p.ph_hi - p.ph_lo > 1) bar = xcd_barrier_post(bar.bar, (volatile LAS unsigned*)(lds + MISC_OFF) + 8);
#define GRID_BAR() xcd_barrier(bar)
#else
#define GRID_BAR() do { } while (0)
#endif
    const int lo = p.ph_lo, hi = p.ph_hi;
#ifndef PHASE_MASK
#define PHASE_MASK 63
#endif
#define IN(k) (((PHASE_MASK >> (k)) & 1) && lo <= (k) && (k) < hi)
#define BOTH(k) (IN(k) && IN((k) + 1))
    if (IN(0)) { p0_prologue(p, lds, vcu, G, tid, wave, lane); if (BOTH(0)) GRID_BAR(); }
    if (IN(1)) { p1_norm(p, vcu, G, wave, lane); if (BOTH(1)) GRID_BAR(); }
    if (IN(2)) {
        pg8::Gemm g{(const bf16_t*)(p.ws + WS_HN), (const bf16_t*)(p.ws + WS_WIN), M_, INP, 1024}; pg8::StaticOrder S; S.init(M_, INP, G, bx);
        EpiInProj E{p.ws, p.in[I_QNG], p.in[I_KSNG], p.in[I_KWNG]};
        pg8::gemm_phase<EpiInProj, pg8::StaticOrder, true, true>(PG8_PTR(lds), g, S, E);
        if (BOTH(2)) GRID_BAR();
    }
    if (IN(3)) {
        for (int u = vcu; u < B_ * SSM_NG; u += G) ssm_unit(p, lds, u, tid, wave, lane);
        for (int u = vcu; u < CMP_UNITS; u += G) compress_unit(p, lds, u, tid, wave, lane);
        if (BOTH(3)) GRID_BAR();
    }
    if (IN(4)) {
        p4_attention(p, lds, vcu, G, tid, wave, lane);
        pg8::Gemm g{(const bf16_t*)(p.ws + WS_YG), (const bf16_t*)(p.ws + WS_WGLU), M_, 512, 512}; pg8::StaticOrder S; S.init(M_, 512, G, bx);
        EpiGlu E{(const bf16_t*)(p.ws + WS_YG), (const bf16_t*)(p.ws + WS_ZS), (bf16_t*)(p.ws + WS_MIX), p.in[I_GLUB]};
        pg8::gemm_phase<EpiGlu, pg8::StaticOrder, true, true>(PG8_PTR(lds), g, S, E);
        if (BOTH(4)) GRID_BAR();
    }
    if (IN(5)) {
        pg8::Gemm g{(const bf16_t*)(p.ws + WS_MIX), (const bf16_t*)(p.ws + WS_WO), M_, 1024, 1024}; pg8::StaticOrder S; S.init(M_, 1024, G, bx);
        EpiOut E{p.in[I_X], p.out, (const float*)(p.ws + WS_MOD)};
        pg8::gemm_phase<EpiOut, pg8::StaticOrder, true, true>(PG8_PTR(lds), g, S, E);
    }
#undef IN
#undef BOTH
}

extern "C" void kernel_launch(void* const* d_in, const int* in_sizes, int n_in, void* d_out, int out_size, void* d_ws, size_t ws_size, hipStream_t stream) {
    static int grid = 0;
    if (grid == 0) {
        if (n_in != N_IN || out_size != M_ * D_ || ws_size < WS_END) { fprintf(stderr, "kernel_launch: unexpected shapes (n_in %d out %d ws %zu need %zu)\n", n_in, out_size, ws_size, (size_t)WS_END); grid = -1; return; }
#ifdef CPU_EMU
        grid = EMU_GRID;
#else
        int dev = 0, cus = 0, per_cu = 0;
        if (hipGetDevice(&dev) != hipSuccess || hipDeviceGetAttribute(&cus, hipDeviceAttributeMultiprocessorCount, dev) != hipSuccess) { grid = -1; return; }
        if (hipFuncSetAttribute((const void*)fwd_kernel, hipFuncAttributeMaxDynamicSharedMemorySize, LDS_BYTES) != hipSuccess) { fprintf(stderr, "kernel_launch: hipFuncSetAttribute failed\n"); grid = -1; return; }
        if (hipOccupancyMaxActiveBlocksPerMultiprocessor(&per_cu, (const void*)fwd_kernel, 512, LDS_BYTES) != hipSuccess || per_cu < 1) { fprintf(stderr, "kernel_launch: occupancy query says %d blocks per CU\n", per_cu); per_cu = 1; }
        (void)hipGetLastError();
        grid = cus;
#endif
    }
    if (grid < 0) return;
    (void)hipMemsetAsync((char*)d_ws + WS_CTL, 0, CTL_ZERO_BYTES, stream);
    Params a{};
    for (int i = 0; i < N_IN; ++i) a.in[i] = (const float*)d_in[i];
    a.out = (float*)d_out; a.ws = (unsigned char*)d_ws;
    for (int li = 0; li < N_LAUNCH; ++li) {
        a.ph_lo = (N_LAUNCH == 1) ? 0 : li; a.ph_hi = (N_LAUNCH == 1) ? N_PHASES : li + 1; a.li = 0;
#ifdef CPU_EMU
        emu_launch((unsigned)grid, 512u, [&]() { fwd_kernel(a); });
#else
        hipLaunchKernelGGL(fwd_kernel, dim3(grid), dim3(512), LDS_BYTES, stream, a);
#endif
    }
}
```

```cpp
#ifndef CPU_EMU
#include <hip/hip_runtime.h>
#endif
#include <cstdio>
#include <cstdint>
#include <cmath>

#ifndef BATCH_N
#define BATCH_N 8
#endif
#ifndef SEQ_LEN
#define SEQ_LEN 8192
#endif
#ifndef N_LAUNCH
#define N_LAUNCH 1
#endif
#define DEV __device__ __forceinline__

typedef unsigned short bf16_t;
typedef short bf16x8 __attribute__((ext_vector_type(8)));
typedef float f32x4 __attribute__((ext_vector_type(4)));
typedef float f32x2 __attribute__((ext_vector_type(2)));
typedef unsigned u32x4 __attribute__((ext_vector_type(4)));
typedef unsigned u32x2 __attribute__((ext_vector_type(2)));

constexpr int B_ = BATCH_N, T_ = SEQ_LEN, D_ = 1024, M_ = B_ * T_;
constexpr int NH = 8, HD = 64, NGRP = 2;
constexpr int NCMP = (T_ - 32) / 16 + 1;
constexpr int NCP = T_ / 16;
constexpr int NSB = T_ / 64;
constexpr int INW = 2840, INP = 3072;
constexpr int SSM_NG = 32, SSM_P = 64, SSM_C = 16, SSM_W = 512;
constexpr int SSM_L = 64;
constexpr int SSM_CG = 32;
constexpr int SSM_NCG = T_ / (SSM_L * SSM_CG);
constexpr float EPS_ = 1e-6f;
static_assert(T_ % 2048 == 0 && NSB <= 128, "shape assumptions");

enum { I_X = 0, I_C, I_WADA, I_BADA, I_NORMG, I_WIN, I_QNG, I_KCNG, I_KSNG, I_KWNG, I_POSK, I_POSV, I_W1K, I_W2K, I_W1V, I_W2V,
       I_ARE, I_AIM, I_LOGDT, I_BRE, I_BIM, I_CRE, I_CIM, I_SSMD, I_GLUW, I_GLUB, I_WOUT, N_IN };

constexpr size_t MiB = 1u << 20;
constexpr size_t al(size_t x) { return (x + MiB - 1) / MiB * MiB; }
constexpr size_t WS_CTL = 0, CTL_ZERO_BYTES = 64 * 1024;
constexpr size_t WS_MOD = 1 * MiB;
constexpr size_t WS_ROPE = WS_MOD + al((size_t)B_ * 3072 * 4);
constexpr size_t WS_CPOS = WS_ROPE + al((size_t)T_ * 64 * 4);
constexpr size_t WS_LAM64 = WS_CPOS + 4096;
constexpr size_t WS_KT = WS_CPOS + MiB;
constexpr size_t WS_WST = WS_KT + al((size_t)32 * 65 * 256 * 2);
constexpr size_t WS_WOUTS = WS_WST + al((size_t)32 * 128 * 1024 * 2);
constexpr size_t WS_WIN = WS_WOUTS + al((size_t)32 * 1024 * 128 * 2);
constexpr size_t WS_WO = WS_WIN + al((size_t)INP * 1024 * 2);
constexpr size_t WS_WGLU = WS_WO + al((size_t)1024 * 1024 * 2);
constexpr size_t WS_W1K = WS_WGLU + MiB, WS_W1V = WS_W1K + MiB;
constexpr size_t WS_W2K = WS_W1V + MiB, WS_W2V = WS_W2K + 64 * 1024;
constexpr size_t WS_KC = WS_W2K + MiB;
constexpr size_t WS_VC = WS_KC + al((size_t)B_ * NCP * 128 * 2);
constexpr size_t WS_G = WS_VC + al((size_t)B_ * NCP * 128 * 2);
constexpr size_t WS_HN = WS_G + al((size_t)M_ * 32 * 4);
constexpr size_t WS_Q = WS_HN + al((size_t)M_ * 1024 * 2);
constexpr size_t WS_QR = WS_Q + al((size_t)M_ * 512 * 2);
constexpr size_t WS_CR = WS_QR + al((size_t)M_ * 512 * 2);
constexpr size_t WS_SL = WS_CR + al((size_t)M_ * 256 * 2);
constexpr size_t WS_WN = WS_SL + al((size_t)M_ * 256 * 2);
constexpr size_t WS_ZA = WS_WN + al((size_t)M_ * 256 * 2);
constexpr size_t WS_U = WS_ZA + al((size_t)M_ * 512 * 2);
constexpr size_t WS_ZS = WS_U + al((size_t)M_ * 512 * 2);
constexpr size_t WS_YG = WS_ZS + al((size_t)M_ * 512 * 2);
constexpr size_t WS_MIX = WS_YG + al((size_t)M_ * 512 * 2);
constexpr size_t WS_END = WS_MIX + al((size_t)M_ * 1024 * 2);

constexpr int RING_BYTES = 131072;
constexpr int MISC_OFF = RING_BYTES;
constexpr int LDS_BYTES = 147456;

DEV unsigned f2bf(float f) { unsigned u = __builtin_bit_cast(unsigned, f); return (u + 0x7fffu + ((u >> 16) & 1u)) >> 16; }
DEV float bf2f(unsigned h) { return __builtin_bit_cast(float, h << 16); }
#ifdef CPU_EMU
DEV unsigned pk2(float lo, float hi) { return f2bf(lo) | (f2bf(hi) << 16); }
DEV float exp2_fast(float x) { return exp2f(x); }
DEV float rcp_fast(float x) { return 1.0f / x; }
DEV f32x4 mfma16(bf16x8 a, bf16x8 b, f32x4 c) { return emu_mfma16(a, b, c); }
#define WAVE_ID() ((int)(threadIdx.x >> 6))
#else
typedef __bf16 bf16x2_t __attribute__((ext_vector_type(2)));
DEV unsigned pk2(float lo, float hi) { f32x2 v = {lo, hi}; bf16x2_t b = __builtin_convertvector(v, bf16x2_t); return __builtin_bit_cast(unsigned, b); }
DEV float exp2_fast(float x) { return __builtin_amdgcn_exp2f(x); }
DEV float rcp_fast(float x) { return __builtin_amdgcn_rcpf(x); }
DEV f32x4 mfma16(bf16x8 a, bf16x8 b, f32x4 c) { return __builtin_amdgcn_mfma_f32_16x16x32_bf16(a, b, c, 0, 0, 0); }
#define WAVE_ID() (__builtin_amdgcn_readfirstlane((int)(threadIdx.x >> 6)))
#endif
#ifdef CPU_EMU
#define EXPF(x) expf(x)
#else
#define EXPF(x) __expf(x)
#endif
DEV float silu_f(float v) { return v / (1.0f + EXPF(-v)); }
DEV float sigmoid_f(float v) { return 1.0f / (1.0f + EXPF(-v)); }
DEV float gelu_tanh_f(float v) { const float u = 0.7978845608028654f * (v + 0.044715f * v * v * v); const float e = EXPF(2.0f * u); return v * (1.0f - 1.0f / (e + 1.0f)); }
DEV float wave_sum(float v) {
#pragma unroll
    for (int o = 1; o < 64; o <<= 1) v += __shfl_xor(v, o);
    return v;
}
DEV float wave_max(float v) {
#pragma unroll
    for (int o = 1; o < 64; o <<= 1) v = fmaxf(v, __shfl_xor(v, o));
    return v;
}
DEV bf16x8 ld8(const bf16_t* p) { return *(const bf16x8*)p; }
namespace pg8 {
#define PG8_LAS __attribute__((address_space(3)))
typedef unsigned short bf16_t;
typedef short bf16x8 __attribute__((ext_vector_type(8)));
typedef float f32x4 __attribute__((ext_vector_type(4)));
typedef unsigned u32x4 __attribute__((ext_vector_type(4)));
constexpr int BM = 256, BK = 64, HALF = 128, HTB = HALF * BK * 2  , STAGE_BYTES = 8 * HTB, NXCD = 8, WGM = 8;

__host__ __device__ __forceinline__ int lds_byte(int r, int c) { const int st = (r >> 4) * 2 + (c >> 5), rr = r & 15, cc = c & 31, ob = rr * 64 + cc * 2; return st * 1024 + (ob ^ (((ob >> 9) & 1) << 5)); }
__host__ __device__ __forceinline__ void stage_rc(int b, int& R, int& C) { const int st = b / 1024, sb = b % 1024, swz = sb ^ (((sb >> 9) & 1) << 5); R = (st >> 1) * 16 + swz / 64; C = (st & 1) * 32 + (swz % 64) / 2; }
__host__ __device__ __forceinline__ int perm32(int rho) { const int n = rho >> 4, i = rho & 15; return 8 * (i >> 2) + 4 * n + (i & 3); }

struct Unit { int pm, pn; };
struct Gemm { const bf16_t* A; const bf16_t* Bt; int M, N, K; };

struct StaticOrder {
    int nM, nN, nwg, G, c;
    __host__ __device__ void init(int M, int N, int G_, int c_) { nM = M / BM; nN = N / BM; nwg = nM * nN; G = G_; c = c_; }
    __host__ __device__ bool next(int i, Unit& u) const {
        const long L = (long)i * G + c; if (L >= nwg) return false;
        int wgid = (int)L; { const int q = nwg / NXCD, r = nwg % NXCD, xcd = wgid % NXCD, off = wgid / NXCD; wgid = (xcd < r ? xcd * (q + 1) : r * (q + 1) + (xcd - r) * q) + off; }
        const int nig = WGM * nN, gid = wgid / nig, fm = gid * WGM, gsz = (nM - fm) < WGM ? (nM - fm) : WGM;
        u.pm = fm + ((wgid % nig) % gsz); u.pn = (wgid % nig) / gsz; return true;
    }
    __device__ __forceinline__ void a_ready(const Unit&) const {}
    __device__ __forceinline__ void done(const Unit&) const {}
};

#ifndef CPU_EMU
__device__ __forceinline__ unsigned cvt_pk_bf16(float lo, float hi) { unsigned r; asm volatile("v_cvt_pk_bf16_f32 %0, %1, %2" : "=v"(r) : "v"(lo), "v"(hi)); return r; }
template <class Epi, class Sched, bool ALIGN_EPI = false, bool SP2 = false>
__device__ __forceinline__ void gemm_phase(PG8_LAS unsigned char* lds, const Gemm g, const Sched& S, const Epi& E) {
    const int tid = threadIdx.x, wid = __builtin_amdgcn_readfirstlane(tid >> 6), lane = tid & 63, wr = wid >> 2, wc = wid & 3, fr = lane & 15, fq = lane >> 4;
    const int K = g.K, nt = K / BK;
    unsigned voffA[2], voffB[2];
#pragma unroll
    for (int i = 0; i < 2; ++i) { int R, C; stage_rc(tid * 16 + i * 8192, R, C); const int Rb = Epi::PERM ? ((R & ~31) + perm32(R & 31)) : R;
        voffA[i] = (unsigned)(R * K + C) * 2u; voffB[i] = (unsigned)(Rb * K + C) * 2u; }
    const size_t kstep = (size_t)(BK * 2);
    const size_t hstep = (size_t)HALF * K * 2;
    const size_t tstep = 2 * hstep;
    const unsigned ldsw = (unsigned)wid * 1024u;
    const int aoff = lds_byte(wr * 64 + fr, fq * 8), boff = lds_byte(wc * 32 + fr, fq * 8);
#define PG8_SA(b, h) (((b) * 2 + (h)) * HTB)
#define PG8_SB(b, h) ((4 + (b) * 2 + (h)) * HTB)
#define PG8_STAGE(bufoff, gbase, voff) do { _Pragma("unroll") for (int _i = 0; _i < 2; ++_i) \
        __builtin_amdgcn_global_load_lds((const unsigned*)((const char*)(gbase) + (voff)[_i]), (PG8_LAS unsigned*)(lds + (bufoff) + ldsw + _i * 8192), 16, 0, 0); } while (0)
#define PG8_LDA(dst, b, h) do { _Pragma("unroll") for (int m = 0; m < 4; ++m) _Pragma("unroll") for (int k = 0; k < 2; ++k) dst[m][k] = *(const PG8_LAS bf16x8*)(lds + PG8_SA(b, h) + aoff + m * 2048 + k * 1024); } while (0)
#define PG8_LDB(dst, b, h) do { _Pragma("unroll") for (int n = 0; n < 2; ++n) _Pragma("unroll") for (int k = 0; k < 2; ++k) dst[n][k] = *(const PG8_LAS bf16x8*)(lds + PG8_SB(b, h) + boff + n * 2048 + k * 1024); } while (0)
#define PG8_MMA(ai, bj, At, Bt) do { __builtin_amdgcn_s_setprio(1); _Pragma("unroll") for (int m = 0; m < 4; ++m) _Pragma("unroll") for (int n = 0; n < 2; ++n) _Pragma("unroll") for (int k = 0; k < 2; ++k) \
        acc[ai][bj][m][n] = __builtin_amdgcn_mfma_f32_16x16x32_bf16(Bt[n][k], At[m][k], acc[ai][bj][m][n], 0, 0, 0); __builtin_amdgcn_s_setprio(0); } while (0)
#define PG8_WAIT_V(n) asm volatile("s_waitcnt vmcnt(" #n ")" ::: "memory")
#define PG8_WAIT_L(n) asm volatile("s_waitcnt lgkmcnt(" #n ")" ::: "memory")
#define PG8_BAR __builtin_amdgcn_s_barrier()
#define PG8_SCHED __builtin_amdgcn_sched_barrier(0)
    Unit cur, nxt; int ui = 0;
    if (!S.next(0, cur)) return;
    f32x4 acc[2][2][4][2];
#pragma unroll
    for (int a = 0; a < 2; ++a)
#pragma unroll
        for (int b = 0; b < 2; ++b)
#pragma unroll
            for (int m = 0; m < 4; ++m)
#pragma unroll
                for (int n = 0; n < 2; ++n) acc[a][b][m][n] = (f32x4){0.f, 0.f, 0.f, 0.f};
    bf16x8 At[4][2], B0[2][2], B1[2][2];
    const char* cA = (const char*)g.A + (size_t)cur.pm * tstep; const char* cB = (const char*)g.Bt + (size_t)cur.pn * tstep;
    S.a_ready(cur);
    if constexpr (SP2) {
        PG8_STAGE(PG8_SB(0, 0), cB, voffB); PG8_STAGE(PG8_SB(0, 1), cB + hstep, voffB); PG8_STAGE(PG8_SA(0, 0), cA, voffA); PG8_STAGE(PG8_SA(0, 1), cA + hstep, voffA);
        if (wr == 1) PG8_BAR;
        PG8_WAIT_V(2); PG8_BAR;
        PG8_STAGE(PG8_SB(1, 0), cB + kstep, voffB); PG8_STAGE(PG8_SA(1, 0), cA + kstep, voffA); PG8_STAGE(PG8_SB(1, 1), cB + hstep + kstep, voffB);
        PG8_WAIT_V(6); PG8_BAR;
    } else {
        PG8_STAGE(PG8_SB(0, 0), cB, voffB); PG8_STAGE(PG8_SA(0, 0), cA, voffA); PG8_STAGE(PG8_SB(0, 1), cB + hstep, voffB); PG8_STAGE(PG8_SA(0, 1), cA + hstep, voffA);
        if (wr == 1) PG8_BAR;
        PG8_WAIT_V(4); PG8_BAR;
        PG8_STAGE(PG8_SB(1, 0), cB + kstep, voffB); PG8_STAGE(PG8_SA(1, 0), cA + kstep, voffA); PG8_STAGE(PG8_SB(1, 1), cB + hstep + kstep, voffB);
        PG8_WAIT_V(6); PG8_BAR;
    }
    for (;;) {
        const bool has_next = S.next(ui + 1, nxt);
        const char* nA = has_next ? (const char*)g.A + (size_t)nxt.pm * tstep : cA; const char* nB = has_next ? (const char*)g.Bt + (size_t)nxt.pn * tstep : cB;
        for (int t = 0; t < nt; t += 2) {
            const bool last = (t == nt - 2);
            const char* a1 = cA + (size_t)(t + 1) * kstep;
            const char* a2 = last ? nA : cA + (size_t)(t + 2) * kstep; const char* b2 = last ? nB : cB + (size_t)(t + 2) * kstep;
            const char* a3 = a2 + kstep; const char* b3 = b2 + kstep;
            if (last && has_next) S.a_ready(nxt);
            if constexpr (SP2) {
            PG8_LDB(B0, 0, 0); PG8_LDB(B1, 0, 1); PG8_SCHED; PG8_LDA(At, 0, 0); PG8_STAGE(PG8_SA(1, 1), a1 + hstep, voffA);
            PG8_WAIT_V(8); PG8_WAIT_L(0); PG8_BAR; PG8_MMA(0, 0, At, B0); PG8_MMA(0, 1, At, B1); PG8_BAR; PG8_SCHED;
            PG8_LDA(At, 0, 1); PG8_STAGE(PG8_SB(0, 0), b2, voffB); PG8_STAGE(PG8_SB(0, 1), b2 + hstep, voffB); PG8_STAGE(PG8_SA(0, 0), a2, voffA);
            PG8_WAIT_V(8); PG8_WAIT_L(0); PG8_BAR; PG8_MMA(1, 0, At, B0); PG8_MMA(1, 1, At, B1); PG8_BAR; PG8_SCHED;
            PG8_LDB(B0, 1, 0); PG8_LDB(B1, 1, 1); PG8_SCHED; PG8_LDA(At, 1, 0); PG8_STAGE(PG8_SA(0, 1), a2 + hstep, voffA);
            PG8_WAIT_V(8); PG8_WAIT_L(0); PG8_BAR; PG8_MMA(0, 0, At, B0); PG8_MMA(0, 1, At, B1); PG8_BAR; PG8_SCHED;
            PG8_LDA(At, 1, 1); PG8_STAGE(PG8_SB(1, 0), b3, voffB); PG8_STAGE(PG8_SB(1, 1), b3 + hstep, voffB); PG8_STAGE(PG8_SA(1, 0), a3, voffA);
            PG8_WAIT_V(8); PG8_WAIT_L(0); PG8_BAR; PG8_MMA(1, 0, At, B0); PG8_MMA(1, 1, At, B1); PG8_BAR; PG8_SCHED;
            } else {
            PG8_LDB(B0, 0, 0); PG8_SCHED; PG8_LDA(At, 0, 0); PG8_STAGE(PG8_SA(1, 1), a1 + hstep, voffA);
            PG8_WAIT_L(8); PG8_BAR; PG8_WAIT_L(0); PG8_MMA(0, 0, At, B0); PG8_BAR; PG8_SCHED;
            PG8_LDB(B1, 0, 1); PG8_STAGE(PG8_SB(0, 0), b2, voffB);
            PG8_BAR; PG8_WAIT_L(0); PG8_MMA(0, 1, At, B1); PG8_BAR;
            PG8_LDA(At, 0, 1); PG8_STAGE(PG8_SA(0, 0), a2, voffA);
            PG8_BAR; PG8_WAIT_L(0); PG8_MMA(1, 0, At, B0); PG8_BAR; PG8_SCHED;
            PG8_STAGE(PG8_SB(0, 1), b2 + hstep, voffB);
            PG8_WAIT_V(6); PG8_BAR; PG8_MMA(1, 1, At, B1); PG8_BAR;
            PG8_LDB(B0, 1, 0); PG8_SCHED; PG8_LDA(At, 1, 0); PG8_STAGE(PG8_SA(0, 1), a2 + hstep, voffA);
            PG8_WAIT_L(8); PG8_BAR; PG8_WAIT_L(0); PG8_MMA(0, 0, At, B0); PG8_BAR; PG8_SCHED;
            PG8_LDB(B1, 1, 1); PG8_STAGE(PG8_SB(1, 0), b3, voffB);
            PG8_BAR; PG8_WAIT_L(0); PG8_MMA(0, 1, At, B1); PG8_BAR;
            PG8_LDA(At, 1, 1); PG8_STAGE(PG8_SA(1, 0), a3, voffA);
            PG8_BAR; PG8_WAIT_L(0); PG8_MMA(1, 0, At, B0); PG8_BAR; PG8_SCHED;
            PG8_STAGE(PG8_SB(1, 1), b3 + hstep, voffB);
            PG8_WAIT_V(6); PG8_BAR; PG8_MMA(1, 1, At, B1); PG8_BAR;
            }
        }
        if constexpr (ALIGN_EPI) { if (wr == 0) PG8_BAR; }
        if constexpr (!Epi::AFTER_DRAIN) { E(acc, cur, wr, wc, fr, fq); S.done(cur); }
        if (!has_next) break;
#pragma unroll
        for (int a = 0; a < 2; ++a)
#pragma unroll
            for (int b = 0; b < 2; ++b)
#pragma unroll
                for (int m = 0; m < 4; ++m)
#pragma unroll
                    for (int n = 0; n < 2; ++n) acc[a][b][m][n] = (f32x4){0.f, 0.f, 0.f, 0.f};
        cur = nxt; cA = nA; cB = nB; ++ui;
        if constexpr (ALIGN_EPI) { if (wr == 1) PG8_BAR; }
    }
    PG8_WAIT_V(0);
    if constexpr (!ALIGN_EPI) { if (wr == 0) PG8_BAR; }
    PG8_BAR;
    if constexpr (Epi::AFTER_DRAIN) { E.fused(acc, cur, wr, wc, fr, fq, lds, wid, lane); S.done(cur); }
#undef PG8_SA
#undef PG8_SB
#undef PG8_STAGE
#undef PG8_LDA
#undef PG8_LDB
#undef PG8_MMA
#undef PG8_WAIT_V
#undef PG8_WAIT_L
#undef PG8_BAR
#undef PG8_SCHED
}
}
#define PG8_PTR(x) ((__attribute__((address_space(3))) unsigned char*)(x))
#else
template <class Epi, class Sched, bool ALIGN_EPI = false, bool SP2 = false>
inline void gemm_phase(unsigned char* lds, const Gemm g, const Sched& S, const Epi& E) {
    const int tid = threadIdx.x, wid = tid >> 6, lane = tid & 63, wr = wid >> 2, wc = wid & 3, fr = lane & 15, fq = lane >> 4;
    Unit cur;
    for (int ui = 0; S.next(ui, cur); ++ui) {
        f32x4 acc[2][2][4][2];
        for (int ai = 0; ai < 2; ++ai) for (int bj = 0; bj < 2; ++bj) for (int m = 0; m < 4; ++m) for (int n = 0; n < 2; ++n) for (int i = 0; i < 4; ++i) {
            const int row = 256 * cur.pm + 128 * ai + 64 * wr + 16 * m + fr;
            const int col = 256 * cur.pn + 128 * bj + 32 * wc + (Epi::PERM ? 8 * fq + 4 * n + i : 16 * n + 4 * fq + i);
            const bf16_t* a = g.A + (size_t)row * g.K; const bf16_t* b = g.Bt + (size_t)col * g.K; float s = 0.f;
            for (int k = 0; k < g.K; ++k) s += emu_bf2f(a[k]) * emu_bf2f(b[k]);
            acc[ai][bj][m][n][i] = s; }
        E(acc, cur, wr, wc, fr, fq);
    }
}
}
#define PG8_PTR(x) (x)
#endif
#ifdef CPU_EMU
#define WAVE_SYNC() emu_wave_sync()
#define SCHED_FENCE() do { } while (0)
#define LAUNDER_V(x) do { } while (0)
#else
#define LAUNDER_V(x) asm volatile("" : "+v"(x))
#define WAVE_SYNC() asm volatile("s_waitcnt lgkmcnt(0)" ::: "memory")
#define SCHED_FENCE() __builtin_amdgcn_sched_barrier(0)
#endif

struct Params { const float* in[N_IN]; float* out; unsigned char* ws; int ph_lo, ph_hi, li, pad; };

constexpr float QSCALE = 0.125f * 1.4426950408889634f;
struct EpiInProj {
    static constexpr bool PERM = true, AFTER_DRAIN = false;
    unsigned char* ws; const float* qng; const float* ksng; const float* kwng;
    DEV void operator()(const f32x4 (&acc)[2][2][4][2], const pg8::Unit& u, int wr, int wc, int fr, int fq) const {
        const int pn = u.pn; const int row0 = u.pm * 256 + wr * 64 + fr;
        int kind; bf16_t* dst = nullptr; bf16_t* dst2 = nullptr; int pitch = 512, colb = 0; const float* gv = nullptr;
        if (pn < 2) { kind = 2; dst = (bf16_t*)(ws + WS_Q); dst2 = (bf16_t*)(ws + WS_QR); colb = (4 * pn + wc) * 64; gv = qng; }
        else if (pn == 2) { kind = 0; dst = (bf16_t*)(ws + WS_CR); pitch = 256; colb = wc * 64; }
        else if (pn == 3) { kind = wc < 2 ? 1 : 0; dst = (bf16_t*)(ws + WS_SL); pitch = 256; colb = wc * 64; gv = ksng; }
        else if (pn == 4) { kind = wc < 2 ? 1 : 0; dst = (bf16_t*)(ws + WS_WN); pitch = 256; colb = wc * 64; gv = kwng; }
        else if (pn < 7) { kind = 3; dst = (bf16_t*)(ws + WS_ZA); colb = (4 * (pn - 5) + wc) * 64; }
        else if (pn < 9) { kind = 0; dst = (bf16_t*)(ws + WS_U); colb = (4 * (pn - 7) + wc) * 64; }
        else if (pn < 11) { kind = 3; dst = (bf16_t*)(ws + WS_ZS); colb = (4 * (pn - 9) + wc) * 64; }
        else { kind = (wc == 0) ? 4 : 5; }
        if (kind == 5) return;
        float g1[8], g2[8];
        if (kind == 1 || kind == 2) {
#pragma unroll
            for (int i = 0; i < 8; ++i) { const float qs = (kind == 2) ? QSCALE : 1.0f; g1[i] = gv[8 * fq + i] * qs; g2[i] = gv[32 + 8 * fq + i] * qs; }
        }
        const float* rope = (const float*)(ws + WS_ROPE);
#pragma unroll
        for (int ai = 0; ai < 2; ++ai)
#pragma unroll
            for (int m = 0; m < 4; ++m) {
                const int row = row0 + ai * 128 + m * 16;
                float x1[8], x2[8];
#pragma unroll
                for (int i = 0; i < 4; ++i) { x1[i] = acc[ai][0][m][0][i]; x1[4 + i] = acc[ai][0][m][1][i]; x2[i] = acc[ai][1][m][0][i]; x2[4 + i] = acc[ai][1][m][1][i]; }
                if (kind == 4) {
                    float* G = (float*)(ws + WS_G) + (size_t)row * 32 + 8 * fq;
                    f32x4 o0, o1;
#pragma unroll
                    for (int i = 0; i < 4; ++i) { o0[i] = sigmoid_f(x1[i]); o1[i] = sigmoid_f(x1[4 + i]); }
                    *(f32x4*)G = o0; *(f32x4*)(G + 4) = o1;
                    continue;
                }
                if (kind == 1 || kind == 2) {
                    float ss = 0.f;
#pragma unroll
                    for (int i = 0; i < 8; ++i) ss += x1[i] * x1[i] + x2[i] * x2[i];
                    ss += __shfl_xor(ss, 16); ss += __shfl_xor(ss, 32);
                    const float rinv = rsqrtf(ss * (1.0f / 64.0f) + EPS_);
#pragma unroll
                    for (int i = 0; i < 8; ++i) { x1[i] = x1[i] * rinv * g1[i]; x2[i] = x2[i] * rinv * g2[i]; }
                    if (kind == 2) {
                        bf16_t* o = dst + (size_t)row * pitch + colb + 8 * fq;
                        *(u32x4*)o = (u32x4){pk2(x1[0], x1[1]), pk2(x1[2], x1[3]), pk2(x1[4], x1[5]), pk2(x1[6], x1[7])};
                        *(u32x4*)(o + 32) = (u32x4){pk2(x2[0], x2[1]), pk2(x2[2], x2[3]), pk2(x2[4], x2[5]), pk2(x2[6], x2[7])};
                    }
                    const int t = row % T_;
                    const float* cs = rope + (size_t)t * 32 + 8 * fq; const float* sn = cs + (size_t)T_ * 32;
                    const f32x4 c0 = *(const f32x4*)cs, c1 = *(const f32x4*)(cs + 4), s0 = *(const f32x4*)sn, s1 = *(const f32x4*)(sn + 4);
#pragma unroll
                    for (int i = 0; i < 8; ++i) { const float c = i < 4 ? c0[i & 3] : c1[i & 3], s = i < 4 ? s0[i & 3] : s1[i & 3]; const float a = x1[i], b = x2[i]; x1[i] = a * c - b * s; x2[i] = b * c + a * s; }
                } else if (kind == 3) {
#pragma unroll
                    for (int i = 0; i < 8; ++i) { x1[i] = silu_f(x1[i]); x2[i] = silu_f(x2[i]); }
                }
                bf16_t* o = (kind == 2 ? dst2 : dst) + (size_t)row * pitch + colb + 8 * fq;
                *(u32x4*)o = (u32x4){pk2(x1[0], x1[1]), pk2(x1[2], x1[3]), pk2(x1[4], x1[5]), pk2(x1[6], x1[7])};
                *(u32x4*)(o + 32) = (u32x4){pk2(x2[0], x2[1]), pk2(x2[2], x2[3]), pk2(x2[4], x2[5]), pk2(x2[6], x2[7])};
            }
    }
};

struct EpiGlu {
    static constexpr bool PERM = true, AFTER_DRAIN = false;
    const bf16_t* YG; const bf16_t* ZS; bf16_t* MIX; const float* glub;
    DEV void operator()(const f32x4 (&acc)[2][2][4][2], const pg8::Unit& u, int wr, int wc, int fr, int fq) const {
        const int row0 = u.pm * 256 + wr * 64 + fr, col0 = u.pn * 256 + wc * 32 + 8 * fq;
#pragma unroll
        for (int bj = 0; bj < 2; ++bj) {
            const int col = col0 + bj * 128;
            const f32x4 b0 = *(const f32x4*)(glub + col), b1 = *(const f32x4*)(glub + col + 4);
#pragma unroll
            for (int ai = 0; ai < 2; ++ai)
#pragma unroll
                for (int m = 0; m < 4; ++m) {
                    const int row = row0 + ai * 128 + m * 16;
                    const u32x4 yv = *(const u32x4*)(YG + (size_t)row * 512 + col), zv = *(const u32x4*)(ZS + (size_t)row * 512 + col);
                    float o[8];
#pragma unroll
                    for (int i = 0; i < 8; ++i) {
                        const float a = (i < 4 ? acc[ai][bj][m][0][i & 3] : acc[ai][bj][m][1][i & 3]) + (i < 4 ? b0[i & 3] : b1[i & 3]);
                        const unsigned yw = yv[i >> 1], zw = zv[i >> 1];
                        const float y = bf2f((i & 1) ? (yw >> 16) : (yw & 0xffffu)), z = bf2f((i & 1) ? (zw >> 16) : (zw & 0xffffu));
                        o[i] = y * sigmoid_f(a) * z;
                    }
                    *(u32x4*)(MIX + (size_t)row * 1024 + 512 + col) = (u32x4){pk2(o[0], o[1]), pk2(o[2], o[3]), pk2(o[4], o[5]), pk2(o[6], o[7])};
                }
        }
    }
};

struct EpiOut {
    static constexpr bool PERM = true, AFTER_DRAIN = false;
    const float* x; float* out; const float* mod;
    DEV void operator()(const f32x4 (&acc)[2][2][4][2], const pg8::Unit& u, int wr, int wc, int fr, int fq) const {
        const int row0 = u.pm * 256 + wr * 64 + fr, col0 = u.pn * 256 + wc * 32 + 8 * fq; const int b = (u.pm * 256) / T_;
#pragma unroll
        for (int bj = 0; bj < 2; ++bj) {
            const int col = col0 + bj * 128;
            const f32x4 g0 = *(const f32x4*)(mod + (size_t)b * 3072 + 2048 + col), g1 = *(const f32x4*)(mod + (size_t)b * 3072 + 2048 + col + 4);
#pragma unroll
            for (int ai = 0; ai < 2; ++ai)
#pragma unroll
                for (int m = 0; m < 4; ++m) {
                    const size_t off = (size_t)(row0 + ai * 128 + m * 16) * 1024 + col;
                    const f32x4 x0 = *(const f32x4*)(x + off), x1 = *(const f32x4*)(x + off + 4);
                    *(f32x4*)(out + off) = x0 + g0 * acc[ai][bj][m][0];
                    *(f32x4*)(out + off + 4) = x1 + g1 * acc[ai][bj][m][1];
                }
        }
    }
};

DEV void tr_item(const float* W, int Nsrc, int K, int k0, int col0, int nvalid, bf16_t* WT, int drow0, float* scr, int lane) {
    const int c = lane & 31;
#pragma unroll 8
    for (int i = 0; i < 32; ++i) { const int kk = 2 * i + (lane >> 5); scr[kk * 33 + c] = (c < nvalid) ? W[(size_t)(k0 + kk) * Nsrc + col0 + c] : 0.f; }
    WAVE_SYNC();
    const int c8 = lane & 7;
#pragma unroll
    for (int j = 0; j < 4; ++j) { const int n = (lane >> 3) + 8 * j; const float* s = scr + (8 * c8) * 33 + n;
        u32x4 o; o.x = pk2(s[0 * 33], s[1 * 33]); o.y = pk2(s[2 * 33], s[3 * 33]); o.z = pk2(s[4 * 33], s[5 * 33]); o.w = pk2(s[6 * 33], s[7 * 33]);
        *(u32x4*)(WT + (size_t)(drow0 + n) * K + k0 + 8 * c8) = o; }
    WAVE_SYNC();
}

DEV void p0_prologue(const Params& p, unsigned char* lds, int vcu, int G, int tid, int wave, int lane) {
    unsigned char* ws = p.ws;
    {
        const float* c = p.in[I_C]; const float* w = p.in[I_WADA]; const float* ba = p.in[I_BADA]; float* mod = (float*)(ws + WS_MOD);
        for (int cb = vcu; cb < 256; cb += G)
            for (int b = wave; b < B_; b += 8) {
                float a[12];
#pragma unroll
                for (int j = 0; j < 12; ++j) a[j] = 0.f;
                for (int i = 0; i < 16; ++i) {
                    const int k = lane + 64 * i; const float s = silu_f(c[b * 1024 + k]);
                    const f32x4* wp = (const f32x4*)(w + (size_t)k * 3072 + 12 * cb); const f32x4 w0 = wp[0], w1 = wp[1], w2 = wp[2];
#pragma unroll
                    for (int j = 0; j < 4; ++j) { a[j] += s * w0[j]; a[4 + j] += s * w1[j]; a[8 + j] += s * w2[j]; }
                }
#pragma unroll
                for (int j = 0; j < 12; ++j) a[j] = wave_sum(a[j]);
                if (lane == 0) {
#pragma unroll
                    for (int j = 0; j < 12; ++j) mod[b * 3072 + 12 * cb + j] = a[j] + ba[12 * cb + j];
                }
            }
    }
    {
        float* scr = (float*)(lds + wave * 16384);
        const int gw = vcu * 8 + wave, NGW = G * 8;
        constexpr int I_IN = 96 * 16, I_O = 32 * 16, I_GL = 16 * 8, I_W1 = 8 * 32, I_W2 = 2 * 4;
        constexpr int NIT = I_IN + I_O + I_GL + 2 * I_W1 + 2 * I_W2;
        for (int it = gw; it < NIT; it += NGW) {
            int r = it;
            if (r < I_IN) {
                const int ci = r / 16, kb = r % 16, n0 = 32 * ci, pn = n0 >> 8, bj = (n0 >> 7) & 1, wc = (n0 >> 5) & 3, L0 = 256 * pn + 64 * wc + 32 * bj;
                int oc, nv; if (L0 < 1792) { oc = L0; nv = 32; } else if (L0 < 2816) { oc = L0 + 24; nv = 32; } else if (L0 == 2816) { oc = 1792; nv = 24; } else { oc = 0; nv = 0; }
                tr_item(p.in[I_WIN], INW, 1024, 64 * kb, oc, nv, (bf16_t*)(ws + WS_WIN), n0, scr, lane); continue; }
            r -= I_IN;
            if (r < I_O) { tr_item(p.in[I_WOUT], 1024, 1024, 64 * (r % 16), 32 * (r / 16), 32, (bf16_t*)(ws + WS_WO), 32 * (r / 16), scr, lane); continue; }
            r -= I_O;
            if (r < I_GL) { tr_item(p.in[I_GLUW], 512, 512, 64 * (r % 8), 32 * (r / 8), 32, (bf16_t*)(ws + WS_WGLU), 32 * (r / 8), scr, lane); continue; }
            r -= I_GL;
            if (r < I_W1) { tr_item(p.in[I_W1K], 256, 2048, 64 * (r % 32), 32 * (r / 32), 32, (bf16_t*)(ws + WS_W1K), 32 * (r / 32), scr, lane); continue; }
            r -= I_W1;
            if (r < I_W1) { tr_item(p.in[I_W1V], 256, 2048, 64 * (r % 32), 32 * (r / 32), 32, (bf16_t*)(ws + WS_W1V), 32 * (r / 32), scr, lane); continue; }
            r -= I_W1;
            if (r < I_W2) { tr_item(p.in[I_W2K], 64, 256, 64 * (r % 4), 32 * (r / 4), 32, (bf16_t*)(ws + WS_W2K), 32 * (r / 4), scr, lane); continue; }
            r -= I_W2;
            tr_item(p.in[I_W2V], 64, 256, 64 * (r % 4), 32 * (r / 4), 32, (bf16_t*)(ws + WS_W2V), 32 * (r / 4), scr, lane);
        }
    }
    {
        float* rc = (float*)(ws + WS_ROPE); float* rs = rc + (size_t)T_ * 32;
        for (int i = vcu * 512 + tid; i < T_ * 32; i += G * 512) {
            const int t = i >> 5, d = i & 31;
            const float inv = (float)(1.0 / pow(10000.0, (double)d / 32.0));
            const float ang = (float)t * inv;
            rc[i] = (float)cos((double)ang); rs[i] = (float)sin((double)ang);
        }
    }
    __syncthreads();
    {
        f32x2* lp = (f32x2*)lds;
        f32x2* bb = lp + 64;
        f32x2* cc = bb + 1024;
        f32x2* ee = cc + 1024;
        for (int it = vcu; it < 32 * 13 + 2; it += G) {
            if (it >= 32 * 13) {
                const int kv = it - 32 * 13; const float* pos = p.in[kv ? I_POSV : I_POSK]; const float* w1 = p.in[kv ? I_W1V : I_W1K];
                if (tid < 256) { float a = 0.f; for (int i = 0; i < 2048; ++i) a += pos[i] * w1[(size_t)i * 256 + tid]; ((float*)(ws + WS_CPOS))[kv * 256 + tid] = a; }
                continue;
            }
            const int g = it / 13, nb = it % 13;
            const float dt = expf(p.in[I_LOGDT][g]);
            for (int e = tid; e < 1024; e += 512) {
                const int pp = e >> 4, ci = e & 15;
                const float ar = p.in[I_ARE][g * 64 + pp], ai = p.in[I_AIM][g * 64 + pp], x = ar * dt, y = ai * dt;
                const float em1 = expm1f(x), ex = em1 + 1.0f, cy = cosf(y), sy = sinf(y), sh = sinf(0.5f * y);
                const float lr = em1 * cy - 2.0f * sh * sh, li = ex * sy;
                const float den = ar * ar + ai * ai, fr_ = (lr * ar + li * ai) / den, fi_ = (li * ar - lr * ai) / den;
                const float br = p.in[I_BRE][(g * 64 + pp) * 16 + ci], bi = p.in[I_BIM][(g * 64 + pp) * 16 + ci];
                bb[e] = (f32x2){fr_ * br - fi_ * bi, fr_ * bi + fi_ * br};
                const int co = e >> 6, p2 = e & 63;
                cc[e] = (f32x2){p.in[I_CRE][(g * 16 + co) * 64 + p2], p.in[I_CIM][(g * 16 + co) * 64 + p2]};
            }
            for (int n = 5 * nb; n < 5 * nb + 5; ++n) {
                if (tid < 64) {
                    const float ar = p.in[I_ARE][g * 64 + tid], ai = p.in[I_AIM][g * 64 + tid];
                    const float mag = expf(ar * dt * (float)n), ang = ai * dt * (float)n;
                    lp[tid] = (f32x2){mag * cosf(ang), mag * sinf(ang)};
                }
                __syncthreads();
                for (int e = tid; e < 1024; e += 512) { const f32x2 l = lp[e >> 4], b = bb[e]; ee[e] = (f32x2){l.x * b.x - l.y * b.y, l.x * b.y + l.y * b.x}; }
                __syncthreads();
                if (n < 64) {
                    bf16_t* KT = (bf16_t*)(ws + WS_KT) + (size_t)g * 65 * 256;
                    if (tid < 256) {
                        const int co = tid >> 4, ci = tid & 15; float a = 0.f;
                        for (int pp = 0; pp < 64; ++pp) { const f32x2 c = cc[co * 64 + pp], e = ee[pp * 16 + ci]; a += c.x * e.x - c.y * e.y; }
                        KT[(n + 1) * 256 + tid] = (bf16_t)f2bf(a);
                        if (n == 0) KT[tid] = 0;
                    }
                    bf16_t* WST = (bf16_t*)(ws + WS_WST) + (size_t)g * 128 * 1024; const int sidx = 63 - n;
                    for (int e = tid; e < 1024; e += 512) { const int pp = e >> 4, ci = e & 15; const f32x2 v = ee[e];
                        WST[(size_t)pp * 1024 + sidx * 16 + ci] = (bf16_t)f2bf(v.x); WST[(size_t)(64 + pp) * 1024 + sidx * 16 + ci] = (bf16_t)f2bf(v.y); }
                }
                if (n >= 1) {
                    bf16_t* WO = (bf16_t*)(ws + WS_WOUTS) + (size_t)g * 1024 * 128; const int t = n - 1;
                    for (int e = tid; e < 1024; e += 512) { const int co = e >> 6, pp = e & 63; const f32x2 c = cc[e], l = lp[pp];
                        WO[(size_t)(t * 16 + co) * 128 + pp] = (bf16_t)f2bf(c.x * l.x - c.y * l.y); WO[(size_t)(t * 16 + co) * 128 + 64 + pp] = (bf16_t)f2bf(-(c.x * l.y + c.y * l.x)); }
                }
                if (n == 64 && tid < 64) ((f32x2*)(ws + WS_LAM64))[g * 64 + tid] = lp[tid];
                __syncthreads();
            }
        }
    }
}

DEV void p1_norm(const Params& p, int vcu, int G, int wave, int lane) {
    const float* x = p.in[I_X]; const float* ng = p.in[I_NORMG]; const float* mod = (const float*)(p.ws + WS_MOD); bf16_t* HN = (bf16_t*)(p.ws + WS_HN);
    const int gw = vcu * 8 + wave, NGW = G * 8;
    constexpr int RB = 32;
    for (int it = gw; it < M_ / RB; it += NGW) {
        const int r0 = it * RB, b = r0 / T_;
        f32x4 cs[4], sh[4];
#pragma unroll
        for (int j = 0; j < 4; ++j) { const int k = 4 * lane + 256 * j; const f32x4 g = *(const f32x4*)(ng + k), sc = *(const f32x4*)(mod + (size_t)b * 3072 + 1024 + k);
            cs[j] = g * (sc + 1.0f); sh[j] = *(const f32x4*)(mod + (size_t)b * 3072 + k); }
        for (int r = r0; r < r0 + RB; ++r) {
            const f32x4* xr = (const f32x4*)(x + (size_t)r * 1024) + lane; f32x4 v[4]; float s = 0.f;
#pragma unroll
            for (int j = 0; j < 4; ++j) { v[j] = xr[64 * j]; s += (v[j].x * v[j].x + v[j].y * v[j].y) + (v[j].z * v[j].z + v[j].w * v[j].w); }
            const float rinv = rsqrtf(wave_sum(s) * (1.0f / 1024.0f) + EPS_);
            u32x2* o = (u32x2*)(HN + (size_t)r * 1024) + lane;
#pragma unroll
            for (int j = 0; j < 4; ++j) { const f32x4 h = v[j] * rinv * cs[j] + sh[j]; o[64 * j] = (u32x2){pk2(h.x, h.y), pk2(h.z, h.w)}; }
        }
    }
}

constexpr int UL_CH = 2064;
constexpr int SSM_UL = 0, SSM_KT = 32 * UL_CH, SSM_SLOC = SSM_KT + 65 * 256 * 2, SSM_CBT = SSM_SLOC + 128 * 32 * 4, SSM_END = SSM_CBT + 32 * 272;
static_assert(SSM_END <= RING_BYTES, "ssm lds");
DEV void ssm_unit(const Params& p, unsigned char* lds, int unit, int tid, int wave, int lane) {
    const int b = unit / SSM_NG, g = unit % SSM_NG; const int l16 = lane & 15, q4 = lane >> 4;
    unsigned char* ws = p.ws;
    const bf16_t* U = (const bf16_t*)(ws + WS_U); bf16_t* YG = (bf16_t*)(ws + WS_YG);
    const bf16_t* WST = (const bf16_t*)(ws + WS_WST) + (size_t)g * 128 * 1024; const bf16_t* WO = (const bf16_t*)(ws + WS_WOUTS) + (size_t)g * 1024 * 128;
    unsigned char* ul = lds + SSM_UL; bf16_t* ktl = (bf16_t*)(lds + SSM_KT); float* sloc = (float*)(lds + SSM_SLOC); bf16_t* cbt = (bf16_t*)(lds + SSM_CBT);
    { const u32x4* src = (const u32x4*)((const bf16_t*)(ws + WS_KT) + (size_t)g * 65 * 256); u32x4* dstv = (u32x4*)ktl; for (int i = tid; i < 65 * 256 * 2 / 16; i += 512) dstv[i] = src[i]; }
    float sre = 0.f, sim = 0.f; f32x2 lam = {0.f, 0.f};
    if (wave == 0) lam = ((const f32x2*)(ws + WS_LAM64))[g * 64 + lane];
    f32x4 dsk = *(const f32x4*)(p.in[I_SSMD] + 16 * g + 4 * q4);
    for (int cg = 0; cg < SSM_NCG; ++cg) {
        const size_t tokbase = (size_t)b * T_ + (size_t)cg * 2048;
#pragma unroll
        for (int i = 0; i < 8; ++i) { const int idx = tid + 512 * i, tok = idx >> 1, hf = idx & 1;
            *(u32x4*)(ul + (tok >> 6) * UL_CH + (tok & 63) * 32 + hf * 16) = *(const u32x4*)(U + (tokbase + tok) * 512 + 16 * g + 8 * hf); }
        __syncthreads();
        {
            f32x4 a1[2] = {(f32x4){0.f, 0.f, 0.f, 0.f}, (f32x4){0.f, 0.f, 0.f, 0.f}};
            const bf16_t* ap = WST + (size_t)(16 * wave + l16) * 1024 + 8 * q4;
            const unsigned char* bp = ul + l16 * UL_CH + (q4 >> 1) * 32 + (q4 & 1) * 16;
#pragma unroll 4
            for (int ks = 0; ks < 32; ++ks) {
                const bf16x8 a = ld8(ap + 32 * ks);
                const bf16x8 b0 = *(const bf16x8*)(bp + ks * 64), b1 = *(const bf16x8*)(bp + 16 * UL_CH + ks * 64);
                a1[0] = mfma16(a, b0, a1[0]); a1[1] = mfma16(a, b1, a1[1]);
            }
#pragma unroll
            for (int ct = 0; ct < 2; ++ct)
#pragma unroll
                for (int r = 0; r < 4; ++r) sloc[(16 * wave + 4 * q4 + r) * 32 + 16 * ct + l16] = a1[ct][r];
        }
        __syncthreads();
        if (wave == 0) {
            for (int c = 0; c < 32; ++c) {
                cbt[c * 136 + lane] = (bf16_t)f2bf(sre); cbt[c * 136 + 64 + lane] = (bf16_t)f2bf(sim);
                const float lr = sloc[lane * 32 + c], li = sloc[(64 + lane) * 32 + c];
                const float nr = lam.x * sre - lam.y * sim + lr, ni = lam.x * sim + lam.y * sre + li; sre = nr; sim = ni;
            }
        }
        __syncthreads();
        for (int i = 0; i < 8; ++i) {
            const int t = wave + 8 * i;
            f32x4 a3[2] = {(f32x4){0.f, 0.f, 0.f, 0.f}, (f32x4){0.f, 0.f, 0.f, 0.f}};
            const unsigned char* bp = ul + l16 * UL_CH + (q4 >> 1) * 32 + (q4 & 1) * 16;
            const bf16_t* kp = ktl + (t - (q4 >> 1) + 1) * 256 + l16 * 16 + 8 * (q4 & 1);
            const int nks = (t >> 1) + 1;
            for (int ks = 0; ks < nks; ++ks) {
                const bf16x8 a = ld8(kp - ks * 512);
                const bf16x8 b0 = *(const bf16x8*)(bp + ks * 64), b1 = *(const bf16x8*)(bp + 16 * UL_CH + ks * 64);
                a3[0] = mfma16(a, b0, a3[0]); a3[1] = mfma16(a, b1, a3[1]);
            }
            const bf16_t* wp = WO + (size_t)(t * 16 + l16) * 128 + 8 * q4;
#pragma unroll
            for (int ks = 0; ks < 4; ++ks) {
                const bf16x8 a = ld8(wp + 32 * ks);
                const bf16x8 b0 = ld8(cbt + l16 * 136 + 32 * ks + 8 * q4), b1 = ld8(cbt + (16 + l16) * 136 + 32 * ks + 8 * q4);
                a3[0] = mfma16(a, b0, a3[0]); a3[1] = mfma16(a, b1, a3[1]);
            }
#pragma unroll
            for (int ct = 0; ct < 2; ++ct) {
                const int chunk = 16 * ct + l16; const size_t tok = tokbase + (size_t)chunk * 64 + t;
                const u32x2 uv = *(const u32x2*)(ul + chunk * UL_CH + t * 32 + 8 * q4);
                float y[4];
#pragma unroll
                for (int r = 0; r < 4; ++r) { const unsigned w = uv[r >> 1]; const float uu = bf2f((r & 1) ? (w >> 16) : (w & 0xffffu)); y[r] = gelu_tanh_f(a3[ct][r] + dsk[r] * uu); }
                *(u32x2*)(YG + tok * 512 + 16 * g + 4 * q4) = (u32x2){pk2(y[0], y[1]), pk2(y[2], y[3])};
            }
        }
        __syncthreads();
    }
}

constexpr int CMP_TOK = 0, CMP_H = 528 * 128, CMP_OUT = CMP_H + 32 * 528, CMP_END = CMP_OUT + 32 * 64 * 4;
static_assert(CMP_END <= RING_BYTES, "cmp lds");
constexpr int CMP_UNITS = 2 * B_ * NGRP * (NCP / 32);
DEV void compress_unit(const Params& p, unsigned char* lds, int unit, int tid, int wave, int lane) {
    int r = unit; const int nb = r % (NCP / 32); r /= (NCP / 32); const int g = r % NGRP; r /= NGRP; const int b = r % B_; const int kv = r / B_;
    const int l16 = lane & 15, q4 = lane >> 4; unsigned char* ws = p.ws;
    const bf16_t* CR = (const bf16_t*)(ws + WS_CR); const bf16_t* w1t = (const bf16_t*)(ws + (kv ? WS_W1V : WS_W1K)); const bf16_t* w2t = (const bf16_t*)(ws + (kv ? WS_W2V : WS_W2K));
    const float* cpos = (const float*)(ws + WS_CPOS) + kv * 256;
    unsigned char* tokl = lds + CMP_TOK; bf16_t* hl = (bf16_t*)(lds + CMP_H); float* outl = (float*)(lds + CMP_OUT);
    const int n0 = 32 * nb, tk0 = 16 * n0;
    for (int idx = tid; idx < 528 * 8; idx += 512) {
        const int tl = idx >> 3, ch = idx & 7; const int tok = tk0 + tl;
        u32x4 v = (u32x4){0u, 0u, 0u, 0u};
        if (tok < T_) v = *(const u32x4*)(CR + ((size_t)b * T_ + tok) * 256 + kv * 128 + g * 64 + 8 * ch);
        *(u32x4*)(tokl + (tl * 8 + (ch ^ ((tl >> 4) & 7))) * 16) = v;
    }
    __syncthreads();
    f32x4 acc[2][2];
#pragma unroll
    for (int a = 0; a < 2; ++a)
#pragma unroll
        for (int c = 0; c < 2; ++c) acc[a][c] = (f32x4){0.f, 0.f, 0.f, 0.f};
    const bf16_t* bp0 = w1t + (size_t)(32 * wave + l16) * 2048 + 8 * q4; const bf16_t* bp1 = bp0 + (size_t)16 * 2048;
#pragma unroll 4
    for (int ks = 0; ks < 64; ++ks) {
        const int l = ks >> 1, chunk = 4 * (ks & 1) + q4;
        const int tl0 = 16 * l16 + l, tl1 = 16 * (16 + l16) + l;
        const bf16x8 a0 = *(const bf16x8*)(tokl + (tl0 * 8 + (chunk ^ ((tl0 >> 4) & 7))) * 16), a1 = *(const bf16x8*)(tokl + (tl1 * 8 + (chunk ^ ((tl1 >> 4) & 7))) * 16);
        const bf16x8 b0 = ld8(bp0 + 32 * ks), b1 = ld8(bp1 + 32 * ks);
        acc[0][0] = mfma16(a0, b0, acc[0][0]); acc[0][1] = mfma16(a0, b1, acc[0][1]); acc[1][0] = mfma16(a1, b0, acc[1][0]); acc[1][1] = mfma16(a1, b1, acc[1][1]);
    }
#pragma unroll
    for (int rt = 0; rt < 2; ++rt)
#pragma unroll
        for (int ct = 0; ct < 2; ++ct) { const int j = 32 * wave + 16 * ct + l16; const float cp = cpos[j];
#pragma unroll
            for (int rr = 0; rr < 4; ++rr) hl[(16 * rt + 4 * q4 + rr) * 264 + j] = (bf16_t)f2bf(gelu_tanh_f(acc[rt][ct][rr] + cp)); }
    __syncthreads();
    {
        const int rt = wave >> 2, ct = wave & 3; f32x4 a2 = (f32x4){0.f, 0.f, 0.f, 0.f};
#pragma unroll
        for (int ks = 0; ks < 8; ++ks) { const bf16x8 a = ld8(hl + (16 * rt + l16) * 264 + 32 * ks + 8 * q4), bq = ld8(w2t + (size_t)(16 * ct + l16) * 256 + 32 * ks + 8 * q4); a2 = mfma16(a, bq, a2); }
#pragma unroll
        for (int rr = 0; rr < 4; ++rr) outl[(16 * rt + 4 * q4 + rr) * 64 + 16 * ct + l16] = a2[rr];
    }
    __syncthreads();
    {
        const int row = tid >> 4, c4 = tid & 15; f32x4 v = *(const f32x4*)(outl + row * 64 + 4 * c4);
        if (kv == 0) {
            float ss = v.x * v.x + v.y * v.y + v.z * v.z + v.w * v.w;
            ss += __shfl_xor(ss, 1); ss += __shfl_xor(ss, 2); ss += __shfl_xor(ss, 4); ss += __shfl_xor(ss, 8);
            const float rinv = rsqrtf(ss * (1.0f / 64.0f) + EPS_); const f32x4 gk = *(const f32x4*)(p.in[I_KCNG] + 4 * c4);
            v = v * rinv * gk;
        }
        const int n = n0 + row; if (n >= NCMP) v = (f32x4){0.f, 0.f, 0.f, 0.f};
        bf16_t* dst = (bf16_t*)(ws + (kv ? WS_VC : WS_KC)) + (((size_t)b * NCP + n) * NGRP + g) * 64 + 4 * c4;
        *(u32x2*)dst = (u32x2){pk2(v.x, v.y), pk2(v.z, v.w)};
    }
    __syncthreads();
}

constexpr int AT_KB = 0, AT_VB = 2 * 9216, AT_IA = 4 * 9216, AT_IB = AT_IA + 64 * 128 * 4, AT_SEL = AT_IB + 64 * 128 * 4, AT_END = AT_SEL + 64 * 16;
static_assert(AT_END <= RING_BYTES, "attn lds");
constexpr int AT_UNITS = B_ * NGRP * NSB;

#ifdef CPU_EMU
DEV float quad_sum(float v) { v += __shfl_xor(v, 1); v += __shfl_xor(v, 2); return v; }
DEV u32x2 lds_tr16(const bf16_t* p) {
    const int w = threadIdx.x >> 6, l = threadIdx.x & 63; const unsigned long long a = (unsigned long long)(uintptr_t)p;
    emu_xbuf[w][l][0] = (unsigned)a; emu_xbuf[w][l][1] = (unsigned)(a >> 32); emu_wave_sync();
    const int g = l >> 4, i = l & 15; unsigned short e[4];
    for (int q = 0; q < 4; ++q) { const int src = 16 * g + 4 * q + (i >> 2); const unsigned long long sa = (unsigned long long)emu_xbuf[w][src][0] | ((unsigned long long)emu_xbuf[w][src][1] << 32); e[q] = ((const unsigned short*)(uintptr_t)sa)[i & 3]; }
    emu_wave_sync();
    return (u32x2){(unsigned)e[0] | ((unsigned)e[1] << 16), (unsigned)e[2] | ((unsigned)e[3] << 16)};
}
#else
DEV float quad_sum(float v) {
    v += __builtin_bit_cast(float, __builtin_amdgcn_mov_dpp(__builtin_bit_cast(int, v), 0xB1, 0xF, 0xF, true));
    v += __builtin_bit_cast(float, __builtin_amdgcn_mov_dpp(__builtin_bit_cast(int, v), 0x4E, 0xF, 0xF, true));
    return v;
}
typedef short v4i16_t __attribute__((ext_vector_type(4)));
DEV u32x2 lds_tr16(const bf16_t* p) { return __builtin_bit_cast(u32x2, __builtin_amdgcn_ds_read_tr16_b64_v4i16((__attribute__((address_space(3))) v4i16_t*)p)); }
#endif

template <int MODE>
DEV void attn_pass(const bf16_t* Kg, const bf16_t* Vg, int pitch, int jlo, int jhi, unsigned char* lds, const bf16x8 (&qf)[2][2], f32x4 (&oacc)[2][4], float (&lsum)[2], const float (&linv)[2],
                   float m0l, const int (&ttok)[2], const unsigned long long (&slo)[2], const unsigned long long (&shi)[2], int t0, int qb, int tid, int wave, int lane_) {
    LAUNDER_V(tid); const int lane = tid & 63; (void)lane_;
    const int l16 = lane & 15, q4 = lane >> 4, hg = lane & 3, tau = l16 >> 2;
    const int key = tid >> 3, ch = tid & 7;
    float* impA = (float*)(lds + AT_IA); float* impB = (float*)(lds + AT_IB);
    u32x4 kreg, vreg = (u32x4){0u, 0u, 0u, 0u};
    kreg = *(const u32x4*)(Kg + (size_t)(64 * jlo + key) * pitch + 8 * ch);
    if (MODE != 0) vreg = *(const u32x4*)(Vg + (size_t)(64 * jlo + key) * pitch + 8 * ch);
    *(u32x4*)(lds + AT_KB + (key * 72 + 8 * ch) * 2) = kreg;
    if (MODE != 0) *(u32x4*)(lds + AT_VB + (key * 72 + 8 * ch) * 2) = vreg;
    __syncthreads();
    const float NINF = -INFINITY;
    for (int jt = jlo; jt <= jhi; ++jt) {
        const int cb = (jt - jlo) & 1;
        if (jt < jhi) {
            kreg = *(const u32x4*)(Kg + (size_t)(64 * (jt + 1) + key) * pitch + 8 * ch);
            if (MODE != 0) vreg = *(const u32x4*)(Vg + (size_t)(64 * (jt + 1) + key) * pitch + 8 * ch);
        }
        const bf16_t* kb = (const bf16_t*)(lds + AT_KB + cb * 9216); const bf16_t* vb = (const bf16_t*)(lds + AT_VB + cb * 9216);
        bool nm;
        if (MODE <= 1) nm = (16 * (64 * jt + 63) + 31 > t0);
        else if (MODE == 2) nm = (jt == qb);
        else nm = (jt == qb) || (jt + 8 == qb);
#pragma unroll
        for (int sl = 0; sl < 2; ++sl) {
            float cinit = -m0l;
            if (MODE == 2) { const int selbit = (int)((jt < 64 ? (slo[sl] >> jt) : (shi[sl] >> (jt - 64))) & 1ull); if (!__any(selbit)) continue; if (!selbit) cinit = NINF; }
            SCHED_FENCE();
            f32x4 s[4];
#pragma unroll
            for (int kt = 0; kt < 4; ++kt) { s[kt] = (f32x4){cinit, cinit, cinit, cinit};
#pragma unroll
                for (int ks = 0; ks < 2; ++ks) { const bf16x8 a = ld8(kb + (16 * kt + l16) * 72 + 32 * ks + 8 * q4); s[kt] = mfma16(a, qf[sl][ks], s[kt]); } }
            if (nm) {
                const int t = ttok[sl];
#pragma unroll
                for (int kt = 0; kt < 4; ++kt)
#pragma unroll
                    for (int r = 0; r < 4; ++r) {
                        const int kk = 64 * jt + 16 * kt + 4 * q4 + r; bool valid;
                        if (MODE <= 1) valid = (16 * kk + 31 <= t);
                        else if (MODE == 2) valid = (kk <= t);
                        else valid = (kk <= t) && (kk + 512 > t);
                        s[kt][r] = valid ? s[kt][r] : NINF;
                    }
            }
            float psum = 0.f;
#pragma unroll
            for (int kt = 0; kt < 4; ++kt)
#pragma unroll
                for (int r = 0; r < 4; ++r) { float pv = exp2_fast(s[kt][r]); if (MODE == 1) pv *= linv[sl]; s[kt][r] = pv; psum += pv; }
            if (MODE != 1) lsum[sl] += psum;
            if (MODE == 1) {
#pragma unroll
                for (int kt = 0; kt < 4; ++kt) {
                    const float a = quad_sum(2.0f * (s[kt][0] + s[kt][1] + s[kt][2]) + s[kt][3]), bq = quad_sum(s[kt][3]);
                    if (hg == 0) { const int j = 16 * jt + 4 * kt + q4; const int tl = 8 * wave + 4 * sl + tau; impA[tl * 128 + j] = a; impB[tl * 128 + j] = bq; }
                }
            }
            SCHED_FENCE();
            if (MODE != 0) {
#pragma unroll
                for (int a2 = 0; a2 < 2; ++a2) {
                    const u32x4 pw = (u32x4){pk2(s[2 * a2][0], s[2 * a2][1]), pk2(s[2 * a2][2], s[2 * a2][3]), pk2(s[2 * a2 + 1][0], s[2 * a2 + 1][1]), pk2(s[2 * a2 + 1][2], s[2 * a2 + 1][3])};
                    const bf16x8 pf = __builtin_bit_cast(bf16x8, pw);
                    const bf16_t* vr = vb + (32 * a2 + 4 * q4 + (l16 >> 2)) * 72 + 4 * (l16 & 3);
#pragma unroll
                    for (int dt = 0; dt < 4; ++dt) {
                        const u32x2 lo = lds_tr16(vr + 16 * dt), hi = lds_tr16(vr + 16 * 72 + 16 * dt);
                        const bf16x8 a = __builtin_bit_cast(bf16x8, (u32x4){lo.x, lo.y, hi.x, hi.y});
                        oacc[sl][dt] = mfma16(a, pf, oacc[sl][dt]);
                    }
                }
            }
        }
        if (jt < jhi) {
            *(u32x4*)(lds + AT_KB + (cb ^ 1) * 9216 + (key * 72 + 8 * ch) * 2) = kreg;
            if (MODE != 0) *(u32x4*)(lds + AT_VB + (cb ^ 1) * 9216 + (key * 72 + 8 * ch) * 2) = vreg;
        }
        __syncthreads();
    }
}

DEV void attn_unit(const Params& p, unsigned char* lds, int b, int g, int qb, float m0c, float m0s, float m0w, int tid, int wave, int lane_) {
    LAUNDER_V(tid); const int lane = tid & 63; (void)lane_;
    unsigned char* ws = p.ws;
    const int l16 = lane & 15, q4 = lane >> 4, hg = lane & 3, tau = l16 >> 2; const int t0 = 64 * qb;
    const bf16_t* Q = (const bf16_t*)(ws + WS_Q); const bf16_t* QR = (const bf16_t*)(ws + WS_QR);
    const bf16_t* KC = (const bf16_t*)(ws + WS_KC) + (size_t)b * NCP * 128 + g * 64; const bf16_t* VC = (const bf16_t*)(ws + WS_VC) + (size_t)b * NCP * 128 + g * 64;
    const bf16_t* SL = (const bf16_t*)(ws + WS_SL) + (size_t)b * T_ * 256 + g * 64; const bf16_t* WN = (const bf16_t*)(ws + WS_WN) + (size_t)b * T_ * 256 + g * 64;
    const float* G = (const float*)(ws + WS_G);
    constexpr float LOG2E = 1.4426950408889634f;
    int ttok[2]; size_t rowg[2];
#pragma unroll
    for (int sl = 0; sl < 2; ++sl) { ttok[sl] = t0 + 8 * wave + 4 * sl + tau; rowg[sl] = (size_t)b * T_ + ttok[sl]; }
    const int h = 4 * g + hg;
    bf16x8 qf[2][2]; f32x4 oacc[2][4], outa[2][4]; float lsum[2] = {0.f, 0.f}, linv[2] = {0.f, 0.f};
    unsigned long long slo[2] = {0ull, 0ull}, shi[2] = {0ull, 0ull};
#pragma unroll
    for (int sl = 0; sl < 2; ++sl)
#pragma unroll
        for (int dt = 0; dt < 4; ++dt) { oacc[sl][dt] = (f32x4){0.f, 0.f, 0.f, 0.f}; outa[sl][dt] = (f32x4){0.f, 0.f, 0.f, 0.f}; }
#pragma unroll
    for (int sl = 0; sl < 2; ++sl)
#pragma unroll
        for (int ks = 0; ks < 2; ++ks) qf[sl][ks] = ld8(Q + rowg[sl] * 512 + h * 64 + 32 * ks + 8 * q4);
    const int ncmp = 4 * qb + 3;
    const int jhc = (ncmp - 1) >> 6;
    attn_pass<0>(KC, VC, 128, 0, jhc, lds, qf, oacc, lsum, linv, m0c * LOG2E, ttok, slo, shi, t0, qb, tid, wave, lane);
#pragma unroll
    for (int sl = 0; sl < 2; ++sl) { float L = lsum[sl]; L += __shfl_xor(L, 16); L += __shfl_xor(L, 32); linv[sl] = L > 0.f ? 1.0f / L : 0.f; lsum[sl] = 0.f; }
    attn_pass<1>(KC, VC, 128, 0, jhc, lds, qf, oacc, lsum, linv, m0c * LOG2E, ttok, slo, shi, t0, qb, tid, wave, lane);
#pragma unroll
    for (int sl = 0; sl < 2; ++sl) { const float gt = G[rowg[sl] * 32 + 3 * h + 0];
#pragma unroll
        for (int dt = 0; dt < 4; ++dt) { outa[sl][dt] = oacc[sl][dt] * gt; oacc[sl][dt] = (f32x4){0.f, 0.f, 0.f, 0.f}; } }
    {
        const float* impA = (const float*)(lds + AT_IA); const float* impB = (const float*)(lds + AT_IB); unsigned long long* sel = (unsigned long long*)(lds + AT_SEL);
        const unsigned long long lt_mask = (1ull << lane) - 1ull;
        for (int tk = 0; tk < 8; ++tk) {
            const int tl = 8 * wave + tk; const float* ia = impA + tl * 128; const float* ib = impB + tl * 128;
            const int j0 = lane, j1 = lane + 64;
            unsigned k0 = 0u, k1 = 0u;
            if (j0 <= qb) k0 = ((j0 == 0 || j0 == qb || j0 == qb - 1) ? 0x7f800000u : __builtin_bit_cast(unsigned, ia[j0] + ib[j0 - 1])) + 1u;
            if (j1 <= qb) k1 = ((j1 == qb || j1 == qb - 1) ? 0x7f800000u : __builtin_bit_cast(unsigned, ia[j1] + ib[j1 - 1])) + 1u;
            unsigned th = 0u;
            for (int bit = 31; bit >= 0; --bit) {
                const unsigned cand = th | (1u << bit);
                const int cnt = __builtin_popcountll(__ballot(k0 >= cand)) + __builtin_popcountll(__ballot(k1 >= cand));
                if (cnt >= 16) th = cand;
            }
            const unsigned long long g0 = __ballot(k0 > th), g1 = __ballot(k1 > th), e0 = __ballot(k0 == th), e1 = __ballot(k1 == th);
            const int need = (th == 0u) ? 0 : 16 - __builtin_popcountll(g0) - __builtin_popcountll(g1);
            const int n0 = __builtin_popcountll(e0);
            const bool s0 = (k0 > th) || (k0 == th && __builtin_popcountll(e0 & lt_mask) < need);
            const bool s1 = (k1 > th) || (k1 == th && n0 + __builtin_popcountll(e1 & lt_mask) < need);
            const unsigned long long m0 = __ballot(s0), m1 = __ballot(s1);
            if (lane == 0) { sel[tl * 2] = m0; sel[tl * 2 + 1] = m1; }
        }
    }
    __syncthreads();
    {
        const unsigned long long* sel = (const unsigned long long*)(lds + AT_SEL);
#pragma unroll
        for (int sl = 0; sl < 2; ++sl) { const int tl = 8 * wave + 4 * sl + tau; slo[sl] = sel[tl * 2]; shi[sl] = sel[tl * 2 + 1]; }
    }
    float* outl = (float*)(lds + AT_IA) + tid;
#pragma unroll
    for (int sl = 0; sl < 2; ++sl)
#pragma unroll
        for (int dt = 0; dt < 4; ++dt)
#pragma unroll
            for (int r = 0; r < 4; ++r) outl[(sl * 16 + dt * 4 + r) * 512] = outa[sl][dt][r];
#pragma unroll
    for (int sl = 0; sl < 2; ++sl)
#pragma unroll
        for (int ks = 0; ks < 2; ++ks) qf[sl][ks] = ld8(QR + rowg[sl] * 512 + h * 64 + 32 * ks + 8 * q4);
    attn_pass<2>(SL, SL + 128, 256, 0, qb, lds, qf, oacc, lsum, linv, m0s * LOG2E, ttok, slo, shi, t0, qb, tid, wave, lane);
#pragma unroll
    for (int sl = 0; sl < 2; ++sl) { float L = lsum[sl]; L += __shfl_xor(L, 16); L += __shfl_xor(L, 32); const float sc = (L > 0.f ? 1.0f / L : 0.f) * G[rowg[sl] * 32 + 3 * h + 1]; lsum[sl] = 0.f;
#pragma unroll
        for (int dt = 0; dt < 4; ++dt) {
#pragma unroll
            for (int r = 0; r < 4; ++r) outl[(sl * 16 + dt * 4 + r) * 512] += oacc[sl][dt][r] * sc;
            oacc[sl][dt] = (f32x4){0.f, 0.f, 0.f, 0.f}; } }
    attn_pass<3>(WN, WN + 128, 256, qb >= 8 ? qb - 8 : 0, qb, lds, qf, oacc, lsum, linv, m0w * LOG2E, ttok, slo, shi, t0, qb, tid, wave, lane);
#pragma unroll
    for (int sl = 0; sl < 2; ++sl) { float L = lsum[sl]; L += __shfl_xor(L, 16); L += __shfl_xor(L, 32); const float sc = (L > 0.f ? 1.0f / L : 0.f) * G[rowg[sl] * 32 + 3 * h + 2];
#pragma unroll
        for (int dt = 0; dt < 4; ++dt)
#pragma unroll
            for (int r = 0; r < 4; ++r) outa[sl][dt][r] = outl[(sl * 16 + dt * 4 + r) * 512] + oacc[sl][dt][r] * sc; }
    const bf16_t* ZA = (const bf16_t*)(ws + WS_ZA); bf16_t* MIX = (bf16_t*)(ws + WS_MIX);
#pragma unroll
    for (int sl = 0; sl < 2; ++sl)
#pragma unroll
        for (int dt = 0; dt < 4; ++dt) {
            const int col = h * 64 + 16 * dt + 4 * q4; const u32x2 zv = *(const u32x2*)(ZA + rowg[sl] * 512 + col);
            float o[4];
#pragma unroll
            for (int r = 0; r < 4; ++r) { const unsigned w = zv[r >> 1]; o[r] = outa[sl][dt][r] * bf2f((r & 1) ? (w >> 16) : (w & 0xffffu)); }
            *(u32x2*)(MIX + rowg[sl] * 1024 + col) = (u32x2){pk2(o[0], o[1]), pk2(o[2], o[3])};
        }
    __syncthreads();
}

DEV void p4_attention(const Params& p, unsigned char* lds, int vcu, int G, int tid, int wave, int lane) {
    const float gq = wave_max(fabsf(p.in[I_QNG][lane])), gc = wave_max(fabsf(p.in[I_KCNG][lane])), gs = wave_max(fabsf(p.in[I_KSNG][lane])), gw = wave_max(fabsf(p.in[I_KWNG][lane]));
    const float m0c = 8.2f * gq * gc, m0s = 8.2f * gq * gs, m0w = 8.2f * gq * gw;
    for (int i = 0;; ++i) {
        const long L = (long)i * G + vcu; if (L >= AT_UNITS) break;
        const int per = B_ * NGRP * 16;
        const int k = (int)(L / per), v = (int)(L % per), bg = v >> 4, s = v & 15;
        const int nrounds = NSB / 16;
        const int qb = 32 * (k >> 1) + ((k & 1) ? 31 - s : s);
        (void)nrounds;
        attn_unit(p, lds, bg / NGRP, bg % NGRP, qb, m0c, m0s, m0w, tid, wave, lane);
    }
}

#ifndef CPU_EMU
#define GAS __attribute__((address_space(1)))
#define LAS __attribute__((address_space(3)))
#define XB_TMO      128
#define XB_XCNT(j)  (256  + 64 * (j))
#define XB_XSUB(j)  (1280 + 64 * (j))
#define XB_XGEN(j)  (2304 + 64 * (j))
#define XB_TOP      3328
#define XB_TOPGEN   3392
#define XCD_BAR_WORDS 3456
#define XB_SPIN_CAP (1u << 20)
__device__ __forceinline__ unsigned xb_ld(unsigned* p)              { return __hip_atomic_load(p, __ATOMIC_RELAXED, __HIP_MEMORY_SCOPE_AGENT); }
__device__ __forceinline__ unsigned xb_add(unsigned* p, unsigned v) { return __hip_atomic_fetch_add(p, v, __ATOMIC_RELAXED, __HIP_MEMORY_SCOPE_AGENT); }
__device__ __forceinline__ unsigned xb_xcc_id() { return (unsigned)__builtin_amdgcn_s_getreg((3 << 11) | 20) & 0xFu; }
#define XB_SPIN(cond, bar) do { unsigned _sp = 0; while (cond) { __builtin_amdgcn_s_sleep(1); \
    if ((++_sp & 255u) == 0u) { if (xb_ld(&(bar)[XB_TMO])) break; if (_sp > XB_SPIN_CAP) { atomicAdd(&(bar)[XB_TMO], 1u); break; } } } } while (0)
struct XcdBarrier { unsigned* bar; unsigned x; volatile LAS unsigned* st; };
__device__ __forceinline__ XcdBarrier xcd_barrier_post(unsigned* bar, volatile LAS unsigned* st) {
    XcdBarrier b; b.bar = bar; b.x = xb_xcc_id(); b.st = st;
    if (threadIdx.x == 0) (void)xb_add(&bar[XB_XCNT(b.x)], 1u);
    return b;
}
__device__ __forceinline__ void xcd_barrier_complete(unsigned* bar, unsigned x, unsigned& nloc, unsigned& nx) {
    const unsigned G = gridDim.x * gridDim.y * gridDim.z;
    unsigned sum, cnt, mine, sp = 0u;
    for (;;) {
        sum = 0u; cnt = 0u; mine = 0u;
#pragma unroll
        for (unsigned j = 0; j < 16; ++j) { const unsigned c = xb_ld(&bar[XB_XCNT(j)]); sum += c; cnt += (c > 0u) ? 1u : 0u; mine = (j == x) ? c : mine; }
        if (sum == G) break;
        __builtin_amdgcn_s_sleep(1);
        if ((++sp & 255u) == 0u) { if (xb_ld(&bar[XB_TMO])) break; if (sp > XB_SPIN_CAP) { atomicAdd(&bar[XB_TMO], 1u); break; } }
    }
    nloc = mine > 0u ? mine : 1u; nx = cnt > 0u ? cnt : 1u;
}
__device__ __forceinline__ void xcd_barrier(const XcdBarrier& b) {
    asm volatile("s_waitcnt vmcnt(0)" ::: "memory");
    __syncthreads();
    if (threadIdx.x == 0) {
        unsigned* bar = b.bar;
        __builtin_amdgcn_s_waitcnt(0);
        unsigned nloc = b.st[0], nx = b.st[1];
        if (nloc == 0u) { xcd_barrier_complete(bar, b.x, nloc, nx); b.st[0] = nloc; b.st[1] = nx; }
        const unsigned old = xb_add(&bar[XB_XSUB(b.x)], 1u);
        const unsigned gen = old / nloc;
        if (old + 1u == (gen + 1u) * nloc) {
            __builtin_amdgcn_fence(__ATOMIC_RELEASE, "agent");
            asm volatile("s_waitcnt vmcnt(0)" ::: "memory");
            const unsigned og = xb_add(&bar[XB_TOP], 1u);
            const unsigned tg = og / nx;
            if (og + 1u == (tg + 1u) * nx) xb_add(&bar[XB_TOPGEN], 1u);
            else XB_SPIN(xb_ld(&bar[XB_TOPGEN]) == tg, bar);
            __builtin_amdgcn_fence(__ATOMIC_ACQUIRE, "agent");
            xb_add(&bar[XB_XGEN(b.x)], 1u);
            asm volatile("s_waitcnt vmcnt(0)" ::: "memory");
        } else {
            XB_SPIN(xb_ld(&bar[XB_XGEN(b.x)]) == gen, bar);
            __builtin_amdgcn_fence(__ATOMIC_ACQUIRE, "agent");
            asm volatile("s_waitcnt vmcnt(0)" ::: "memory");
        }
    }
    __syncthreads();
}
#endif

constexpr int N_PHASES = 6;
__global__ void __launch_bounds__(512, 2) fwd_kernel(Params p) {
#ifdef CPU_EMU
    unsigned char* lds = emu_smem;
#else
    extern __shared__ __attribute__((aligned(16))) unsigned char lds[];
#endif
    const int tid = threadIdx.x, lane = tid & 63, wave = WAVE_ID();
    const int G = gridDim.x; const int bx = blockIdx.x; const int vcu = (G % 8 == 0) ? (bx % 8) * (G / 8) + bx / 8 : bx;
#ifndef CPU_EMU
    for (int u = tid; u < 64; u += 512) ((LAS unsigned*)(lds + MISC_OFF))[u] = 0u;
    __syncthreads();
    XcdBarrier bar; bar.bar = (unsigned*)(p.ws + WS_CTL) + 1024 + p.li * XCD_BAR_WORDS; bar.x = 0; bar.st = nullptr;
    if (p.ph_hi - p.ph_lo > 1) bar = xcd_barrier_post(bar.bar, (volatile LAS unsigned*)(lds + MISC_OFF) + 8);
#define GRID_BAR() xcd_barrier(bar)
#else
#define GRID_BAR() do { } while (0)
#endif
    const int lo = p.ph_lo, hi = p.ph_hi;
#ifndef PHASE_MASK
#define PHASE_MASK 63
#endif
#define IN(k) (((PHASE_MASK >> (k)) & 1) && lo <= (k) && (k) < hi)
#define BOTH(k) (IN(k) && IN((k) + 1))
#ifndef REP_PHASE
#define REP_PHASE -1
#endif
#define REPS(k) for (int rep_ = 0; rep_ < ((k) == REP_PHASE ? 2 : 1); ++rep_)
    if (IN(0)) { REPS(0) { p0_prologue(p, lds, vcu, G, tid, wave, lane); __syncthreads(); } if (BOTH(0)) GRID_BAR(); }
    if (IN(1)) { REPS(1) p1_norm(p, vcu, G, wave, lane); if (BOTH(1)) GRID_BAR(); }
    if (IN(2)) {
        pg8::Gemm g{(const bf16_t*)(p.ws + WS_HN), (const bf16_t*)(p.ws + WS_WIN), M_, INP, 1024}; pg8::StaticOrder S; S.init(M_, INP, G, bx);
        EpiInProj E{p.ws, p.in[I_QNG], p.in[I_KSNG], p.in[I_KWNG]};
        REPS(2) pg8::gemm_phase<EpiInProj, pg8::StaticOrder, true, true>(PG8_PTR(lds), g, S, E);
        if (BOTH(2)) GRID_BAR();
    }
    if (IN(3)) {
        REPS(3) for (int u = vcu; u < B_ * SSM_NG; u += G) ssm_unit(p, lds, u, tid, wave, lane);
        REPS(6) for (int u = vcu; u < CMP_UNITS; u += G) compress_unit(p, lds, u, tid, wave, lane);
        if (BOTH(3)) GRID_BAR();
    }
    if (IN(4)) {
        REPS(4) p4_attention(p, lds, vcu, G, tid, wave, lane);
        pg8::Gemm g{(const bf16_t*)(p.ws + WS_YG), (const bf16_t*)(p.ws + WS_WGLU), M_, 512, 512}; pg8::StaticOrder S; S.init(M_, 512, G, bx);
        EpiGlu E{(const bf16_t*)(p.ws + WS_YG), (const bf16_t*)(p.ws + WS_ZS), (bf16_t*)(p.ws + WS_MIX), p.in[I_GLUB]};
        REPS(7) pg8::gemm_phase<EpiGlu, pg8::StaticOrder, true, true>(PG8_PTR(lds), g, S, E);
        if (BOTH(4)) GRID_BAR();
    }
    if (IN(5)) {
        pg8::Gemm g{(const bf16_t*)(p.ws + WS_MIX), (const bf16_t*)(p.ws + WS_WO), M_, 1024, 1024}; pg8::StaticOrder S; S.init(M_, 1024, G, bx);
        EpiOut E{p.in[I_X], p.out, (const float*)(p.ws + WS_MOD)};
        REPS(5) pg8::gemm_phase<EpiOut, pg8::StaticOrder, true, true>(PG8_PTR(lds), g, S, E);
    }
#undef IN
#undef BOTH
}

extern "C" void kernel_launch(void* const* d_in, const int* in_sizes, int n_in, void* d_out, int out_size, void* d_ws, size_t ws_size, hipStream_t stream) {
    static int grid = 0;
    if (grid == 0) {
        if (n_in != N_IN || out_size != M_ * D_ || ws_size < WS_END) { fprintf(stderr, "kernel_launch: unexpected shapes (n_in %d out %d ws %zu need %zu)\n", n_in, out_size, ws_size, (size_t)WS_END); grid = -1; return; }
#ifdef CPU_EMU
        grid = EMU_GRID;
#else
        int dev = 0, cus = 0, per_cu = 0;
        if (hipGetDevice(&dev) != hipSuccess || hipDeviceGetAttribute(&cus, hipDeviceAttributeMultiprocessorCount, dev) != hipSuccess) { grid = -1; return; }
        if (hipFuncSetAttribute((const void*)fwd_kernel, hipFuncAttributeMaxDynamicSharedMemorySize, LDS_BYTES) != hipSuccess) { fprintf(stderr, "kernel_launch: hipFuncSetAttribute failed\n"); grid = -1; return; }
        if (hipOccupancyMaxActiveBlocksPerMultiprocessor(&per_cu, (const void*)fwd_kernel, 512, LDS_BYTES) != hipSuccess || per_cu < 1) { fprintf(stderr, "kernel_launch: occupancy query says %d blocks per CU\n", per_cu); per_cu = 1; }
        (void)hipGetLastError();
        grid = cus;
#endif
    }
    if (grid < 0) return;
    (void)hipMemsetAsync((char*)d_ws + WS_CTL, 0, CTL_ZERO_BYTES, stream);
    Params a{};
    for (int i = 0; i < N_IN; ++i) a.in[i] = (const float*)d_in[i];
    a.out = (float*)d_out; a.ws = (unsigned char*)d_ws;
    for (int li = 0; li < N_LAUNCH; ++li) {
        a.ph_lo = (N_LAUNCH == 1) ? 0 : li; a.ph_hi = (N_LAUNCH == 1) ? N_PHASES : li + 1; a.li = 0;
#ifdef CPU_EMU
        emu_launch((unsigned)grid, 512u, [&]() { fwd_kernel(a); });
#else
        hipLaunchKernelGGL(fwd_kernel, dim3(grid), dim3(512), LDS_BYTES, stream, a);
#endif
    }
}
```

```cpp
#ifndef CPU_EMU
#include <hip/hip_runtime.h>
#endif
#include <cstdio>
#include <cstdint>
#include <cmath>

#ifndef BATCH_N
#define BATCH_N 8
#endif
#ifndef SEQ_LEN
#define SEQ_LEN 8192
#endif
#ifndef N_LAUNCH
#define N_LAUNCH 1
#endif
#define DEV __device__ __forceinline__

typedef unsigned short bf16_t;
typedef short bf16x8 __attribute__((ext_vector_type(8)));
typedef float f32x4 __attribute__((ext_vector_type(4)));
typedef float f32x16 __attribute__((ext_vector_type(16)));
typedef float f32x2 __attribute__((ext_vector_type(2)));
typedef unsigned u32x4 __attribute__((ext_vector_type(4)));
typedef unsigned u32x2 __attribute__((ext_vector_type(2)));

constexpr int B_ = BATCH_N, T_ = SEQ_LEN, D_ = 1024, M_ = B_ * T_;
constexpr int NH = 8, HD = 64, NGRP = 2;
constexpr int NCMP = (T_ - 32) / 16 + 1;
constexpr int NCP = T_ / 16;
constexpr int NSB = T_ / 64;
constexpr int INW = 2840, INP = 3072;
constexpr int SSM_NG = 32, SSM_P = 64, SSM_C = 16, SSM_W = 512;
constexpr int SSM_L = 64;
constexpr int SSM_CG = 32;
constexpr int SSM_NCG = T_ / (SSM_L * SSM_CG);
constexpr float EPS_ = 1e-6f;
static_assert(T_ % 2048 == 0 && NSB <= 128, "shape assumptions");

enum { I_X = 0, I_C, I_WADA, I_BADA, I_NORMG, I_WIN, I_QNG, I_KCNG, I_KSNG, I_KWNG, I_POSK, I_POSV, I_W1K, I_W2K, I_W1V, I_W2V,
       I_ARE, I_AIM, I_LOGDT, I_BRE, I_BIM, I_CRE, I_CIM, I_SSMD, I_GLUW, I_GLUB, I_WOUT, N_IN };

constexpr size_t MiB = 1u << 20;
constexpr size_t al(size_t x) { return (x + MiB - 1) / MiB * MiB; }
constexpr size_t WS_CTL = 0, CTL_ZERO_BYTES = 64 * 1024;
constexpr size_t WS_MOD = 1 * MiB;
constexpr size_t WS_ROPE = WS_MOD + al((size_t)B_ * 3072 * 4);
constexpr size_t WS_CPOS = WS_CTL + 24576;
constexpr size_t WS_LAM64 = WS_ROPE + al((size_t)T_ * 64 * 4);
constexpr size_t WS_KT = WS_LAM64 + MiB;
constexpr size_t WS_WST = WS_KT + al((size_t)32 * 65 * 256 * 2);
constexpr size_t WS_WOUTS = WS_WST + al((size_t)32 * 128 * 1024 * 2);
constexpr size_t WS_WIN = WS_WOUTS + al((size_t)32 * 1024 * 128 * 2);
constexpr size_t WS_WO = WS_WIN + al((size_t)INP * 1024 * 2);
constexpr size_t WS_WGLU = WS_WO + al((size_t)1024 * 1024 * 2);
constexpr size_t WS_W1K = WS_WGLU + MiB, WS_W1V = WS_W1K + MiB;
constexpr size_t WS_W2K = WS_W1V + MiB, WS_W2V = WS_W2K + 64 * 1024;
constexpr size_t WS_KC = WS_W2K + MiB;
constexpr size_t WS_VC = WS_KC + al((size_t)B_ * NCP * 128 * 2);
constexpr size_t WS_G = WS_VC + al((size_t)B_ * NCP * 128 * 2);
constexpr size_t WS_HN = WS_G + al((size_t)M_ * 32 * 4);
constexpr size_t WS_Q = WS_HN + al((size_t)M_ * 1024 * 2);
constexpr size_t WS_QR = WS_Q + al((size_t)M_ * 512 * 2);
constexpr size_t WS_CR = WS_QR + al((size_t)M_ * 512 * 2);
constexpr size_t WS_SL = WS_CR + al((size_t)M_ * 256 * 2);
constexpr size_t WS_WN = WS_SL + al((size_t)M_ * 256 * 2);
constexpr size_t WS_ZA = WS_WN + al((size_t)M_ * 256 * 2);
constexpr size_t WS_U = WS_ZA + al((size_t)M_ * 512 * 2);
constexpr size_t WS_ZS = WS_U + al((size_t)M_ * 512 * 2);
constexpr size_t WS_YG = WS_ZS + al((size_t)M_ * 512 * 2);
constexpr size_t WS_MIX = WS_YG + al((size_t)M_ * 512 * 2);
constexpr size_t WS_VT = WS_MIX + al((size_t)M_ * 1024 * 2);
constexpr size_t WS_KF = WS_VT + al((size_t)M_ * 128 * 2);
constexpr size_t WS_END = WS_KF + al((size_t)M_ * 128 * 2);

constexpr int RING_BYTES = 131072;
constexpr int LDS_BYTES = 155648;
constexpr int MISC_OFF = LDS_BYTES - 256;

DEV unsigned f2bf(float f) { unsigned u = __builtin_bit_cast(unsigned, f); return (u + 0x7fffu + ((u >> 16) & 1u)) >> 16; }
DEV float bf2f(unsigned h) { return __builtin_bit_cast(float, h << 16); }
#ifdef CPU_EMU
DEV unsigned pk2(float lo, float hi) { return f2bf(lo) | (f2bf(hi) << 16); }
DEV float exp2_fast(float x) { return exp2f(x); }
DEV float rcp_fast(float x) { return 1.0f / x; }
DEV float log2_fast(float x) { return log2f(x); }
DEV int f2i_rn(float x) { return (int)floorf(x + 0.5f); }
DEV f32x4 mfma16(bf16x8 a, bf16x8 b, f32x4 c) { return emu_mfma16(a, b, c); }
DEV f32x16 mfma32(bf16x8 a, bf16x8 b, f32x16 c) { return emu_mfma32(a, b, c); }
#define WAVE_ID() ((int)(threadIdx.x >> 6))
#else
typedef __bf16 bf16x2_t __attribute__((ext_vector_type(2)));
DEV unsigned pk2(float lo, float hi) { f32x2 v = {lo, hi}; bf16x2_t b = __builtin_convertvector(v, bf16x2_t); return __builtin_bit_cast(unsigned, b); }
DEV float exp2_fast(float x) { return __builtin_amdgcn_exp2f(x); }
DEV float rcp_fast(float x) { return __builtin_amdgcn_rcpf(x); }
DEV float log2_fast(float x) { return __builtin_amdgcn_logf(x); }
DEV int f2i_rn(float x) { int r; asm("v_cvt_rpi_i32_f32 %0, %1" : "=v"(r) : "v"(x)); return r; }
DEV f32x4 mfma16(bf16x8 a, bf16x8 b, f32x4 c) { return __builtin_amdgcn_mfma_f32_16x16x32_bf16(a, b, c, 0, 0, 0); }
DEV f32x16 mfma32(bf16x8 a, bf16x8 b, f32x16 c) { return __builtin_amdgcn_mfma_f32_32x32x16_bf16(a, b, c, 0, 0, 0); }
#define WAVE_ID() (__builtin_amdgcn_readfirstlane((int)(threadIdx.x >> 6)))
#endif
#ifdef CPU_EMU
#define EXPF(x) expf(x)
#else
#define EXPF(x) __expf(x)
#endif
DEV float silu_f(float v) { return v * rcp_fast(1.0f + EXPF(-v)); }
DEV float sigmoid_f(float v) { return rcp_fast(1.0f + EXPF(-v)); }
DEV float gelu_tanh_f(float v) { const float u = 0.7978845608028654f * (v + 0.044715f * v * v * v); const float e = EXPF(2.0f * u); return v * (1.0f - rcp_fast(e + 1.0f)); }
DEV float wave_sum(float v) {
#pragma unroll
    for (int o = 1; o < 64; o <<= 1) v += __shfl_xor(v, o);
    return v;
}
DEV float wave_max(float v) {
#pragma unroll
    for (int o = 1; o < 64; o <<= 1) v = fmaxf(v, __shfl_xor(v, o));
    return v;
}
DEV bf16x8 ld8(const bf16_t* p) { return *(const bf16x8*)p; }
namespace pg8 {
#define PG8_LAS __attribute__((address_space(3)))
typedef unsigned short bf16_t;
typedef short bf16x8 __attribute__((ext_vector_type(8)));
typedef float f32x4 __attribute__((ext_vector_type(4)));
typedef unsigned u32x4 __attribute__((ext_vector_type(4)));
constexpr int BM = 256, BK = 64, HALF = 128, HTB = HALF * BK * 2  , STAGE_BYTES = 8 * HTB, NXCD = 8, WGM = 8;

__host__ __device__ __forceinline__ int lds_byte(int r, int c) { const int st = (r >> 4) * 2 + (c >> 5), rr = r & 15, cc = c & 31, ob = rr * 64 + cc * 2; return st * 1024 + (ob ^ (((ob >> 9) & 1) << 5)); }
__host__ __device__ __forceinline__ void stage_rc(int b, int& R, int& C) { const int st = b / 1024, sb = b % 1024, swz = sb ^ (((sb >> 9) & 1) << 5); R = (st >> 1) * 16 + swz / 64; C = (st & 1) * 32 + (swz % 64) / 2; }
__host__ __device__ __forceinline__ int perm32(int rho) { const int n = rho >> 4, i = rho & 15; return 8 * (i >> 2) + 4 * n + (i & 3); }

struct Unit { int pm, pn; };
struct Gemm { const bf16_t* A; const bf16_t* Bt; int M, N, K; };

struct StaticOrder {
    int nM, nN, nwg, G, c;
    __host__ __device__ void init(int M, int N, int G_, int c_) { nM = M / BM; nN = N / BM; nwg = nM * nN; G = G_; c = c_; }
    __host__ __device__ bool next(int i, Unit& u) const {
        const long L = (long)i * G + c; if (L >= nwg) return false;
        int wgid = (int)L; { const int q = nwg / NXCD, r = nwg % NXCD, xcd = wgid % NXCD, off = wgid / NXCD; wgid = (xcd < r ? xcd * (q + 1) : r * (q + 1) + (xcd - r) * q) + off; }
        const int nig = WGM * nN, gid = wgid / nig, fm = gid * WGM, gsz = (nM - fm) < WGM ? (nM - fm) : WGM;
        u.pm = fm + ((wgid % nig) % gsz); u.pn = (wgid % nig) / gsz; return true;
    }
    __device__ __forceinline__ void a_ready(const Unit&) const {}
    __device__ __forceinline__ void done(const Unit&) const {}
};

#ifndef CPU_EMU
__device__ __forceinline__ unsigned cvt_pk_bf16(float lo, float hi) { unsigned r; asm volatile("v_cvt_pk_bf16_f32 %0, %1, %2" : "=v"(r) : "v"(lo), "v"(hi)); return r; }
template <class Epi, class Sched, bool ALIGN_EPI = false, bool SP2 = false>
__device__ __forceinline__ void gemm_phase(PG8_LAS unsigned char* lds, const Gemm g, const Sched& S, const Epi& E) {
    const int tid = threadIdx.x, wid = __builtin_amdgcn_readfirstlane(tid >> 6), lane = tid & 63, wr = wid >> 2, wc = wid & 3, fr = lane & 15, fq = lane >> 4;
    const int K = g.K, nt = K / BK;
    unsigned voffA[2], voffB[2];
#pragma unroll
    for (int i = 0; i < 2; ++i) { int R, C; stage_rc(tid * 16 + i * 8192, R, C); const int Rb = Epi::PERM ? ((R & ~31) + perm32(R & 31)) : R;
        voffA[i] = (unsigned)(R * K + C) * 2u; voffB[i] = (unsigned)(Rb * K + C) * 2u; }
    const size_t kstep = (size_t)(BK * 2);
    const size_t hstep = (size_t)HALF * K * 2;
    const size_t tstep = 2 * hstep;
    const unsigned ldsw = (unsigned)wid * 1024u;
    const int aoff = lds_byte(wr * 64 + fr, fq * 8), boff = lds_byte(wc * 32 + fr, fq * 8);
#define PG8_SA(b, h) (((b) * 2 + (h)) * HTB)
#define PG8_SB(b, h) ((4 + (b) * 2 + (h)) * HTB)
#define PG8_STAGE(bufoff, gbase, voff) do { _Pragma("unroll") for (int _i = 0; _i < 2; ++_i) \
        __builtin_amdgcn_global_load_lds((const unsigned*)((const char*)(gbase) + (voff)[_i]), (PG8_LAS unsigned*)(lds + (bufoff) + ldsw + _i * 8192), 16, 0, 0); } while (0)
#define PG8_LDA(dst, b, h) do { _Pragma("unroll") for (int m = 0; m < 4; ++m) _Pragma("unroll") for (int k = 0; k < 2; ++k) dst[m][k] = *(const PG8_LAS bf16x8*)(lds + PG8_SA(b, h) + aoff + m * 2048 + k * 1024); } while (0)
#define PG8_LDB(dst, b, h) do { _Pragma("unroll") for (int n = 0; n < 2; ++n) _Pragma("unroll") for (int k = 0; k < 2; ++k) dst[n][k] = *(const PG8_LAS bf16x8*)(lds + PG8_SB(b, h) + boff + n * 2048 + k * 1024); } while (0)
#define PG8_MMA(ai, bj, At, Bt) do { __builtin_amdgcn_s_setprio(1); _Pragma("unroll") for (int m = 0; m < 4; ++m) _Pragma("unroll") for (int n = 0; n < 2; ++n) _Pragma("unroll") for (int k = 0; k < 2; ++k) \
        acc[ai][bj][m][n] = __builtin_amdgcn_mfma_f32_16x16x32_bf16(Bt[n][k], At[m][k], acc[ai][bj][m][n], 0, 0, 0); __builtin_amdgcn_s_setprio(0); } while (0)
#define PG8_WAIT_V(n) asm volatile("s_waitcnt vmcnt(" #n ")" ::: "memory")
#define PG8_WAIT_L(n) asm volatile("s_waitcnt lgkmcnt(" #n ")" ::: "memory")
#define PG8_BAR __builtin_amdgcn_s_barrier()
#define PG8_SCHED __builtin_amdgcn_sched_barrier(0)
    Unit cur, nxt; int ui = 0;
    if (!S.next(0, cur)) return;
    f32x4 acc[2][2][4][2];
#pragma unroll
    for (int a = 0; a < 2; ++a)
#pragma unroll
        for (int b = 0; b < 2; ++b)
#pragma unroll
            for (int m = 0; m < 4; ++m)
#pragma unroll
                for (int n = 0; n < 2; ++n) acc[a][b][m][n] = (f32x4){0.f, 0.f, 0.f, 0.f};
    bf16x8 At[4][2], B0[2][2], B1[2][2];
    const char* cA = (const char*)g.A + (size_t)cur.pm * tstep; const char* cB = (const char*)g.Bt + (size_t)cur.pn * tstep;
    S.a_ready(cur);
    if constexpr (SP2) {
        PG8_STAGE(PG8_SB(0, 0), cB, voffB); PG8_STAGE(PG8_SB(0, 1), cB + hstep, voffB); PG8_STAGE(PG8_SA(0, 0), cA, voffA); PG8_STAGE(PG8_SA(0, 1), cA + hstep, voffA);
        if (wr == 1) PG8_BAR;
        PG8_WAIT_V(2); PG8_BAR;
        PG8_STAGE(PG8_SB(1, 0), cB + kstep, voffB); PG8_STAGE(PG8_SA(1, 0), cA + kstep, voffA); PG8_STAGE(PG8_SB(1, 1), cB + hstep + kstep, voffB);
        PG8_WAIT_V(6); PG8_BAR;
    } else {
        PG8_STAGE(PG8_SB(0, 0), cB, voffB); PG8_STAGE(PG8_SA(0, 0), cA, voffA); PG8_STAGE(PG8_SB(0, 1), cB + hstep, voffB); PG8_STAGE(PG8_SA(0, 1), cA + hstep, voffA);
        if (wr == 1) PG8_BAR;
        PG8_WAIT_V(4); PG8_BAR;
        PG8_STAGE(PG8_SB(1, 0), cB + kstep, voffB); PG8_STAGE(PG8_SA(1, 0), cA + kstep, voffA); PG8_STAGE(PG8_SB(1, 1), cB + hstep + kstep, voffB);
        PG8_WAIT_V(6); PG8_BAR;
    }
    for (;;) {
        const bool has_next = S.next(ui + 1, nxt);
        const char* nA = has_next ? (const char*)g.A + (size_t)nxt.pm * tstep : cA; const char* nB = has_next ? (const char*)g.Bt + (size_t)nxt.pn * tstep : cB;
        for (int t = 0; t < nt; t += 2) {
            const bool last = (t == nt - 2);
            const char* a1 = cA + (size_t)(t + 1) * kstep;
            const char* a2 = last ? nA : cA + (size_t)(t + 2) * kstep; const char* b2 = last ? nB : cB + (size_t)(t + 2) * kstep;
            const char* a3 = a2 + kstep; const char* b3 = b2 + kstep;
            if (last && has_next) S.a_ready(nxt);
            if constexpr (SP2) {
            PG8_LDB(B0, 0, 0); PG8_LDB(B1, 0, 1); PG8_SCHED; PG8_LDA(At, 0, 0); PG8_STAGE(PG8_SA(1, 1), a1 + hstep, voffA);
            PG8_WAIT_V(8); PG8_WAIT_L(0); PG8_BAR; PG8_MMA(0, 0, At, B0); PG8_MMA(0, 1, At, B1); PG8_BAR; PG8_SCHED;
            PG8_LDA(At, 0, 1); PG8_STAGE(PG8_SB(0, 0), b2, voffB); PG8_STAGE(PG8_SB(0, 1), b2 + hstep, voffB); PG8_STAGE(PG8_SA(0, 0), a2, voffA);
            PG8_WAIT_V(8); PG8_WAIT_L(0); PG8_BAR; PG8_MMA(1, 0, At, B0); PG8_MMA(1, 1, At, B1); PG8_BAR; PG8_SCHED;
            PG8_LDB(B0, 1, 0); PG8_LDB(B1, 1, 1); PG8_SCHED; PG8_LDA(At, 1, 0); PG8_STAGE(PG8_SA(0, 1), a2 + hstep, voffA);
            PG8_WAIT_V(8); PG8_WAIT_L(0); PG8_BAR; PG8_MMA(0, 0, At, B0); PG8_MMA(0, 1, At, B1); PG8_BAR; PG8_SCHED;
            PG8_LDA(At, 1, 1); PG8_STAGE(PG8_SB(1, 0), b3, voffB); PG8_STAGE(PG8_SB(1, 1), b3 + hstep, voffB); PG8_STAGE(PG8_SA(1, 0), a3, voffA);
            PG8_WAIT_V(8); PG8_WAIT_L(0); PG8_BAR; PG8_MMA(1, 0, At, B0); PG8_MMA(1, 1, At, B1); PG8_BAR; PG8_SCHED;
            } else {
            PG8_LDB(B0, 0, 0); PG8_SCHED; PG8_LDA(At, 0, 0); PG8_STAGE(PG8_SA(1, 1), a1 + hstep, voffA);
            PG8_WAIT_L(8); PG8_BAR; PG8_WAIT_L(0); PG8_MMA(0, 0, At, B0); PG8_BAR; PG8_SCHED;
            PG8_LDB(B1, 0, 1); PG8_STAGE(PG8_SB(0, 0), b2, voffB);
            PG8_BAR; PG8_WAIT_L(0); PG8_MMA(0, 1, At, B1); PG8_BAR;
            PG8_LDA(At, 0, 1); PG8_STAGE(PG8_SA(0, 0), a2, voffA);
            PG8_BAR; PG8_WAIT_L(0); PG8_MMA(1, 0, At, B0); PG8_BAR; PG8_SCHED;
            PG8_STAGE(PG8_SB(0, 1), b2 + hstep, voffB);
            PG8_WAIT_V(6); PG8_BAR; PG8_MMA(1, 1, At, B1); PG8_BAR;
            PG8_LDB(B0, 1, 0); PG8_SCHED; PG8_LDA(At, 1, 0); PG8_STAGE(PG8_SA(0, 1), a2 + hstep, voffA);
            PG8_WAIT_L(8); PG8_BAR; PG8_WAIT_L(0); PG8_MMA(0, 0, At, B0); PG8_BAR; PG8_SCHED;
            PG8_LDB(B1, 1, 1); PG8_STAGE(PG8_SB(1, 0), b3, voffB);
            PG8_BAR; PG8_WAIT_L(0); PG8_MMA(0, 1, At, B1); PG8_BAR;
            PG8_LDA(At, 1, 1); PG8_STAGE(PG8_SA(1, 0), a3, voffA);
            PG8_BAR; PG8_WAIT_L(0); PG8_MMA(1, 0, At, B0); PG8_BAR; PG8_SCHED;
            PG8_STAGE(PG8_SB(1, 1), b3 + hstep, voffB);
            PG8_WAIT_V(6); PG8_BAR; PG8_MMA(1, 1, At, B1); PG8_BAR;
            }
        }
        if constexpr (ALIGN_EPI) { if (wr == 0) PG8_BAR; }
        if constexpr (!Epi::AFTER_DRAIN) { E(acc, cur, wr, wc, fr, fq); S.done(cur); }
        if (!has_next) break;
#pragma unroll
        for (int a = 0; a < 2; ++a)
#pragma unroll
            for (int b = 0; b < 2; ++b)
#pragma unroll
                for (int m = 0; m < 4; ++m)
#pragma unroll
                    for (int n = 0; n < 2; ++n) acc[a][b][m][n] = (f32x4){0.f, 0.f, 0.f, 0.f};
        cur = nxt; cA = nA; cB = nB; ++ui;
        if constexpr (ALIGN_EPI) { if (wr == 1) PG8_BAR; }
    }
    PG8_WAIT_V(0);
    if constexpr (!ALIGN_EPI) { if (wr == 0) PG8_BAR; }
    PG8_BAR;
    if constexpr (Epi::AFTER_DRAIN) { E.fused(acc, cur, wr, wc, fr, fq, lds, wid, lane); S.done(cur); }
#undef PG8_SA
#undef PG8_SB
#undef PG8_STAGE
#undef PG8_LDA
#undef PG8_LDB
#undef PG8_MMA
#undef PG8_WAIT_V
#undef PG8_WAIT_L
#undef PG8_BAR
#undef PG8_SCHED
}
}
#define PG8_PTR(x) ((__attribute__((address_space(3))) unsigned char*)(x))
#else
template <class Epi, class Sched, bool ALIGN_EPI = false, bool SP2 = false>
inline void gemm_phase(unsigned char* lds, const Gemm g, const Sched& S, const Epi& E) {
    const int tid = threadIdx.x, wid = tid >> 6, lane = tid & 63, wr = wid >> 2, wc = wid & 3, fr = lane & 15, fq = lane >> 4;
    Unit cur;
    for (int ui = 0; S.next(ui, cur); ++ui) {
        f32x4 acc[2][2][4][2];
        for (int ai = 0; ai < 2; ++ai) for (int bj = 0; bj < 2; ++bj) for (int m = 0; m < 4; ++m) for (int n = 0; n < 2; ++n) for (int i = 0; i < 4; ++i) {
            const int row = 256 * cur.pm + 128 * ai + 64 * wr + 16 * m + fr;
            const int col = 256 * cur.pn + 128 * bj + 32 * wc + (Epi::PERM ? 8 * fq + 4 * n + i : 16 * n + 4 * fq + i);
            const bf16_t* a = g.A + (size_t)row * g.K; const bf16_t* b = g.Bt + (size_t)col * g.K; float s = 0.f;
            for (int k = 0; k < g.K; ++k) s += emu_bf2f(a[k]) * emu_bf2f(b[k]);
            acc[ai][bj][m][n][i] = s; }
        E(acc, cur, wr, wc, fr, fq);
    }
}
}
#define PG8_PTR(x) (x)
#endif
#ifdef CPU_EMU
#define WAVE_SYNC() emu_wave_sync()
#define SCHED_FENCE() do { } while (0)
#define LAUNDER_V(x) do { } while (0)
#define LDS_BARRIER() __syncthreads()
#else
#define LDS_BARRIER() do { asm volatile("s_waitcnt lgkmcnt(0)" ::: "memory"); __builtin_amdgcn_s_barrier(); asm volatile("" ::: "memory"); } while (0)
#define LAUNDER_V(x) asm volatile("" : "+v"(x))
#define WAVE_SYNC() asm volatile("s_waitcnt lgkmcnt(0)" ::: "memory")
#define SCHED_FENCE() __builtin_amdgcn_sched_barrier(0)
#endif

struct Params { const float* in[N_IN]; float* out; unsigned char* ws; int ph_lo, ph_hi, li, pad; };

constexpr float QSCALE = 0.125f * 1.4426950408889634f;
DEV void gates_rows(unsigned char* ws, size_t row0, int lane) {
    const int r = lane & 15, kq = lane >> 4;
    const bf16_t* HN = (const bf16_t*)(ws + WS_HN) + (row0 + r) * 1024 + 8 * kq;
    const bf16_t* WG = (const bf16_t*)(ws + WS_WIN) + (size_t)(2816 + r) * 1024 + 8 * kq;
    f32x4 acc[2][2];
#pragma unroll
    for (int rb = 0; rb < 2; ++rb)
#pragma unroll
        for (int cb = 0; cb < 2; ++cb) acc[rb][cb] = (f32x4){0.f, 0.f, 0.f, 0.f};
    bf16x8 hb[2][4][2], wb[2][4][2];
#define GU_LOAD(bt) do { _Pragma("unroll") for (int q = 0; q < 4; ++q) { const int s_ = 4 * (bt) + q; hb[(bt) & 1][q][0] = ld8(HN + 32 * s_); hb[(bt) & 1][q][1] = ld8(HN + 16 * 1024 + 32 * s_); \
        wb[(bt) & 1][q][0] = ld8(WG + 32 * s_); wb[(bt) & 1][q][1] = ld8(WG + 16 * 1024 + 32 * s_); } } while (0)
    GU_LOAD(0);
#pragma unroll
    for (int bt = 0; bt < 8; ++bt) {
        if (bt < 7) GU_LOAD(bt + 1);
        SCHED_FENCE();
#pragma unroll
        for (int q = 0; q < 4; ++q) {
            const bf16x8 h0 = hb[bt & 1][q][0], h1 = hb[bt & 1][q][1], w0 = wb[bt & 1][q][0], w1 = wb[bt & 1][q][1];
            acc[0][0] = mfma16(w0, h0, acc[0][0]); acc[0][1] = mfma16(w1, h0, acc[0][1]);
            acc[1][0] = mfma16(w0, h1, acc[1][0]); acc[1][1] = mfma16(w1, h1, acc[1][1]);
        }
        SCHED_FENCE();
    }
#undef GU_LOAD
    float* Gp = (float*)(ws + WS_G);
#pragma unroll
    for (int rb = 0; rb < 2; ++rb)
#pragma unroll
        for (int cb = 0; cb < 2; ++cb) { f32x4 o;
#pragma unroll
            for (int i = 0; i < 4; ++i) o[i] = sigmoid_f(acc[rb][cb][i]);
            *(f32x4*)(Gp + (row0 + 16 * rb + r) * 32 + 16 * cb + 4 * kq) = o; }
}

struct EpiInProj {
    static constexpr bool PERM = true, AFTER_DRAIN = false;
    unsigned char* ws; const float* qng; const float* ksng; const float* kwng;
    DEV void operator()(const f32x4 (&acc)[2][2][4][2], const pg8::Unit& u, int wr, int wc, int fr, int fq) const {
        const int pn = u.pn; const int row0 = u.pm * 256 + wr * 64 + fr;
        int kind; bf16_t* dst = nullptr; bf16_t* dst2 = nullptr; int pitch = 512, colb = 0; const float* gv = nullptr;
        if (pn < 2) { kind = 2; dst = (bf16_t*)(ws + WS_Q); dst2 = (bf16_t*)(ws + WS_QR); colb = (4 * pn + wc) * 64; gv = qng; }
        else if (pn == 2) { kind = 0; dst = (bf16_t*)(ws + WS_CR); pitch = 256; colb = wc * 64; }
        else if (pn == 3) { kind = wc < 2 ? 1 : 0; dst = (bf16_t*)(ws + WS_SL); pitch = 256; colb = wc * 64; gv = ksng; }
        else if (pn == 4) { kind = wc < 2 ? 1 : 0; dst = (bf16_t*)(ws + WS_WN); pitch = 256; colb = wc * 64; gv = kwng; }
        else if (pn < 7) { kind = 3; dst = (bf16_t*)(ws + WS_ZA); colb = (4 * (pn - 5) + wc) * 64; }
        else if (pn < 9) { kind = 0; dst = (bf16_t*)(ws + WS_U); colb = (4 * (pn - 7) + wc) * 64; }
        else if (pn < 11) { kind = 3; dst = (bf16_t*)(ws + WS_ZS); colb = (4 * (pn - 9) + wc) * 64; }
        else { kind = (wc == 0) ? 4 : 5; }
        if (kind == 5) return;
        float g1[8], g2[8];
        if (kind == 1 || kind == 2) {
#pragma unroll
            for (int i = 0; i < 8; ++i) { const float qs = (kind == 2) ? QSCALE : 1.0f; g1[i] = gv[8 * fq + i] * qs; g2[i] = gv[32 + 8 * fq + i] * qs; }
        }
        const float* rope = (const float*)(ws + WS_ROPE);
#pragma unroll
        for (int ai = 0; ai < 2; ++ai)
#pragma unroll
            for (int m = 0; m < 4; ++m) {
                const int row = row0 + ai * 128 + m * 16;
                float x1[8], x2[8];
#pragma unroll
                for (int i = 0; i < 4; ++i) { x1[i] = acc[ai][0][m][0][i]; x1[4 + i] = acc[ai][0][m][1][i]; x2[i] = acc[ai][1][m][0][i]; x2[4 + i] = acc[ai][1][m][1][i]; }
                if (kind == 4) {
                    float* G = (float*)(ws + WS_G) + (size_t)row * 32 + 8 * fq;
                    f32x4 o0, o1;
#pragma unroll
                    for (int i = 0; i < 4; ++i) { o0[i] = sigmoid_f(x1[i]); o1[i] = sigmoid_f(x1[4 + i]); }
                    *(f32x4*)G = o0; *(f32x4*)(G + 4) = o1;
                    continue;
                }
                if (kind == 1 || kind == 2) {
                    float ss = 0.f;
#pragma unroll
                    for (int i = 0; i < 8; ++i) ss += x1[i] * x1[i] + x2[i] * x2[i];
                    ss += __shfl_xor(ss, 16); ss += __shfl_xor(ss, 32);
                    const float rinv = rsqrtf(ss * (1.0f / 64.0f) + EPS_);
#pragma unroll
                    for (int i = 0; i < 8; ++i) { x1[i] = x1[i] * rinv * g1[i]; x2[i] = x2[i] * rinv * g2[i]; }
                    if (kind == 2) {
                        bf16_t* o = dst + (size_t)row * pitch + colb + 8 * fq;
                        *(u32x4*)o = (u32x4){pk2(x1[0], x1[1]), pk2(x1[2], x1[3]), pk2(x1[4], x1[5]), pk2(x1[6], x1[7])};
                        *(u32x4*)(o + 32) = (u32x4){pk2(x2[0], x2[1]), pk2(x2[2], x2[3]), pk2(x2[4], x2[5]), pk2(x2[6], x2[7])};
                    }
                    const int t = row % T_;
                    const float* cs = rope + (size_t)t * 32 + 8 * fq; const float* sn = cs + (size_t)T_ * 32;
                    const f32x4 c0 = *(const f32x4*)cs, c1 = *(const f32x4*)(cs + 4), s0 = *(const f32x4*)sn, s1 = *(const f32x4*)(sn + 4);
#pragma unroll
                    for (int i = 0; i < 8; ++i) { const float c = i < 4 ? c0[i & 3] : c1[i & 3], s = i < 4 ? s0[i & 3] : s1[i & 3]; const float a = x1[i], b = x2[i]; x1[i] = a * c - b * s; x2[i] = b * c + a * s; }
                } else if (kind == 3) {
#pragma unroll
                    for (int i = 0; i < 8; ++i) { x1[i] = silu_f(x1[i]); x2[i] = silu_f(x2[i]); }
                }
                bf16_t* o = (kind == 2 ? dst2 : dst) + (size_t)row * pitch + colb + 8 * fq;
                *(u32x4*)o = (u32x4){pk2(x1[0], x1[1]), pk2(x1[2], x1[3]), pk2(x1[4], x1[5]), pk2(x1[6], x1[7])};
                *(u32x4*)(o + 32) = (u32x4){pk2(x2[0], x2[1]), pk2(x2[2], x2[3]), pk2(x2[4], x2[5]), pk2(x2[6], x2[7])};
            }
    }
};

struct EpiGlu {
    static constexpr bool PERM = true, AFTER_DRAIN = false;
    const bf16_t* YG; const bf16_t* ZS; bf16_t* MIX; const float* glub;
    DEV void operator()(const f32x4 (&acc)[2][2][4][2], const pg8::Unit& u, int wr, int wc, int fr, int fq) const {
        const int row0 = u.pm * 256 + wr * 64 + fr, col0 = u.pn * 256 + wc * 32 + 8 * fq;
        f32x4 bv[2][2]; u32x4 ya[2][2], za[2][2];
#pragma unroll
        for (int bj = 0; bj < 2; ++bj) { bv[bj][0] = *(const f32x4*)(glub + col0 + bj * 128); bv[bj][1] = *(const f32x4*)(glub + col0 + bj * 128 + 4); }
#define EG_ROW(grp, mm) (row0 + (((grp) >> 1) & 1) * 128 + (2 * ((grp) & 1) + (mm)) * 16)
#define EG_COL(grp) (col0 + ((grp) >> 2) * 128)
#define EG_LOAD(grp) do { _Pragma("unroll") for (int mm = 0; mm < 2; ++mm) { ya[(grp) & 1][mm] = *(const u32x4*)(YG + (size_t)EG_ROW(grp, mm) * 512 + EG_COL(grp)); za[(grp) & 1][mm] = *(const u32x4*)(ZS + (size_t)EG_ROW(grp, mm) * 512 + EG_COL(grp)); } } while (0)
        EG_LOAD(0);
#pragma unroll
        for (int grp = 0; grp < 8; ++grp) {
            const int bj = grp >> 2, ai = (grp >> 1) & 1;
            if (grp < 7) EG_LOAD(grp + 1);
            SCHED_FENCE();
#pragma unroll
            for (int mm = 0; mm < 2; ++mm) {
                const int m = 2 * (grp & 1) + mm; const u32x4 yv = ya[grp & 1][mm], zv = za[grp & 1][mm];
                float o[8];
#pragma unroll
                for (int i = 0; i < 8; ++i) {
                    const float a = (i < 4 ? acc[ai][bj][m][0][i & 3] : acc[ai][bj][m][1][i & 3]) + (i < 4 ? bv[bj][0][i & 3] : bv[bj][1][i & 3]);
                    const unsigned yw = yv[i >> 1], zw = zv[i >> 1];
                    const float y = bf2f((i & 1) ? (yw >> 16) : (yw & 0xffffu)), z = bf2f((i & 1) ? (zw >> 16) : (zw & 0xffffu));
                    o[i] = y * sigmoid_f(a) * z;
                }
                *(u32x4*)(MIX + (size_t)EG_ROW(grp, mm) * 1024 + 512 + EG_COL(grp)) = (u32x4){pk2(o[0], o[1]), pk2(o[2], o[3]), pk2(o[4], o[5]), pk2(o[6], o[7])};
            }
            SCHED_FENCE();
        }
#undef EG_ROW
#undef EG_COL
#undef EG_LOAD
    }
};

struct EpiOut {
    static constexpr bool PERM = true, AFTER_DRAIN = false;
    const float* x; float* out; const float* mod;
    DEV void operator()(const f32x4 (&acc)[2][2][4][2], const pg8::Unit& u, int wr, int wc, int fr, int fq) const {
        const int row0 = u.pm * 256 + wr * 64 + fr, col0 = u.pn * 256 + wc * 32 + 8 * fq; const int b = (u.pm * 256) / T_;
        f32x4 gv[2][2], xa[2][2][2];
#pragma unroll
        for (int bj = 0; bj < 2; ++bj) { gv[bj][0] = *(const f32x4*)(mod + (size_t)b * 3072 + 2048 + col0 + bj * 128); gv[bj][1] = *(const f32x4*)(mod + (size_t)b * 3072 + 2048 + col0 + bj * 128 + 4); }
#define EO_OFF(grp, mm) ((size_t)(row0 + (((grp) >> 1) & 1) * 128 + (2 * ((grp) & 1) + (mm)) * 16) * 1024 + col0 + ((grp) >> 2) * 128)
#define EO_LOAD(grp) do { _Pragma("unroll") for (int mm = 0; mm < 2; ++mm) { xa[(grp) & 1][mm][0] = *(const f32x4*)(x + EO_OFF(grp, mm)); xa[(grp) & 1][mm][1] = *(const f32x4*)(x + EO_OFF(grp, mm) + 4); } } while (0)
        EO_LOAD(0);
#pragma unroll
        for (int grp = 0; grp < 8; ++grp) {
            const int bj = grp >> 2, ai = (grp >> 1) & 1;
            if (grp < 7) EO_LOAD(grp + 1);
            SCHED_FENCE();
#pragma unroll
            for (int mm = 0; mm < 2; ++mm) {
                const int m = 2 * (grp & 1) + mm;
                *(f32x4*)(out + EO_OFF(grp, mm)) = xa[grp & 1][mm][0] + gv[bj][0] * acc[ai][bj][m][0];
                *(f32x4*)(out + EO_OFF(grp, mm) + 4) = xa[grp & 1][mm][1] + gv[bj][1] * acc[ai][bj][m][1];
            }
            SCHED_FENCE();
        }
#undef EO_OFF
#undef EO_LOAD
    }
};

DEV size_t frag_idx(int row, int k, int K) { return ((size_t)((row >> 4) * (K >> 5) + (k >> 5)) * 64 + 16 * ((k >> 3) & 3) + (row & 15)) * 8 + (k & 7); }
DEV void tr_item(const float* W, int Nsrc, int K, int k0, int col0, int nvalid, bf16_t* WT, int drow0, float* scr, int lane, bool frag = false) {
    const int c = lane & 31;
#pragma unroll 8
    for (int i = 0; i < 32; ++i) { const int kk = 2 * i + (lane >> 5); scr[kk * 33 + c] = (c < nvalid) ? W[(size_t)(k0 + kk) * Nsrc + col0 + c] : 0.f; }
    WAVE_SYNC();
    const int c8 = lane & 7;
#pragma unroll
    for (int j = 0; j < 4; ++j) { const int n = (lane >> 3) + 8 * j; const float* s = scr + (8 * c8) * 33 + n;
        u32x4 o; o.x = pk2(s[0 * 33], s[1 * 33]); o.y = pk2(s[2 * 33], s[3 * 33]); o.z = pk2(s[4 * 33], s[5 * 33]); o.w = pk2(s[6 * 33], s[7 * 33]);
        const int row = drow0 + n, k8 = (k0 >> 3) + c8;
        *(u32x4*)(WT + (frag ? ((size_t)((row >> 4) * (K >> 5) + (k8 >> 2)) * 64 + 16 * (k8 & 3) + (row & 15)) * 8 : (size_t)row * K + k0 + 8 * c8)) = o; }
    WAVE_SYNC();
}

DEV void p0_prologue(const Params& p, unsigned char* lds, int vcu, int G, int tid, int wave, int lane) {
    unsigned char* ws = p.ws;
    {
        const float* c = p.in[I_C]; const float* w = p.in[I_WADA]; const float* ba = p.in[I_BADA]; float* mod = (float*)(ws + WS_MOD);
        for (int cb = vcu; cb < 256; cb += G)
            for (int b = wave; b < B_; b += 8) {
                float a[12];
#pragma unroll
                for (int j = 0; j < 12; ++j) a[j] = 0.f;
#pragma unroll 8
                for (int i = 0; i < 16; ++i) {
                    const int k = lane + 64 * i; const float s = silu_f(c[b * 1024 + k]);
                    const f32x4* wp = (const f32x4*)(w + (size_t)k * 3072 + 12 * cb); const f32x4 w0 = wp[0], w1 = wp[1], w2 = wp[2];
#pragma unroll
                    for (int j = 0; j < 4; ++j) { a[j] += s * w0[j]; a[4 + j] += s * w1[j]; a[8 + j] += s * w2[j]; }
                }
#pragma unroll
                for (int j = 0; j < 12; ++j) a[j] = wave_sum(a[j]);
                if (lane == 0) {
#pragma unroll
                    for (int j = 0; j < 12; ++j) mod[b * 3072 + 12 * cb + j] = a[j] + ba[12 * cb + j];
                }
            }
    }
    {
        float* scr = (float*)(lds + wave * 16384);
        const int gw = vcu * 8 + wave, NGW = G * 8;
        constexpr int I_IN = 96 * 16, I_O = 32 * 16, I_GL = 16 * 8, I_W1 = 8 * 32, I_W2 = 2 * 4;
        constexpr int NIT = I_IN + I_O + I_GL + 2 * I_W1 + 2 * I_W2;
        for (int it = gw; it < NIT; it += NGW) {
            int r = it;
            if (r < I_IN) {
                const int ci = r / 16, kb = r % 16, n0 = 32 * ci, pn = n0 >> 8, bj = (n0 >> 7) & 1, wc = (n0 >> 5) & 3, L0 = 256 * pn + 64 * wc + 32 * bj;
                int oc, nv; if (L0 < 1792) { oc = L0; nv = 32; } else if (L0 < 2816) { oc = L0 + 24; nv = 32; } else if (L0 == 2816) { oc = 1792; nv = 24; } else { oc = 0; nv = 0; }
                tr_item(p.in[I_WIN], INW, 1024, 64 * kb, oc, nv, (bf16_t*)(ws + WS_WIN), n0, scr, lane); continue; }
            r -= I_IN;
            if (r < I_O) { tr_item(p.in[I_WOUT], 1024, 1024, 64 * (r % 16), 32 * (r / 16), 32, (bf16_t*)(ws + WS_WO), 32 * (r / 16), scr, lane); continue; }
            r -= I_O;
            if (r < I_GL) { tr_item(p.in[I_GLUW], 512, 512, 64 * (r % 8), 32 * (r / 8), 32, (bf16_t*)(ws + WS_WGLU), 32 * (r / 8), scr, lane); continue; }
            r -= I_GL;
            if (r < I_W1) { tr_item(p.in[I_W1K], 256, 2048, 64 * (r % 32), 32 * (r / 32), 32, (bf16_t*)(ws + WS_W1K), 32 * (r / 32), scr, lane, true); continue; }
            r -= I_W1;
            if (r < I_W1) { tr_item(p.in[I_W1V], 256, 2048, 64 * (r % 32), 32 * (r / 32), 32, (bf16_t*)(ws + WS_W1V), 32 * (r / 32), scr, lane, true); continue; }
            r -= I_W1;
            if (r < I_W2) { tr_item(p.in[I_W2K], 64, 256, 64 * (r % 4), 32 * (r / 4), 32, (bf16_t*)(ws + WS_W2K), 32 * (r / 4), scr, lane); continue; }
            r -= I_W2;
            tr_item(p.in[I_W2V], 64, 256, 64 * (r % 4), 32 * (r / 4), 32, (bf16_t*)(ws + WS_W2V), 32 * (r / 4), scr, lane);
        }
    }
    {
        const float H1[32] = {2.037182617e+01f, 1.527673340e+01f, 1.145593262e+01f, 8.590698242e+00f, 6.442138672e+00f, 4.830932617e+00f, 3.622680664e+00f, 2.716613770e+00f, 2.037170410e+00f, 1.527679443e+00f, 1.145599365e+00f, 8.590698242e-01f, 6.442108154e-01f, 4.830932617e-01f, 3.622665405e-01f, 2.716636658e-01f, 2.037181854e-01f, 1.527671814e-01f, 1.145591736e-01f, 8.590698242e-02f, 6.442165375e-02f, 4.830932617e-02f, 3.622674942e-02f, 2.716636658e-02f, 2.037191391e-02f, 1.527667046e-02f, 1.145589352e-02f, 8.590698242e-03f, 6.442129612e-03f, 4.830896854e-03f, 3.622680902e-03f, 2.716630697e-03f};
        const float L1[32] = {6.543887594e-06f, -1.416575378e-05f, -9.063650396e-06f, 3.259562436e-05f, 4.341966076e-07f, -9.333384696e-06f, 3.694024997e-07f, 1.383195467e-05f, 1.289177635e-05f, -7.611160072e-06f, -7.100949915e-06f, 3.214027856e-06f, 3.140712124e-06f, -1.001640385e-06f, 1.570408244e-06f, -8.980337611e-07f, 1.371793559e-07f, 1.700163388e-08f, 6.043357104e-08f, 3.195055172e-07f, -2.581333831e-07f, -9.542085166e-08f, 6.167339706e-08f, -9.075201035e-08f, -8.022654185e-08f, 4.843524337e-08f, 2.941089683e-08f, 3.325492770e-08f, 9.949448376e-09f, 2.627999152e-08f, 1.475850692e-10f, -2.996157100e-09f};
        const float H2[32] = {1.591548920e-01f, 1.193494797e-01f, 8.949947357e-02f, 6.711483002e-02f, 5.032920837e-02f, 3.774166107e-02f, 2.830219269e-02f, 2.122354507e-02f, 1.591539383e-02f, 1.193499565e-02f, 8.949995041e-03f, 6.711483002e-03f, 5.032896996e-03f, 3.774166107e-03f, 2.830207348e-03f, 2.122372389e-03f, 1.591548324e-03f, 1.193493605e-03f, 8.949935436e-04f, 6.711483002e-04f, 5.032941699e-04f, 3.774166107e-04f, 2.830214798e-04f, 2.122372389e-04f, 1.591555774e-04f, 1.193489879e-04f, 8.949916810e-05f, 6.711483002e-05f, 5.032913759e-05f, 3.774138168e-05f, 2.830219455e-05f, 2.122367732e-05f};
        const float L2[32] = {5.112412182e-08f, -1.106699514e-07f, -7.080976872e-08f, 2.546533153e-07f, 3.392160997e-09f, -7.291706794e-08f, 2.885957029e-09f, 1.080621459e-07f, 1.007170027e-07f, -5.946218806e-08f, -5.547617121e-08f, 2.510959263e-08f, 2.453681347e-08f, -7.825315507e-09f, 1.226881441e-08f, -7.015888759e-09f, 1.071713718e-09f, 1.328252647e-10f, 4.721372737e-10f, 2.496136853e-09f, -2.016667056e-09f, -7.454754036e-10f, 4.818234145e-10f, -7.090000809e-10f, -6.267698582e-10f, 3.784003388e-10f, 2.297726315e-10f, 2.598041227e-10f, 7.773006544e-11f, 2.053124337e-10f, 1.153008353e-12f, -2.340747735e-11f};
        float* rc = (float*)(ws + WS_ROPE); float* rs = rc + (size_t)T_ * 32;
        for (int i = vcu * 512 + tid; i < T_ * 32; i += G * 512) {
            const int t = i >> 5, d = i & 31; const float th = (float)(t >> 7), tl = (float)(t & 127);
            const float a = th * H1[d], c = tl * H2[d];
            float rev = (a - floorf(a)) + (c - floorf(c)) + (th * L1[d] + tl * L2[d]);
            rev -= floorf(rev);
#ifdef CPU_EMU
            rc[i] = cosf(6.283185307179586f * rev); rs[i] = sinf(6.283185307179586f * rev);
#else
            rc[i] = __builtin_amdgcn_cosf(rev); rs[i] = __builtin_amdgcn_sinf(rev);
#endif
        }
    }
    __syncthreads();
    {
        f32x2* lp = (f32x2*)lds;
        f32x2* bb = lp + 64;
        f32x2* cc = bb + 1024;
        f32x2* ee = cc + 1024;
        for (int it = vcu; it < 32 * 13 + 32; it += G) {
            if (it >= 32 * 13) {
                const int r = it - 32 * 13, kv = r >> 4, ks = r & 15; const float* pos = p.in[kv ? I_POSV : I_POSK]; const float* w1 = p.in[kv ? I_W1V : I_W1K];
                const int j = tid & 255, i0 = 128 * ks + 64 * (tid >> 8); float a = 0.f;
#pragma unroll 16
                for (int i = i0; i < i0 + 64; ++i) a += pos[i] * w1[(size_t)i * 256 + j];
                atomicAdd((unsigned*)(ws + WS_CPOS) + kv * 256 + j, (unsigned)(int)__builtin_rintf(a * 16777216.0f));
                continue;
            }
            const int g = it / 13, nb = it % 13;
            const float dt = expf(p.in[I_LOGDT][g]);
            for (int e = tid; e < 1024; e += 512) {
                const int pp = e >> 4, ci = e & 15;
                const float ar = p.in[I_ARE][g * 64 + pp], ai = p.in[I_AIM][g * 64 + pp], x = ar * dt, y = ai * dt;
                const float em1 = expm1f(x), ex = em1 + 1.0f, cy = cosf(y), sy = sinf(y), sh = sinf(0.5f * y);
                const float lr = em1 * cy - 2.0f * sh * sh, li = ex * sy;
                const float den = ar * ar + ai * ai, fr_ = (lr * ar + li * ai) / den, fi_ = (li * ar - lr * ai) / den;
                const float br = p.in[I_BRE][(g * 64 + pp) * 16 + ci], bi = p.in[I_BIM][(g * 64 + pp) * 16 + ci];
                bb[e] = (f32x2){fr_ * br - fi_ * bi, fr_ * bi + fi_ * br};
                const int co = e >> 6, p2 = e & 63;
                cc[e] = (f32x2){p.in[I_CRE][(g * 16 + co) * 64 + p2], p.in[I_CIM][(g * 16 + co) * 64 + p2]};
            }
            for (int n = 5 * nb; n < 5 * nb + 5; ++n) {
                if (tid < 64) {
                    const float ar = p.in[I_ARE][g * 64 + tid], ai = p.in[I_AIM][g * 64 + tid];
                    const float mag = expf(ar * dt * (float)n), ang = ai * dt * (float)n;
                    lp[tid] = (f32x2){mag * cosf(ang), mag * sinf(ang)};
                }
                __syncthreads();
                for (int e = tid; e < 1024; e += 512) { const f32x2 l = lp[e >> 4], b = bb[e]; ee[e] = (f32x2){l.x * b.x - l.y * b.y, l.x * b.y + l.y * b.x}; }
                __syncthreads();
                if (n < 64) {
                    bf16_t* KT = (bf16_t*)(ws + WS_KT) + (size_t)g * 65 * 256;
                    if (tid < 256) {
                        const int co = tid >> 4, ci = tid & 15; float a = 0.f;
                        for (int pp = 0; pp < 64; ++pp) { const f32x2 c = cc[co * 64 + pp], e = ee[pp * 16 + ci]; a += c.x * e.x - c.y * e.y; }
                        KT[(n + 1) * 256 + tid] = (bf16_t)f2bf(a);
                        if (n == 0) KT[tid] = 0;
                    }
                    bf16_t* WST = (bf16_t*)(ws + WS_WST) + (size_t)g * 128 * 1024; const int sidx = 63 - n;
                    for (int e = tid; e < 1024; e += 512) { const int pp = e >> 4, ci = e & 15; const f32x2 v = ee[e];
                        WST[frag_idx(pp, sidx * 16 + ci, 1024)] = (bf16_t)f2bf(v.x); WST[frag_idx(64 + pp, sidx * 16 + ci, 1024)] = (bf16_t)f2bf(v.y); }
                }
                if (n >= 1) {
                    bf16_t* WO = (bf16_t*)(ws + WS_WOUTS) + (size_t)g * 1024 * 128; const int t = n - 1;
                    for (int e = tid; e < 1024; e += 512) { const int co = e >> 6, pp = e & 63; const f32x2 c = cc[e], l = lp[pp];
                        WO[frag_idx(t * 16 + co, pp, 128)] = (bf16_t)f2bf(c.x * l.x - c.y * l.y); WO[frag_idx(t * 16 + co, 64 + pp, 128)] = (bf16_t)f2bf(-(c.x * l.y + c.y * l.x)); }
                }
                if (n == 64 && tid < 64) ((f32x2*)(ws + WS_LAM64))[g * 64 + tid] = lp[tid];
                __syncthreads();
            }
        }
    }
}

DEV void p1_norm(const Params& p, int vcu, int G, int wave, int lane) {
    const float* x = p.in[I_X]; const float* ng = p.in[I_NORMG]; const float* mod = (const float*)(p.ws + WS_MOD); bf16_t* HN = (bf16_t*)(p.ws + WS_HN);
    const int gw = vcu * 8 + wave, NGW = G * 8;
    constexpr int RB = 32;
    for (int it = gw; it < M_ / RB; it += NGW) {
        const int r0 = it * RB, b = r0 / T_;
        f32x4 cs[4], sh[4];
#pragma unroll
        for (int j = 0; j < 4; ++j) { const int k = 4 * lane + 256 * j; const f32x4 g = *(const f32x4*)(ng + k), sc = *(const f32x4*)(mod + (size_t)b * 3072 + 1024 + k);
            cs[j] = g * (sc + 1.0f); sh[j] = *(const f32x4*)(mod + (size_t)b * 3072 + k); }
        for (int r = r0; r < r0 + RB; ++r) {
            const f32x4* xr = (const f32x4*)(x + (size_t)r * 1024) + lane; f32x4 v[4]; float s = 0.f;
#pragma unroll
            for (int j = 0; j < 4; ++j) { v[j] = xr[64 * j]; s += (v[j].x * v[j].x + v[j].y * v[j].y) + (v[j].z * v[j].z + v[j].w * v[j].w); }
            const float rinv = rsqrtf(wave_sum(s) * (1.0f / 1024.0f) + EPS_);
            u32x2* o = (u32x2*)(HN + (size_t)r * 1024) + lane;
#pragma unroll
            for (int j = 0; j < 4; ++j) { const f32x4 h = v[j] * rinv * cs[j] + sh[j]; o[64 * j] = (u32x2){pk2(h.x, h.y), pk2(h.z, h.w)}; }
        }
#ifndef CPU_EMU
        asm volatile("s_waitcnt vmcnt(0)" ::: "memory");
#else
        emu_wave_sync();
#endif
        gates_rows(p.ws, (size_t)r0, lane);
    }
}

constexpr int UL_CH = 2064;
constexpr int SSM_UL = 0, SSM_KT = 32 * UL_CH, SSM_SLOC = SSM_KT + 65 * 256 * 2, SSM_CBT = SSM_SLOC + 128 * 32 * 4, SSM_END = SSM_CBT + 32 * 272;
static_assert(SSM_END <= RING_BYTES, "ssm lds");
DEV void ssm_unit(const Params& p, unsigned char* lds, int unit, int tid, int wave, int lane) {
    const int b = unit / SSM_NG, g = unit % SSM_NG; const int l16 = lane & 15, q4 = lane >> 4;
    unsigned char* ws = p.ws;
    const bf16_t* U = (const bf16_t*)(ws + WS_U); bf16_t* YG = (bf16_t*)(ws + WS_YG);
    const bf16_t* WST = (const bf16_t*)(ws + WS_WST) + (size_t)g * 128 * 1024; const bf16_t* WO = (const bf16_t*)(ws + WS_WOUTS) + (size_t)g * 1024 * 128;
    unsigned char* ul = lds + SSM_UL; bf16_t* ktl = (bf16_t*)(lds + SSM_KT); float* sloc = (float*)(lds + SSM_SLOC); bf16_t* cbt = (bf16_t*)(lds + SSM_CBT);
    { const u32x4* src = (const u32x4*)((const bf16_t*)(ws + WS_KT) + (size_t)g * 65 * 256); u32x4* dstv = (u32x4*)ktl; for (int i = tid; i < 65 * 256 * 2 / 16; i += 512) dstv[i] = src[i]; }
    float sre = 0.f, sim = 0.f; f32x2 lam = {0.f, 0.f};
    if (wave == 0) lam = ((const f32x2*)(ws + WS_LAM64))[g * 64 + lane];
    f32x4 dsk = *(const f32x4*)(p.in[I_SSMD] + 16 * g + 4 * q4);
    for (int cg = 0; cg < SSM_NCG; ++cg) {
        const size_t tokbase = (size_t)b * T_ + (size_t)cg * 2048;
#pragma unroll
        for (int i = 0; i < 8; ++i) { const int idx = tid + 512 * i, tok = idx >> 1, hf = idx & 1;
            *(u32x4*)(ul + (tok >> 6) * UL_CH + (tok & 63) * 32 + hf * 16) = *(const u32x4*)(U + (tokbase + tok) * 512 + 16 * g + 8 * hf); }
        __syncthreads();
        {
            f32x4 a1[2] = {(f32x4){0.f, 0.f, 0.f, 0.f}, (f32x4){0.f, 0.f, 0.f, 0.f}};
            const bf16_t* ap = WST + ((size_t)wave * 32 * 64 + lane) * 8;
            const unsigned char* bp = ul + l16 * UL_CH + (q4 >> 1) * 32 + (q4 & 1) * 16;
            bf16x8 aa[2][4];
#pragma unroll
            for (int q = 0; q < 4; ++q) aa[0][q] = ld8(ap + 512 * q);
#pragma unroll
            for (int kb = 0; kb < 8; ++kb) {
                if (kb < 7) {
#pragma unroll
                    for (int q = 0; q < 4; ++q) aa[(kb + 1) & 1][q] = ld8(ap + 512 * (4 * kb + 4 + q));
                }
                SCHED_FENCE();
#pragma unroll
                for (int q = 0; q < 4; ++q) { const int ks = 4 * kb + q;
                    const bf16x8 b0 = *(const bf16x8*)(bp + ks * 64), b1 = *(const bf16x8*)(bp + 16 * UL_CH + ks * 64);
                    a1[0] = mfma16(aa[kb & 1][q], b0, a1[0]); a1[1] = mfma16(aa[kb & 1][q], b1, a1[1]); }
                SCHED_FENCE();
            }
#pragma unroll
            for (int ct = 0; ct < 2; ++ct)
#pragma unroll
                for (int r = 0; r < 4; ++r) sloc[(16 * wave + 4 * q4 + r) * 32 + 16 * ct + l16] = a1[ct][r];
        }
        __syncthreads();
        if (wave == 0) {
            for (int c = 0; c < 32; ++c) {
                cbt[c * 136 + lane] = (bf16_t)f2bf(sre); cbt[c * 136 + 64 + lane] = (bf16_t)f2bf(sim);
                const float lr = sloc[lane * 32 + c], li = sloc[(64 + lane) * 32 + c];
                const float nr = lam.x * sre - lam.y * sim + lr, ni = lam.x * sim + lam.y * sre + li; sre = nr; sim = ni;
            }
        }
        __syncthreads();
        for (int i = 0; i < 8; ++i) {
            const int t = wave + 8 * i;
            f32x4 a3[2] = {(f32x4){0.f, 0.f, 0.f, 0.f}, (f32x4){0.f, 0.f, 0.f, 0.f}};
            const unsigned char* bp = ul + l16 * UL_CH + (q4 >> 1) * 32 + (q4 & 1) * 16;
            const bf16_t* kp = ktl + (t - (q4 >> 1) + 1) * 256 + l16 * 16 + 8 * (q4 & 1);
            const int nks = (t >> 1) + 1;
            const bf16_t* wp = WO + ((size_t)t * 4 * 64 + lane) * 8;
            bf16x8 wa[4];
#pragma unroll
            for (int ks = 0; ks < 4; ++ks) wa[ks] = ld8(wp + 512 * ks);
            {
                bf16x8 an = ld8(kp), b0n = *(const bf16x8*)(bp), b1n = *(const bf16x8*)(bp + 16 * UL_CH);
                for (int ks = 0; ks < nks; ++ks) {
                    const bf16x8 a = an, b0 = b0n, b1 = b1n;
                    const int kn = (ks + 1 < nks) ? ks + 1 : ks;
                    an = ld8(kp - kn * 512); b0n = *(const bf16x8*)(bp + kn * 64); b1n = *(const bf16x8*)(bp + 16 * UL_CH + kn * 64);
                    a3[0] = mfma16(a, b0, a3[0]); a3[1] = mfma16(a, b1, a3[1]);
                }
            }
#pragma unroll
            for (int ks = 0; ks < 4; ++ks) {
                const bf16x8 b0 = ld8(cbt + l16 * 136 + 32 * ks + 8 * q4), b1 = ld8(cbt + (16 + l16) * 136 + 32 * ks + 8 * q4);
                a3[0] = mfma16(wa[ks], b0, a3[0]); a3[1] = mfma16(wa[ks], b1, a3[1]);
            }
#pragma unroll
            for (int ct = 0; ct < 2; ++ct) {
                const int chunk = 16 * ct + l16; const size_t tok = tokbase + (size_t)chunk * 64 + t;
                const u32x2 uv = *(const u32x2*)(ul + chunk * UL_CH + t * 32 + 8 * q4);
                float y[4];
#pragma unroll
                for (int r = 0; r < 4; ++r) { const unsigned w = uv[r >> 1]; const float uu = bf2f((r & 1) ? (w >> 16) : (w & 0xffffu)); y[r] = gelu_tanh_f(a3[ct][r] + dsk[r] * uu); }
                *(u32x2*)(YG + tok * 512 + 16 * g + 4 * q4) = (u32x2){pk2(y[0], y[1]), pk2(y[2], y[3])};
            }
        }
        __syncthreads();
    }
}

constexpr int CMP_TOK = 0, CMP_H = 528 * 128, CMP_OUT = CMP_H + 32 * 528, CMP_END = CMP_OUT + 32 * 64 * 4;
static_assert(CMP_END <= RING_BYTES, "cmp lds");
constexpr int CMP_UNITS = 2 * B_ * NGRP * (NCP / 32);
DEV void compress_unit(const Params& p, unsigned char* lds, int unit, int tid, int wave, int lane) {
    int r = unit; const int nb = r % (NCP / 32); r /= (NCP / 32); const int g = r % NGRP; r /= NGRP; const int b = r % B_; const int kv = r / B_;
    const int l16 = lane & 15, q4 = lane >> 4; unsigned char* ws = p.ws;
    const bf16_t* CR = (const bf16_t*)(ws + WS_CR); const bf16_t* w1t = (const bf16_t*)(ws + (kv ? WS_W1V : WS_W1K)); const bf16_t* w2t = (const bf16_t*)(ws + (kv ? WS_W2V : WS_W2K));
    const float* cpos = (const float*)(ws + WS_CPOS) + kv * 256;
    unsigned char* tokl = lds + CMP_TOK; bf16_t* hl = (bf16_t*)(lds + CMP_H); float* outl = (float*)(lds + CMP_OUT);
    const int n0 = 32 * nb, tk0 = 16 * n0;
    for (int idx = tid; idx < 528 * 8; idx += 512) {
        const int tl = idx >> 3, ch = idx & 7; const int tok = tk0 + tl;
        u32x4 v = (u32x4){0u, 0u, 0u, 0u};
        if (tok < T_) v = *(const u32x4*)(CR + ((size_t)b * T_ + tok) * 256 + kv * 128 + g * 64 + 8 * ch);
        *(u32x4*)(tokl + (tl * 8 + (ch ^ ((tl >> 4) & 7))) * 16) = v;
    }
    __syncthreads();
    f32x4 acc[2][2];
#pragma unroll
    for (int a = 0; a < 2; ++a)
#pragma unroll
        for (int c = 0; c < 2; ++c) acc[a][c] = (f32x4){0.f, 0.f, 0.f, 0.f};
    const bf16_t* bp0 = w1t + ((size_t)(2 * wave) * 64 * 64 + lane) * 8; const bf16_t* bp1 = bp0 + (size_t)64 * 64 * 8;
    bf16x8 bb[2][4][2];
#pragma unroll
    for (int q = 0; q < 4; ++q) { bb[0][q][0] = ld8(bp0 + 512 * q); bb[0][q][1] = ld8(bp1 + 512 * q); }
#pragma unroll
    for (int kb = 0; kb < 16; ++kb) {
        if (kb < 15) {
#pragma unroll
            for (int q = 0; q < 4; ++q) { bb[(kb + 1) & 1][q][0] = ld8(bp0 + 512 * (4 * kb + 4 + q)); bb[(kb + 1) & 1][q][1] = ld8(bp1 + 512 * (4 * kb + 4 + q)); }
        }
        SCHED_FENCE();
#pragma unroll
        for (int q = 0; q < 4; ++q) { const int ks = 4 * kb + q;
            const int l = ks >> 1, chunk = 4 * (ks & 1) + q4;
            const int tl0 = 16 * l16 + l, tl1 = 16 * (16 + l16) + l;
            const bf16x8 a0 = *(const bf16x8*)(tokl + (tl0 * 8 + (chunk ^ ((tl0 >> 4) & 7))) * 16), a1 = *(const bf16x8*)(tokl + (tl1 * 8 + (chunk ^ ((tl1 >> 4) & 7))) * 16);
            const bf16x8 b0 = bb[kb & 1][q][0], b1 = bb[kb & 1][q][1];
            acc[0][0] = mfma16(a0, b0, acc[0][0]); acc[0][1] = mfma16(a0, b1, acc[0][1]); acc[1][0] = mfma16(a1, b0, acc[1][0]); acc[1][1] = mfma16(a1, b1, acc[1][1]); }
        SCHED_FENCE();
    }
#pragma unroll
    for (int rt = 0; rt < 2; ++rt)
#pragma unroll
        for (int ct = 0; ct < 2; ++ct) { const int j = 32 * wave + 16 * ct + l16; const float cp = (float)((const int*)cpos)[j] * (1.0f / 16777216.0f);
#pragma unroll
            for (int rr = 0; rr < 4; ++rr) hl[(16 * rt + 4 * q4 + rr) * 264 + j] = (bf16_t)f2bf(gelu_tanh_f(acc[rt][ct][rr] + cp)); }
    __syncthreads();
    {
        const int rt = wave >> 2, ct = wave & 3; f32x4 a2 = (f32x4){0.f, 0.f, 0.f, 0.f};
#pragma unroll
        for (int ks = 0; ks < 8; ++ks) { const bf16x8 a = ld8(hl + (16 * rt + l16) * 264 + 32 * ks + 8 * q4), bq = ld8(w2t + (size_t)(16 * ct + l16) * 256 + 32 * ks + 8 * q4); a2 = mfma16(a, bq, a2); }
#pragma unroll
        for (int rr = 0; rr < 4; ++rr) outl[(16 * rt + 4 * q4 + rr) * 64 + 16 * ct + l16] = a2[rr];
    }
    __syncthreads();
    {
        const int row = tid >> 4, c4 = tid & 15; f32x4 v = *(const f32x4*)(outl + row * 64 + 4 * c4);
        if (kv == 0) {
            float ss = v.x * v.x + v.y * v.y + v.z * v.z + v.w * v.w;
            ss += __shfl_xor(ss, 1); ss += __shfl_xor(ss, 2); ss += __shfl_xor(ss, 4); ss += __shfl_xor(ss, 8);
            const float rinv = rsqrtf(ss * (1.0f / 64.0f) + EPS_); const f32x4 gk = *(const f32x4*)(p.in[I_KCNG] + 4 * c4);
            v = v * rinv * gk;
        }
        const int n = n0 + row; if (n >= NCMP) v = (f32x4){0.f, 0.f, 0.f, 0.f};
        bf16_t* dst = (bf16_t*)(ws + (kv ? WS_VC : WS_KC)) + (((size_t)b * NCP + n) * NGRP + g) * 64 + 4 * c4;
        *(u32x2*)dst = (u32x2){pk2(v.x, v.y), pk2(v.z, v.w)};
    }
    __syncthreads();
}

constexpr int VT_UNITS = B_ * NGRP * (T_ / 64);
struct VtPre { u32x4 v, k; };
DEV void vt_fetch(const Params& p, int unit, int tid, VtPre& r) {
    const int tb = unit % (T_ / 64), bg = unit / (T_ / 64), b = bg / NGRP, g = bg % NGRP;
    const bf16_t* SLk = (const bf16_t*)(p.ws + WS_SL) + ((size_t)b * T_ + 64 * tb) * 256 + g * 64; const bf16_t* SLv = SLk + 128;
    { const int tok = tid >> 3, ch = tid & 7; r.v = *(const u32x4*)(SLv + (size_t)tok * 256 + 8 * ch); }
    {
      const int kt = tid >> 8, ks = (tid >> 6) & 3, h = (tid >> 5) & 1, r32 = tid & 31, kr = (r32 & ~12) | ((r32 & 8) >> 1) | ((r32 & 4) << 1);
      r.k = *(const u32x4*)(SLk + (size_t)(32 * kt + kr) * 256 + 16 * ks + 8 * h); }
}
DEV void vt_unit(const Params& p, unsigned char* lds, int unit, int tid, const VtPre& r) {
    const int tb = unit % (T_ / 64), bg = unit / (T_ / 64);
    bf16_t* VF = (bf16_t*)(p.ws + WS_VT) + ((size_t)bg * (T_ / 64) + tb) * 4096; bf16_t* KF = (bf16_t*)(p.ws + WS_KF) + ((size_t)bg * (T_ / 64) + tb) * 4096;
    bf16_t* tile = (bf16_t*)lds;
    { const int tok = tid >> 3, ch = tid & 7; *(u32x4*)(tile + tok * 72 + 8 * ch) = r.v; }
    *(u32x4*)(KF + tid * 8) = r.k;
    __syncthreads();
    { const int dim = tid >> 3, c8 = tid & 7; unsigned short e[8];
#pragma unroll
      for (int i = 0; i < 8; ++i) e[i] = tile[(8 * c8 + i) * 72 + dim];
      *(u32x4*)(VF + (((dim >> 5) * 4 + (c8 >> 1)) * 64 + 32 * (c8 & 1) + (dim & 31)) * 8) = (u32x4){(unsigned)e[0] | ((unsigned)e[1] << 16), (unsigned)e[2] | ((unsigned)e[3] << 16), (unsigned)e[4] | ((unsigned)e[5] << 16), (unsigned)e[6] | ((unsigned)e[7] << 16)}; }
    __syncthreads();
}

constexpr int AT_KB = 0, AT_VOFF = 128 * 160, AT_STAGE = 2 * AT_VOFF, AT_IA = 2 * AT_STAGE, AT_IB = AT_IA + 64 * 128 * 4, AT_SEL = AT_IB + 64 * 128 * 4, AT_TM = AT_SEL + 64 * 16, AT_END = AT_TM + 128 * 8;
constexpr int EN_QL = 0, EN_OL = 40960, EN_LL = EN_OL + 256 * 65 * 4, EN_END = EN_LL + 1024;
static_assert(EN_END + 16 * 512 * 4 <= AT_SEL && 256 * 72 * 2 <= EN_OL, "engine lds");
static_assert(AT_END <= MISC_OFF, "attn lds");
constexpr int AT_UNITS = B_ * NGRP * NSB;

#ifdef CPU_EMU
DEV int row16_sum(int v) { v += __shfl_xor(v, 8); v += __shfl_xor(v, 4); v += __shfl_xor(v, 2); v += __shfl_xor(v, 1); return v; }
DEV int row16_shr(int v, int n) { const int l = threadIdx.x & 63; const int r = __shfl(v, (l & 15) >= n ? l - n : l); return (l & 15) >= n ? r : 0; }
DEV float quad_sum(float v) { v += __shfl_xor(v, 1); v += __shfl_xor(v, 2); return v; }
DEV u32x2 lds_tr16(const bf16_t* p) {
    const int w = threadIdx.x >> 6, l = threadIdx.x & 63; const unsigned long long a = (unsigned long long)(uintptr_t)p;
    emu_xbuf[w][l][0] = (unsigned)a; emu_xbuf[w][l][1] = (unsigned)(a >> 32); emu_wave_sync();
    const int g = l >> 4, i = l & 15; unsigned short e[4];
    for (int q = 0; q < 4; ++q) { const int src = 16 * g + 4 * q + (i >> 2); const unsigned long long sa = (unsigned long long)emu_xbuf[w][src][0] | ((unsigned long long)emu_xbuf[w][src][1] << 32); e[q] = ((const unsigned short*)(uintptr_t)sa)[i & 3]; }
    emu_wave_sync();
    return (u32x2){(unsigned)e[0] | ((unsigned)e[1] << 16), (unsigned)e[2] | ((unsigned)e[3] << 16)};
}
#else
DEV int row16_sum(int v) {
    v += __builtin_amdgcn_update_dpp(0, v, 0x128, 0xF, 0xF, false); v += __builtin_amdgcn_update_dpp(0, v, 0x124, 0xF, 0xF, false);
    v += __builtin_amdgcn_update_dpp(0, v, 0x122, 0xF, 0xF, false); v += __builtin_amdgcn_update_dpp(0, v, 0x121, 0xF, 0xF, false); return v;
}
#define row16_shr(v, n) __builtin_amdgcn_update_dpp(0, (v), 0x110 + (n), 0xF, 0xF, true)
DEV float quad_sum(float v) {
    v += __builtin_bit_cast(float, __builtin_amdgcn_mov_dpp(__builtin_bit_cast(int, v), 0xB1, 0xF, 0xF, true));
    v += __builtin_bit_cast(float, __builtin_amdgcn_mov_dpp(__builtin_bit_cast(int, v), 0x4E, 0xF, 0xF, true));
    return v;
}
typedef short v4i16_t __attribute__((ext_vector_type(4)));
DEV u32x2 lds_tr16(const bf16_t* p) { return __builtin_bit_cast(u32x2, __builtin_amdgcn_ds_read_tr16_b64_v4i16((__attribute__((address_space(3))) v4i16_t*)p)); }
#endif

#ifdef PROBE_TIMING
#define TSTAMP(v) do { __builtin_amdgcn_sched_barrier(0); v = __builtin_amdgcn_s_memtime(); __builtin_amdgcn_s_waitcnt(0xC07F); __builtin_amdgcn_sched_barrier(0); } while (0)
#else
#define TSTAMP(v) do { } while (0)
#endif
#ifndef PROBE_MODE
#define PROBE_MODE -1
#endif
constexpr int ATS = 80;
template <int MODE>
DEV void attn_tile(const bf16_t* kb, const bf16_t* vb, int jt, const bf16x8 (&qf)[4], f32x16 (&oacc)[2], float& lsum, float linv, const f32x16& negm, int ttok,
                   unsigned long long slo, unsigned long long shi, int t0, int qb, float* impA, float* impB, int wave, int lane) {
    const float NINF = -INFINITY;
    const int c32 = lane & 31, h = lane >> 5, hg = lane & 3, tau = c32 >> 2;
    bool nm;
    if (MODE <= 1) nm = (16 * (64 * jt + 63) + 31 > t0);
    else if (MODE == 2) nm = (jt == qb);
    else nm = (jt == qb) || (jt + 8 == qb);
    f32x16 s[2];
    if (nm) {
        const float nm0 = negm[0];
        if (MODE == 3 && jt != qb) {
            const int d2 = ttok - 512 - 64 * jt - 4 * h;
#pragma unroll
            for (int kt = 0; kt < 2; ++kt) {
                f32x16 cm;
#pragma unroll
                for (int i = 0; i < 16; ++i) cm[i] = (32 * kt + (i & 3) + 8 * (i >> 2) > d2) ? nm0 : NINF;
                s[kt] = mfma32(ld8(kb + (32 * kt + c32) * ATS + 8 * h), qf[0], cm);
            }
        } else {
            const int d = ((MODE <= 1) ? ((ttok - 31) >> 4) : ttok) - 64 * jt - 4 * h;
#pragma unroll
            for (int kt = 0; kt < 2; ++kt) {
                f32x16 cm;
#pragma unroll
                for (int i = 0; i < 16; ++i) cm[i] = (32 * kt + (i & 3) + 8 * (i >> 2) <= d) ? nm0 : NINF;
                s[kt] = mfma32(ld8(kb + (32 * kt + c32) * ATS + 8 * h), qf[0], cm);
            }
        }
    } else {
#pragma unroll
        for (int kt = 0; kt < 2; ++kt) s[kt] = mfma32(ld8(kb + (32 * kt + c32) * ATS + 8 * h), qf[0], negm);
    }
#pragma unroll
    for (int kt = 0; kt < 2; ++kt)
#pragma unroll
        for (int ks = 1; ks < 4; ++ks) { const bf16x8 a = ld8(kb + (32 * kt + c32) * ATS + 16 * ks + 8 * h); s[kt] = mfma32(a, qf[ks], s[kt]); }
    float psum = 0.f;
#pragma unroll
    for (int kt = 0; kt < 2; ++kt)
#pragma unroll
        for (int i = 0; i < 16; ++i) { const float pv = exp2_fast(s[kt][i]); s[kt][i] = pv; psum += pv; }
    if (MODE != 1) lsum += psum;
    if (MODE == 1) {
#pragma unroll
        for (int kt = 0; kt < 2; ++kt)
#pragma unroll
            for (int gq = 0; gq < 4; ++gq) {
                const float a = quad_sum(2.0f * (s[kt][4 * gq] + s[kt][4 * gq + 1] + s[kt][4 * gq + 2]) + s[kt][4 * gq + 3]), bq = quad_sum(s[kt][4 * gq + 3]);
                if (hg == 0) { const int j = 16 * jt + 8 * kt + 2 * gq + h; const int tl = 8 * wave + tau; impA[tl * 128 + j] = a; impB[tl * 128 + j] = bq; }
            }
    }
    if (MODE != 0) {
        const int l15 = lane & 15, g1 = (lane >> 4) & 1;
#pragma unroll
        for (int kt = 0; kt < 2; ++kt)
#pragma unroll
            for (int sp = 0; sp < 2; ++sp) {
                u32x4 pw = (u32x4){pk2(s[kt][8 * sp], s[kt][8 * sp + 1]), pk2(s[kt][8 * sp + 2], s[kt][8 * sp + 3]), pk2(s[kt][8 * sp + 4], s[kt][8 * sp + 5]), pk2(s[kt][8 * sp + 6], s[kt][8 * sp + 7])};
                const bf16x8 pf = __builtin_bit_cast(bf16x8, pw);
                const bf16_t* vr = vb + (32 * kt + 16 * sp + 4 * h + (l15 >> 2)) * ATS + 16 * g1 + 4 * (l15 & 3);
#pragma unroll
                for (int dt = 0; dt < 2; ++dt) {
                    const u32x2 lo = lds_tr16(vr + 32 * dt), hi = lds_tr16(vr + 8 * ATS + 32 * dt);
                    oacc[dt] = mfma32(__builtin_bit_cast(bf16x8, (u32x4){lo.x, lo.y, hi.x, hi.y}), pf, oacc[dt]);
                }
            }
    }
}

DEV void at_preload(const bf16_t* Kg, const bf16_t* Vg, int pitch, int jlo, int jhi, int tid, u32x4 (&pk)[2], u32x4 (&pv)[2]) {
    const int key = tid >> 3, ch = tid & 7;
#pragma unroll
    for (int u = 0; u < 2; ++u) { const int jt = jlo + u; pk[u] = (u32x4){0u, 0u, 0u, 0u}; pv[u] = pk[u];
        if (jt <= jhi) { pk[u] = *(const u32x4*)(Kg + (size_t)(64 * jt + key) * pitch + 8 * ch); pv[u] = *(const u32x4*)(Vg + (size_t)(64 * jt + key) * pitch + 8 * ch); } }
}

template <int MODE, bool PRE = false>
DEV void attn_pass(const bf16_t* Kg, const bf16_t* Vg, int pitch, int jlo, int jhi, unsigned char* lds, const bf16x8 (&qf)[4], f32x16 (&oacc)[2], float& lsum, float linv,
                   float m0l, int ttok, unsigned long long slo, unsigned long long shi, int t0, int qb, int tid, int wave, int lane_, unsigned long long& tcomp, unsigned long long& tpass,
                   const u32x4* pk = nullptr, const u32x4* pv = nullptr) {
    unsigned long long tc0_ = 0, tc1_ = 0, tp0_ = 0, tp1_ = 0; TSTAMP(tp0_);
    LAUNDER_V(tid); const int lane = tid & 63; (void)lane_;
    const int key = tid >> 3, ch = tid & 7;
    float* impA = (float*)(lds + AT_IA); float* impB = (float*)(lds + AT_IB);
    const int nsteps = (jhi - jlo + 2) >> 1;
    const u32x4 Z4 = (u32x4){0u, 0u, 0u, 0u};
    f32x16 negm;
    float nm0_ = (MODE == 1) ? (log2_fast(linv) - m0l) : -m0l;
    LAUNDER_V(nm0_);
#pragma unroll
    for (int i = 0; i < 16; ++i) negm[i] = nm0_;
    u32x4 rk[2][2], rv[2][2];
#define AT_LOAD(set, st) do { _Pragma("unroll") for (int u_ = 0; u_ < 2; ++u_) { const int jt_ = jlo + 2 * (st) + u_; rk[set][u_] = Z4; rv[set][u_] = Z4; \
        if (jt_ <= jhi) { rk[set][u_] = *(const u32x4*)(Kg + (size_t)(64 * jt_ + key) * pitch + 8 * ch); if (MODE != 0) rv[set][u_] = *(const u32x4*)(Vg + (size_t)(64 * jt_ + key) * pitch + 8 * ch); } } } while (0)
#define AT_WRITE(set, stage) do { _Pragma("unroll") for (int u_ = 0; u_ < 2; ++u_) { *(u32x4*)(lds + AT_KB + (stage) * AT_STAGE + ((64 * u_ + key) * ATS + 8 * ch) * 2) = rk[set][u_]; \
        if (MODE != 0) *(u32x4*)(lds + AT_KB + (stage) * AT_STAGE + AT_VOFF + ((64 * u_ + key) * ATS + 8 * ch) * 2) = rv[set][u_]; } } while (0)
    if (PRE) { rk[0][0] = pk[0]; rk[0][1] = pk[1]; rv[0][0] = pv[0]; rv[0][1] = pv[1]; } else AT_LOAD(0, 0);
    AT_WRITE(0, 0);
    if (MODE != 2 && nsteps > 1) AT_LOAD(1, 1); else { rk[1][0] = Z4; rk[1][1] = Z4; rv[1][0] = Z4; rv[1][1] = Z4; }
    __syncthreads();
#define AT_COMPUTE(st) do { const int stage_ = (st) & 1; TSTAMP(tc0_); \
        _Pragma("unroll") for (int u = 0; u < 2; ++u) { const int jt = jlo + 2 * (st) + u; if (jt > jhi) break; \
            const bf16_t* kb = (const bf16_t*)(lds + AT_KB + stage_ * AT_STAGE) + 64 * ATS * u; const bf16_t* vb = (const bf16_t*)(lds + AT_KB + stage_ * AT_STAGE + AT_VOFF) + 64 * ATS * u; \
            attn_tile<MODE>(kb, vb, jt, qf, oacc, lsum, linv, negm, ttok, slo, shi, t0, qb, impA, impB, wave, lane); } TSTAMP(tc1_); if (MODE == PROBE_MODE) tcomp += tc1_ - tc0_; } while (0)
    for (int st = 0; st < nsteps; st += 2) {
        if (MODE != 2 && st + 2 < nsteps) AT_LOAD(0, st + 2);
        AT_COMPUTE(st);
        if (MODE != 2 && st + 1 < nsteps) AT_WRITE(1, 1);
        LDS_BARRIER();
        if (MODE == 2 || st + 1 >= nsteps) break;
        if (st + 3 < nsteps) AT_LOAD(1, st + 3);
        AT_COMPUTE(st + 1);
        if (st + 2 < nsteps) AT_WRITE(0, 0);
        LDS_BARRIER();
    }
#undef AT_LOAD
#undef AT_WRITE
#undef AT_COMPUTE
    TSTAMP(tp1_); if (MODE == PROBE_MODE) tpass += tp1_ - tp0_;
}

DEV unsigned char* en_tl(unsigned char* lds, int j) { return j <= 124 ? lds + AT_SEL + 64 * (j - 1) : lds + MISC_OFF + 160; }
static_assert(AT_SEL + 64 * 124 <= MISC_OFF, "token lists");

DEV void attn_unit(const Params& p, unsigned char* lds, int b, int g, int qb, float m0c, float m0s, float m0w, int tid, int wave, int lane_) {
    LAUNDER_V(tid); const int lane = tid & 63; (void)lane_;
    unsigned char* ws = p.ws;
    const int c32 = lane & 31, h = lane >> 5, hg = lane & 3, tau = c32 >> 2; const int t0 = 64 * qb;
    const bf16_t* Q = (const bf16_t*)(ws + WS_Q); const bf16_t* QR = (const bf16_t*)(ws + WS_QR);
    const bf16_t* KC = (const bf16_t*)(ws + WS_KC) + (size_t)b * NCP * 128 + g * 64; const bf16_t* VC = (const bf16_t*)(ws + WS_VC) + (size_t)b * NCP * 128 + g * 64;
    const bf16_t* SL = (const bf16_t*)(ws + WS_SL) + (size_t)b * T_ * 256 + g * 64; const bf16_t* WN = (const bf16_t*)(ws + WS_WN) + (size_t)b * T_ * 256 + g * 64;
    const float* G = (const float*)(ws + WS_G);
    constexpr float LOG2E = 1.4426950408889634f;
    const int ttok = t0 + 8 * wave + tau; const size_t rowg = (size_t)b * T_ + ttok;
    const int hd = 4 * g + hg;
    bf16x8 qf[4]; f32x16 oacc[2], outa[2]; float lsum = 0.f, linv = 0.f; unsigned long long tcomp = 0, tpass = 0;
    unsigned long long slo = 0ull, shi = 0ull;
#pragma unroll
    for (int dt = 0; dt < 2; ++dt)
#pragma unroll
        for (int i = 0; i < 16; ++i) { oacc[dt][i] = 0.f; outa[dt][i] = 0.f; }
#pragma unroll
    for (int ks = 0; ks < 4; ++ks) qf[ks] = ld8(Q + rowg * 512 + hd * 64 + 16 * ks + 8 * h);
    const int ncmp = 4 * qb + 3;
    const int jhc = (ncmp - 1) >> 6;
#ifndef REP_CMP
#define REP_CMP 1
#endif
    for (int rep_ = 0; rep_ < REP_CMP; ++rep_) { lsum = 0.f;
    attn_pass<0>(KC, VC, 128, 0, jhc, lds, qf, oacc, lsum, linv, m0c * LOG2E, ttok, slo, shi, t0, qb, tid, wave, lane, tcomp, tpass); }
    { float L = lsum; L += __shfl_xor(L, 32); linv = L > 0.f ? 1.0f / L : 0.f; lsum = 0.f; }
    attn_pass<1>(KC, VC, 128, 0, jhc, lds, qf, oacc, lsum, linv, m0c * LOG2E, ttok, slo, shi, t0, qb, tid, wave, lane, tcomp, tpass);
    { const float gt = G[rowg * 32 + 3 * hd + 0];
#pragma unroll
        for (int dt = 0; dt < 2; ++dt)
#pragma unroll
            for (int i = 0; i < 16; ++i) { outa[dt][i] = oacc[dt][i] * gt; oacc[dt][i] = 0.f; } }
    {
        const float* impA = (const float*)(lds + AT_IA); const float* impB = (const float*)(lds + AT_IB); unsigned long long* sel = (unsigned long long*)(lds + AT_SEL);
        unsigned char* sel8 = (unsigned char*)sel;
        const int row16 = lane >> 4, i16 = lane & 15;
        {
            unsigned k[2][8], th[2] = {0u, 0u};
#pragma unroll
            for (int rnd = 0; rnd < 2; ++rnd) {
                const int tl = 8 * wave + 4 * rnd + row16; const float* ia = impA + tl * 128; const float* ib = impB + tl * 128;
                const f32x4 a0 = *(const f32x4*)(ia + 8 * i16), a1 = *(const f32x4*)(ia + 8 * i16 + 4), b0 = *(const f32x4*)(ib + 8 * i16), b1 = *(const f32x4*)(ib + 8 * i16 + 4);
                const float bm1 = ib[8 * i16 - 1];
#pragma unroll
                for (int c = 0; c < 8; ++c) { const int j = 8 * i16 + c;
                    const float av = c < 4 ? a0[c & 3] : a1[c & 3], bv = (c == 0) ? bm1 : (c <= 4 ? b0[(c - 1) & 3] : b1[(c - 5) & 3]);
                    const unsigned kv = __builtin_bit_cast(unsigned, av + bv) + 1u;
                    k[rnd][c] = (j > qb) ? 0u : ((j == 0 || j == qb || j == qb - 1) ? 0x7f800001u : kv); }
            }
#pragma unroll 1
            for (int bit = 30; bit >= 0; --bit) {
                const unsigned bm = 1u << bit;
#pragma unroll
                for (int rnd = 0; rnd < 2; ++rnd) {
                    const unsigned cand = th[rnd] | bm;
                    const int c01 = ((k[rnd][0] >= cand) ? 1 : 0) + ((k[rnd][1] >= cand) ? 1 : 0), c23 = ((k[rnd][2] >= cand) ? 1 : 0) + ((k[rnd][3] >= cand) ? 1 : 0);
                    const int c45 = ((k[rnd][4] >= cand) ? 1 : 0) + ((k[rnd][5] >= cand) ? 1 : 0), c67 = ((k[rnd][6] >= cand) ? 1 : 0) + ((k[rnd][7] >= cand) ? 1 : 0);
                    const int cnt = row16_sum((c01 + c23) + (c45 + c67));
                    th[rnd] = (cnt >= 16) ? cand : th[rnd];
                }
            }
#pragma unroll
            for (int rnd = 0; rnd < 2; ++rnd) {
                const int tl = 8 * wave + 4 * rnd + row16;
                int gt = 0, eq = 0;
#pragma unroll
                for (int c = 0; c < 8; ++c) { gt += (k[rnd][c] > th[rnd]) ? 1 : 0; eq += (k[rnd][c] == th[rnd]) ? 1 : 0; }
                const int need = (th[rnd] == 0u) ? 0 : 16 - row16_sum(gt);
                int pre = eq;
                { int t_ = row16_shr(pre, 1); pre += t_; t_ = row16_shr(pre, 2); pre += t_; t_ = row16_shr(pre, 4); pre += t_; t_ = row16_shr(pre, 8); pre += t_; }
                int run = pre - eq; unsigned bits = 0u;
#pragma unroll
                for (int c = 0; c < 8; ++c) {
                    if (k[rnd][c] > th[rnd]) bits |= 1u << c;
                    else if (k[rnd][c] == th[rnd]) { if (run < need) bits |= 1u << c; ++run; }
                }
                sel8[tl * 16 + i16] = (unsigned char)bits;
            }
        }
    }
    __syncthreads();
    {
        const unsigned long long* sel = (const unsigned long long*)(lds + AT_SEL);
        const unsigned long long mylo = sel[lane * 2], myhi = sel[lane * 2 + 1];
        __syncthreads();
        for (int jj = 0; jj < 16; ++jj) { const int j = 16 * wave + jj; if (j < 1 || j > 125) continue;
            const int bit = (int)(((j < 64) ? (mylo >> j) : (myhi >> (j - 64))) & 1ull); const unsigned long long m = __ballot(bit);
            unsigned char* tl = en_tl(lds, j);
            const int pos = __builtin_popcountll(m & ((1ull << lane) - 1ull)), cnt = __builtin_popcountll(m);
            if (bit) tl[pos] = (unsigned char)lane;
            if (lane < 16 && cnt + lane < 64) tl[cnt + lane] = 0xFFu; }
    }
    float* outl = (float*)(lds + AT_IA) + tid;
#pragma unroll
    for (int dt = 0; dt < 2; ++dt)
#pragma unroll
        for (int i = 0; i < 16; ++i) outl[(dt * 16 + i) * 512] = outa[dt][i];
#pragma unroll
    for (int ks = 0; ks < 4; ++ks) qf[ks] = ld8(QR + rowg * 512 + hd * 64 + 16 * ks + 8 * h);
#ifndef REP_WIN
#define REP_WIN 1
#endif
    for (int rep_ = 0; rep_ < REP_WIN; ++rep_)
    attn_pass<3>(WN, WN + 128, 256, qb >= 8 ? qb - 8 : 0, qb, lds, qf, oacc, lsum, linv, m0w * LOG2E, ttok, slo, shi, t0, qb, tid, wave, lane, tcomp, tpass);
    { float L = lsum; L += __shfl_xor(L, 32); const float sc = (L > 0.f ? 1.0f / L : 0.f) * G[rowg * 32 + 3 * hd + 2]; lsum = 0.f;
#pragma unroll
        for (int dt = 0; dt < 2; ++dt)
#pragma unroll
            for (int i = 0; i < 16; ++i) { outa[dt][i] = outl[(dt * 16 + i) * 512] + oacc[dt][i] * sc; oacc[dt][i] = 0.f; } }
    __syncthreads();
    {
        bf16_t* QL = (bf16_t*)(lds + EN_QL); float* OL = (float*)(lds + EN_OL); float* LL = (float*)(lds + EN_LL);
        float* outp = (float*)(lds + EN_END) + tid;
#pragma unroll
        for (int i = 0; i < 16; ++i) outp[i * 512] = outa[1][i];
        for (int i = tid; i < (EN_LL + 1024 - EN_OL) / 16; i += 512) ((u32x4*)(lds + EN_OL))[i] = (u32x4){0u, 0u, 0u, 0u};
        unsigned* qcnt = (unsigned*)(lds + MISC_OFF + 128);
        if (tid == 0) *qcnt = 0u;
#pragma unroll
        for (int k = 0; k < 4; ++k) { const int idx = tid + 512 * k, tok = idx >> 5, c = idx & 31;
            *(u32x4*)(QL + (tok * 4 + (c >> 3)) * 72 + (c & 7) * 8) = *(const u32x4*)(QR + ((size_t)b * T_ + t0 + tok) * 512 + g * 256 + c * 8); }
        __syncthreads();
        const bf16_t* VT = (const bf16_t*)(ws + WS_VT) + (size_t)(b * NGRP + g) * (T_ / 64) * 4096; const bf16_t* KF = (const bf16_t*)(ws + WS_KF) + (size_t)(b * NGRP + g) * (T_ / 64) * 4096;
        const int r32 = lane & 31, kr = (r32 & ~12) | ((r32 & 8) >> 1) | ((r32 & 4) << 1);
        const float cs0 = 17.0f - m0s * LOG2E;
#ifndef REP_SLC
#define REP_SLC 1
#endif
        for (;;) {
            unsigned tk_ = 0u; if (lane == 0) tk_ = atomicAdd(qcnt, 1u);
            tk_ = (unsigned)__shfl((int)tk_, 0);
#ifndef CPU_EMU
            tk_ = (unsigned)__builtin_amdgcn_readfirstlane((int)tk_);
#endif
            const int j = 1 + (int)tk_; if (j > qb - 2) break;
            const unsigned char* tl = en_tl(lds, j);
            int first = tl[0];
#ifndef CPU_EMU
            first = __builtin_amdgcn_readfirstlane(first);
#endif
            if (first == 0xFF) continue;
            bf16x8 kfr[2][4], vfr[2][4];
#pragma unroll
            for (int kt = 0; kt < 2; ++kt)
#pragma unroll
                for (int ks = 0; ks < 4; ++ks) kfr[kt][ks] = ld8(KF + (size_t)j * 4096 + ((kt * 4 + ks) * 64 + lane) * 8);
#pragma unroll
            for (int dt = 0; dt < 2; ++dt)
#pragma unroll
                for (int q = 0; q < 4; ++q) vfr[dt][q] = ld8(VT + (size_t)j * 4096 + ((dt * 4 + q) * 64 + lane) * 8);
            for (int gi = 0; gi < 8; ++gi) {
                const int tokidx = tl[8 * gi + tau];
                const bool valid = tokidx != 0xFF;
                if (!__any(valid)) break;
                const int ti = valid ? tokidx : 0; const int row = ti * 4 + hg;
                bf16x8 qg[4];
#pragma unroll
                for (int ks = 0; ks < 4; ++ks) qg[ks] = ld8(QL + row * 72 + 16 * ks + 8 * h);
                f32x16 s2[2];
#pragma unroll
                for (int kt = 0; kt < 2; ++kt) {
#pragma unroll
                    for (int i = 0; i < 16; ++i) s2[kt][i] = cs0;
#pragma unroll
                    for (int ks = 0; ks < 4; ++ks) s2[kt] = mfma32(kfr[kt][ks], qg[ks], s2[kt]);
                }
                float psum = 0.f;
#pragma unroll
                for (int kt = 0; kt < 2; ++kt)
#pragma unroll
                    for (int i = 0; i < 16; ++i) { const float pv = exp2_fast(s2[kt][i]); s2[kt][i] = pv; psum += pv; }
                u32x4 pw[4];
#pragma unroll
                for (int q = 0; q < 4; ++q) { const int kt = q >> 1, sp = q & 1;
                    pw[q] = (u32x4){pk2(s2[kt][8 * sp], s2[kt][8 * sp + 1]), pk2(s2[kt][8 * sp + 2], s2[kt][8 * sp + 3]), pk2(s2[kt][8 * sp + 4], s2[kt][8 * sp + 5]), pk2(s2[kt][8 * sp + 6], s2[kt][8 * sp + 7])}; }
                if (!__all(valid)) {
                    const unsigned pm = valid ? 0xffffffffu : 0u;
#pragma unroll
                    for (int q = 0; q < 4; ++q) { pw[q].x &= pm; pw[q].y &= pm; pw[q].z &= pm; pw[q].w &= pm; }
                }
                f32x16 o2[2];
#pragma unroll
                for (int dt = 0; dt < 2; ++dt) {
#pragma unroll
                    for (int i = 0; i < 16; ++i) o2[dt][i] = 0.f;
#pragma unroll
                    for (int q = 0; q < 4; ++q) o2[dt] = mfma32(vfr[dt][q], __builtin_bit_cast(bf16x8, pw[q]), o2[dt]);
                }
                psum += __shfl_xor(psum, 32);
                if (valid) {
                    unsigned* orow = (unsigned*)(OL + row * 65 + 4 * h);
#pragma unroll
                    for (int dt = 0; dt < 2; ++dt)
#pragma unroll
                        for (int i = 0; i < 16; ++i) atomicAdd(orow + 32 * dt + (i & 3) + 8 * (i >> 2), (unsigned)f2i_rn(o2[dt][i]));
                    if (h == 0) atomicAdd((unsigned*)(LL + row), (unsigned)f2i_rn(psum));
                }
            }
        }
        {
            const int key = tid >> 3, ch = tid & 7;
            const int nft = qb >= 2 ? 3 : qb + 1;
            u32x4 fk[3], fv[3];
#pragma unroll
            for (int u = 0; u < 3; ++u) { const int jt = (u == 0) ? 0 : (qb >= 2 ? qb - 2 + u : u); fk[u] = (u32x4){0u, 0u, 0u, 0u}; fv[u] = fk[u];
                if (u < nft) { fk[u] = *(const u32x4*)(SL + (size_t)(64 * jt + key) * 256 + 8 * ch); fv[u] = *(const u32x4*)(SL + 128 + (size_t)(64 * jt + key) * 256 + 8 * ch); } }
#pragma unroll
            for (int ks = 0; ks < 4; ++ks) qf[ks] = ld8(QR + rowg * 512 + hd * 64 + 16 * ks + 8 * h);
            __syncthreads();
            const int row = (8 * wave + tau) * 4 + hg;
            float Lf = (h == 0) ? (float)((const int*)LL)[row] : 0.f;
            f32x16 of[2];
            { const int* orow = (const int*)(OL + row * 65 + 4 * h);
#pragma unroll
              for (int dt = 0; dt < 2; ++dt)
#pragma unroll
                  for (int i = 0; i < 16; ++i) of[dt][i] = (float)orow[32 * dt + (i & 3) + 8 * (i >> 2)]; }
            __syncthreads();
#pragma unroll
            for (int u = 0; u < 3; ++u) { unsigned char* slot = lds + AT_KB + (u >> 1) * AT_STAGE + ((64 * (u & 1) + key) * ATS + 8 * ch) * 2;
                *(u32x4*)slot = fk[u]; *(u32x4*)(slot + AT_VOFF) = fv[u]; }
            f32x16 negm; float nm0_ = 17.0f - m0s * LOG2E; LAUNDER_V(nm0_);
#pragma unroll
            for (int i = 0; i < 16; ++i) negm[i] = nm0_;
            __syncthreads();
#pragma unroll 1
            for (int u = 0; u < nft; ++u) { const int jt = (u == 0) ? 0 : (qb >= 2 ? qb - 2 + u : u);
                const bf16_t* kb = (const bf16_t*)(lds + AT_KB + (u >> 1) * AT_STAGE) + 64 * ATS * (u & 1);
                attn_tile<2>(kb, kb + AT_VOFF / 2, jt, qf, of, Lf, linv, negm, ttok, 0ull, 0ull, t0, qb, (float*)(lds + AT_IA), (float*)(lds + AT_IB), wave, lane); }
            Lf += __shfl_xor(Lf, 32);
            const float sc = (Lf > 0.f ? 1.0f / Lf : 0.f) * G[rowg * 32 + 3 * hd + 1];
#pragma unroll
            for (int dt = 0; dt < 2; ++dt)
#pragma unroll
                for (int i = 0; i < 16; ++i) outa[dt][i] = (dt == 1 ? outp[i * 512] : outa[dt][i]) + of[dt][i] * sc;
        }
    }
    {
        const bf16_t* ZA = (const bf16_t*)(ws + WS_ZA); bf16_t* MIX = (bf16_t*)(ws + WS_MIX);
        unsigned char* stg = lds + EN_END + wave * 256;
        const int rr = lane >> 3, pc = lane & 7;
        u32x4 zr[4];
#pragma unroll
        for (int j = 0; j < 4; ++j) { const int r = 8 * j + rr; const size_t grow = (size_t)b * T_ + t0 + 8 * wave + (r >> 2);
            zr[j] = *(const u32x4*)(ZA + grow * 512 + (4 * g + (r & 3)) * 64 + 8 * pc); }
        WAVE_SYNC();
#pragma unroll
        for (int j = 0; j < 4; ++j) { const int r = 8 * j + rr; *(u32x4*)(stg + (r >> 1) * 2048 + (r & 1) * 128 + 16 * pc) = zr[j]; }
        WAVE_SYNC();
        unsigned char* myrow = stg + (c32 >> 1) * 2048 + (c32 & 1) * 128;
#pragma unroll
        for (int dt = 0; dt < 2; ++dt)
#pragma unroll
            for (int gq = 0; gq < 4; ++gq) {
                u32x2* slot = (u32x2*)(myrow + (32 * dt + 8 * gq + 4 * h) * 2); const u32x2 zv = *slot;
                float o[4];
#pragma unroll
                for (int r = 0; r < 4; ++r) { const unsigned w = zv[r >> 1]; o[r] = outa[dt][4 * gq + r] * bf2f((r & 1) ? (w >> 16) : (w & 0xffffu)); }
                *slot = (u32x2){pk2(o[0], o[1]), pk2(o[2], o[3])};
            }
        WAVE_SYNC();
#pragma unroll
        for (int j = 0; j < 4; ++j) { const int r = 8 * j + rr; const size_t grow = (size_t)b * T_ + t0 + 8 * wave + (r >> 2);
            *(u32x4*)(MIX + grow * 1024 + (4 * g + (r & 3)) * 64 + 8 * pc) = *(const u32x4*)(stg + (r >> 1) * 2048 + (r & 1) * 128 + 16 * pc); }
    }
    __syncthreads();
#ifdef PROBE_TIMING
    if (b == PROBE_B && g == 0 && qb == PROBE_QB && tid == PROBE_TID) { float* tr = (float*)(ws + WS_CTL + 32768); tr[0] = (float)tcomp; tr[1] = (float)tpass; }
#endif
}

DEV void p4_attention(const Params& p, unsigned char* lds, int vcu, int G, int tid, int wave, int lane) {
    const float gq = wave_max(fabsf(p.in[I_QNG][lane])), gc = wave_max(fabsf(p.in[I_KCNG][lane])), gs = wave_max(fabsf(p.in[I_KSNG][lane])), gw = wave_max(fabsf(p.in[I_KWNG][lane]));
    const float m0c = 8.2f * gq * gc, m0s = 8.2f * gq * gs, m0w = 8.2f * gq * gw;
#ifndef CPU_EMU
    if (wave >= 4) __builtin_amdgcn_s_setprio(1);
#endif
    for (int i = 0;; ++i) {
        const long L = (long)i * G + vcu; if (L >= AT_UNITS) break;
        int bg, qb;
        if (G == 256 && B_ * NGRP == 16 && NSB == 128) {
            const int xcd = vcu >> 5, c = vcu & 31, r = i & 3;
            bg = 2 * xcd + (i >> 2); qb = (r == 0) ? c : (r == 1) ? 63 - c : (r == 2) ? 64 + c : 127 - c;
        } else {
            const int per = B_ * NGRP * 16;
            const int k = (int)(L / per), v = (int)(L % per), s = v & 15;
            bg = v >> 4; qb = 32 * (k >> 1) + ((k & 1) ? 31 - s : s);
        }
        attn_unit(p, lds, bg / NGRP, bg % NGRP, qb, m0c, m0s, m0w, tid, wave, lane);
    }
#ifndef CPU_EMU
    __builtin_amdgcn_s_setprio(0);
#endif
}

#ifndef CPU_EMU
#define GAS __attribute__((address_space(1)))
#define LAS __attribute__((address_space(3)))
#define XB_TMO      128
#define XB_XCNT(j)  (256  + 64 * (j))
#define XB_XSUB(j)  (1280 + 64 * (j))
#define XB_XGEN(j)  (2304 + 64 * (j))
#define XB_TOP      3328
#define XB_TOPGEN   3392
#define XCD_BAR_WORDS 3456
#define XB_SPIN_CAP (1u << 20)
__device__ __forceinline__ unsigned xb_ld(unsigned* p)              { return __hip_atomic_load(p, __ATOMIC_RELAXED, __HIP_MEMORY_SCOPE_AGENT); }
__device__ __forceinline__ unsigned xb_add(unsigned* p, unsigned v) { return __hip_atomic_fetch_add(p, v, __ATOMIC_RELAXED, __HIP_MEMORY_SCOPE_AGENT); }
__device__ __forceinline__ unsigned xb_xcc_id() { return (unsigned)__builtin_amdgcn_s_getreg((3 << 11) | 20) & 0xFu; }
#define XB_SPIN(cond, bar) do { unsigned _sp = 0; while (cond) { __builtin_amdgcn_s_sleep(1); \
    if ((++_sp & 255u) == 0u) { if (xb_ld(&(bar)[XB_TMO])) break; if (_sp > XB_SPIN_CAP) { atomicAdd(&(bar)[XB_TMO], 1u); break; } } } } while (0)
struct XcdBarrier { unsigned* bar; unsigned x; volatile LAS unsigned* st; };
__device__ __forceinline__ XcdBarrier xcd_barrier_post(unsigned* bar, volatile LAS unsigned* st) {
    XcdBarrier b; b.bar = bar; b.x = xb_xcc_id(); b.st = st;
    if (threadIdx.x == 0) (void)xb_add(&bar[XB_XCNT(b.x)], 1u);
    return b;
}
__device__ __forceinline__ void xcd_barrier_complete(unsigned* bar, unsigned x, unsigned& nloc, unsigned& nx) {
    const unsigned G = gridDim.x * gridDim.y * gridDim.z;
    unsigned sum, cnt, mine, sp = 0u;
    for (;;) {
        sum = 0u; cnt = 0u; mine = 0u;
#pragma unroll
        for (unsigned j = 0; j < 16; ++j) { const unsigned c = xb_ld(&bar[XB_XCNT(j)]); sum += c; cnt += (c > 0u) ? 1u : 0u; mine = (j == x) ? c : mine; }
        if (sum == G) break;
        __builtin_amdgcn_s_sleep(1);
        if ((++sp & 255u) == 0u) { if (xb_ld(&bar[XB_TMO])) break; if (sp > XB_SPIN_CAP) { atomicAdd(&bar[XB_TMO], 1u); break; } }
    }
    nloc = mine > 0u ? mine : 1u; nx = cnt > 0u ? cnt : 1u;
}
__device__ __forceinline__ void xcd_barrier(const XcdBarrier& b) {
    asm volatile("s_waitcnt vmcnt(0)" ::: "memory");
    __syncthreads();
    if (threadIdx.x == 0) {
        unsigned* bar = b.bar;
        __builtin_amdgcn_s_waitcnt(0);
        unsigned nloc = b.st[0], nx = b.st[1];
        if (nloc == 0u) { xcd_barrier_complete(bar, b.x, nloc, nx); b.st[0] = nloc; b.st[1] = nx; }
        const unsigned old = xb_add(&bar[XB_XSUB(b.x)], 1u);
        const unsigned gen = old / nloc;
        if (old + 1u == (gen + 1u) * nloc) {
            __builtin_amdgcn_fence(__ATOMIC_RELEASE, "agent");
            asm volatile("s_waitcnt vmcnt(0)" ::: "memory");
            const unsigned og = xb_add(&bar[XB_TOP], 1u);
            const unsigned tg = og / nx;
            if (og + 1u == (tg + 1u) * nx) xb_add(&bar[XB_TOPGEN], 1u);
            else XB_SPIN(xb_ld(&bar[XB_TOPGEN]) == tg, bar);
            __builtin_amdgcn_fence(__ATOMIC_ACQUIRE, "agent");
            xb_add(&bar[XB_XGEN(b.x)], 1u);
            asm volatile("s_waitcnt vmcnt(0)" ::: "memory");
        } else {
            XB_SPIN(xb_ld(&bar[XB_XGEN(b.x)]) == gen, bar);
            __builtin_amdgcn_fence(__ATOMIC_ACQUIRE, "agent");
            asm volatile("s_waitcnt vmcnt(0)" ::: "memory");
        }
    }
    __syncthreads();
}
#endif

#ifndef CPU_EMU
__device__ __forceinline__ void group_barrier(unsigned* cnt, unsigned target) {
    asm volatile("s_waitcnt vmcnt(0)" ::: "memory");
    __syncthreads();
    if (threadIdx.x == 0) {
        __builtin_amdgcn_fence(__ATOMIC_RELEASE, "agent");
        asm volatile("s_waitcnt vmcnt(0)" ::: "memory");
        (void)xb_add(cnt, 1u);
        unsigned sp = 0u;
        while (xb_ld(cnt) < target) { __builtin_amdgcn_s_sleep(1); if (++sp > (XB_SPIN_CAP << 4)) break; }
        __builtin_amdgcn_fence(__ATOMIC_ACQUIRE, "agent");
        asm volatile("s_waitcnt vmcnt(0)" ::: "memory");
    }
    __syncthreads();
}
constexpr size_t WS_GBAR = WS_CTL + 20480;
static_assert(WS_CTL + 4096 + XCD_BAR_WORDS * 4 <= WS_GBAR && WS_GBAR + 8 * 256 <= WS_CPOS, "group barrier words");
static_assert(WS_CTL + 4096 + XCD_BAR_WORDS * 4 <= WS_CPOS && WS_CPOS + 2048 <= WS_CTL + 32768 && 32768 + 64 <= CTL_ZERO_BYTES, "barrier words vs cpos");
#endif
constexpr int N_PHASES = 6;
__global__ void __launch_bounds__(512, 2) fwd_kernel(Params p) {
#ifdef CPU_EMU
    unsigned char* lds = emu_smem;
#else
    extern __shared__ __attribute__((aligned(16))) unsigned char lds[];
#endif
    const int tid = threadIdx.x, lane = tid & 63, wave = WAVE_ID();
    const int G = gridDim.x; const int bx = blockIdx.x; const int vcu = (G % 8 == 0) ? (bx % 8) * (G / 8) + bx / 8 : bx;
#ifndef CPU_EMU
    for (int u = tid; u < 64; u += 512) ((LAS unsigned*)(lds + MISC_OFF))[u] = 0u;
    __syncthreads();
    XcdBarrier bar; bar.bar = (unsigned*)(p.ws + WS_CTL) + 1024 + p.li * XCD_BAR_WORDS; bar.x = 0; bar.st = nullptr;
    if (p.ph_hi - p.ph_lo > 1) bar = xcd_barrier_post(bar.bar, (volatile LAS unsigned*)(lds + MISC_OFF) + 8);
#define GRID_BAR() xcd_barrier(bar)
    const bool grp_ok = (G == 256 && B_ == 8 && T_ == 8192);
    unsigned* gcnt = (unsigned*)(p.ws + WS_GBAR) + 64 * (bx & 7); unsigned gtgt = 0u;
#define GROUP_BAR() do { if (grp_ok) { gtgt += 32u; group_barrier(gcnt, gtgt); } else { xcd_barrier(bar); } } while (0)
#else
#define GRID_BAR() do { } while (0)
#define GROUP_BAR() do { } while (0)
#endif
    const int lo = p.ph_lo, hi = p.ph_hi;
#ifndef PHASE_MASK
#define PHASE_MASK 63
#endif
#define IN(k) (((PHASE_MASK >> (k)) & 1) && lo <= (k) && (k) < hi)
#define BOTH(k) (IN(k) && IN((k) + 1))
#ifndef REP_PHASE
#define REP_PHASE -1
#endif
#define REPS(k) for (int rep_ = 0; rep_ < ((k) == REP_PHASE ? 2 : 1); ++rep_)
    if (IN(0)) { REPS(0) { p0_prologue(p, lds, vcu, G, tid, wave, lane); __syncthreads(); } if (BOTH(0)) GRID_BAR(); }
    if (IN(1)) { REPS(1) p1_norm(p, vcu, G, wave, lane); if (BOTH(1)) GROUP_BAR(); }
    if (IN(2)) {
        constexpr int INGEMM = 2816;
#ifdef REP_INPROJ
        struct RepOrder { pg8::StaticOrder S; int cnt; __device__ bool next(int i, pg8::Unit& u) const { return S.next(i < cnt ? i : i - cnt, u) && i < 2 * cnt; } __device__ void a_ready(const pg8::Unit&) const {} __device__ void done(const pg8::Unit&) const {} };
        pg8::Gemm g{(const bf16_t*)(p.ws + WS_HN), (const bf16_t*)(p.ws + WS_WIN), M_, INGEMM, 1024}; RepOrder S; S.S.init(M_, INGEMM, G, bx); S.cnt = (S.S.nwg - bx + G - 1) / G;
#define INPROJ_ORDER RepOrder
#else
        pg8::Gemm g{(const bf16_t*)(p.ws + WS_HN), (const bf16_t*)(p.ws + WS_WIN), M_, INGEMM, 1024}; pg8::StaticOrder S; S.init(M_, INGEMM, G, bx);
#define INPROJ_ORDER pg8::StaticOrder
#endif
        EpiInProj E{p.ws, p.in[I_QNG], p.in[I_KSNG], p.in[I_KWNG]};
        pg8::gemm_phase<EpiInProj, INPROJ_ORDER, true, true>(PG8_PTR(lds), g, S, E);
        if (BOTH(2)) GROUP_BAR();
    }
    if (IN(3)) {
        REPS(3) for (int u = vcu; u < B_ * SSM_NG; u += G) ssm_unit(p, lds, u, tid, wave, lane);
        REPS(6) for (int u = vcu; u < CMP_UNITS; u += G) compress_unit(p, lds, u, tid, wave, lane);
        {
            const bool local = (G == 256 && B_ == 8);
            auto vt_of = [&](int k) -> int { if (local) { if (k >= VT_UNITS / 256) return -1; const int loc = (vcu & 31) + 32 * k; return ((vcu >> 5) * NGRP + (loc >> 7)) * (T_ / 64) + (loc & 127); }
                                               const int u = vcu + k * G; return u < VT_UNITS ? u : -1; };
            VtPre cur, nxt; int u = vt_of(0);
            if (u >= 0) vt_fetch(p, u, tid, cur);
            for (int k = 0; u >= 0; ++k) {
                const int un = vt_of(k + 1); nxt = cur;
                if (un >= 0) vt_fetch(p, un, tid, nxt);
                vt_unit(p, lds, u, tid, cur);
                cur = nxt; u = un;
            }
        }
        if (BOTH(3)) GROUP_BAR();
    }
    if (IN(4)) {
        REPS(4) p4_attention(p, lds, vcu, G, tid, wave, lane);
        pg8::Gemm g{(const bf16_t*)(p.ws + WS_YG), (const bf16_t*)(p.ws + WS_WGLU), M_, 512, 512}; pg8::StaticOrder S; S.init(M_, 512, G, bx);
        EpiGlu E{(const bf16_t*)(p.ws + WS_YG), (const bf16_t*)(p.ws + WS_ZS), (bf16_t*)(p.ws + WS_MIX), p.in[I_GLUB]};
        REPS(7) pg8::gemm_phase<EpiGlu, pg8::StaticOrder, true, true>(PG8_PTR(lds), g, S, E);
        if (BOTH(4)) GROUP_BAR();
    }
    if (IN(5)) {
        pg8::Gemm g{(const bf16_t*)(p.ws + WS_MIX), (const bf16_t*)(p.ws + WS_WO), M_, 1024, 1024}; pg8::StaticOrder S; S.init(M_, 1024, G, bx);
        EpiOut E{p.in[I_X], p.out, (const float*)(p.ws + WS_MOD)};
        REPS(5) pg8::gemm_phase<EpiOut, pg8::StaticOrder, true, true>(PG8_PTR(lds), g, S, E);
#ifdef PROBE_TIMING
        GRID_BAR();
        if (bx == 0 && tid == 0) { const float* tr = (const float*)(p.ws + WS_CTL + 32768); p.out[0] += tr[PROBE_WHICH] * 1e-3f; }
#endif
    }
#undef IN
#undef BOTH
}

extern "C" void kernel_launch(void* const* d_in, const int* in_sizes, int n_in, void* d_out, int out_size, void* d_ws, size_t ws_size, hipStream_t stream) {
    static int grid = 0;
    if (grid == 0) {
        if (n_in != N_IN || out_size != M_ * D_ || ws_size < WS_END) { fprintf(stderr, "kernel_launch: unexpected shapes (n_in %d out %d ws %zu need %zu)\n", n_in, out_size, ws_size, (size_t)WS_END); grid = -1; return; }
#ifdef CPU_EMU
        grid = EMU_GRID;
#else
        int dev = 0, cus = 0, per_cu = 0;
        if (hipGetDevice(&dev) != hipSuccess || hipDeviceGetAttribute(&cus, hipDeviceAttributeMultiprocessorCount, dev) != hipSuccess) { grid = -1; return; }
        if (hipFuncSetAttribute((const void*)fwd_kernel, hipFuncAttributeMaxDynamicSharedMemorySize, LDS_BYTES) != hipSuccess) { fprintf(stderr, "kernel_launch: hipFuncSetAttribute failed\n"); grid = -1; return; }
        if (hipOccupancyMaxActiveBlocksPerMultiprocessor(&per_cu, (const void*)fwd_kernel, 512, LDS_BYTES) != hipSuccess || per_cu < 1) { fprintf(stderr, "kernel_launch: occupancy query says %d blocks per CU\n", per_cu); per_cu = 1; }
        (void)hipGetLastError();
        grid = cus;
#endif
    }
    if (grid < 0) return;
    (void)hipMemsetAsync((char*)d_ws + WS_CTL, 0, CTL_ZERO_BYTES, stream);
    Params a{};
    for (int i = 0; i < N_IN; ++i) a.in[i] = (const float*)d_in[i];
    a.out = (float*)d_out; a.ws = (unsigned char*)d_ws;
    for (int li = 0; li < N_LAUNCH; ++li) {
        a.ph_lo = (N_LAUNCH == 1) ? 0 : li; a.ph_hi = (N_LAUNCH == 1) ? N_PHASES : li + 1; a.li = 0;
#ifdef CPU_EMU
        emu_launch((unsigned)grid, 512u, [&]() { fwd_kernel(a); });
#else
        hipLaunchKernelGGL(fwd_kernel, dim3(grid), dim3(512), LDS_BYTES, stream, a);
#endif
    }
}
```

```cpp
#ifndef CPU_EMU
#include <hip/hip_runtime.h>
#endif
#include <cstdio>
#include <cstdint>
#include <cmath>

#ifndef BATCH_N
#define BATCH_N 8
#endif
#ifndef SEQ_LEN
#define SEQ_LEN 8192
#endif
#ifndef N_LAUNCH
#define N_LAUNCH 1
#endif
#define DEV __device__ __forceinline__

typedef unsigned short bf16_t;
typedef short bf16x8 __attribute__((ext_vector_type(8)));
typedef float f32x4 __attribute__((ext_vector_type(4)));
typedef float f32x16 __attribute__((ext_vector_type(16)));
typedef float f32x2 __attribute__((ext_vector_type(2)));
typedef unsigned u32x4 __attribute__((ext_vector_type(4)));
typedef unsigned u32x2 __attribute__((ext_vector_type(2)));

constexpr int B_ = BATCH_N, T_ = SEQ_LEN, D_ = 1024, M_ = B_ * T_;
constexpr int NH = 8, HD = 64, NGRP = 2;
constexpr int NCMP = (T_ - 32) / 16 + 1;
constexpr int NCP = T_ / 16;
constexpr int NSB = T_ / 64;
constexpr int INW = 2840, INP = 3072;
constexpr int SSM_NG = 32, SSM_P = 64, SSM_C = 16, SSM_W = 512;
constexpr int SSM_L = 64;
constexpr int SSM_CG = 32;
constexpr int SSM_NCG = T_ / (SSM_L * SSM_CG);
constexpr float EPS_ = 1e-6f;
static_assert(T_ % 2048 == 0 && NSB <= 128, "shape assumptions");

enum { I_X = 0, I_C, I_WADA, I_BADA, I_NORMG, I_WIN, I_QNG, I_KCNG, I_KSNG, I_KWNG, I_POSK, I_POSV, I_W1K, I_W2K, I_W1V, I_W2V,
       I_ARE, I_AIM, I_LOGDT, I_BRE, I_BIM, I_CRE, I_CIM, I_SSMD, I_GLUW, I_GLUB, I_WOUT, N_IN };

constexpr size_t MiB = 1u << 20;
constexpr size_t al(size_t x) { return (x + MiB - 1) / MiB * MiB; }
constexpr size_t WS_CTL = 0, CTL_ZERO_BYTES = 64 * 1024;
constexpr size_t WS_MOD = 1 * MiB;
constexpr size_t WS_ROPE = WS_MOD + al((size_t)B_ * 3072 * 4);
constexpr size_t WS_CPOS = WS_CTL + 24576;
constexpr size_t WS_LAM64 = WS_ROPE + al((size_t)T_ * 64 * 4);
constexpr size_t WS_KT = WS_LAM64 + MiB;
constexpr size_t WS_WST = WS_KT + al((size_t)32 * 65 * 256 * 2);
constexpr size_t WS_WOUTS = WS_WST + al((size_t)32 * 128 * 1024 * 2);
constexpr size_t WS_WIN = WS_WOUTS + al((size_t)32 * 1024 * 128 * 2);
constexpr size_t WS_WO = WS_WIN + al((size_t)INP * 1024 * 2);
constexpr size_t WS_WGLU = WS_WO + al((size_t)1024 * 1024 * 2);
constexpr size_t WS_W1K = WS_WGLU + MiB, WS_W1V = WS_W1K + MiB;
constexpr size_t WS_W2K = WS_W1V + MiB, WS_W2V = WS_W2K + 64 * 1024;
constexpr size_t WS_KC = WS_W2K + MiB;
constexpr size_t WS_VC = WS_KC + al((size_t)B_ * NCP * 128 * 2);
constexpr size_t WS_G = WS_VC + al((size_t)B_ * NCP * 128 * 2);
constexpr size_t WS_HN = WS_G + al((size_t)M_ * 32 * 4);
constexpr size_t WS_Q = WS_HN + al((size_t)M_ * 1024 * 2);
constexpr size_t WS_QR = WS_Q + al((size_t)M_ * 512 * 2);
constexpr size_t WS_CR = WS_QR + al((size_t)M_ * 512 * 2);
constexpr size_t WS_SL = WS_CR + al((size_t)M_ * 256 * 2);
constexpr size_t WS_WN = WS_SL + al((size_t)M_ * 256 * 2);
constexpr size_t WS_ZA = WS_WN + al((size_t)M_ * 256 * 2);
constexpr size_t WS_U = WS_ZA + al((size_t)M_ * 512 * 2);
constexpr size_t WS_ZS = WS_U + al((size_t)M_ * 512 * 2);
constexpr size_t WS_YG = WS_ZS + al((size_t)M_ * 512 * 2);
constexpr size_t WS_MIX = WS_YG + al((size_t)M_ * 512 * 2);
constexpr size_t WS_VT = WS_MIX + al((size_t)M_ * 1024 * 2);
constexpr size_t WS_KF = WS_VT + al((size_t)M_ * 128 * 2);
constexpr size_t WS_END = WS_KF + al((size_t)M_ * 128 * 2);

constexpr int RING_BYTES = 131072;
constexpr int LDS_BYTES = 155648;
constexpr int MISC_OFF = LDS_BYTES - 256;

DEV unsigned f2bf(float f) { unsigned u = __builtin_bit_cast(unsigned, f); return (u + 0x7fffu + ((u >> 16) & 1u)) >> 16; }
DEV float bf2f(unsigned h) { return __builtin_bit_cast(float, h << 16); }
#ifdef CPU_EMU
DEV unsigned pk2(float lo, float hi) { return f2bf(lo) | (f2bf(hi) << 16); }
DEV float exp2_fast(float x) { return exp2f(x); }
DEV float rcp_fast(float x) { return 1.0f / x; }
DEV float log2_fast(float x) { return log2f(x); }
DEV int f2i_rn(float x) { return (int)floorf(x + 0.5f); }
DEV f32x4 mfma16(bf16x8 a, bf16x8 b, f32x4 c) { return emu_mfma16(a, b, c); }
DEV f32x16 mfma32(bf16x8 a, bf16x8 b, f32x16 c) { return emu_mfma32(a, b, c); }
#define WAVE_ID() ((int)(threadIdx.x >> 6))
#else
typedef __bf16 bf16x2_t __attribute__((ext_vector_type(2)));
DEV unsigned pk2(float lo, float hi) { f32x2 v = {lo, hi}; bf16x2_t b = __builtin_convertvector(v, bf16x2_t); return __builtin_bit_cast(unsigned, b); }
DEV float exp2_fast(float x) { return __builtin_amdgcn_exp2f(x); }
DEV float rcp_fast(float x) { return __builtin_amdgcn_rcpf(x); }
DEV float log2_fast(float x) { return __builtin_amdgcn_logf(x); }
DEV int f2i_rn(float x) { int r; asm("v_cvt_rpi_i32_f32 %0, %1" : "=v"(r) : "v"(x)); return r; }
DEV f32x4 mfma16(bf16x8 a, bf16x8 b, f32x4 c) { return __builtin_amdgcn_mfma_f32_16x16x32_bf16(a, b, c, 0, 0, 0); }
DEV f32x16 mfma32(bf16x8 a, bf16x8 b, f32x16 c) { return __builtin_amdgcn_mfma_f32_32x32x16_bf16(a, b, c, 0, 0, 0); }
#define WAVE_ID() (__builtin_amdgcn_readfirstlane((int)(threadIdx.x >> 6)))
#endif
#ifdef CPU_EMU
#define EXPF(x) expf(x)
#else
#define EXPF(x) __expf(x)
#endif
DEV float silu_f(float v) { return v * rcp_fast(1.0f + EXPF(-v)); }
DEV float sigmoid_f(float v) { return rcp_fast(1.0f + EXPF(-v)); }
DEV float gelu_tanh_f(float v) { const float u = 0.7978845608028654f * (v + 0.044715f * v * v * v); const float e = EXPF(2.0f * u); return v * (1.0f - rcp_fast(e + 1.0f)); }
DEV float wave_sum(float v) {
#pragma unroll
    for (int o = 1; o < 64; o <<= 1) v += __shfl_xor(v, o);
    return v;
}
DEV float wave_max(float v) {
#pragma unroll
    for (int o = 1; o < 64; o <<= 1) v = fmaxf(v, __shfl_xor(v, o));
    return v;
}
DEV bf16x8 ld8(const bf16_t* p) { return *(const bf16x8*)p; }
namespace pg8 {
#define PG8_LAS __attribute__((address_space(3)))
typedef unsigned short bf16_t;
typedef short bf16x8 __attribute__((ext_vector_type(8)));
typedef float f32x4 __attribute__((ext_vector_type(4)));
typedef unsigned u32x4 __attribute__((ext_vector_type(4)));
constexpr int BM = 256, BK = 64, HALF = 128, HTB = HALF * BK * 2  , STAGE_BYTES = 8 * HTB, NXCD = 8, WGM = 8;

__host__ __device__ __forceinline__ int lds_byte(int r, int c) { const int st = (r >> 4) * 2 + (c >> 5), rr = r & 15, cc = c & 31, ob = rr * 64 + cc * 2; return st * 1024 + (ob ^ (((ob >> 9) & 1) << 5)); }
__host__ __device__ __forceinline__ void stage_rc(int b, int& R, int& C) { const int st = b / 1024, sb = b % 1024, swz = sb ^ (((sb >> 9) & 1) << 5); R = (st >> 1) * 16 + swz / 64; C = (st & 1) * 32 + (swz % 64) / 2; }
__host__ __device__ __forceinline__ int perm32(int rho) { const int n = rho >> 4, i = rho & 15; return 8 * (i >> 2) + 4 * n + (i & 3); }

struct Unit { int pm, pn; };
struct Gemm { const bf16_t* A; const bf16_t* Bt; int M, N, K; };

struct StaticOrder {
    int nM, nN, nwg, G, c;
    __host__ __device__ void init(int M, int N, int G_, int c_) { nM = M / BM; nN = N / BM; nwg = nM * nN; G = G_; c = c_; }
    __host__ __device__ bool next(int i, Unit& u) const {
        const long L = (long)i * G + c; if (L >= nwg) return false;
        int wgid = (int)L; { const int q = nwg / NXCD, r = nwg % NXCD, xcd = wgid % NXCD, off = wgid / NXCD; wgid = (xcd < r ? xcd * (q + 1) : r * (q + 1) + (xcd - r) * q) + off; }
        const int nig = WGM * nN, gid = wgid / nig, fm = gid * WGM, gsz = (nM - fm) < WGM ? (nM - fm) : WGM;
        u.pm = fm + ((wgid % nig) % gsz); u.pn = (wgid % nig) / gsz; return true;
    }
    __device__ __forceinline__ void a_ready(const Unit&) const {}
    __device__ __forceinline__ void done(const Unit&) const {}
};

#ifndef CPU_EMU
__device__ __forceinline__ unsigned cvt_pk_bf16(float lo, float hi) { unsigned r; asm volatile("v_cvt_pk_bf16_f32 %0, %1, %2" : "=v"(r) : "v"(lo), "v"(hi)); return r; }
template <class Epi, class Sched, bool ALIGN_EPI = false, bool SP2 = false>
__device__ __forceinline__ void gemm_phase(PG8_LAS unsigned char* lds, const Gemm g, const Sched& S, const Epi& E) {
    const int tid = threadIdx.x, wid = __builtin_amdgcn_readfirstlane(tid >> 6), lane = tid & 63, wr = wid >> 2, wc = wid & 3, fr = lane & 15, fq = lane >> 4;
    const int K = g.K, nt = K / BK;
    unsigned voffA[2], voffB[2];
#pragma unroll
    for (int i = 0; i < 2; ++i) { int R, C; stage_rc(tid * 16 + i * 8192, R, C); const int Rb = Epi::PERM ? ((R & ~31) + perm32(R & 31)) : R;
        voffA[i] = (unsigned)(R * K + C) * 2u; voffB[i] = (unsigned)(Rb * K + C) * 2u; }
    const size_t kstep = (size_t)(BK * 2);
    const size_t hstep = (size_t)HALF * K * 2;
    const size_t tstep = 2 * hstep;
    const unsigned ldsw = (unsigned)wid * 1024u;
    const int aoff = lds_byte(wr * 64 + fr, fq * 8), boff = lds_byte(wc * 32 + fr, fq * 8);
#define PG8_SA(b, h) (((b) * 2 + (h)) * HTB)
#define PG8_SB(b, h) ((4 + (b) * 2 + (h)) * HTB)
#define PG8_STAGE(bufoff, gbase, voff) do { _Pragma("unroll") for (int _i = 0; _i < 2; ++_i) \
        __builtin_amdgcn_global_load_lds((const unsigned*)((const char*)(gbase) + (voff)[_i]), (PG8_LAS unsigned*)(lds + (bufoff) + ldsw + _i * 8192), 16, 0, 0); } while (0)
#define PG8_LDA(dst, b, h) do { _Pragma("unroll") for (int m = 0; m < 4; ++m) _Pragma("unroll") for (int k = 0; k < 2; ++k) dst[m][k] = *(const PG8_LAS bf16x8*)(lds + PG8_SA(b, h) + aoff + m * 2048 + k * 1024); } while (0)
#define PG8_LDB(dst, b, h) do { _Pragma("unroll") for (int n = 0; n < 2; ++n) _Pragma("unroll") for (int k = 0; k < 2; ++k) dst[n][k] = *(const PG8_LAS bf16x8*)(lds + PG8_SB(b, h) + boff + n * 2048 + k * 1024); } while (0)
#define PG8_MMA(ai, bj, At, Bt) do { __builtin_amdgcn_s_setprio(1); _Pragma("unroll") for (int m = 0; m < 4; ++m) _Pragma("unroll") for (int n = 0; n < 2; ++n) _Pragma("unroll") for (int k = 0; k < 2; ++k) \
        acc[ai][bj][m][n] = __builtin_amdgcn_mfma_f32_16x16x32_bf16(Bt[n][k], At[m][k], acc[ai][bj][m][n], 0, 0, 0); __builtin_amdgcn_s_setprio(0); } while (0)
#define PG8_WAIT_V(n) asm volatile("s_waitcnt vmcnt(" #n ")" ::: "memory")
#define PG8_WAIT_L(n) asm volatile("s_waitcnt lgkmcnt(" #n ")" ::: "memory")
#define PG8_BAR __builtin_amdgcn_s_barrier()
#define PG8_SCHED __builtin_amdgcn_sched_barrier(0)
    Unit cur, nxt; int ui = 0;
    if (!S.next(0, cur)) return;
    f32x4 acc[2][2][4][2];
#pragma unroll
    for (int a = 0; a < 2; ++a)
#pragma unroll
        for (int b = 0; b < 2; ++b)
#pragma unroll
            for (int m = 0; m < 4; ++m)
#pragma unroll
                for (int n = 0; n < 2; ++n) acc[a][b][m][n] = (f32x4){0.f, 0.f, 0.f, 0.f};
    bf16x8 At[4][2], B0[2][2], B1[2][2];
    const char* cA = (const char*)g.A + (size_t)cur.pm * tstep; const char* cB = (const char*)g.Bt + (size_t)cur.pn * tstep;
    S.a_ready(cur);
    if constexpr (SP2) {
        PG8_STAGE(PG8_SB(0, 0), cB, voffB); PG8_STAGE(PG8_SB(0, 1), cB + hstep, voffB); PG8_STAGE(PG8_SA(0, 0), cA, voffA); PG8_STAGE(PG8_SA(0, 1), cA + hstep, voffA);
        if (wr == 1) PG8_BAR;
        PG8_WAIT_V(2); PG8_BAR;
        PG8_STAGE(PG8_SB(1, 0), cB + kstep, voffB); PG8_STAGE(PG8_SA(1, 0), cA + kstep, voffA); PG8_STAGE(PG8_SB(1, 1), cB + hstep + kstep, voffB);
        PG8_WAIT_V(6); PG8_BAR;
    } else {
        PG8_STAGE(PG8_SB(0, 0), cB, voffB); PG8_STAGE(PG8_SA(0, 0), cA, voffA); PG8_STAGE(PG8_SB(0, 1), cB + hstep, voffB); PG8_STAGE(PG8_SA(0, 1), cA + hstep, voffA);
        if (wr == 1) PG8_BAR;
        PG8_WAIT_V(4); PG8_BAR;
        PG8_STAGE(PG8_SB(1, 0), cB + kstep, voffB); PG8_STAGE(PG8_SA(1, 0), cA + kstep, voffA); PG8_STAGE(PG8_SB(1, 1), cB + hstep + kstep, voffB);
        PG8_WAIT_V(6); PG8_BAR;
    }
    for (;;) {
        const bool has_next = S.next(ui + 1, nxt);
        const char* nA = has_next ? (const char*)g.A + (size_t)nxt.pm * tstep : cA; const char* nB = has_next ? (const char*)g.Bt + (size_t)nxt.pn * tstep : cB;
        for (int t = 0; t < nt; t += 2) {
            const bool last = (t == nt - 2);
            const char* a1 = cA + (size_t)(t + 1) * kstep;
            const char* a2 = last ? nA : cA + (size_t)(t + 2) * kstep; const char* b2 = last ? nB : cB + (size_t)(t + 2) * kstep;
            const char* a3 = a2 + kstep; const char* b3 = b2 + kstep;
            if (last && has_next) S.a_ready(nxt);
            if constexpr (SP2) {
            PG8_LDB(B0, 0, 0); PG8_LDB(B1, 0, 1); PG8_SCHED; PG8_LDA(At, 0, 0); PG8_STAGE(PG8_SA(1, 1), a1 + hstep, voffA);
            PG8_WAIT_V(8); PG8_WAIT_L(0); PG8_BAR; PG8_MMA(0, 0, At, B0); PG8_MMA(0, 1, At, B1); PG8_BAR; PG8_SCHED;
            PG8_LDA(At, 0, 1); PG8_STAGE(PG8_SB(0, 0), b2, voffB); PG8_STAGE(PG8_SB(0, 1), b2 + hstep, voffB); PG8_STAGE(PG8_SA(0, 0), a2, voffA);
            PG8_WAIT_V(8); PG8_WAIT_L(0); PG8_BAR; PG8_MMA(1, 0, At, B0); PG8_MMA(1, 1, At, B1); PG8_BAR; PG8_SCHED;
            PG8_LDB(B0, 1, 0); PG8_LDB(B1, 1, 1); PG8_SCHED; PG8_LDA(At, 1, 0); PG8_STAGE(PG8_SA(0, 1), a2 + hstep, voffA);
            PG8_WAIT_V(8); PG8_WAIT_L(0); PG8_BAR; PG8_MMA(0, 0, At, B0); PG8_MMA(0, 1, At, B1); PG8_BAR; PG8_SCHED;
            PG8_LDA(At, 1, 1); PG8_STAGE(PG8_SB(1, 0), b3, voffB); PG8_STAGE(PG8_SB(1, 1), b3 + hstep, voffB); PG8_STAGE(PG8_SA(1, 0), a3, voffA);
            PG8_WAIT_V(8); PG8_WAIT_L(0); PG8_BAR; PG8_MMA(1, 0, At, B0); PG8_MMA(1, 1, At, B1); PG8_BAR; PG8_SCHED;
            } else {
            PG8_LDB(B0, 0, 0); PG8_SCHED; PG8_LDA(At, 0, 0); PG8_STAGE(PG8_SA(1, 1), a1 + hstep, voffA);
            PG8_WAIT_L(8); PG8_BAR; PG8_WAIT_L(0); PG8_MMA(0, 0, At, B0); PG8_BAR; PG8_SCHED;
            PG8_LDB(B1, 0, 1); PG8_STAGE(PG8_SB(0, 0), b2, voffB);
            PG8_BAR; PG8_WAIT_L(0); PG8_MMA(0, 1, At, B1); PG8_BAR;
            PG8_LDA(At, 0, 1); PG8_STAGE(PG8_SA(0, 0), a2, voffA);
            PG8_BAR; PG8_WAIT_L(0); PG8_MMA(1, 0, At, B0); PG8_BAR; PG8_SCHED;
            PG8_STAGE(PG8_SB(0, 1), b2 + hstep, voffB);
            PG8_WAIT_V(6); PG8_BAR; PG8_MMA(1, 1, At, B1); PG8_BAR;
            PG8_LDB(B0, 1, 0); PG8_SCHED; PG8_LDA(At, 1, 0); PG8_STAGE(PG8_SA(0, 1), a2 + hstep, voffA);
            PG8_WAIT_L(8); PG8_BAR; PG8_WAIT_L(0); PG8_MMA(0, 0, At, B0); PG8_BAR; PG8_SCHED;
            PG8_LDB(B1, 1, 1); PG8_STAGE(PG8_SB(1, 0), b3, voffB);
            PG8_BAR; PG8_WAIT_L(0); PG8_MMA(0, 1, At, B1); PG8_BAR;
            PG8_LDA(At, 1, 1); PG8_STAGE(PG8_SA(1, 0), a3, voffA);
            PG8_BAR; PG8_WAIT_L(0); PG8_MMA(1, 0, At, B0); PG8_BAR; PG8_SCHED;
            PG8_STAGE(PG8_SB(1, 1), b3 + hstep, voffB);
            PG8_WAIT_V(6); PG8_BAR; PG8_MMA(1, 1, At, B1); PG8_BAR;
            }
        }
        if constexpr (ALIGN_EPI) { if (wr == 0) PG8_BAR; }
        if constexpr (!Epi::AFTER_DRAIN) { E(acc, cur, wr, wc, fr, fq); S.done(cur); }
        if (!has_next) break;
#pragma unroll
        for (int a = 0; a < 2; ++a)
#pragma unroll
            for (int b = 0; b < 2; ++b)
#pragma unroll
                for (int m = 0; m < 4; ++m)
#pragma unroll
                    for (int n = 0; n < 2; ++n) acc[a][b][m][n] = (f32x4){0.f, 0.f, 0.f, 0.f};
        cur = nxt; cA = nA; cB = nB; ++ui;
        if constexpr (ALIGN_EPI) { if (wr == 1) PG8_BAR; }
    }
    PG8_WAIT_V(0);
    if constexpr (!ALIGN_EPI) { if (wr == 0) PG8_BAR; }
    PG8_BAR;
    if constexpr (Epi::AFTER_DRAIN) { E.fused(acc, cur, wr, wc, fr, fq, lds, wid, lane); S.done(cur); }
#undef PG8_SA
#undef PG8_SB
#undef PG8_STAGE
#undef PG8_LDA
#undef PG8_LDB
#undef PG8_MMA
#undef PG8_WAIT_V
#undef PG8_WAIT_L
#undef PG8_BAR
#undef PG8_SCHED
}
}
#define PG8_PTR(x) ((__attribute__((address_space(3))) unsigned char*)(x))
#else
template <class Epi, class Sched, bool ALIGN_EPI = false, bool SP2 = false>
inline void gemm_phase(unsigned char* lds, const Gemm g, const Sched& S, const Epi& E) {
    const int tid = threadIdx.x, wid = tid >> 6, lane = tid & 63, wr = wid >> 2, wc = wid & 3, fr = lane & 15, fq = lane >> 4;
    Unit cur;
    for (int ui = 0; S.next(ui, cur); ++ui) {
        f32x4 acc[2][2][4][2];
        for (int ai = 0; ai < 2; ++ai) for (int bj = 0; bj < 2; ++bj) for (int m = 0; m < 4; ++m) for (int n = 0; n < 2; ++n) for (int i = 0; i < 4; ++i) {
            const int row = 256 * cur.pm + 128 * ai + 64 * wr + 16 * m + fr;
            const int col = 256 * cur.pn + 128 * bj + 32 * wc + (Epi::PERM ? 8 * fq + 4 * n + i : 16 * n + 4 * fq + i);
            const bf16_t* a = g.A + (size_t)row * g.K; const bf16_t* b = g.Bt + (size_t)col * g.K; float s = 0.f;
            for (int k = 0; k < g.K; ++k) s += emu_bf2f(a[k]) * emu_bf2f(b[k]);
            acc[ai][bj][m][n][i] = s; }
        E(acc, cur, wr, wc, fr, fq);
    }
}
}
#define PG8_PTR(x) (x)
#endif
#ifdef CPU_EMU
#define WAVE_SYNC() emu_wave_sync()
#define SCHED_FENCE() do { } while (0)
#define LAUNDER_V(x) do { } while (0)
#define LDS_BARRIER() __syncthreads()
#else
#define LDS_BARRIER() do { asm volatile("s_waitcnt lgkmcnt(0)" ::: "memory"); __builtin_amdgcn_s_barrier(); asm volatile("" ::: "memory"); } while (0)
#define LAUNDER_V(x) asm volatile("" : "+v"(x))
#define WAVE_SYNC() asm volatile("s_waitcnt lgkmcnt(0)" ::: "memory")
#define SCHED_FENCE() __builtin_amdgcn_sched_barrier(0)
#endif

struct Params { const float* in[N_IN]; float* out; unsigned char* ws; int ph_lo, ph_hi, li, pad; };

constexpr float QSCALE = 0.125f * 1.4426950408889634f;
DEV void gates_rows(unsigned char* ws, size_t row0, int lane) {
    const int r = lane & 15, kq = lane >> 4;
    const bf16_t* HN = (const bf16_t*)(ws + WS_HN) + (row0 + r) * 1024 + 8 * kq;
    const bf16_t* WG = (const bf16_t*)(ws + WS_WIN) + (size_t)(2816 + r) * 1024 + 8 * kq;
    f32x4 acc[2][2];
#pragma unroll
    for (int rb = 0; rb < 2; ++rb)
#pragma unroll
        for (int cb = 0; cb < 2; ++cb) acc[rb][cb] = (f32x4){0.f, 0.f, 0.f, 0.f};
    bf16x8 hb[2][4][2], wb[2][4][2];
#define GU_LOAD(bt) do { _Pragma("unroll") for (int q = 0; q < 4; ++q) { const int s_ = 4 * (bt) + q; hb[(bt) & 1][q][0] = ld8(HN + 32 * s_); hb[(bt) & 1][q][1] = ld8(HN + 16 * 1024 + 32 * s_); \
        wb[(bt) & 1][q][0] = ld8(WG + 32 * s_); wb[(bt) & 1][q][1] = ld8(WG + 16 * 1024 + 32 * s_); } } while (0)
    GU_LOAD(0);
#pragma unroll
    for (int bt = 0; bt < 8; ++bt) {
        if (bt < 7) GU_LOAD(bt + 1);
        SCHED_FENCE();
#pragma unroll
        for (int q = 0; q < 4; ++q) {
            const bf16x8 h0 = hb[bt & 1][q][0], h1 = hb[bt & 1][q][1], w0 = wb[bt & 1][q][0], w1 = wb[bt & 1][q][1];
            acc[0][0] = mfma16(w0, h0, acc[0][0]); acc[0][1] = mfma16(w1, h0, acc[0][1]);
            acc[1][0] = mfma16(w0, h1, acc[1][0]); acc[1][1] = mfma16(w1, h1, acc[1][1]);
        }
        SCHED_FENCE();
    }
#undef GU_LOAD
    float* Gp = (float*)(ws + WS_G);
#pragma unroll
    for (int rb = 0; rb < 2; ++rb)
#pragma unroll
        for (int cb = 0; cb < 2; ++cb) { f32x4 o;
#pragma unroll
            for (int i = 0; i < 4; ++i) o[i] = sigmoid_f(acc[rb][cb][i]);
            *(f32x4*)(Gp + (row0 + 16 * rb + r) * 32 + 16 * cb + 4 * kq) = o; }
}

struct EpiInProj {
    static constexpr bool PERM = true, AFTER_DRAIN = false;
    unsigned char* ws; const float* qng; const float* ksng; const float* kwng;
    DEV void operator()(const f32x4 (&acc)[2][2][4][2], const pg8::Unit& u, int wr, int wc, int fr, int fq) const {
        const int pn = u.pn; const int row0 = u.pm * 256 + wr * 64 + fr;
        int kind; bf16_t* dst = nullptr; bf16_t* dst2 = nullptr; int pitch = 512, colb = 0; const float* gv = nullptr;
        if (pn < 2) { kind = 2; dst = (bf16_t*)(ws + WS_Q); dst2 = (bf16_t*)(ws + WS_QR); colb = (4 * pn + wc) * 64; gv = qng; }
        else if (pn == 2) { kind = 0; dst = (bf16_t*)(ws + WS_CR); pitch = 256; colb = wc * 64; }
        else if (pn == 3) { kind = wc < 2 ? 1 : 0; dst = (bf16_t*)(ws + WS_SL); pitch = 256; colb = wc * 64; gv = ksng; }
        else if (pn == 4) { kind = wc < 2 ? 1 : 0; dst = (bf16_t*)(ws + WS_WN); pitch = 256; colb = wc * 64; gv = kwng; }
        else if (pn < 7) { kind = 3; dst = (bf16_t*)(ws + WS_ZA); colb = (4 * (pn - 5) + wc) * 64; }
        else if (pn < 9) { kind = 0; dst = (bf16_t*)(ws + WS_U); colb = (4 * (pn - 7) + wc) * 64; }
        else if (pn < 11) { kind = 3; dst = (bf16_t*)(ws + WS_ZS); colb = (4 * (pn - 9) + wc) * 64; }
        else { kind = (wc == 0) ? 4 : 5; }
        if (kind == 5) return;
        float g1[8], g2[8];
        if (kind == 1 || kind == 2) {
#pragma unroll
            for (int i = 0; i < 8; ++i) { const float qs = (kind == 2) ? QSCALE : 1.0f; g1[i] = gv[8 * fq + i] * qs; g2[i] = gv[32 + 8 * fq + i] * qs; }
        }
        const float* rope = (const float*)(ws + WS_ROPE);
#pragma unroll
        for (int ai = 0; ai < 2; ++ai)
#pragma unroll
            for (int m = 0; m < 4; ++m) {
                const int row = row0 + ai * 128 + m * 16;
                float x1[8], x2[8];
#pragma unroll
                for (int i = 0; i < 4; ++i) { x1[i] = acc[ai][0][m][0][i]; x1[4 + i] = acc[ai][0][m][1][i]; x2[i] = acc[ai][1][m][0][i]; x2[4 + i] = acc[ai][1][m][1][i]; }
                if (kind == 4) {
                    float* G = (float*)(ws + WS_G) + (size_t)row * 32 + 8 * fq;
                    f32x4 o0, o1;
#pragma unroll
                    for (int i = 0; i < 4; ++i) { o0[i] = sigmoid_f(x1[i]); o1[i] = sigmoid_f(x1[4 + i]); }
                    *(f32x4*)G = o0; *(f32x4*)(G + 4) = o1;
                    continue;
                }
                if (kind == 1 || kind == 2) {
                    float ss = 0.f;
#pragma unroll
                    for (int i = 0; i < 8; ++i) ss += x1[i] * x1[i] + x2[i] * x2[i];
                    ss += __shfl_xor(ss, 16); ss += __shfl_xor(ss, 32);
                    const float rinv = rsqrtf(ss * (1.0f / 64.0f) + EPS_);
#pragma unroll
                    for (int i = 0; i < 8; ++i) { x1[i] = x1[i] * rinv * g1[i]; x2[i] = x2[i] * rinv * g2[i]; }
                    if (kind == 2) {
                        bf16_t* o = dst + (size_t)row * pitch + colb + 8 * fq;
                        *(u32x4*)o = (u32x4){pk2(x1[0], x1[1]), pk2(x1[2], x1[3]), pk2(x1[4], x1[5]), pk2(x1[6], x1[7])};
                        *(u32x4*)(o + 32) = (u32x4){pk2(x2[0], x2[1]), pk2(x2[2], x2[3]), pk2(x2[4], x2[5]), pk2(x2[6], x2[7])};
                    }
                    const int t = row % T_;
                    const float* cs = rope + (size_t)t * 32 + 8 * fq; const float* sn = cs + (size_t)T_ * 32;
                    const f32x4 c0 = *(const f32x4*)cs, c1 = *(const f32x4*)(cs + 4), s0 = *(const f32x4*)sn, s1 = *(const f32x4*)(sn + 4);
#pragma unroll
                    for (int i = 0; i < 8; ++i) { const float c = i < 4 ? c0[i & 3] : c1[i & 3], s = i < 4 ? s0[i & 3] : s1[i & 3]; const float a = x1[i], b = x2[i]; x1[i] = a * c - b * s; x2[i] = b * c + a * s; }
                } else if (kind == 3) {
#pragma unroll
                    for (int i = 0; i < 8; ++i) { x1[i] = silu_f(x1[i]); x2[i] = silu_f(x2[i]); }
                }
                bf16_t* o = (kind == 2 ? dst2 : dst) + (size_t)row * pitch + colb + 8 * fq;
                *(u32x4*)o = (u32x4){pk2(x1[0], x1[1]), pk2(x1[2], x1[3]), pk2(x1[4], x1[5]), pk2(x1[6], x1[7])};
                *(u32x4*)(o + 32) = (u32x4){pk2(x2[0], x2[1]), pk2(x2[2], x2[3]), pk2(x2[4], x2[5]), pk2(x2[6], x2[7])};
            }
    }
};

struct EpiGlu {
    static constexpr bool PERM = true, AFTER_DRAIN = false;
    const bf16_t* YG; const bf16_t* ZS; bf16_t* MIX; const float* glub;
    DEV void operator()(const f32x4 (&acc)[2][2][4][2], const pg8::Unit& u, int wr, int wc, int fr, int fq) const {
        const int row0 = u.pm * 256 + wr * 64 + fr, col0 = u.pn * 256 + wc * 32 + 8 * fq;
        f32x4 bv[2][2]; u32x4 ya[2][2], za[2][2];
#pragma unroll
        for (int bj = 0; bj < 2; ++bj) { bv[bj][0] = *(const f32x4*)(glub + col0 + bj * 128); bv[bj][1] = *(const f32x4*)(glub + col0 + bj * 128 + 4); }
#define EG_ROW(grp, mm) (row0 + (((grp) >> 1) & 1) * 128 + (2 * ((grp) & 1) + (mm)) * 16)
#define EG_COL(grp) (col0 + ((grp) >> 2) * 128)
#define EG_LOAD(grp) do { _Pragma("unroll") for (int mm = 0; mm < 2; ++mm) { ya[(grp) & 1][mm] = *(const u32x4*)(YG + (size_t)EG_ROW(grp, mm) * 512 + EG_COL(grp)); za[(grp) & 1][mm] = *(const u32x4*)(ZS + (size_t)EG_ROW(grp, mm) * 512 + EG_COL(grp)); } } while (0)
        EG_LOAD(0);
#pragma unroll
        for (int grp = 0; grp < 8; ++grp) {
            const int bj = grp >> 2, ai = (grp >> 1) & 1;
            if (grp < 7) EG_LOAD(grp + 1);
            SCHED_FENCE();
#pragma unroll
            for (int mm = 0; mm < 2; ++mm) {
                const int m = 2 * (grp & 1) + mm; const u32x4 yv = ya[grp & 1][mm], zv = za[grp & 1][mm];
                float o[8];
#pragma unroll
                for (int i = 0; i < 8; ++i) {
                    const float a = (i < 4 ? acc[ai][bj][m][0][i & 3] : acc[ai][bj][m][1][i & 3]) + (i < 4 ? bv[bj][0][i & 3] : bv[bj][1][i & 3]);
                    const unsigned yw = yv[i >> 1], zw = zv[i >> 1];
                    const float y = bf2f((i & 1) ? (yw >> 16) : (yw & 0xffffu)), z = bf2f((i & 1) ? (zw >> 16) : (zw & 0xffffu));
                    o[i] = y * sigmoid_f(a) * z;
                }
                *(u32x4*)(MIX + (size_t)EG_ROW(grp, mm) * 1024 + 512 + EG_COL(grp)) = (u32x4){pk2(o[0], o[1]), pk2(o[2], o[3]), pk2(o[4], o[5]), pk2(o[6], o[7])};
            }
            SCHED_FENCE();
        }
#undef EG_ROW
#undef EG_COL
#undef EG_LOAD
    }
};

struct EpiOut {
    static constexpr bool PERM = true, AFTER_DRAIN = false;
    const float* x; float* out; const float* mod;
    DEV void operator()(const f32x4 (&acc)[2][2][4][2], const pg8::Unit& u, int wr, int wc, int fr, int fq) const {
        const int row0 = u.pm * 256 + wr * 64 + fr, col0 = u.pn * 256 + wc * 32 + 8 * fq; const int b = (u.pm * 256) / T_;
        f32x4 gv[2][2], xa[2][2][2];
#pragma unroll
        for (int bj = 0; bj < 2; ++bj) { gv[bj][0] = *(const f32x4*)(mod + (size_t)b * 3072 + 2048 + col0 + bj * 128); gv[bj][1] = *(const f32x4*)(mod + (size_t)b * 3072 + 2048 + col0 + bj * 128 + 4); }
#define EO_OFF(grp, mm) ((size_t)(row0 + (((grp) >> 1) & 1) * 128 + (2 * ((grp) & 1) + (mm)) * 16) * 1024 + col0 + ((grp) >> 2) * 128)
#define EO_LOAD(grp) do { _Pragma("unroll") for (int mm = 0; mm < 2; ++mm) { xa[(grp) & 1][mm][0] = *(const f32x4*)(x + EO_OFF(grp, mm)); xa[(grp) & 1][mm][1] = *(const f32x4*)(x + EO_OFF(grp, mm) + 4); } } while (0)
        EO_LOAD(0);
#pragma unroll
        for (int grp = 0; grp < 8; ++grp) {
            const int bj = grp >> 2, ai = (grp >> 1) & 1;
            if (grp < 7) EO_LOAD(grp + 1);
            SCHED_FENCE();
#pragma unroll
            for (int mm = 0; mm < 2; ++mm) {
                const int m = 2 * (grp & 1) + mm;
                *(f32x4*)(out + EO_OFF(grp, mm)) = xa[grp & 1][mm][0] + gv[bj][0] * acc[ai][bj][m][0];
                *(f32x4*)(out + EO_OFF(grp, mm) + 4) = xa[grp & 1][mm][1] + gv[bj][1] * acc[ai][bj][m][1];
            }
            SCHED_FENCE();
        }
#undef EO_OFF
#undef EO_LOAD
    }
};

DEV size_t frag_idx(int row, int k, int K) { return ((size_t)((row >> 4) * (K >> 5) + (k >> 5)) * 64 + 16 * ((k >> 3) & 3) + (row & 15)) * 8 + (k & 7); }
DEV void tr_item(const float* W, int Nsrc, int K, int k0, int col0, int nvalid, bf16_t* WT, int drow0, float* scr, int lane, bool frag = false) {
    const int c = lane & 31;
#pragma unroll 8
    for (int i = 0; i < 32; ++i) { const int kk = 2 * i + (lane >> 5); scr[kk * 33 + c] = (c < nvalid) ? W[(size_t)(k0 + kk) * Nsrc + col0 + c] : 0.f; }
    WAVE_SYNC();
    const int c8 = lane & 7;
#pragma unroll
    for (int j = 0; j < 4; ++j) { const int n = (lane >> 3) + 8 * j; const float* s = scr + (8 * c8) * 33 + n;
        u32x4 o; o.x = pk2(s[0 * 33], s[1 * 33]); o.y = pk2(s[2 * 33], s[3 * 33]); o.z = pk2(s[4 * 33], s[5 * 33]); o.w = pk2(s[6 * 33], s[7 * 33]);
        const int row = drow0 + n, k8 = (k0 >> 3) + c8;
        *(u32x4*)(WT + (frag ? ((size_t)((row >> 4) * (K >> 5) + (k8 >> 2)) * 64 + 16 * (k8 & 3) + (row & 15)) * 8 : (size_t)row * K + k0 + 8 * c8)) = o; }
    WAVE_SYNC();
}

DEV void p0_prologue(const Params& p, unsigned char* lds, int vcu, int G, int tid, int wave, int lane) {
    unsigned char* ws = p.ws;
    {
        const float* c = p.in[I_C]; const float* w = p.in[I_WADA]; const float* ba = p.in[I_BADA]; float* mod = (float*)(ws + WS_MOD);
        for (int cb = vcu; cb < 256; cb += G)
            for (int b = wave; b < B_; b += 8) {
                float a[12];
#pragma unroll
                for (int j = 0; j < 12; ++j) a[j] = 0.f;
#pragma unroll 8
                for (int i = 0; i < 16; ++i) {
                    const int k = lane + 64 * i; const float s = silu_f(c[b * 1024 + k]);
                    const f32x4* wp = (const f32x4*)(w + (size_t)k * 3072 + 12 * cb); const f32x4 w0 = wp[0], w1 = wp[1], w2 = wp[2];
#pragma unroll
                    for (int j = 0; j < 4; ++j) { a[j] += s * w0[j]; a[4 + j] += s * w1[j]; a[8 + j] += s * w2[j]; }
                }
#pragma unroll
                for (int j = 0; j < 12; ++j) a[j] = wave_sum(a[j]);
                if (lane == 0) {
#pragma unroll
                    for (int j = 0; j < 12; ++j) mod[b * 3072 + 12 * cb + j] = a[j] + ba[12 * cb + j];
                }
            }
    }
    {
        float* scr = (float*)(lds + wave * 16384);
        const int gw = vcu * 8 + wave, NGW = G * 8;
        constexpr int I_IN = 96 * 16, I_O = 32 * 16, I_GL = 16 * 8, I_W1 = 8 * 32, I_W2 = 2 * 4;
        constexpr int NIT = I_IN + I_O + I_GL + 2 * I_W1 + 2 * I_W2;
        for (int it = gw; it < NIT; it += NGW) {
            int r = it;
            if (r < I_IN) {
                const int ci = r / 16, kb = r % 16, n0 = 32 * ci, pn = n0 >> 8, bj = (n0 >> 7) & 1, wc = (n0 >> 5) & 3, L0 = 256 * pn + 64 * wc + 32 * bj;
                int oc, nv; if (L0 < 1792) { oc = L0; nv = 32; } else if (L0 < 2816) { oc = L0 + 24; nv = 32; } else if (L0 == 2816) { oc = 1792; nv = 24; } else { oc = 0; nv = 0; }
                tr_item(p.in[I_WIN], INW, 1024, 64 * kb, oc, nv, (bf16_t*)(ws + WS_WIN), n0, scr, lane); continue; }
            r -= I_IN;
            if (r < I_O) { tr_item(p.in[I_WOUT], 1024, 1024, 64 * (r % 16), 32 * (r / 16), 32, (bf16_t*)(ws + WS_WO), 32 * (r / 16), scr, lane); continue; }
            r -= I_O;
            if (r < I_GL) { tr_item(p.in[I_GLUW], 512, 512, 64 * (r % 8), 32 * (r / 8), 32, (bf16_t*)(ws + WS_WGLU), 32 * (r / 8), scr, lane); continue; }
            r -= I_GL;
            if (r < I_W1) { tr_item(p.in[I_W1K], 256, 2048, 64 * (r % 32), 32 * (r / 32), 32, (bf16_t*)(ws + WS_W1K), 32 * (r / 32), scr, lane, true); continue; }
            r -= I_W1;
            if (r < I_W1) { tr_item(p.in[I_W1V], 256, 2048, 64 * (r % 32), 32 * (r / 32), 32, (bf16_t*)(ws + WS_W1V), 32 * (r / 32), scr, lane, true); continue; }
            r -= I_W1;
            if (r < I_W2) { tr_item(p.in[I_W2K], 64, 256, 64 * (r % 4), 32 * (r / 4), 32, (bf16_t*)(ws + WS_W2K), 32 * (r / 4), scr, lane); continue; }
            r -= I_W2;
            tr_item(p.in[I_W2V], 64, 256, 64 * (r % 4), 32 * (r / 4), 32, (bf16_t*)(ws + WS_W2V), 32 * (r / 4), scr, lane);
        }
    }
    {
        const float H1[32] = {2.037182617e+01f, 1.527673340e+01f, 1.145593262e+01f, 8.590698242e+00f, 6.442138672e+00f, 4.830932617e+00f, 3.622680664e+00f, 2.716613770e+00f, 2.037170410e+00f, 1.527679443e+00f, 1.145599365e+00f, 8.590698242e-01f, 6.442108154e-01f, 4.830932617e-01f, 3.622665405e-01f, 2.716636658e-01f, 2.037181854e-01f, 1.527671814e-01f, 1.145591736e-01f, 8.590698242e-02f, 6.442165375e-02f, 4.830932617e-02f, 3.622674942e-02f, 2.716636658e-02f, 2.037191391e-02f, 1.527667046e-02f, 1.145589352e-02f, 8.590698242e-03f, 6.442129612e-03f, 4.830896854e-03f, 3.622680902e-03f, 2.716630697e-03f};
        const float L1[32] = {6.543887594e-06f, -1.416575378e-05f, -9.063650396e-06f, 3.259562436e-05f, 4.341966076e-07f, -9.333384696e-06f, 3.694024997e-07f, 1.383195467e-05f, 1.289177635e-05f, -7.611160072e-06f, -7.100949915e-06f, 3.214027856e-06f, 3.140712124e-06f, -1.001640385e-06f, 1.570408244e-06f, -8.980337611e-07f, 1.371793559e-07f, 1.700163388e-08f, 6.043357104e-08f, 3.195055172e-07f, -2.581333831e-07f, -9.542085166e-08f, 6.167339706e-08f, -9.075201035e-08f, -8.022654185e-08f, 4.843524337e-08f, 2.941089683e-08f, 3.325492770e-08f, 9.949448376e-09f, 2.627999152e-08f, 1.475850692e-10f, -2.996157100e-09f};
        const float H2[32] = {1.591548920e-01f, 1.193494797e-01f, 8.949947357e-02f, 6.711483002e-02f, 5.032920837e-02f, 3.774166107e-02f, 2.830219269e-02f, 2.122354507e-02f, 1.591539383e-02f, 1.193499565e-02f, 8.949995041e-03f, 6.711483002e-03f, 5.032896996e-03f, 3.774166107e-03f, 2.830207348e-03f, 2.122372389e-03f, 1.591548324e-03f, 1.193493605e-03f, 8.949935436e-04f, 6.711483002e-04f, 5.032941699e-04f, 3.774166107e-04f, 2.830214798e-04f, 2.122372389e-04f, 1.591555774e-04f, 1.193489879e-04f, 8.949916810e-05f, 6.711483002e-05f, 5.032913759e-05f, 3.774138168e-05f, 2.830219455e-05f, 2.122367732e-05f};
        const float L2[32] = {5.112412182e-08f, -1.106699514e-07f, -7.080976872e-08f, 2.546533153e-07f, 3.392160997e-09f, -7.291706794e-08f, 2.885957029e-09f, 1.080621459e-07f, 1.007170027e-07f, -5.946218806e-08f, -5.547617121e-08f, 2.510959263e-08f, 2.453681347e-08f, -7.825315507e-09f, 1.226881441e-08f, -7.015888759e-09f, 1.071713718e-09f, 1.328252647e-10f, 4.721372737e-10f, 2.496136853e-09f, -2.016667056e-09f, -7.454754036e-10f, 4.818234145e-10f, -7.090000809e-10f, -6.267698582e-10f, 3.784003388e-10f, 2.297726315e-10f, 2.598041227e-10f, 7.773006544e-11f, 2.053124337e-10f, 1.153008353e-12f, -2.340747735e-11f};
        float* rc = (float*)(ws + WS_ROPE); float* rs = rc + (size_t)T_ * 32;
        for (int i = vcu * 512 + tid; i < T_ * 32; i += G * 512) {
            const int t = i >> 5, d = i & 31; const float th = (float)(t >> 7), tl = (float)(t & 127);
            const float a = th * H1[d], c = tl * H2[d];
            float rev = (a - floorf(a)) + (c - floorf(c)) + (th * L1[d] + tl * L2[d]);
            rev -= floorf(rev);
#ifdef CPU_EMU
            rc[i] = cosf(6.283185307179586f * rev); rs[i] = sinf(6.283185307179586f * rev);
#else
            rc[i] = __builtin_amdgcn_cosf(rev); rs[i] = __builtin_amdgcn_sinf(rev);
#endif
        }
    }
    __syncthreads();
    {
        f32x2* lp = (f32x2*)lds;
        f32x2* bb = lp + 64;
        f32x2* cc = bb + 1024;
        f32x2* ee = cc + 1024;
        for (int it = vcu; it < 32 * 13 + 32; it += G) {
            if (it >= 32 * 13) {
                const int r = it - 32 * 13, kv = r >> 4, ks = r & 15; const float* pos = p.in[kv ? I_POSV : I_POSK]; const float* w1 = p.in[kv ? I_W1V : I_W1K];
                const int j = tid & 255, i0 = 128 * ks + 64 * (tid >> 8); float a = 0.f;
#pragma unroll 16
                for (int i = i0; i < i0 + 64; ++i) a += pos[i] * w1[(size_t)i * 256 + j];
                atomicAdd((unsigned*)(ws + WS_CPOS) + kv * 256 + j, (unsigned)(int)__builtin_rintf(a * 16777216.0f));
                continue;
            }
            const int g = it / 13, nb = it % 13;
            const float dt = expf(p.in[I_LOGDT][g]);
            for (int e = tid; e < 1024; e += 512) {
                const int pp = e >> 4, ci = e & 15;
                const float ar = p.in[I_ARE][g * 64 + pp], ai = p.in[I_AIM][g * 64 + pp], x = ar * dt, y = ai * dt;
                const float em1 = expm1f(x), ex = em1 + 1.0f, cy = cosf(y), sy = sinf(y), sh = sinf(0.5f * y);
                const float lr = em1 * cy - 2.0f * sh * sh, li = ex * sy;
                const float den = ar * ar + ai * ai, fr_ = (lr * ar + li * ai) / den, fi_ = (li * ar - lr * ai) / den;
                const float br = p.in[I_BRE][(g * 64 + pp) * 16 + ci], bi = p.in[I_BIM][(g * 64 + pp) * 16 + ci];
                bb[e] = (f32x2){fr_ * br - fi_ * bi, fr_ * bi + fi_ * br};
                const int co = e >> 6, p2 = e & 63;
                cc[e] = (f32x2){p.in[I_CRE][(g * 16 + co) * 64 + p2], p.in[I_CIM][(g * 16 + co) * 64 + p2]};
            }
            for (int n = 5 * nb; n < 5 * nb + 5; ++n) {
                if (tid < 64) {
                    const float ar = p.in[I_ARE][g * 64 + tid], ai = p.in[I_AIM][g * 64 + tid];
                    const float mag = expf(ar * dt * (float)n), ang = ai * dt * (float)n;
                    lp[tid] = (f32x2){mag * cosf(ang), mag * sinf(ang)};
                }
                __syncthreads();
                for (int e = tid; e < 1024; e += 512) { const f32x2 l = lp[e >> 4], b = bb[e]; ee[e] = (f32x2){l.x * b.x - l.y * b.y, l.x * b.y + l.y * b.x}; }
                __syncthreads();
                if (n < 64) {
                    bf16_t* KT = (bf16_t*)(ws + WS_KT) + (size_t)g * 65 * 256;
                    if (tid < 256) {
                        const int co = tid >> 4, ci = tid & 15; float a = 0.f;
                        for (int pp = 0; pp < 64; ++pp) { const f32x2 c = cc[co * 64 + pp], e = ee[pp * 16 + ci]; a += c.x * e.x - c.y * e.y; }
                        KT[(n + 1) * 256 + tid] = (bf16_t)f2bf(a);
                        if (n == 0) KT[tid] = 0;
                    }
                    bf16_t* WST = (bf16_t*)(ws + WS_WST) + (size_t)g * 128 * 1024; const int sidx = 63 - n;
                    for (int e = tid; e < 1024; e += 512) { const int pp = e >> 4, ci = e & 15; const f32x2 v = ee[e];
                        WST[frag_idx(pp, sidx * 16 + ci, 1024)] = (bf16_t)f2bf(v.x); WST[frag_idx(64 + pp, sidx * 16 + ci, 1024)] = (bf16_t)f2bf(v.y); }
                }
                if (n >= 1) {
                    bf16_t* WO = (bf16_t*)(ws + WS_WOUTS) + (size_t)g * 1024 * 128; const int t = n - 1;
                    for (int e = tid; e < 1024; e += 512) { const int co = e >> 6, pp = e & 63; const f32x2 c = cc[e], l = lp[pp];
                        WO[frag_idx(t * 16 + co, pp, 128)] = (bf16_t)f2bf(c.x * l.x - c.y * l.y); WO[frag_idx(t * 16 + co, 64 + pp, 128)] = (bf16_t)f2bf(-(c.x * l.y + c.y * l.x)); }
                }
                if (n == 64 && tid < 64) ((f32x2*)(ws + WS_LAM64))[g * 64 + tid] = lp[tid];
                __syncthreads();
            }
        }
    }
}

DEV void p1_norm(const Params& p, int vcu, int G, int wave, int lane) {
    const float* x = p.in[I_X]; const float* ng = p.in[I_NORMG]; const float* mod = (const float*)(p.ws + WS_MOD); bf16_t* HN = (bf16_t*)(p.ws + WS_HN);
    const int gw = vcu * 8 + wave, NGW = G * 8;
    constexpr int RB = 32;
    for (int it = gw; it < M_ / RB; it += NGW) {
        const int r0 = it * RB, b = r0 / T_;
        f32x4 cs[4], sh[4];
#pragma unroll
        for (int j = 0; j < 4; ++j) { const int k = 4 * lane + 256 * j; const f32x4 g = *(const f32x4*)(ng + k), sc = *(const f32x4*)(mod + (size_t)b * 3072 + 1024 + k);
            cs[j] = g * (sc + 1.0f); sh[j] = *(const f32x4*)(mod + (size_t)b * 3072 + k); }
        for (int r = r0; r < r0 + RB; ++r) {
            const f32x4* xr = (const f32x4*)(x + (size_t)r * 1024) + lane; f32x4 v[4]; float s = 0.f;
#pragma unroll
            for (int j = 0; j < 4; ++j) { v[j] = xr[64 * j]; s += (v[j].x * v[j].x + v[j].y * v[j].y) + (v[j].z * v[j].z + v[j].w * v[j].w); }
            const float rinv = rsqrtf(wave_sum(s) * (1.0f / 1024.0f) + EPS_);
            u32x2* o = (u32x2*)(HN + (size_t)r * 1024) + lane;
#pragma unroll
            for (int j = 0; j < 4; ++j) { const f32x4 h = v[j] * rinv * cs[j] + sh[j]; o[64 * j] = (u32x2){pk2(h.x, h.y), pk2(h.z, h.w)}; }
        }
#ifndef CPU_EMU
        asm volatile("s_waitcnt vmcnt(0)" ::: "memory");
#else
        emu_wave_sync();
#endif
        gates_rows(p.ws, (size_t)r0, lane);
    }
}

constexpr int UL_CH = 2064;
constexpr int SSM_UL = 0, SSM_KT = 32 * UL_CH, SSM_SLOC = SSM_KT + 65 * 256 * 2, SSM_CBT = SSM_SLOC + 128 * 32 * 4, SSM_END = SSM_CBT + 32 * 272;
static_assert(SSM_END <= RING_BYTES, "ssm lds");
DEV void ssm_unit(const Params& p, unsigned char* lds, int unit, int tid, int wave, int lane) {
    const int b = unit / SSM_NG, g = unit % SSM_NG; const int l16 = lane & 15, q4 = lane >> 4;
    unsigned char* ws = p.ws;
    const bf16_t* U = (const bf16_t*)(ws + WS_U); bf16_t* YG = (bf16_t*)(ws + WS_YG);
    const bf16_t* WST = (const bf16_t*)(ws + WS_WST) + (size_t)g * 128 * 1024; const bf16_t* WO = (const bf16_t*)(ws + WS_WOUTS) + (size_t)g * 1024 * 128;
    unsigned char* ul = lds + SSM_UL; bf16_t* ktl = (bf16_t*)(lds + SSM_KT); float* sloc = (float*)(lds + SSM_SLOC); bf16_t* cbt = (bf16_t*)(lds + SSM_CBT);
    { const u32x4* src = (const u32x4*)((const bf16_t*)(ws + WS_KT) + (size_t)g * 65 * 256); u32x4* dstv = (u32x4*)ktl; for (int i = tid; i < 65 * 256 * 2 / 16; i += 512) dstv[i] = src[i]; }
    float sre = 0.f, sim = 0.f; f32x2 lam = {0.f, 0.f};
    if (wave == 0) lam = ((const f32x2*)(ws + WS_LAM64))[g * 64 + lane];
    f32x4 dsk = *(const f32x4*)(p.in[I_SSMD] + 16 * g + 4 * q4);
    for (int cg = 0; cg < SSM_NCG; ++cg) {
        const size_t tokbase = (size_t)b * T_ + (size_t)cg * 2048;
#pragma unroll
        for (int i = 0; i < 8; ++i) { const int idx = tid + 512 * i, tok = idx >> 1, hf = idx & 1;
            *(u32x4*)(ul + (tok >> 6) * UL_CH + (tok & 63) * 32 + hf * 16) = *(const u32x4*)(U + (tokbase + tok) * 512 + 16 * g + 8 * hf); }
        __syncthreads();
        {
            f32x4 a1[2] = {(f32x4){0.f, 0.f, 0.f, 0.f}, (f32x4){0.f, 0.f, 0.f, 0.f}};
            const bf16_t* ap = WST + ((size_t)wave * 32 * 64 + lane) * 8;
            const unsigned char* bp = ul + l16 * UL_CH + (q4 >> 1) * 32 + (q4 & 1) * 16;
            bf16x8 aa[2][4];
#pragma unroll
            for (int q = 0; q < 4; ++q) aa[0][q] = ld8(ap + 512 * q);
#pragma unroll
            for (int kb = 0; kb < 8; ++kb) {
                if (kb < 7) {
#pragma unroll
                    for (int q = 0; q < 4; ++q) aa[(kb + 1) & 1][q] = ld8(ap + 512 * (4 * kb + 4 + q));
                }
                SCHED_FENCE();
#pragma unroll
                for (int q = 0; q < 4; ++q) { const int ks = 4 * kb + q;
                    const bf16x8 b0 = *(const bf16x8*)(bp + ks * 64), b1 = *(const bf16x8*)(bp + 16 * UL_CH + ks * 64);
                    a1[0] = mfma16(aa[kb & 1][q], b0, a1[0]); a1[1] = mfma16(aa[kb & 1][q], b1, a1[1]); }
                SCHED_FENCE();
            }
#pragma unroll
            for (int ct = 0; ct < 2; ++ct)
#pragma unroll
                for (int r = 0; r < 4; ++r) sloc[(16 * wave + 4 * q4 + r) * 32 + 16 * ct + l16] = a1[ct][r];
        }
        __syncthreads();
        if (wave == 0) {
            for (int c = 0; c < 32; ++c) {
                cbt[c * 136 + lane] = (bf16_t)f2bf(sre); cbt[c * 136 + 64 + lane] = (bf16_t)f2bf(sim);
                const float lr = sloc[lane * 32 + c], li = sloc[(64 + lane) * 32 + c];
                const float nr = lam.x * sre - lam.y * sim + lr, ni = lam.x * sim + lam.y * sre + li; sre = nr; sim = ni;
            }
        }
        __syncthreads();
        for (int i = 0; i < 8; ++i) {
            const int t = wave + 8 * i;
            f32x4 a3[2] = {(f32x4){0.f, 0.f, 0.f, 0.f}, (f32x4){0.f, 0.f, 0.f, 0.f}};
            const unsigned char* bp = ul + l16 * UL_CH + (q4 >> 1) * 32 + (q4 & 1) * 16;
            const bf16_t* kp = ktl + (t - (q4 >> 1) + 1) * 256 + l16 * 16 + 8 * (q4 & 1);
            const int nks = (t >> 1) + 1;
            const bf16_t* wp = WO + ((size_t)t * 4 * 64 + lane) * 8;
            bf16x8 wa[4];
#pragma unroll
            for (int ks = 0; ks < 4; ++ks) wa[ks] = ld8(wp + 512 * ks);
            {
                bf16x8 an = ld8(kp), b0n = *(const bf16x8*)(bp), b1n = *(const bf16x8*)(bp + 16 * UL_CH);
                for (int ks = 0; ks < nks; ++ks) {
                    const bf16x8 a = an, b0 = b0n, b1 = b1n;
                    const int kn = (ks + 1 < nks) ? ks + 1 : ks;
                    an = ld8(kp - kn * 512); b0n = *(const bf16x8*)(bp + kn * 64); b1n = *(const bf16x8*)(bp + 16 * UL_CH + kn * 64);
                    a3[0] = mfma16(a, b0, a3[0]); a3[1] = mfma16(a, b1, a3[1]);
                }
            }
#pragma unroll
            for (int ks = 0; ks < 4; ++ks) {
                const bf16x8 b0 = ld8(cbt + l16 * 136 + 32 * ks + 8 * q4), b1 = ld8(cbt + (16 + l16) * 136 + 32 * ks + 8 * q4);
                a3[0] = mfma16(wa[ks], b0, a3[0]); a3[1] = mfma16(wa[ks], b1, a3[1]);
            }
#pragma unroll
            for (int ct = 0; ct < 2; ++ct) {
                const int chunk = 16 * ct + l16; const size_t tok = tokbase + (size_t)chunk * 64 + t;
                const u32x2 uv = *(const u32x2*)(ul + chunk * UL_CH + t * 32 + 8 * q4);
                float y[4];
#pragma unroll
                for (int r = 0; r < 4; ++r) { const unsigned w = uv[r >> 1]; const float uu = bf2f((r & 1) ? (w >> 16) : (w & 0xffffu)); y[r] = gelu_tanh_f(a3[ct][r] + dsk[r] * uu); }
                *(u32x2*)(YG + tok * 512 + 16 * g + 4 * q4) = (u32x2){pk2(y[0], y[1]), pk2(y[2], y[3])};
            }
        }
        __syncthreads();
    }
}

constexpr int CMP_TOK = 0, CMP_H = 528 * 128, CMP_OUT = CMP_H + 32 * 528, CMP_END = CMP_OUT + 32 * 64 * 4;
static_assert(CMP_END <= RING_BYTES, "cmp lds");
constexpr int CMP_UNITS = 2 * B_ * NGRP * (NCP / 32);
DEV void compress_unit(const Params& p, unsigned char* lds, int unit, int tid, int wave, int lane) {
    int r = unit; const int nb = r % (NCP / 32); r /= (NCP / 32); const int g = r % NGRP; r /= NGRP; const int b = r % B_; const int kv = r / B_;
    const int l16 = lane & 15, q4 = lane >> 4; unsigned char* ws = p.ws;
    const bf16_t* CR = (const bf16_t*)(ws + WS_CR); const bf16_t* w1t = (const bf16_t*)(ws + (kv ? WS_W1V : WS_W1K)); const bf16_t* w2t = (const bf16_t*)(ws + (kv ? WS_W2V : WS_W2K));
    const float* cpos = (const float*)(ws + WS_CPOS) + kv * 256;
    unsigned char* tokl = lds + CMP_TOK; bf16_t* hl = (bf16_t*)(lds + CMP_H); float* outl = (float*)(lds + CMP_OUT);
    const int n0 = 32 * nb, tk0 = 16 * n0;
    for (int idx = tid; idx < 528 * 8; idx += 512) {
        const int tl = idx >> 3, ch = idx & 7; const int tok = tk0 + tl;
        u32x4 v = (u32x4){0u, 0u, 0u, 0u};
        if (tok < T_) v = *(const u32x4*)(CR + ((size_t)b * T_ + tok) * 256 + kv * 128 + g * 64 + 8 * ch);
        *(u32x4*)(tokl + (tl * 8 + (ch ^ ((tl >> 4) & 7))) * 16) = v;
    }
    __syncthreads();
    f32x4 acc[2][2];
#pragma unroll
    for (int a = 0; a < 2; ++a)
#pragma unroll
        for (int c = 0; c < 2; ++c) acc[a][c] = (f32x4){0.f, 0.f, 0.f, 0.f};
    const bf16_t* bp0 = w1t + ((size_t)(2 * wave) * 64 * 64 + lane) * 8; const bf16_t* bp1 = bp0 + (size_t)64 * 64 * 8;
    bf16x8 bb[2][4][2];
#pragma unroll
    for (int q = 0; q < 4; ++q) { bb[0][q][0] = ld8(bp0 + 512 * q); bb[0][q][1] = ld8(bp1 + 512 * q); }
#pragma unroll
    for (int kb = 0; kb < 16; ++kb) {
        if (kb < 15) {
#pragma unroll
            for (int q = 0; q < 4; ++q) { bb[(kb + 1) & 1][q][0] = ld8(bp0 + 512 * (4 * kb + 4 + q)); bb[(kb + 1) & 1][q][1] = ld8(bp1 + 512 * (4 * kb + 4 + q)); }
        }
        SCHED_FENCE();
#pragma unroll
        for (int q = 0; q < 4; ++q) { const int ks = 4 * kb + q;
            const int l = ks >> 1, chunk = 4 * (ks & 1) + q4;
            const int tl0 = 16 * l16 + l, tl1 = 16 * (16 + l16) + l;
            const bf16x8 a0 = *(const bf16x8*)(tokl + (tl0 * 8 + (chunk ^ ((tl0 >> 4) & 7))) * 16), a1 = *(const bf16x8*)(tokl + (tl1 * 8 + (chunk ^ ((tl1 >> 4) & 7))) * 16);
            const bf16x8 b0 = bb[kb & 1][q][0], b1 = bb[kb & 1][q][1];
            acc[0][0] = mfma16(a0, b0, acc[0][0]); acc[0][1] = mfma16(a0, b1, acc[0][1]); acc[1][0] = mfma16(a1, b0, acc[1][0]); acc[1][1] = mfma16(a1, b1, acc[1][1]); }
        SCHED_FENCE();
    }
#pragma unroll
    for (int rt = 0; rt < 2; ++rt)
#pragma unroll
        for (int ct = 0; ct < 2; ++ct) { const int j = 32 * wave + 16 * ct + l16; const float cp = (float)((const int*)cpos)[j] * (1.0f / 16777216.0f);
#pragma unroll
            for (int rr = 0; rr < 4; ++rr) hl[(16 * rt + 4 * q4 + rr) * 264 + j] = (bf16_t)f2bf(gelu_tanh_f(acc[rt][ct][rr] + cp)); }
    __syncthreads();
    {
        const int rt = wave >> 2, ct = wave & 3; f32x4 a2 = (f32x4){0.f, 0.f, 0.f, 0.f};
#pragma unroll
        for (int ks = 0; ks < 8; ++ks) { const bf16x8 a = ld8(hl + (16 * rt + l16) * 264 + 32 * ks + 8 * q4), bq = ld8(w2t + (size_t)(16 * ct + l16) * 256 + 32 * ks + 8 * q4); a2 = mfma16(a, bq, a2); }
#pragma unroll
        for (int rr = 0; rr < 4; ++rr) outl[(16 * rt + 4 * q4 + rr) * 64 + 16 * ct + l16] = a2[rr];
    }
    __syncthreads();
    {
        const int row = tid >> 4, c4 = tid & 15; f32x4 v = *(const f32x4*)(outl + row * 64 + 4 * c4);
        if (kv == 0) {
            float ss = v.x * v.x + v.y * v.y + v.z * v.z + v.w * v.w;
            ss += __shfl_xor(ss, 1); ss += __shfl_xor(ss, 2); ss += __shfl_xor(ss, 4); ss += __shfl_xor(ss, 8);
            const float rinv = rsqrtf(ss * (1.0f / 64.0f) + EPS_); const f32x4 gk = *(const f32x4*)(p.in[I_KCNG] + 4 * c4);
            v = v * rinv * gk;
        }
        const int n = n0 + row; if (n >= NCMP) v = (f32x4){0.f, 0.f, 0.f, 0.f};
        bf16_t* dst = (bf16_t*)(ws + (kv ? WS_VC : WS_KC)) + (((size_t)b * NCP + n) * NGRP + g) * 64 + 4 * c4;
        *(u32x2*)dst = (u32x2){pk2(v.x, v.y), pk2(v.z, v.w)};
    }
    __syncthreads();
}

constexpr int VT_UNITS = B_ * NGRP * (T_ / 64);
struct VtPre { u32x4 v, k; };
DEV void vt_fetch(const Params& p, int unit, int tid, VtPre& r) {
    const int tb = unit % (T_ / 64), bg = unit / (T_ / 64), b = bg / NGRP, g = bg % NGRP;
    const bf16_t* SLk = (const bf16_t*)(p.ws + WS_SL) + ((size_t)b * T_ + 64 * tb) * 256 + g * 64; const bf16_t* SLv = SLk + 128;
    { const int tok = tid >> 3, ch = tid & 7; r.v = *(const u32x4*)(SLv + (size_t)tok * 256 + 8 * ch); }
    {
      const int kt = tid >> 8, ks = (tid >> 6) & 3, h = (tid >> 5) & 1, r32 = tid & 31, kr = (r32 & ~12) | ((r32 & 8) >> 1) | ((r32 & 4) << 1);
      r.k = *(const u32x4*)(SLk + (size_t)(32 * kt + kr) * 256 + 16 * ks + 8 * h); }
}
DEV void vt_unit(const Params& p, unsigned char* lds, int unit, int tid, const VtPre& r) {
    const int tb = unit % (T_ / 64), bg = unit / (T_ / 64);
    bf16_t* VF = (bf16_t*)(p.ws + WS_VT) + ((size_t)bg * (T_ / 64) + tb) * 4096; bf16_t* KF = (bf16_t*)(p.ws + WS_KF) + ((size_t)bg * (T_ / 64) + tb) * 4096;
    bf16_t* tile = (bf16_t*)lds;
    { const int tok = tid >> 3, ch = tid & 7; *(u32x4*)(tile + tok * 72 + 8 * ch) = r.v; }
    *(u32x4*)(KF + tid * 8) = r.k;
    __syncthreads();
    { const int dim = tid >> 3, c8 = tid & 7; unsigned short e[8];
#pragma unroll
      for (int i = 0; i < 8; ++i) e[i] = tile[(8 * c8 + i) * 72 + dim];
      *(u32x4*)(VF + (((dim >> 5) * 4 + (c8 >> 1)) * 64 + 32 * (c8 & 1) + (dim & 31)) * 8) = (u32x4){(unsigned)e[0] | ((unsigned)e[1] << 16), (unsigned)e[2] | ((unsigned)e[3] << 16), (unsigned)e[4] | ((unsigned)e[5] << 16), (unsigned)e[6] | ((unsigned)e[7] << 16)}; }
    __syncthreads();
}

constexpr int AT_KB = 0, AT_VOFF = 128 * 160, AT_STAGE = 2 * AT_VOFF, AT_IA = 2 * AT_STAGE, AT_IB = AT_IA + 64 * 128 * 4, AT_SEL = AT_IB + 64 * 128 * 4, AT_TM = AT_SEL + 64 * 16, AT_END = AT_TM + 128 * 8;
constexpr int EN_QL = 0, EN_OL = 40960, EN_LL = EN_OL + 256 * 65 * 4, EN_END = EN_LL + 1024;
static_assert(EN_END + 16 * 512 * 4 <= AT_SEL && 256 * 72 * 2 <= EN_OL, "engine lds");
static_assert(AT_END <= MISC_OFF, "attn lds");
constexpr int AT_UNITS = B_ * NGRP * NSB;

#ifdef CPU_EMU
DEV int row16_sum(int v) { v += __shfl_xor(v, 8); v += __shfl_xor(v, 4); v += __shfl_xor(v, 2); v += __shfl_xor(v, 1); return v; }
DEV int row16_shr(int v, int n) { const int l = threadIdx.x & 63; const int r = __shfl(v, (l & 15) >= n ? l - n : l); return (l & 15) >= n ? r : 0; }
DEV float quad_sum(float v) { v += __shfl_xor(v, 1); v += __shfl_xor(v, 2); return v; }
DEV u32x2 lds_tr16(const bf16_t* p) {
    const int w = threadIdx.x >> 6, l = threadIdx.x & 63; const unsigned long long a = (unsigned long long)(uintptr_t)p;
    emu_xbuf[w][l][0] = (unsigned)a; emu_xbuf[w][l][1] = (unsigned)(a >> 32); emu_wave_sync();
    const int g = l >> 4, i = l & 15; unsigned short e[4];
    for (int q = 0; q < 4; ++q) { const int src = 16 * g + 4 * q + (i >> 2); const unsigned long long sa = (unsigned long long)emu_xbuf[w][src][0] | ((unsigned long long)emu_xbuf[w][src][1] << 32); e[q] = ((const unsigned short*)(uintptr_t)sa)[i & 3]; }
    emu_wave_sync();
    return (u32x2){(unsigned)e[0] | ((unsigned)e[1] << 16), (unsigned)e[2] | ((unsigned)e[3] << 16)};
}
#else
DEV int row16_sum(int v) {
    v += __builtin_amdgcn_update_dpp(0, v, 0x128, 0xF, 0xF, false); v += __builtin_amdgcn_update_dpp(0, v, 0x124, 0xF, 0xF, false);
    v += __builtin_amdgcn_update_dpp(0, v, 0x122, 0xF, 0xF, false); v += __builtin_amdgcn_update_dpp(0, v, 0x121, 0xF, 0xF, false); return v;
}
#define row16_shr(v, n) __builtin_amdgcn_update_dpp(0, (v), 0x110 + (n), 0xF, 0xF, true)
DEV float quad_sum(float v) {
    v += __builtin_bit_cast(float, __builtin_amdgcn_mov_dpp(__builtin_bit_cast(int, v), 0xB1, 0xF, 0xF, true));
    v += __builtin_bit_cast(float, __builtin_amdgcn_mov_dpp(__builtin_bit_cast(int, v), 0x4E, 0xF, 0xF, true));
    return v;
}
typedef short v4i16_t __attribute__((ext_vector_type(4)));
DEV u32x2 lds_tr16(const bf16_t* p) { return __builtin_bit_cast(u32x2, __builtin_amdgcn_ds_read_tr16_b64_v4i16((__attribute__((address_space(3))) v4i16_t*)p)); }
#endif

#ifdef PROBE_TIMING
#define TSTAMP(v) do { __builtin_amdgcn_sched_barrier(0); v = __builtin_amdgcn_s_memtime(); __builtin_amdgcn_s_waitcnt(0xC07F); __builtin_amdgcn_sched_barrier(0); } while (0)
#else
#define TSTAMP(v) do { } while (0)
#endif
#ifndef PROBE_MODE
#define PROBE_MODE -1
#endif
constexpr int ATS = 80;
template <int MODE>
DEV void attn_tile(const bf16_t* kb, const bf16_t* vb, int jt, const bf16x8 (&qf)[4], f32x16 (&oacc)[2], float& lsum, float linv, const f32x16& negm, int ttok,
                   unsigned long long slo, unsigned long long shi, int t0, int qb, float* impA, float* impB, int wave, int lane) {
    const float NINF = -INFINITY;
    const int c32 = lane & 31, h = lane >> 5, hg = lane & 3, tau = c32 >> 2;
    bool nm;
    if (MODE <= 1) nm = (16 * (64 * jt + 63) + 31 > t0);
    else if (MODE == 2) nm = (jt == qb);
    else nm = (jt == qb) || (jt + 8 == qb);
    f32x16 s[2];
    if (nm) {
        const float nm0 = negm[0];
        if (MODE == 3 && jt != qb) {
            const int d2 = ttok - 512 - 64 * jt - 4 * h;
#pragma unroll
            for (int kt = 0; kt < 2; ++kt) {
                f32x16 cm;
#pragma unroll
                for (int i = 0; i < 16; ++i) cm[i] = (32 * kt + (i & 3) + 8 * (i >> 2) > d2) ? nm0 : NINF;
                s[kt] = mfma32(ld8(kb + (32 * kt + c32) * ATS + 8 * h), qf[0], cm);
            }
        } else {
            const int d = ((MODE <= 1) ? ((ttok - 31) >> 4) : ttok) - 64 * jt - 4 * h;
#pragma unroll
            for (int kt = 0; kt < 2; ++kt) {
                f32x16 cm;
#pragma unroll
                for (int i = 0; i < 16; ++i) cm[i] = (32 * kt + (i & 3) + 8 * (i >> 2) <= d) ? nm0 : NINF;
                s[kt] = mfma32(ld8(kb + (32 * kt + c32) * ATS + 8 * h), qf[0], cm);
            }
        }
    } else {
#pragma unroll
        for (int kt = 0; kt < 2; ++kt) s[kt] = mfma32(ld8(kb + (32 * kt + c32) * ATS + 8 * h), qf[0], negm);
    }
#pragma unroll
    for (int kt = 0; kt < 2; ++kt)
#pragma unroll
        for (int ks = 1; ks < 4; ++ks) { const bf16x8 a = ld8(kb + (32 * kt + c32) * ATS + 16 * ks + 8 * h); s[kt] = mfma32(a, qf[ks], s[kt]); }
    float psum = 0.f;
#pragma unroll
    for (int kt = 0; kt < 2; ++kt)
#pragma unroll
        for (int i = 0; i < 16; ++i) { const float pv = exp2_fast(s[kt][i]); s[kt][i] = pv; psum += pv; }
    if (MODE != 1) lsum += psum;
    if (MODE == 1) {
#pragma unroll
        for (int kt = 0; kt < 2; ++kt)
#pragma unroll
            for (int gq = 0; gq < 4; ++gq) {
                const float a = quad_sum(2.0f * (s[kt][4 * gq] + s[kt][4 * gq + 1] + s[kt][4 * gq + 2]) + s[kt][4 * gq + 3]), bq = quad_sum(s[kt][4 * gq + 3]);
                if (hg == 0) { const int j = 16 * jt + 8 * kt + 2 * gq + h; const int tl = 8 * wave + tau; impA[tl * 128 + j] = a; impB[tl * 128 + j] = bq; }
            }
    }
    if (MODE != 0) {
        const int l15 = lane & 15, g1 = (lane >> 4) & 1;
#pragma unroll
        for (int kt = 0; kt < 2; ++kt)
#pragma unroll
            for (int sp = 0; sp < 2; ++sp) {
                u32x4 pw = (u32x4){pk2(s[kt][8 * sp], s[kt][8 * sp + 1]), pk2(s[kt][8 * sp + 2], s[kt][8 * sp + 3]), pk2(s[kt][8 * sp + 4], s[kt][8 * sp + 5]), pk2(s[kt][8 * sp + 6], s[kt][8 * sp + 7])};
                const bf16x8 pf = __builtin_bit_cast(bf16x8, pw);
                const bf16_t* vr = vb + (32 * kt + 16 * sp + 4 * h + (l15 >> 2)) * ATS + 16 * g1 + 4 * (l15 & 3);
#pragma unroll
                for (int dt = 0; dt < 2; ++dt) {
                    const u32x2 lo = lds_tr16(vr + 32 * dt), hi = lds_tr16(vr + 8 * ATS + 32 * dt);
                    oacc[dt] = mfma32(__builtin_bit_cast(bf16x8, (u32x4){lo.x, lo.y, hi.x, hi.y}), pf, oacc[dt]);
                }
            }
    }
}

DEV void at_preload(const bf16_t* Kg, const bf16_t* Vg, int pitch, int jlo, int jhi, int tid, u32x4 (&pk)[2], u32x4 (&pv)[2]) {
    const int key = tid >> 3, ch = tid & 7;
#pragma unroll
    for (int u = 0; u < 2; ++u) { const int jt = jlo + u; pk[u] = (u32x4){0u, 0u, 0u, 0u}; pv[u] = pk[u];
        if (jt <= jhi) { pk[u] = *(const u32x4*)(Kg + (size_t)(64 * jt + key) * pitch + 8 * ch); pv[u] = *(const u32x4*)(Vg + (size_t)(64 * jt + key) * pitch + 8 * ch); } }
}

template <int MODE, bool PRE = false>
DEV void attn_pass(const bf16_t* Kg, const bf16_t* Vg, int pitch, int jlo, int jhi, unsigned char* lds, const bf16x8 (&qf)[4], f32x16 (&oacc)[2], float& lsum, float linv,
                   float m0l, int ttok, unsigned long long slo, unsigned long long shi, int t0, int qb, int tid, int wave, int lane_, unsigned long long& tcomp, unsigned long long& tpass,
                   const u32x4* pk = nullptr, const u32x4* pv = nullptr) {
    unsigned long long tc0_ = 0, tc1_ = 0, tp0_ = 0, tp1_ = 0; TSTAMP(tp0_);
    LAUNDER_V(tid); const int lane = tid & 63; (void)lane_;
    const int key = tid >> 3, ch = tid & 7;
    float* impA = (float*)(lds + AT_IA); float* impB = (float*)(lds + AT_IB);
    const int nsteps = (jhi - jlo + 2) >> 1;
    const u32x4 Z4 = (u32x4){0u, 0u, 0u, 0u};
    f32x16 negm;
    float nm0_ = (MODE == 1) ? (log2_fast(linv) - m0l) : -m0l;
    LAUNDER_V(nm0_);
#pragma unroll
    for (int i = 0; i < 16; ++i) negm[i] = nm0_;
    u32x4 rk[2][2], rv[2][2];
#define AT_LOAD(set, st) do { _Pragma("unroll") for (int u_ = 0; u_ < 2; ++u_) { const int jt_ = jlo + 2 * (st) + u_; rk[set][u_] = Z4; rv[set][u_] = Z4; \
        if (jt_ <= jhi) { rk[set][u_] = *(const u32x4*)(Kg + (size_t)(64 * jt_ + key) * pitch + 8 * ch); if (MODE != 0) rv[set][u_] = *(const u32x4*)(Vg + (size_t)(64 * jt_ + key) * pitch + 8 * ch); } } } while (0)
#define AT_WRITE(set, stage) do { _Pragma("unroll") for (int u_ = 0; u_ < 2; ++u_) { *(u32x4*)(lds + AT_KB + (stage) * AT_STAGE + ((64 * u_ + key) * ATS + 8 * ch) * 2) = rk[set][u_]; \
        if (MODE != 0) *(u32x4*)(lds + AT_KB + (stage) * AT_STAGE + AT_VOFF + ((64 * u_ + key) * ATS + 8 * ch) * 2) = rv[set][u_]; } } while (0)
    if (PRE) { rk[0][0] = pk[0]; rk[0][1] = pk[1]; rv[0][0] = pv[0]; rv[0][1] = pv[1]; } else AT_LOAD(0, 0);
    AT_WRITE(0, 0);
    if (MODE != 2 && nsteps > 1) AT_LOAD(1, 1); else { rk[1][0] = Z4; rk[1][1] = Z4; rv[1][0] = Z4; rv[1][1] = Z4; }
    __syncthreads();
#define AT_COMPUTE(st) do { const int stage_ = (st) & 1; TSTAMP(tc0_); \
        _Pragma("unroll") for (int u = 0; u < 2; ++u) { const int jt = jlo + 2 * (st) + u; if (jt > jhi) break; \
            const bf16_t* kb = (const bf16_t*)(lds + AT_KB + stage_ * AT_STAGE) + 64 * ATS * u; const bf16_t* vb = (const bf16_t*)(lds + AT_KB + stage_ * AT_STAGE + AT_VOFF) + 64 * ATS * u; \
            attn_tile<MODE>(kb, vb, jt, qf, oacc, lsum, linv, negm, ttok, slo, shi, t0, qb, impA, impB, wave, lane); } TSTAMP(tc1_); if (MODE == PROBE_MODE) tcomp += tc1_ - tc0_; } while (0)
    for (int st = 0; st < nsteps; st += 2) {
        if (MODE != 2 && st + 2 < nsteps) AT_LOAD(0, st + 2);
        AT_COMPUTE(st);
        if (MODE != 2 && st + 1 < nsteps) AT_WRITE(1, 1);
        LDS_BARRIER();
        if (MODE == 2 || st + 1 >= nsteps) break;
        if (st + 3 < nsteps) AT_LOAD(1, st + 3);
        AT_COMPUTE(st + 1);
        if (st + 2 < nsteps) AT_WRITE(0, 0);
        LDS_BARRIER();
    }
#undef AT_LOAD
#undef AT_WRITE
#undef AT_COMPUTE
    TSTAMP(tp1_); if (MODE == PROBE_MODE) tpass += tp1_ - tp0_;
}

DEV unsigned char* en_tl(unsigned char* lds, int j) { return j <= 124 ? lds + AT_SEL + 64 * (j - 1) : lds + MISC_OFF + 160; }
static_assert(AT_SEL + 64 * 124 <= MISC_OFF, "token lists");

#ifndef SEL_KSH
#define SEL_KSH 12
#endif
DEV void attn_unit(const Params& p, unsigned char* lds, int b, int g, int qb, float m0c, float m0s, float m0w, int tid, int wave, int lane_) {
    LAUNDER_V(tid); const int lane = tid & 63; (void)lane_;
    unsigned char* ws = p.ws;
    const int c32 = lane & 31, h = lane >> 5, hg = lane & 3, tau = c32 >> 2; const int t0 = 64 * qb;
    const bf16_t* Q = (const bf16_t*)(ws + WS_Q); const bf16_t* QR = (const bf16_t*)(ws + WS_QR);
    const bf16_t* KC = (const bf16_t*)(ws + WS_KC) + (size_t)b * NCP * 128 + g * 64; const bf16_t* VC = (const bf16_t*)(ws + WS_VC) + (size_t)b * NCP * 128 + g * 64;
    const bf16_t* SL = (const bf16_t*)(ws + WS_SL) + (size_t)b * T_ * 256 + g * 64; const bf16_t* WN = (const bf16_t*)(ws + WS_WN) + (size_t)b * T_ * 256 + g * 64;
    const float* G = (const float*)(ws + WS_G);
    constexpr float LOG2E = 1.4426950408889634f;
    const int ttok = t0 + 8 * wave + tau; const size_t rowg = (size_t)b * T_ + ttok;
    const int hd = 4 * g + hg;
    bf16x8 qf[4]; f32x16 oacc[2], outa[2]; float lsum = 0.f, linv = 0.f; unsigned long long tcomp = 0, tpass = 0;
    unsigned long long slo = 0ull, shi = 0ull;
#pragma unroll
    for (int dt = 0; dt < 2; ++dt)
#pragma unroll
        for (int i = 0; i < 16; ++i) { oacc[dt][i] = 0.f; outa[dt][i] = 0.f; }
#pragma unroll
    for (int ks = 0; ks < 4; ++ks) qf[ks] = ld8(Q + rowg * 512 + hd * 64 + 16 * ks + 8 * h);
    const int ncmp = 4 * qb + 3;
    const int jhc = (ncmp - 1) >> 6;
#ifndef REP_CMP
#define REP_CMP 1
#endif
    for (int rep_ = 0; rep_ < REP_CMP; ++rep_) { lsum = 0.f;
    attn_pass<0>(KC, VC, 128, 0, jhc, lds, qf, oacc, lsum, linv, m0c * LOG2E, ttok, slo, shi, t0, qb, tid, wave, lane, tcomp, tpass); }
    { float L = lsum; L += __shfl_xor(L, 32); linv = L > 0.f ? 1.0f / L : 0.f; lsum = 0.f; }
    attn_pass<1>(KC, VC, 128, 0, jhc, lds, qf, oacc, lsum, linv, m0c * LOG2E, ttok, slo, shi, t0, qb, tid, wave, lane, tcomp, tpass);
    { const float gt = G[rowg * 32 + 3 * hd + 0];
#pragma unroll
        for (int dt = 0; dt < 2; ++dt)
#pragma unroll
            for (int i = 0; i < 16; ++i) { outa[dt][i] = oacc[dt][i] * gt; oacc[dt][i] = 0.f; } }
    {
        const float* impA = (const float*)(lds + AT_IA); const float* impB = (const float*)(lds + AT_IB); unsigned long long* sel = (unsigned long long*)(lds + AT_SEL);
        unsigned char* sel8 = (unsigned char*)sel;
        const int row16 = lane >> 4, i16 = lane & 15;
        {
            unsigned k[2][8], th[2] = {0u, 0u};
#pragma unroll
            for (int rnd = 0; rnd < 2; ++rnd) {
                const int tl = 8 * wave + 4 * rnd + row16; const float* ia = impA + tl * 128; const float* ib = impB + tl * 128;
                const f32x4 a0 = *(const f32x4*)(ia + 8 * i16), a1 = *(const f32x4*)(ia + 8 * i16 + 4), b0 = *(const f32x4*)(ib + 8 * i16), b1 = *(const f32x4*)(ib + 8 * i16 + 4);
                const float bm1 = ib[8 * i16 - 1];
#pragma unroll
                for (int c = 0; c < 8; ++c) { const int j = 8 * i16 + c;
                    const float av = c < 4 ? a0[c & 3] : a1[c & 3], bv = (c == 0) ? bm1 : (c <= 4 ? b0[(c - 1) & 3] : b1[(c - 5) & 3]);
                    const unsigned kv = (__builtin_bit_cast(unsigned, av + bv) >> SEL_KSH) + 1u;
                    k[rnd][c] = (j > qb) ? 0u : ((j == 0 || j == qb || j == qb - 1) ? (0x7f800000u >> SEL_KSH) + 1u : kv); }
            }
#pragma unroll 1
            for (int bit = 30 - SEL_KSH; bit >= 0; --bit) {
                const unsigned bm = 1u << bit;
#pragma unroll
                for (int rnd = 0; rnd < 2; ++rnd) {
                    const unsigned cand = th[rnd] | bm;
                    const int c01 = ((k[rnd][0] >= cand) ? 1 : 0) + ((k[rnd][1] >= cand) ? 1 : 0), c23 = ((k[rnd][2] >= cand) ? 1 : 0) + ((k[rnd][3] >= cand) ? 1 : 0);
                    const int c45 = ((k[rnd][4] >= cand) ? 1 : 0) + ((k[rnd][5] >= cand) ? 1 : 0), c67 = ((k[rnd][6] >= cand) ? 1 : 0) + ((k[rnd][7] >= cand) ? 1 : 0);
                    const int cnt = row16_sum((c01 + c23) + (c45 + c67));
                    th[rnd] = (cnt >= 16) ? cand : th[rnd];
                }
            }
#pragma unroll
            for (int rnd = 0; rnd < 2; ++rnd) {
                const int tl = 8 * wave + 4 * rnd + row16;
                int gt = 0, eq = 0;
#pragma unroll
                for (int c = 0; c < 8; ++c) { gt += (k[rnd][c] > th[rnd]) ? 1 : 0; eq += (k[rnd][c] == th[rnd]) ? 1 : 0; }
                const int need = (th[rnd] == 0u) ? 0 : 16 - row16_sum(gt);
                int pre = eq;
                { int t_ = row16_shr(pre, 1); pre += t_; t_ = row16_shr(pre, 2); pre += t_; t_ = row16_shr(pre, 4); pre += t_; t_ = row16_shr(pre, 8); pre += t_; }
                int run = pre - eq; unsigned bits = 0u;
#pragma unroll
                for (int c = 0; c < 8; ++c) {
                    if (k[rnd][c] > th[rnd]) bits |= 1u << c;
                    else if (k[rnd][c] == th[rnd]) { if (run < need) bits |= 1u << c; ++run; }
                }
                sel8[tl * 16 + i16] = (unsigned char)bits;
            }
        }
    }
    __syncthreads();
    {
        const unsigned long long* sel = (const unsigned long long*)(lds + AT_SEL);
        const unsigned long long mylo = sel[lane * 2], myhi = sel[lane * 2 + 1];
        __syncthreads();
        for (int jj = 0; jj < 16; ++jj) { const int j = 16 * wave + jj; if (j < 1 || j > 125) continue;
            const int bit = (int)(((j < 64) ? (mylo >> j) : (myhi >> (j - 64))) & 1ull); const unsigned long long m = __ballot(bit);
            unsigned char* tl = en_tl(lds, j);
            const int pos = __builtin_popcountll(m & ((1ull << lane) - 1ull)), cnt = __builtin_popcountll(m);
            if (bit) tl[pos] = (unsigned char)lane;
            if (lane < 16 && cnt + lane < 64) tl[cnt + lane] = 0xFFu; }
    }
    float* outl = (float*)(lds + AT_IA) + tid;
#pragma unroll
    for (int dt = 0; dt < 2; ++dt)
#pragma unroll
        for (int i = 0; i < 16; ++i) outl[(dt * 16 + i) * 512] = outa[dt][i];
#pragma unroll
    for (int ks = 0; ks < 4; ++ks) qf[ks] = ld8(QR + rowg * 512 + hd * 64 + 16 * ks + 8 * h);
#ifndef REP_WIN
#define REP_WIN 1
#endif
    for (int rep_ = 0; rep_ < REP_WIN; ++rep_)
    attn_pass<3>(WN, WN + 128, 256, qb >= 8 ? qb - 8 : 0, qb, lds, qf, oacc, lsum, linv, m0w * LOG2E, ttok, slo, shi, t0, qb, tid, wave, lane, tcomp, tpass);
    { float L = lsum; L += __shfl_xor(L, 32); const float sc = (L > 0.f ? 1.0f / L : 0.f) * G[rowg * 32 + 3 * hd + 2]; lsum = 0.f;
#pragma unroll
        for (int dt = 0; dt < 2; ++dt)
#pragma unroll
            for (int i = 0; i < 16; ++i) { outa[dt][i] = outl[(dt * 16 + i) * 512] + oacc[dt][i] * sc; oacc[dt][i] = 0.f; } }
    __syncthreads();
    {
        bf16_t* QL = (bf16_t*)(lds + EN_QL); float* OL = (float*)(lds + EN_OL); float* LL = (float*)(lds + EN_LL);
        float* outp = (float*)(lds + EN_END) + tid;
#pragma unroll
        for (int i = 0; i < 16; ++i) outp[i * 512] = outa[1][i];
        for (int i = tid; i < (EN_LL + 1024 - EN_OL) / 16; i += 512) ((u32x4*)(lds + EN_OL))[i] = (u32x4){0u, 0u, 0u, 0u};
        unsigned* qcnt = (unsigned*)(lds + MISC_OFF + 128);
        if (tid == 0) *qcnt = 0u;
#pragma unroll
        for (int k = 0; k < 4; ++k) { const int idx = tid + 512 * k, tok = idx >> 5, c = idx & 31;
            *(u32x4*)(QL + (tok * 4 + (c >> 3)) * 72 + (c & 7) * 8) = *(const u32x4*)(QR + ((size_t)b * T_ + t0 + tok) * 512 + g * 256 + c * 8); }
        __syncthreads();
        const bf16_t* VT = (const bf16_t*)(ws + WS_VT) + (size_t)(b * NGRP + g) * (T_ / 64) * 4096; const bf16_t* KF = (const bf16_t*)(ws + WS_KF) + (size_t)(b * NGRP + g) * (T_ / 64) * 4096;
        const int r32 = lane & 31, kr = (r32 & ~12) | ((r32 & 8) >> 1) | ((r32 & 4) << 1);
        const float cs0 = 17.0f - m0s * LOG2E;
#ifndef REP_SLC
#define REP_SLC 1
#endif
        for (;;) {
            unsigned tk_ = 0u; if (lane == 0) tk_ = atomicAdd(qcnt, 1u);
            tk_ = (unsigned)__shfl((int)tk_, 0);
#ifndef CPU_EMU
            tk_ = (unsigned)__builtin_amdgcn_readfirstlane((int)tk_);
#endif
            const int j = 1 + (int)tk_; if (j > qb - 2) break;
            const unsigned char* tl = en_tl(lds, j);
            int first = tl[0];
#ifndef CPU_EMU
            first = __builtin_amdgcn_readfirstlane(first);
#endif
            if (first == 0xFF) continue;
            bf16x8 kfr[2][4], vfr[2][4];
#pragma unroll
            for (int kt = 0; kt < 2; ++kt)
#pragma unroll
                for (int ks = 0; ks < 4; ++ks) kfr[kt][ks] = ld8(KF + (size_t)j * 4096 + ((kt * 4 + ks) * 64 + lane) * 8);
#pragma unroll
            for (int dt = 0; dt < 2; ++dt)
#pragma unroll
                for (int q = 0; q < 4; ++q) vfr[dt][q] = ld8(VT + (size_t)j * 4096 + ((dt * 4 + q) * 64 + lane) * 8);
            for (int gi = 0; gi < 8; ++gi) {
                const int tokidx = tl[8 * gi + tau];
                const bool valid = tokidx != 0xFF;
                if (!__any(valid)) break;
                const int ti = valid ? tokidx : 0; const int row = ti * 4 + hg;
                bf16x8 qg[4];
#pragma unroll
                for (int ks = 0; ks < 4; ++ks) qg[ks] = ld8(QL + row * 72 + 16 * ks + 8 * h);
                f32x16 s2[2];
#pragma unroll
                for (int kt = 0; kt < 2; ++kt) {
#pragma unroll
                    for (int i = 0; i < 16; ++i) s2[kt][i] = cs0;
#pragma unroll
                    for (int ks = 0; ks < 4; ++ks) s2[kt] = mfma32(kfr[kt][ks], qg[ks], s2[kt]);
                }
                float psum = 0.f;
#pragma unroll
                for (int kt = 0; kt < 2; ++kt)
#pragma unroll
                    for (int i = 0; i < 16; ++i) { const float pv = exp2_fast(s2[kt][i]); s2[kt][i] = pv; psum += pv; }
                u32x4 pw[4];
#pragma unroll
                for (int q = 0; q < 4; ++q) { const int kt = q >> 1, sp = q & 1;
                    pw[q] = (u32x4){pk2(s2[kt][8 * sp], s2[kt][8 * sp + 1]), pk2(s2[kt][8 * sp + 2], s2[kt][8 * sp + 3]), pk2(s2[kt][8 * sp + 4], s2[kt][8 * sp + 5]), pk2(s2[kt][8 * sp + 6], s2[kt][8 * sp + 7])}; }
                if (!__all(valid)) {
                    const unsigned pm = valid ? 0xffffffffu : 0u;
#pragma unroll
                    for (int q = 0; q < 4; ++q) { pw[q].x &= pm; pw[q].y &= pm; pw[q].z &= pm; pw[q].w &= pm; }
                }
                f32x16 o2[2];
#pragma unroll
                for (int dt = 0; dt < 2; ++dt) {
#pragma unroll
                    for (int i = 0; i < 16; ++i) o2[dt][i] = 0.f;
#pragma unroll
                    for (int q = 0; q < 4; ++q) o2[dt] = mfma32(vfr[dt][q], __builtin_bit_cast(bf16x8, pw[q]), o2[dt]);
                }
                psum += __shfl_xor(psum, 32);
                if (valid) {
                    unsigned* orow = (unsigned*)(OL + row * 65 + 4 * h);
#pragma unroll
                    for (int dt = 0; dt < 2; ++dt)
#pragma unroll
                        for (int i = 0; i < 16; ++i) atomicAdd(orow + 32 * dt + (i & 3) + 8 * (i >> 2), (unsigned)f2i_rn(o2[dt][i]));
                    if (h == 0) atomicAdd((unsigned*)(LL + row), (unsigned)f2i_rn(psum));
                }
            }
        }
        {
            const int key = tid >> 3, ch = tid & 7;
            const int nft = qb >= 2 ? 3 : qb + 1;
            u32x4 fk[3], fv[3];
#pragma unroll
            for (int u = 0; u < 3; ++u) { const int jt = (u == 0) ? 0 : (qb >= 2 ? qb - 2 + u : u); fk[u] = (u32x4){0u, 0u, 0u, 0u}; fv[u] = fk[u];
                if (u < nft) { fk[u] = *(const u32x4*)(SL + (size_t)(64 * jt + key) * 256 + 8 * ch); fv[u] = *(const u32x4*)(SL + 128 + (size_t)(64 * jt + key) * 256 + 8 * ch); } }
#pragma unroll
            for (int ks = 0; ks < 4; ++ks) qf[ks] = ld8(QR + rowg * 512 + hd * 64 + 16 * ks + 8 * h);
            __syncthreads();
            const int row = (8 * wave + tau) * 4 + hg;
            float Lf = (h == 0) ? (float)((const int*)LL)[row] : 0.f;
            f32x16 of[2];
            { const int* orow = (const int*)(OL + row * 65 + 4 * h);
#pragma unroll
              for (int dt = 0; dt < 2; ++dt)
#pragma unroll
                  for (int i = 0; i < 16; ++i) of[dt][i] = (float)orow[32 * dt + (i & 3) + 8 * (i >> 2)]; }
            __syncthreads();
#pragma unroll
            for (int u = 0; u < 3; ++u) { unsigned char* slot = lds + AT_KB + (u >> 1) * AT_STAGE + ((64 * (u & 1) + key) * ATS + 8 * ch) * 2;
                *(u32x4*)slot = fk[u]; *(u32x4*)(slot + AT_VOFF) = fv[u]; }
            f32x16 negm; float nm0_ = 17.0f - m0s * LOG2E; LAUNDER_V(nm0_);
#pragma unroll
            for (int i = 0; i < 16; ++i) negm[i] = nm0_;
            __syncthreads();
#pragma unroll 1
            for (int u = 0; u < nft; ++u) { const int jt = (u == 0) ? 0 : (qb >= 2 ? qb - 2 + u : u);
                const bf16_t* kb = (const bf16_t*)(lds + AT_KB + (u >> 1) * AT_STAGE) + 64 * ATS * (u & 1);
                attn_tile<2>(kb, kb + AT_VOFF / 2, jt, qf, of, Lf, linv, negm, ttok, 0ull, 0ull, t0, qb, (float*)(lds + AT_IA), (float*)(lds + AT_IB), wave, lane); }
            Lf += __shfl_xor(Lf, 32);
            const float sc = (Lf > 0.f ? 1.0f / Lf : 0.f) * G[rowg * 32 + 3 * hd + 1];
#pragma unroll
            for (int dt = 0; dt < 2; ++dt)
#pragma unroll
                for (int i = 0; i < 16; ++i) outa[dt][i] = (dt == 1 ? outp[i * 512] : outa[dt][i]) + of[dt][i] * sc;
        }
    }
    {
        const bf16_t* ZA = (const bf16_t*)(ws + WS_ZA); bf16_t* MIX = (bf16_t*)(ws + WS_MIX);
        unsigned char* stg = lds + EN_END + wave * 256;
        const int rr = lane >> 3, pc = lane & 7;
        u32x4 zr[4];
#pragma unroll
        for (int j = 0; j < 4; ++j) { const int r = 8 * j + rr; const size_t grow = (size_t)b * T_ + t0 + 8 * wave + (r >> 2);
            zr[j] = *(const u32x4*)(ZA + grow * 512 + (4 * g + (r & 3)) * 64 + 8 * pc); }
        WAVE_SYNC();
#pragma unroll
        for (int j = 0; j < 4; ++j) { const int r = 8 * j + rr; *(u32x4*)(stg + (r >> 1) * 2048 + (r & 1) * 128 + 16 * pc) = zr[j]; }
        WAVE_SYNC();
        unsigned char* myrow = stg + (c32 >> 1) * 2048 + (c32 & 1) * 128;
#pragma unroll
        for (int dt = 0; dt < 2; ++dt)
#pragma unroll
            for (int gq = 0; gq < 4; ++gq) {
                u32x2* slot = (u32x2*)(myrow + (32 * dt + 8 * gq + 4 * h) * 2); const u32x2 zv = *slot;
                float o[4];
#pragma unroll
                for (int r = 0; r < 4; ++r) { const unsigned w = zv[r >> 1]; o[r] = outa[dt][4 * gq + r] * bf2f((r & 1) ? (w >> 16) : (w & 0xffffu)); }
                *slot = (u32x2){pk2(o[0], o[1]), pk2(o[2], o[3])};
            }
        WAVE_SYNC();
#pragma unroll
        for (int j = 0; j < 4; ++j) { const int r = 8 * j + rr; const size_t grow = (size_t)b * T_ + t0 + 8 * wave + (r >> 2);
            *(u32x4*)(MIX + grow * 1024 + (4 * g + (r & 3)) * 64 + 8 * pc) = *(const u32x4*)(stg + (r >> 1) * 2048 + (r & 1) * 128 + 16 * pc); }
    }
    __syncthreads();
#ifdef PROBE_TIMING
    if (b == PROBE_B && g == 0 && qb == PROBE_QB && tid == PROBE_TID) { float* tr = (float*)(ws + WS_CTL + 32768); tr[0] = (float)tcomp; tr[1] = (float)tpass; }
#endif
}

DEV void p4_attention(const Params& p, unsigned char* lds, int vcu, int G, int tid, int wave, int lane) {
    const float gq = wave_max(fabsf(p.in[I_QNG][lane])), gc = wave_max(fabsf(p.in[I_KCNG][lane])), gs = wave_max(fabsf(p.in[I_KSNG][lane])), gw = wave_max(fabsf(p.in[I_KWNG][lane]));
    const float m0c = 8.2f * gq * gc, m0s = 8.2f * gq * gs, m0w = 8.2f * gq * gw;
    for (int i = 0;; ++i) {
        const long L = (long)i * G + vcu; if (L >= AT_UNITS) break;
        int bg, qb;
        if (G == 256 && B_ * NGRP == 16 && NSB == 128) {
            const int xcd = vcu >> 5, c = vcu & 31, r = i & 3;
            bg = 2 * xcd + (i >> 2); qb = (r == 0) ? c : (r == 1) ? 63 - c : (r == 2) ? 64 + c : 127 - c;
        } else {
            const int per = B_ * NGRP * 16;
            const int k = (int)(L / per), v = (int)(L % per), s = v & 15;
            bg = v >> 4; qb = 32 * (k >> 1) + ((k & 1) ? 31 - s : s);
        }
        attn_unit(p, lds, bg / NGRP, bg % NGRP, qb, m0c, m0s, m0w, tid, wave, lane);
    }
}

#ifndef CPU_EMU
#define GAS __attribute__((address_space(1)))
#define LAS __attribute__((address_space(3)))
#define XB_TMO      128
#define XB_XCNT(j)  (256  + 64 * (j))
#define XB_XSUB(j)  (1280 + 64 * (j))
#define XB_XGEN(j)  (2304 + 64 * (j))
#define XB_TOP      3328
#define XB_TOPGEN   3392
#define XCD_BAR_WORDS 3456
#define XB_SPIN_CAP (1u << 20)
__device__ __forceinline__ unsigned xb_ld(unsigned* p)              { return __hip_atomic_load(p, __ATOMIC_RELAXED, __HIP_MEMORY_SCOPE_AGENT); }
__device__ __forceinline__ unsigned xb_add(unsigned* p, unsigned v) { return __hip_atomic_fetch_add(p, v, __ATOMIC_RELAXED, __HIP_MEMORY_SCOPE_AGENT); }
__device__ __forceinline__ unsigned xb_xcc_id() { return (unsigned)__builtin_amdgcn_s_getreg((3 << 11) | 20) & 0xFu; }
#define XB_SPIN(cond, bar) do { unsigned _sp = 0; while (cond) { __builtin_amdgcn_s_sleep(1); \
    if ((++_sp & 255u) == 0u) { if (xb_ld(&(bar)[XB_TMO])) break; if (_sp > XB_SPIN_CAP) { atomicAdd(&(bar)[XB_TMO], 1u); break; } } } } while (0)
struct XcdBarrier { unsigned* bar; unsigned x; volatile LAS unsigned* st; };
__device__ __forceinline__ XcdBarrier xcd_barrier_post(unsigned* bar, volatile LAS unsigned* st) {
    XcdBarrier b; b.bar = bar; b.x = xb_xcc_id(); b.st = st;
    if (threadIdx.x == 0) (void)xb_add(&bar[XB_XCNT(b.x)], 1u);
    return b;
}
__device__ __forceinline__ void xcd_barrier_complete(unsigned* bar, unsigned x, unsigned& nloc, unsigned& nx) {
    const unsigned G = gridDim.x * gridDim.y * gridDim.z;
    unsigned sum, cnt, mine, sp = 0u;
    for (;;) {
        sum = 0u; cnt = 0u; mine = 0u;
#pragma unroll
        for (unsigned j = 0; j < 16; ++j) { const unsigned c = xb_ld(&bar[XB_XCNT(j)]); sum += c; cnt += (c > 0u) ? 1u : 0u; mine = (j == x) ? c : mine; }
        if (sum == G) break;
        __builtin_amdgcn_s_sleep(1);
        if ((++sp & 255u) == 0u) { if (xb_ld(&bar[XB_TMO])) break; if (sp > XB_SPIN_CAP) { atomicAdd(&bar[XB_TMO], 1u); break; } }
    }
    nloc = mine > 0u ? mine : 1u; nx = cnt > 0u ? cnt : 1u;
}
__device__ __forceinline__ void xcd_barrier(const XcdBarrier& b) {
    asm volatile("s_waitcnt vmcnt(0)" ::: "memory");
    __syncthreads();
    if (threadIdx.x == 0) {
        unsigned* bar = b.bar;
        __builtin_amdgcn_s_waitcnt(0);
        unsigned nloc = b.st[0], nx = b.st[1];
        if (nloc == 0u) { xcd_barrier_complete(bar, b.x, nloc, nx); b.st[0] = nloc; b.st[1] = nx; }
        const unsigned old = xb_add(&bar[XB_XSUB(b.x)], 1u);
        const unsigned gen = old / nloc;
        if (old + 1u == (gen + 1u) * nloc) {
            __builtin_amdgcn_fence(__ATOMIC_RELEASE, "agent");
            asm volatile("s_waitcnt vmcnt(0)" ::: "memory");
            const unsigned og = xb_add(&bar[XB_TOP], 1u);
            const unsigned tg = og / nx;
            if (og + 1u == (tg + 1u) * nx) xb_add(&bar[XB_TOPGEN], 1u);
            else XB_SPIN(xb_ld(&bar[XB_TOPGEN]) == tg, bar);
            __builtin_amdgcn_fence(__ATOMIC_ACQUIRE, "agent");
            xb_add(&bar[XB_XGEN(b.x)], 1u);
            asm volatile("s_waitcnt vmcnt(0)" ::: "memory");
        } else {
            XB_SPIN(xb_ld(&bar[XB_XGEN(b.x)]) == gen, bar);
            __builtin_amdgcn_fence(__ATOMIC_ACQUIRE, "agent");
            asm volatile("s_waitcnt vmcnt(0)" ::: "memory");
        }
    }
    __syncthreads();
}
#endif

#ifndef CPU_EMU
__device__ __forceinline__ void group_barrier(unsigned* cnt, unsigned target) {
    asm volatile("s_waitcnt vmcnt(0)" ::: "memory");
    __syncthreads();
    if (threadIdx.x == 0) {
        __builtin_amdgcn_fence(__ATOMIC_RELEASE, "agent");
        asm volatile("s_waitcnt vmcnt(0)" ::: "memory");
        (void)xb_add(cnt, 1u);
        unsigned sp = 0u;
        while (xb_ld(cnt) < target) { __builtin_amdgcn_s_sleep(1); if (++sp > (XB_SPIN_CAP << 4)) break; }
        __builtin_amdgcn_fence(__ATOMIC_ACQUIRE, "agent");
        asm volatile("s_waitcnt vmcnt(0)" ::: "memory");
    }
    __syncthreads();
}
constexpr size_t WS_GBAR = WS_CTL + 20480;
static_assert(WS_CTL + 4096 + XCD_BAR_WORDS * 4 <= WS_GBAR && WS_GBAR + 8 * 256 <= WS_CPOS, "group barrier words");
static_assert(WS_CTL + 4096 + XCD_BAR_WORDS * 4 <= WS_CPOS && WS_CPOS + 2048 <= WS_CTL + 32768 && 32768 + 64 <= CTL_ZERO_BYTES, "barrier words vs cpos");
#endif
constexpr int N_PHASES = 6;
__global__ void __launch_bounds__(512, 2) fwd_kernel(Params p) {
#ifdef CPU_EMU
    unsigned char* lds = emu_smem;
#else
    extern __shared__ __attribute__((aligned(16))) unsigned char lds[];
#endif
    const int tid = threadIdx.x, lane = tid & 63, wave = WAVE_ID();
    const int G = gridDim.x; const int bx = blockIdx.x; const int vcu = (G % 8 == 0) ? (bx % 8) * (G / 8) + bx / 8 : bx;
#ifndef CPU_EMU
    for (int u = tid; u < 64; u += 512) ((LAS unsigned*)(lds + MISC_OFF))[u] = 0u;
    __syncthreads();
    XcdBarrier bar; bar.bar = (unsigned*)(p.ws + WS_CTL) + 1024 + p.li * XCD_BAR_WORDS; bar.x = 0; bar.st = nullptr;
    if (p.ph_hi - p.ph_lo > 1) bar = xcd_barrier_post(bar.bar, (volatile LAS unsigned*)(lds + MISC_OFF) + 8);
#define GRID_BAR() xcd_barrier(bar)
    const bool grp_ok = (G == 256 && B_ == 8 && T_ == 8192);
    unsigned* gcnt = (unsigned*)(p.ws + WS_GBAR) + 64 * (bx & 7); unsigned gtgt = 0u;
#define GROUP_BAR() do { if (grp_ok) { gtgt += 32u; group_barrier(gcnt, gtgt); } else { xcd_barrier(bar); } } while (0)
#else
#define GRID_BAR() do { } while (0)
#define GROUP_BAR() do { } while (0)
#endif
    const int lo = p.ph_lo, hi = p.ph_hi;
#ifndef PHASE_MASK
#define PHASE_MASK 63
#endif
#define IN(k) (((PHASE_MASK >> (k)) & 1) && lo <= (k) && (k) < hi)
#define BOTH(k) (IN(k) && IN((k) + 1))
#ifndef REP_PHASE
#define REP_PHASE -1
#endif
#define REPS(k) for (int rep_ = 0; rep_ < ((k) == REP_PHASE ? 2 : 1); ++rep_)
    if (IN(0)) { REPS(0) { p0_prologue(p, lds, vcu, G, tid, wave, lane); __syncthreads(); } if (BOTH(0)) GRID_BAR(); }
    if (IN(1)) { REPS(1) p1_norm(p, vcu, G, wave, lane); if (BOTH(1)) GROUP_BAR(); }
    if (IN(2)) {
        constexpr int INGEMM = 2816;
#ifdef REP_INPROJ
        struct RepOrder { pg8::StaticOrder S; int cnt; __device__ bool next(int i, pg8::Unit& u) const { return S.next(i < cnt ? i : i - cnt, u) && i < 2 * cnt; } __device__ void a_ready(const pg8::Unit&) const {} __device__ void done(const pg8::Unit&) const {} };
        pg8::Gemm g{(const bf16_t*)(p.ws + WS_HN), (const bf16_t*)(p.ws + WS_WIN), M_, INGEMM, 1024}; RepOrder S; S.S.init(M_, INGEMM, G, bx); S.cnt = (S.S.nwg - bx + G - 1) / G;
#define INPROJ_ORDER RepOrder
#else
        pg8::Gemm g{(const bf16_t*)(p.ws + WS_HN), (const bf16_t*)(p.ws + WS_WIN), M_, INGEMM, 1024}; pg8::StaticOrder S; S.init(M_, INGEMM, G, bx);
#define INPROJ_ORDER pg8::StaticOrder
#endif
        EpiInProj E{p.ws, p.in[I_QNG], p.in[I_KSNG], p.in[I_KWNG]};
        pg8::gemm_phase<EpiInProj, INPROJ_ORDER, true, true>(PG8_PTR(lds), g, S, E);
        if (BOTH(2)) GROUP_BAR();
    }
    if (IN(3)) {
        REPS(3) for (int u = vcu; u < B_ * SSM_NG; u += G) ssm_unit(p, lds, u, tid, wave, lane);
        REPS(6) for (int u = vcu; u < CMP_UNITS; u += G) compress_unit(p, lds, u, tid, wave, lane);
        {
            const bool local = (G == 256 && B_ == 8);
            auto vt_of = [&](int k) -> int { if (local) { if (k >= VT_UNITS / 256) return -1; const int loc = (vcu & 31) + 32 * k; return ((vcu >> 5) * NGRP + (loc >> 7)) * (T_ / 64) + (loc & 127); }
                                               const int u = vcu + k * G; return u < VT_UNITS ? u : -1; };
            VtPre cur, nxt; int u = vt_of(0);
            if (u >= 0) vt_fetch(p, u, tid, cur);
            for (int k = 0; u >= 0; ++k) {
                const int un = vt_of(k + 1); nxt = cur;
                if (un >= 0) vt_fetch(p, un, tid, nxt);
                vt_unit(p, lds, u, tid, cur);
                cur = nxt; u = un;
            }
        }
        if (BOTH(3)) GROUP_BAR();
    }
    if (IN(4)) {
        REPS(4) p4_attention(p, lds, vcu, G, tid, wave, lane);
        pg8::Gemm g{(const bf16_t*)(p.ws + WS_YG), (const bf16_t*)(p.ws + WS_WGLU), M_, 512, 512}; pg8::StaticOrder S; S.init(M_, 512, G, bx);
        EpiGlu E{(const bf16_t*)(p.ws + WS_YG), (const bf16_t*)(p.ws + WS_ZS), (bf16_t*)(p.ws + WS_MIX), p.in[I_GLUB]};
        REPS(7) pg8::gemm_phase<EpiGlu, pg8::StaticOrder, true, true>(PG8_PTR(lds), g, S, E);
        if (BOTH(4)) GROUP_BAR();
    }
    if (IN(5)) {
        pg8::Gemm g{(const bf16_t*)(p.ws + WS_MIX), (const bf16_t*)(p.ws + WS_WO), M_, 1024, 1024}; pg8::StaticOrder S; S.init(M_, 1024, G, bx);
        EpiOut E{p.in[I_X], p.out, (const float*)(p.ws + WS_MOD)};
        REPS(5) pg8::gemm_phase<EpiOut, pg8::StaticOrder, true, true>(PG8_PTR(lds), g, S, E);
#ifdef PROBE_TIMING
        GRID_BAR();
        if (bx == 0 && tid == 0) { const float* tr = (const float*)(p.ws + WS_CTL + 32768); p.out[0] += tr[PROBE_WHICH] * 1e-3f; }
#endif
    }
#undef IN
#undef BOTH
}

extern "C" void kernel_launch(void* const* d_in, const int* in_sizes, int n_in, void* d_out, int out_size, void* d_ws, size_t ws_size, hipStream_t stream) {
    static int grid = 0;
    if (grid == 0) {
        if (n_in != N_IN || out_size != M_ * D_ || ws_size < WS_END) { fprintf(stderr, "kernel_launch: unexpected shapes (n_in %d out %d ws %zu need %zu)\n", n_in, out_size, ws_size, (size_t)WS_END); grid = -1; return; }
#ifdef CPU_EMU
        grid = EMU_GRID;
#else
        int dev = 0, cus = 0, per_cu = 0;
        if (hipGetDevice(&dev) != hipSuccess || hipDeviceGetAttribute(&cus, hipDeviceAttributeMultiprocessorCount, dev) != hipSuccess) { grid = -1; return; }
        if (hipFuncSetAttribute((const void*)fwd_kernel, hipFuncAttributeMaxDynamicSharedMemorySize, LDS_BYTES) != hipSuccess) { fprintf(stderr, "kernel_launch: hipFuncSetAttribute failed\n"); grid = -1; return; }
        if (hipOccupancyMaxActiveBlocksPerMultiprocessor(&per_cu, (const void*)fwd_kernel, 512, LDS_BYTES) != hipSuccess || per_cu < 1) { fprintf(stderr, "kernel_launch: occupancy query says %d blocks per CU\n", per_cu); per_cu = 1; }
        (void)hipGetLastError();
        grid = cus;
#endif
    }
    if (grid < 0) return;
    (void)hipMemsetAsync((char*)d_ws + WS_CTL, 0, CTL_ZERO_BYTES, stream);
    Params a{};
    for (int i = 0; i < N_IN; ++i) a.in[i] = (const float*)d_in[i];
    a.out = (float*)d_out; a.ws = (unsigned char*)d_ws;
    for (int li = 0; li < N_LAUNCH; ++li) {
        a.ph_lo = (N_LAUNCH == 1) ? 0 : li; a.ph_hi = (N_LAUNCH == 1) ? N_PHASES : li + 1; a.li = 0;
#ifdef CPU_EMU
        emu_launch((unsigned)grid, 512u, [&]() { fwd_kernel(a); });
#else
        hipLaunchKernelGGL(fwd_kernel, dim3(grid), dim3(512), LDS_BYTES, stream, a);
#endif
    }
}
```

```cpp
#ifndef CPU_EMU
#include <hip/hip_runtime.h>
#endif
#include <cstdio>
#include <cstdint>
#include <cmath>

#ifndef BATCH_N
#define BATCH_N 8
#endif
#ifndef SEQ_LEN
#define SEQ_LEN 8192
#endif
#ifndef N_LAUNCH
#define N_LAUNCH 1
#endif
#define DEV __device__ __forceinline__

typedef unsigned short bf16_t;
typedef short bf16x8 __attribute__((ext_vector_type(8)));
typedef float f32x4 __attribute__((ext_vector_type(4)));
typedef float f32x16 __attribute__((ext_vector_type(16)));
typedef float f32x2 __attribute__((ext_vector_type(2)));
typedef unsigned u32x4 __attribute__((ext_vector_type(4)));
typedef unsigned u32x2 __attribute__((ext_vector_type(2)));

constexpr int B_ = BATCH_N, T_ = SEQ_LEN, D_ = 1024, M_ = B_ * T_;
constexpr int NH = 8, HD = 64, NGRP = 2;
constexpr int NCMP = (T_ - 32) / 16 + 1;
constexpr int NCP = T_ / 16;
constexpr int NSB = T_ / 64;
constexpr int INW = 2840, INP = 3072;
constexpr int SSM_NG = 32, SSM_P = 64, SSM_C = 16, SSM_W = 512;
constexpr int SSM_L = 64;
constexpr int SSM_CG = 32;
constexpr int SSM_NCG = T_ / (SSM_L * SSM_CG);
constexpr float EPS_ = 1e-6f;
static_assert(T_ % 2048 == 0 && NSB <= 128, "shape assumptions");

enum { I_X = 0, I_C, I_WADA, I_BADA, I_NORMG, I_WIN, I_QNG, I_KCNG, I_KSNG, I_KWNG, I_POSK, I_POSV, I_W1K, I_W2K, I_W1V, I_W2V,
       I_ARE, I_AIM, I_LOGDT, I_BRE, I_BIM, I_CRE, I_CIM, I_SSMD, I_GLUW, I_GLUB, I_WOUT, N_IN };

constexpr size_t MiB = 1u << 20;
constexpr size_t al(size_t x) { return (x + MiB - 1) / MiB * MiB; }
constexpr size_t WS_CTL = 0, CTL_ZERO_BYTES = 64 * 1024;
constexpr size_t WS_MOD = 1 * MiB;
constexpr size_t WS_ROPE = WS_MOD + al((size_t)B_ * 3072 * 4);
constexpr size_t WS_CPOS = WS_CTL + 24576;
constexpr size_t WS_LAM64 = WS_ROPE + al((size_t)T_ * 64 * 4);
constexpr size_t WS_KT = WS_LAM64 + MiB;
constexpr size_t WS_WST = WS_KT + al((size_t)32 * 65 * 256 * 2);
constexpr size_t WS_WOUTS = WS_WST + al((size_t)32 * 128 * 1024 * 2);
constexpr size_t WS_WIN = WS_WOUTS + al((size_t)32 * 1024 * 128 * 2);
constexpr size_t WS_WO = WS_WIN + al((size_t)INP * 1024 * 2);
constexpr size_t WS_WGLU = WS_WO + al((size_t)1024 * 1024 * 2);
constexpr size_t WS_W1K = WS_WGLU + MiB, WS_W1V = WS_W1K + MiB;
constexpr size_t WS_W2K = WS_W1V + MiB, WS_W2V = WS_W2K + 64 * 1024;
constexpr size_t WS_KC = WS_W2K + MiB;
constexpr size_t WS_VC = WS_KC + al((size_t)B_ * NCP * 128 * 2);
constexpr size_t WS_G = WS_VC + al((size_t)B_ * NCP * 128 * 2);
constexpr size_t WS_HN = WS_G + al((size_t)M_ * 32 * 4);
constexpr size_t WS_Q = WS_HN + al((size_t)M_ * 1024 * 2);
constexpr size_t WS_QR = WS_Q + al((size_t)M_ * 512 * 2);
constexpr size_t WS_CR = WS_QR + al((size_t)M_ * 512 * 2);
constexpr size_t WS_SL = WS_CR + al((size_t)M_ * 256 * 2);
constexpr size_t WS_WN = WS_SL + al((size_t)M_ * 256 * 2);
constexpr size_t WS_ZA = WS_WN + al((size_t)M_ * 256 * 2);
constexpr size_t WS_U = WS_ZA + al((size_t)M_ * 512 * 2);
constexpr size_t WS_ZS = WS_U + al((size_t)M_ * 512 * 2);
constexpr size_t WS_YG = WS_ZS + al((size_t)M_ * 512 * 2);
constexpr size_t WS_MIX = WS_YG + al((size_t)M_ * 512 * 2);
constexpr size_t WS_VT = WS_MIX + al((size_t)M_ * 1024 * 2);
constexpr size_t WS_KF = WS_VT + al((size_t)M_ * 128 * 2);
constexpr size_t WS_END = WS_KF + al((size_t)M_ * 128 * 2);

constexpr int RING_BYTES = 131072;
constexpr int LDS_BYTES = 155648;
constexpr int MISC_OFF = LDS_BYTES - 256;

DEV unsigned f2bf(float f) { unsigned u = __builtin_bit_cast(unsigned, f); return (u + 0x7fffu + ((u >> 16) & 1u)) >> 16; }
DEV float bf2f(unsigned h) { return __builtin_bit_cast(float, h << 16); }
#ifdef CPU_EMU
DEV unsigned pk2(float lo, float hi) { return f2bf(lo) | (f2bf(hi) << 16); }
DEV float exp2_fast(float x) { return exp2f(x); }
DEV float rcp_fast(float x) { return 1.0f / x; }
DEV float log2_fast(float x) { return log2f(x); }
DEV int f2i_rn(float x) { return (int)floorf(x + 0.5f); }
DEV f32x4 mfma16(bf16x8 a, bf16x8 b, f32x4 c) { return emu_mfma16(a, b, c); }
DEV f32x16 mfma32(bf16x8 a, bf16x8 b, f32x16 c) { return emu_mfma32(a, b, c); }
#define WAVE_ID() ((int)(threadIdx.x >> 6))
#else
typedef __bf16 bf16x2_t __attribute__((ext_vector_type(2)));
DEV unsigned pk2(float lo, float hi) { f32x2 v = {lo, hi}; bf16x2_t b = __builtin_convertvector(v, bf16x2_t); return __builtin_bit_cast(unsigned, b); }
DEV float exp2_fast(float x) { return __builtin_amdgcn_exp2f(x); }
DEV float rcp_fast(float x) { return __builtin_amdgcn_rcpf(x); }
DEV float log2_fast(float x) { return __builtin_amdgcn_logf(x); }
DEV int f2i_rn(float x) { int r; asm("v_cvt_rpi_i32_f32 %0, %1" : "=v"(r) : "v"(x)); return r; }
DEV f32x4 mfma16(bf16x8 a, bf16x8 b, f32x4 c) { return __builtin_amdgcn_mfma_f32_16x16x32_bf16(a, b, c, 0, 0, 0); }
DEV f32x16 mfma32(bf16x8 a, bf16x8 b, f32x16 c) { return __builtin_amdgcn_mfma_f32_32x32x16_bf16(a, b, c, 0, 0, 0); }
#define WAVE_ID() (__builtin_amdgcn_readfirstlane((int)(threadIdx.x >> 6)))
#endif
#ifdef CPU_EMU
#define EXPF(x) expf(x)
#else
#define EXPF(x) __expf(x)
#endif
DEV float silu_f(float v) { return v * rcp_fast(1.0f + EXPF(-v)); }
DEV float sigmoid_f(float v) { return rcp_fast(1.0f + EXPF(-v)); }
DEV float gelu_tanh_f(float v) { const float u = 0.7978845608028654f * (v + 0.044715f * v * v * v); const float e = EXPF(2.0f * u); return v * (1.0f - rcp_fast(e + 1.0f)); }
DEV float wave_sum(float v) {
#pragma unroll
    for (int o = 1; o < 64; o <<= 1) v += __shfl_xor(v, o);
    return v;
}
DEV float wave_max(float v) {
#pragma unroll
    for (int o = 1; o < 64; o <<= 1) v = fmaxf(v, __shfl_xor(v, o));
    return v;
}
DEV bf16x8 ld8(const bf16_t* p) { return *(const bf16x8*)p; }
namespace pg8 {
#define PG8_LAS __attribute__((address_space(3)))
typedef unsigned short bf16_t;
typedef short bf16x8 __attribute__((ext_vector_type(8)));
typedef float f32x4 __attribute__((ext_vector_type(4)));
typedef unsigned u32x4 __attribute__((ext_vector_type(4)));
constexpr int BM = 256, BK = 64, HALF = 128, HTB = HALF * BK * 2  , STAGE_BYTES = 8 * HTB, NXCD = 8, WGM = 8;

__host__ __device__ __forceinline__ int lds_byte(int r, int c) { const int st = (r >> 4) * 2 + (c >> 5), rr = r & 15, cc = c & 31, ob = rr * 64 + cc * 2; return st * 1024 + (ob ^ (((ob >> 9) & 1) << 5)); }
__host__ __device__ __forceinline__ void stage_rc(int b, int& R, int& C) { const int st = b / 1024, sb = b % 1024, swz = sb ^ (((sb >> 9) & 1) << 5); R = (st >> 1) * 16 + swz / 64; C = (st & 1) * 32 + (swz % 64) / 2; }
__host__ __device__ __forceinline__ int perm32(int rho) { const int n = rho >> 4, i = rho & 15; return 8 * (i >> 2) + 4 * n + (i & 3); }

struct Unit { int pm, pn; };
struct Gemm { const bf16_t* A; const bf16_t* Bt; int M, N, K; };

struct StaticOrder {
    int nM, nN, nwg, G, c;
    __host__ __device__ void init(int M, int N, int G_, int c_) { nM = M / BM; nN = N / BM; nwg = nM * nN; G = G_; c = c_; }
    __host__ __device__ bool next(int i, Unit& u) const {
        const long L = (long)i * G + c; if (L >= nwg) return false;
        int wgid = (int)L; { const int q = nwg / NXCD, r = nwg % NXCD, xcd = wgid % NXCD, off = wgid / NXCD; wgid = (xcd < r ? xcd * (q + 1) : r * (q + 1) + (xcd - r) * q) + off; }
        const int nig = WGM * nN, gid = wgid / nig, fm = gid * WGM, gsz = (nM - fm) < WGM ? (nM - fm) : WGM;
        u.pm = fm + ((wgid % nig) % gsz); u.pn = (wgid % nig) / gsz; return true;
    }
    __device__ __forceinline__ void a_ready(const Unit&) const {}
    __device__ __forceinline__ void done(const Unit&) const {}
};

#ifndef CPU_EMU
__device__ __forceinline__ unsigned cvt_pk_bf16(float lo, float hi) { unsigned r; asm volatile("v_cvt_pk_bf16_f32 %0, %1, %2" : "=v"(r) : "v"(lo), "v"(hi)); return r; }
template <class Epi, class Sched, bool ALIGN_EPI = false, bool SP2 = false>
__device__ __forceinline__ void gemm_phase(PG8_LAS unsigned char* lds, const Gemm g, const Sched& S, const Epi& E) {
    const int tid = threadIdx.x, wid = __builtin_amdgcn_readfirstlane(tid >> 6), lane = tid & 63, wr = wid >> 2, wc = wid & 3, fr = lane & 15, fq = lane >> 4;
    const int K = g.K, nt = K / BK;
    unsigned voffA[2], voffB[2];
#pragma unroll
    for (int i = 0; i < 2; ++i) { int R, C; stage_rc(tid * 16 + i * 8192, R, C); const int Rb = Epi::PERM ? ((R & ~31) + perm32(R & 31)) : R;
        voffA[i] = (unsigned)(R * K + C) * 2u; voffB[i] = (unsigned)(Rb * K + C) * 2u; }
    const size_t kstep = (size_t)(BK * 2);
    const size_t hstep = (size_t)HALF * K * 2;
    const size_t tstep = 2 * hstep;
    const unsigned ldsw = (unsigned)wid * 1024u;
    const int aoff = lds_byte(wr * 64 + fr, fq * 8), boff = lds_byte(wc * 32 + fr, fq * 8);
#define PG8_SA(b, h) (((b) * 2 + (h)) * HTB)
#define PG8_SB(b, h) ((4 + (b) * 2 + (h)) * HTB)
#define PG8_STAGE(bufoff, gbase, voff) do { _Pragma("unroll") for (int _i = 0; _i < 2; ++_i) \
        __builtin_amdgcn_global_load_lds((const unsigned*)((const char*)(gbase) + (voff)[_i]), (PG8_LAS unsigned*)(lds + (bufoff) + ldsw + _i * 8192), 16, 0, 0); } while (0)
#define PG8_LDA(dst, b, h) do { _Pragma("unroll") for (int m = 0; m < 4; ++m) _Pragma("unroll") for (int k = 0; k < 2; ++k) dst[m][k] = *(const PG8_LAS bf16x8*)(lds + PG8_SA(b, h) + aoff + m * 2048 + k * 1024); } while (0)
#define PG8_LDB(dst, b, h) do { _Pragma("unroll") for (int n = 0; n < 2; ++n) _Pragma("unroll") for (int k = 0; k < 2; ++k) dst[n][k] = *(const PG8_LAS bf16x8*)(lds + PG8_SB(b, h) + boff + n * 2048 + k * 1024); } while (0)
#define PG8_MMA(ai, bj, At, Bt) do { __builtin_amdgcn_s_setprio(1); _Pragma("unroll") for (int m = 0; m < 4; ++m) _Pragma("unroll") for (int n = 0; n < 2; ++n) _Pragma("unroll") for (int k = 0; k < 2; ++k) \
        acc[ai][bj][m][n] = __builtin_amdgcn_mfma_f32_16x16x32_bf16(Bt[n][k], At[m][k], acc[ai][bj][m][n], 0, 0, 0); __builtin_amdgcn_s_setprio(0); } while (0)
#define PG8_WAIT_V(n) asm volatile("s_waitcnt vmcnt(" #n ")" ::: "memory")
#define PG8_WAIT_L(n) asm volatile("s_waitcnt lgkmcnt(" #n ")" ::: "memory")
#define PG8_BAR __builtin_amdgcn_s_barrier()
#define PG8_SCHED __builtin_amdgcn_sched_barrier(0)
    Unit cur, nxt; int ui = 0;
    if (!S.next(0, cur)) return;
    f32x4 acc[2][2][4][2];
#pragma unroll
    for (int a = 0; a < 2; ++a)
#pragma unroll
        for (int b = 0; b < 2; ++b)
#pragma unroll
            for (int m = 0; m < 4; ++m)
#pragma unroll
                for (int n = 0; n < 2; ++n) acc[a][b][m][n] = (f32x4){0.f, 0.f, 0.f, 0.f};
    bf16x8 At[4][2], B0[2][2], B1[2][2];
    const char* cA = (const char*)g.A + (size_t)cur.pm * tstep; const char* cB = (const char*)g.Bt + (size_t)cur.pn * tstep;
    S.a_ready(cur);
    if constexpr (SP2) {
        PG8_STAGE(PG8_SB(0, 0), cB, voffB); PG8_STAGE(PG8_SB(0, 1), cB + hstep, voffB); PG8_STAGE(PG8_SA(0, 0), cA, voffA); PG8_STAGE(PG8_SA(0, 1), cA + hstep, voffA);
        if (wr == 1) PG8_BAR;
        PG8_WAIT_V(2); PG8_BAR;
        PG8_STAGE(PG8_SB(1, 0), cB + kstep, voffB); PG8_STAGE(PG8_SA(1, 0), cA + kstep, voffA); PG8_STAGE(PG8_SB(1, 1), cB + hstep + kstep, voffB);
        PG8_WAIT_V(6); PG8_BAR;
    } else {
        PG8_STAGE(PG8_SB(0, 0), cB, voffB); PG8_STAGE(PG8_SA(0, 0), cA, voffA); PG8_STAGE(PG8_SB(0, 1), cB + hstep, voffB); PG8_STAGE(PG8_SA(0, 1), cA + hstep, voffA);
        if (wr == 1) PG8_BAR;
        PG8_WAIT_V(4); PG8_BAR;
        PG8_STAGE(PG8_SB(1, 0), cB + kstep, voffB); PG8_STAGE(PG8_SA(1, 0), cA + kstep, voffA); PG8_STAGE(PG8_SB(1, 1), cB + hstep + kstep, voffB);
        PG8_WAIT_V(6); PG8_BAR;
    }
    for (;;) {
        const bool has_next = S.next(ui + 1, nxt);
        const char* nA = has_next ? (const char*)g.A + (size_t)nxt.pm * tstep : cA; const char* nB = has_next ? (const char*)g.Bt + (size_t)nxt.pn * tstep : cB;
        for (int t = 0; t < nt; t += 2) {
            const bool last = (t == nt - 2);
            const char* a1 = cA + (size_t)(t + 1) * kstep;
            const char* a2 = last ? nA : cA + (size_t)(t + 2) * kstep; const char* b2 = last ? nB : cB + (size_t)(t + 2) * kstep;
            const char* a3 = a2 + kstep; const char* b3 = b2 + kstep;
            if (last && has_next) S.a_ready(nxt);
            if constexpr (SP2) {
            PG8_LDB(B0, 0, 0); PG8_LDB(B1, 0, 1); PG8_SCHED; PG8_LDA(At, 0, 0); PG8_STAGE(PG8_SA(1, 1), a1 + hstep, voffA);
            PG8_WAIT_V(8); PG8_WAIT_L(0); PG8_BAR; PG8_MMA(0, 0, At, B0); PG8_MMA(0, 1, At, B1); PG8_BAR; PG8_SCHED;
            PG8_LDA(At, 0, 1); PG8_STAGE(PG8_SB(0, 0), b2, voffB); PG8_STAGE(PG8_SB(0, 1), b2 + hstep, voffB); PG8_STAGE(PG8_SA(0, 0), a2, voffA);
            PG8_WAIT_V(8); PG8_WAIT_L(0); PG8_BAR; PG8_MMA(1, 0, At, B0); PG8_MMA(1, 1, At, B1); PG8_BAR; PG8_SCHED;
            PG8_LDB(B0, 1, 0); PG8_LDB(B1, 1, 1); PG8_SCHED; PG8_LDA(At, 1, 0); PG8_STAGE(PG8_SA(0, 1), a2 + hstep, voffA);
            PG8_WAIT_V(8); PG8_WAIT_L(0); PG8_BAR; PG8_MMA(0, 0, At, B0); PG8_MMA(0, 1, At, B1); PG8_BAR; PG8_SCHED;
            PG8_LDA(At, 1, 1); PG8_STAGE(PG8_SB(1, 0), b3, voffB); PG8_STAGE(PG8_SB(1, 1), b3 + hstep, voffB); PG8_STAGE(PG8_SA(1, 0), a3, voffA);
            PG8_WAIT_V(8); PG8_WAIT_L(0); PG8_BAR; PG8_MMA(1, 0, At, B0); PG8_MMA(1, 1, At, B1); PG8_BAR; PG8_SCHED;
            } else {
            PG8_LDB(B0, 0, 0); PG8_SCHED; PG8_LDA(At, 0, 0); PG8_STAGE(PG8_SA(1, 1), a1 + hstep, voffA);
            PG8_WAIT_L(8); PG8_BAR; PG8_WAIT_L(0); PG8_MMA(0, 0, At, B0); PG8_BAR; PG8_SCHED;
            PG8_LDB(B1, 0, 1); PG8_STAGE(PG8_SB(0, 0), b2, voffB);
            PG8_BAR; PG8_WAIT_L(0); PG8_MMA(0, 1, At, B1); PG8_BAR;
            PG8_LDA(At, 0, 1); PG8_STAGE(PG8_SA(0, 0), a2, voffA);
            PG8_BAR; PG8_WAIT_L(0); PG8_MMA(1, 0, At, B0); PG8_BAR; PG8_SCHED;
            PG8_STAGE(PG8_SB(0, 1), b2 + hstep, voffB);
            PG8_WAIT_V(6); PG8_BAR; PG8_MMA(1, 1, At, B1); PG8_BAR;
            PG8_LDB(B0, 1, 0); PG8_SCHED; PG8_LDA(At, 1, 0); PG8_STAGE(PG8_SA(0, 1), a2 + hstep, voffA);
            PG8_WAIT_L(8); PG8_BAR; PG8_WAIT_L(0); PG8_MMA(0, 0, At, B0); PG8_BAR; PG8_SCHED;
            PG8_LDB(B1, 1, 1); PG8_STAGE(PG8_SB(1, 0), b3, voffB);
            PG8_BAR; PG8_WAIT_L(0); PG8_MMA(0, 1, At, B1); PG8_BAR;
            PG8_LDA(At, 1, 1); PG8_STAGE(PG8_SA(1, 0), a3, voffA);
            PG8_BAR; PG8_WAIT_L(0); PG8_MMA(1, 0, At, B0); PG8_BAR; PG8_SCHED;
            PG8_STAGE(PG8_SB(1, 1), b3 + hstep, voffB);
            PG8_WAIT_V(6); PG8_BAR; PG8_MMA(1, 1, At, B1); PG8_BAR;
            }
        }
        if constexpr (ALIGN_EPI) { if (wr == 0) PG8_BAR; }
        if constexpr (!Epi::AFTER_DRAIN) { E(acc, cur, wr, wc, fr, fq); S.done(cur); }
        if (!has_next) break;
#pragma unroll
        for (int a = 0; a < 2; ++a)
#pragma unroll
            for (int b = 0; b < 2; ++b)
#pragma unroll
                for (int m = 0; m < 4; ++m)
#pragma unroll
                    for (int n = 0; n < 2; ++n) acc[a][b][m][n] = (f32x4){0.f, 0.f, 0.f, 0.f};
        cur = nxt; cA = nA; cB = nB; ++ui;
        if constexpr (ALIGN_EPI) { if (wr == 1) PG8_BAR; }
    }
    PG8_WAIT_V(0);
    if constexpr (!ALIGN_EPI) { if (wr == 0) PG8_BAR; }
    PG8_BAR;
    if constexpr (Epi::AFTER_DRAIN) { E.fused(acc, cur, wr, wc, fr, fq, lds, wid, lane); S.done(cur); }
#undef PG8_SA
#undef PG8_SB
#undef PG8_STAGE
#undef PG8_LDA
#undef PG8_LDB
#undef PG8_MMA
#undef PG8_WAIT_V
#undef PG8_WAIT_L
#undef PG8_BAR
#undef PG8_SCHED
}
}
#define PG8_PTR(x) ((__attribute__((address_space(3))) unsigned char*)(x))
#else
template <class Epi, class Sched, bool ALIGN_EPI = false, bool SP2 = false>
inline void gemm_phase(unsigned char* lds, const Gemm g, const Sched& S, const Epi& E) {
    const int tid = threadIdx.x, wid = tid >> 6, lane = tid & 63, wr = wid >> 2, wc = wid & 3, fr = lane & 15, fq = lane >> 4;
    Unit cur;
    for (int ui = 0; S.next(ui, cur); ++ui) {
        f32x4 acc[2][2][4][2];
        for (int ai = 0; ai < 2; ++ai) for (int bj = 0; bj < 2; ++bj) for (int m = 0; m < 4; ++m) for (int n = 0; n < 2; ++n) for (int i = 0; i < 4; ++i) {
            const int row = 256 * cur.pm + 128 * ai + 64 * wr + 16 * m + fr;
            const int col = 256 * cur.pn + 128 * bj + 32 * wc + (Epi::PERM ? 8 * fq + 4 * n + i : 16 * n + 4 * fq + i);
            const bf16_t* a = g.A + (size_t)row * g.K; const bf16_t* b = g.Bt + (size_t)col * g.K; float s = 0.f;
            for (int k = 0; k < g.K; ++k) s += emu_bf2f(a[k]) * emu_bf2f(b[k]);
            acc[ai][bj][m][n][i] = s; }
        E(acc, cur, wr, wc, fr, fq);
    }
}
}
#define PG8_PTR(x) (x)
#endif
#ifdef CPU_EMU
#define WAVE_SYNC() emu_wave_sync()
#define SCHED_FENCE() do { } while (0)
#define LAUNDER_V(x) do { } while (0)
#define LDS_BARRIER() __syncthreads()
#else
#define LDS_BARRIER() do { asm volatile("s_waitcnt lgkmcnt(0)" ::: "memory"); __builtin_amdgcn_s_barrier(); asm volatile("" ::: "memory"); } while (0)
#define LAUNDER_V(x) asm volatile("" : "+v"(x))
#define WAVE_SYNC() asm volatile("s_waitcnt lgkmcnt(0)" ::: "memory")
#define SCHED_FENCE() __builtin_amdgcn_sched_barrier(0)
#endif

struct Params { const float* in[N_IN]; float* out; unsigned char* ws; int ph_lo, ph_hi, li, pad; };

constexpr float QSCALE = 0.125f * 1.4426950408889634f;
DEV void gates_rows(unsigned char* ws, size_t row0, int lane) {
    const int r = lane & 15, kq = lane >> 4;
    const bf16_t* HN = (const bf16_t*)(ws + WS_HN) + (row0 + r) * 1024 + 8 * kq;
    const bf16_t* WG = (const bf16_t*)(ws + WS_WIN) + (size_t)(2816 + r) * 1024 + 8 * kq;
    f32x4 acc[2][2];
#pragma unroll
    for (int rb = 0; rb < 2; ++rb)
#pragma unroll
        for (int cb = 0; cb < 2; ++cb) acc[rb][cb] = (f32x4){0.f, 0.f, 0.f, 0.f};
    bf16x8 hb[2][4][2], wb[2][4][2];
#define GU_LOAD(bt) do { _Pragma("unroll") for (int q = 0; q < 4; ++q) { const int s_ = 4 * (bt) + q; hb[(bt) & 1][q][0] = ld8(HN + 32 * s_); hb[(bt) & 1][q][1] = ld8(HN + 16 * 1024 + 32 * s_); \
        wb[(bt) & 1][q][0] = ld8(WG + 32 * s_); wb[(bt) & 1][q][1] = ld8(WG + 16 * 1024 + 32 * s_); } } while (0)
    GU_LOAD(0);
#pragma unroll
    for (int bt = 0; bt < 8; ++bt) {
        if (bt < 7) GU_LOAD(bt + 1);
        SCHED_FENCE();
#pragma unroll
        for (int q = 0; q < 4; ++q) {
            const bf16x8 h0 = hb[bt & 1][q][0], h1 = hb[bt & 1][q][1], w0 = wb[bt & 1][q][0], w1 = wb[bt & 1][q][1];
            acc[0][0] = mfma16(w0, h0, acc[0][0]); acc[0][1] = mfma16(w1, h0, acc[0][1]);
            acc[1][0] = mfma16(w0, h1, acc[1][0]); acc[1][1] = mfma16(w1, h1, acc[1][1]);
        }
        SCHED_FENCE();
    }
#undef GU_LOAD
    float* Gp = (float*)(ws + WS_G);
#pragma unroll
    for (int rb = 0; rb < 2; ++rb)
#pragma unroll
        for (int cb = 0; cb < 2; ++cb) { f32x4 o;
#pragma unroll
            for (int i = 0; i < 4; ++i) o[i] = sigmoid_f(acc[rb][cb][i]);
            *(f32x4*)(Gp + (row0 + 16 * rb + r) * 32 + 16 * cb + 4 * kq) = o; }
}

struct EpiInProj {
    static constexpr bool PERM = true, AFTER_DRAIN = false;
    unsigned char* ws; const float* qng; const float* ksng; const float* kwng;
    DEV void operator()(const f32x4 (&acc)[2][2][4][2], const pg8::Unit& u, int wr, int wc, int fr, int fq) const {
        const int pn = u.pn; const int row0 = u.pm * 256 + wr * 64 + fr;
        int kind; bf16_t* dst = nullptr; bf16_t* dst2 = nullptr; int pitch = 512, colb = 0; const float* gv = nullptr;
        if (pn < 2) { kind = 2; dst = (bf16_t*)(ws + WS_Q); dst2 = (bf16_t*)(ws + WS_QR); colb = (4 * pn + wc) * 64; gv = qng; }
        else if (pn == 2) { kind = 0; dst = (bf16_t*)(ws + WS_CR); pitch = 256; colb = wc * 64; }
        else if (pn == 3) { kind = wc < 2 ? 1 : 0; dst = (bf16_t*)(ws + WS_SL); pitch = 256; colb = wc * 64; gv = ksng; }
        else if (pn == 4) { kind = wc < 2 ? 1 : 0; dst = (bf16_t*)(ws + WS_WN); pitch = 256; colb = wc * 64; gv = kwng; }
        else if (pn < 7) { kind = 3; dst = (bf16_t*)(ws + WS_ZA); colb = (4 * (pn - 5) + wc) * 64; }
        else if (pn < 9) { kind = 0; dst = (bf16_t*)(ws + WS_U); colb = (4 * (pn - 7) + wc) * 64; }
        else if (pn < 11) { kind = 3; dst = (bf16_t*)(ws + WS_ZS); colb = (4 * (pn - 9) + wc) * 64; }
        else { kind = (wc == 0) ? 4 : 5; }
        if (kind == 5) return;
        float g1[8], g2[8];
        if (kind == 1 || kind == 2) {
#pragma unroll
            for (int i = 0; i < 8; ++i) { const float qs = (kind == 2) ? QSCALE : 1.0f; g1[i] = gv[8 * fq + i] * qs; g2[i] = gv[32 + 8 * fq + i] * qs; }
        }
        const float* rope = (const float*)(ws + WS_ROPE);
#pragma unroll
        for (int ai = 0; ai < 2; ++ai)
#pragma unroll
            for (int m = 0; m < 4; ++m) {
                const int row = row0 + ai * 128 + m * 16;
                float x1[8], x2[8];
#pragma unroll
                for (int i = 0; i < 4; ++i) { x1[i] = acc[ai][0][m][0][i]; x1[4 + i] = acc[ai][0][m][1][i]; x2[i] = acc[ai][1][m][0][i]; x2[4 + i] = acc[ai][1][m][1][i]; }
                if (kind == 4) {
                    float* G = (float*)(ws + WS_G) + (size_t)row * 32 + 8 * fq;
                    f32x4 o0, o1;
#pragma unroll
                    for (int i = 0; i < 4; ++i) { o0[i] = sigmoid_f(x1[i]); o1[i] = sigmoid_f(x1[4 + i]); }
                    *(f32x4*)G = o0; *(f32x4*)(G + 4) = o1;
                    continue;
                }
                if (kind == 1 || kind == 2) {
                    float ss = 0.f;
#pragma unroll
                    for (int i = 0; i < 8; ++i) ss += x1[i] * x1[i] + x2[i] * x2[i];
                    ss += __shfl_xor(ss, 16); ss += __shfl_xor(ss, 32);
                    const float rinv = rsqrtf(ss * (1.0f / 64.0f) + EPS_);
#pragma unroll
                    for (int i = 0; i < 8; ++i) { x1[i] = x1[i] * rinv * g1[i]; x2[i] = x2[i] * rinv * g2[i]; }
                    if (kind == 2) {
                        bf16_t* o = dst + (size_t)row * pitch + colb + 8 * fq;
                        *(u32x4*)o = (u32x4){pk2(x1[0], x1[1]), pk2(x1[2], x1[3]), pk2(x1[4], x1[5]), pk2(x1[6], x1[7])};
                        *(u32x4*)(o + 32) = (u32x4){pk2(x2[0], x2[1]), pk2(x2[2], x2[3]), pk2(x2[4], x2[5]), pk2(x2[6], x2[7])};
                    }
                    const int t = row % T_;
                    const float* cs = rope + (size_t)t * 32 + 8 * fq; const float* sn = cs + (size_t)T_ * 32;
                    const f32x4 c0 = *(const f32x4*)cs, c1 = *(const f32x4*)(cs + 4), s0 = *(const f32x4*)sn, s1 = *(const f32x4*)(sn + 4);
#pragma unroll
                    for (int i = 0; i < 8; ++i) { const float c = i < 4 ? c0[i & 3] : c1[i & 3], s = i < 4 ? s0[i & 3] : s1[i & 3]; const float a = x1[i], b = x2[i]; x1[i] = a * c - b * s; x2[i] = b * c + a * s; }
                } else if (kind == 3) {
#pragma unroll
                    for (int i = 0; i < 8; ++i) { x1[i] = silu_f(x1[i]); x2[i] = silu_f(x2[i]); }
                }
                bf16_t* o = (kind == 2 ? dst2 : dst) + (size_t)row * pitch + colb + 8 * fq;
                *(u32x4*)o = (u32x4){pk2(x1[0], x1[1]), pk2(x1[2], x1[3]), pk2(x1[4], x1[5]), pk2(x1[6], x1[7])};
                *(u32x4*)(o + 32) = (u32x4){pk2(x2[0], x2[1]), pk2(x2[2], x2[3]), pk2(x2[4], x2[5]), pk2(x2[6], x2[7])};
            }
    }
};

struct EpiGlu {
    static constexpr bool PERM = true, AFTER_DRAIN = false;
    const bf16_t* YG; const bf16_t* ZS; bf16_t* MIX; const float* glub;
    DEV void operator()(const f32x4 (&acc)[2][2][4][2], const pg8::Unit& u, int wr, int wc, int fr, int fq) const {
        const int row0 = u.pm * 256 + wr * 64 + fr, col0 = u.pn * 256 + wc * 32 + 8 * fq;
        f32x4 bv[2][2]; u32x4 ya[2][2], za[2][2];
#pragma unroll
        for (int bj = 0; bj < 2; ++bj) { bv[bj][0] = *(const f32x4*)(glub + col0 + bj * 128); bv[bj][1] = *(const f32x4*)(glub + col0 + bj * 128 + 4); }
#define EG_ROW(grp, mm) (row0 + (((grp) >> 1) & 1) * 128 + (2 * ((grp) & 1) + (mm)) * 16)
#define EG_COL(grp) (col0 + ((grp) >> 2) * 128)
#define EG_LOAD(grp) do { _Pragma("unroll") for (int mm = 0; mm < 2; ++mm) { ya[(grp) & 1][mm] = *(const u32x4*)(YG + (size_t)EG_ROW(grp, mm) * 512 + EG_COL(grp)); za[(grp) & 1][mm] = *(const u32x4*)(ZS + (size_t)EG_ROW(grp, mm) * 512 + EG_COL(grp)); } } while (0)
        EG_LOAD(0);
#pragma unroll
        for (int grp = 0; grp < 8; ++grp) {
            const int bj = grp >> 2, ai = (grp >> 1) & 1;
            if (grp < 7) EG_LOAD(grp + 1);
            SCHED_FENCE();
#pragma unroll
            for (int mm = 0; mm < 2; ++mm) {
                const int m = 2 * (grp & 1) + mm; const u32x4 yv = ya[grp & 1][mm], zv = za[grp & 1][mm];
                float o[8];
#pragma unroll
                for (int i = 0; i < 8; ++i) {
                    const float a = (i < 4 ? acc[ai][bj][m][0][i & 3] : acc[ai][bj][m][1][i & 3]) + (i < 4 ? bv[bj][0][i & 3] : bv[bj][1][i & 3]);
                    const unsigned yw = yv[i >> 1], zw = zv[i >> 1];
                    const float y = bf2f((i & 1) ? (yw >> 16) : (yw & 0xffffu)), z = bf2f((i & 1) ? (zw >> 16) : (zw & 0xffffu));
                    o[i] = y * sigmoid_f(a) * z;
                }
                *(u32x4*)(MIX + (size_t)EG_ROW(grp, mm) * 1024 + 512 + EG_COL(grp)) = (u32x4){pk2(o[0], o[1]), pk2(o[2], o[3]), pk2(o[4], o[5]), pk2(o[6], o[7])};
            }
            SCHED_FENCE();
        }
#undef EG_ROW
#undef EG_COL
#undef EG_LOAD
    }
};

struct EpiOut {
    static constexpr bool PERM = true, AFTER_DRAIN = false;
    const float* x; float* out; const float* mod;
    DEV void operator()(const f32x4 (&acc)[2][2][4][2], const pg8::Unit& u, int wr, int wc, int fr, int fq) const {
        const int row0 = u.pm * 256 + wr * 64 + fr, col0 = u.pn * 256 + wc * 32 + 8 * fq; const int b = (u.pm * 256) / T_;
        f32x4 gv[2][2], xa[2][2][2];
#pragma unroll
        for (int bj = 0; bj < 2; ++bj) { gv[bj][0] = *(const f32x4*)(mod + (size_t)b * 3072 + 2048 + col0 + bj * 128); gv[bj][1] = *(const f32x4*)(mod + (size_t)b * 3072 + 2048 + col0 + bj * 128 + 4); }
#define EO_OFF(grp, mm) ((size_t)(row0 + (((grp) >> 1) & 1) * 128 + (2 * ((grp) & 1) + (mm)) * 16) * 1024 + col0 + ((grp) >> 2) * 128)
#define EO_LOAD(grp) do { _Pragma("unroll") for (int mm = 0; mm < 2; ++mm) { xa[(grp) & 1][mm][0] = *(const f32x4*)(x + EO_OFF(grp, mm)); xa[(grp) & 1][mm][1] = *(const f32x4*)(x + EO_OFF(grp, mm) + 4); } } while (0)
        EO_LOAD(0);
#pragma unroll
        for (int grp = 0; grp < 8; ++grp) {
            const int bj = grp >> 2, ai = (grp >> 1) & 1;
            if (grp < 7) EO_LOAD(grp + 1);
            SCHED_FENCE();
#pragma unroll
            for (int mm = 0; mm < 2; ++mm) {
                const int m = 2 * (grp & 1) + mm;
                *(f32x4*)(out + EO_OFF(grp, mm)) = xa[grp & 1][mm][0] + gv[bj][0] * acc[ai][bj][m][0];
                *(f32x4*)(out + EO_OFF(grp, mm) + 4) = xa[grp & 1][mm][1] + gv[bj][1] * acc[ai][bj][m][1];
            }
            SCHED_FENCE();
        }
#undef EO_OFF
#undef EO_LOAD
    }
};

DEV size_t frag_idx(int row, int k, int K) { return ((size_t)((row >> 4) * (K >> 5) + (k >> 5)) * 64 + 16 * ((k >> 3) & 3) + (row & 15)) * 8 + (k & 7); }
DEV void tr_item(const float* W, int Nsrc, int K, int k0, int col0, int nvalid, bf16_t* WT, int drow0, float* scr, int lane, bool frag = false) {
    const int c = lane & 31;
#pragma unroll 8
    for (int i = 0; i < 32; ++i) { const int kk = 2 * i + (lane >> 5); scr[kk * 33 + c] = (c < nvalid) ? W[(size_t)(k0 + kk) * Nsrc + col0 + c] : 0.f; }
    WAVE_SYNC();
    const int c8 = lane & 7;
#pragma unroll
    for (int j = 0; j < 4; ++j) { const int n = (lane >> 3) + 8 * j; const float* s = scr + (8 * c8) * 33 + n;
        u32x4 o; o.x = pk2(s[0 * 33], s[1 * 33]); o.y = pk2(s[2 * 33], s[3 * 33]); o.z = pk2(s[4 * 33], s[5 * 33]); o.w = pk2(s[6 * 33], s[7 * 33]);
        const int row = drow0 + n, k8 = (k0 >> 3) + c8;
        *(u32x4*)(WT + (frag ? ((size_t)((row >> 4) * (K >> 5) + (k8 >> 2)) * 64 + 16 * (k8 & 3) + (row & 15)) * 8 : (size_t)row * K + k0 + 8 * c8)) = o; }
    WAVE_SYNC();
}

DEV void p0_prologue(const Params& p, unsigned char* lds, int vcu, int G, int tid, int wave, int lane) {
    unsigned char* ws = p.ws;
    {
        const float* c = p.in[I_C]; const float* w = p.in[I_WADA]; const float* ba = p.in[I_BADA]; float* mod = (float*)(ws + WS_MOD);
        for (int cb = vcu; cb < 256; cb += G)
            for (int b = wave; b < B_; b += 8) {
                float a[12];
#pragma unroll
                for (int j = 0; j < 12; ++j) a[j] = 0.f;
#pragma unroll 8
                for (int i = 0; i < 16; ++i) {
                    const int k = lane + 64 * i; const float s = silu_f(c[b * 1024 + k]);
                    const f32x4* wp = (const f32x4*)(w + (size_t)k * 3072 + 12 * cb); const f32x4 w0 = wp[0], w1 = wp[1], w2 = wp[2];
#pragma unroll
                    for (int j = 0; j < 4; ++j) { a[j] += s * w0[j]; a[4 + j] += s * w1[j]; a[8 + j] += s * w2[j]; }
                }
#pragma unroll
                for (int j = 0; j < 12; ++j) a[j] = wave_sum(a[j]);
                if (lane == 0) {
#pragma unroll
                    for (int j = 0; j < 12; ++j) mod[b * 3072 + 12 * cb + j] = a[j] + ba[12 * cb + j];
                }
            }
    }
    {
        float* scr = (float*)(lds + wave * 16384);
        const int gw = vcu * 8 + wave, NGW = G * 8;
        constexpr int I_IN = 96 * 16, I_O = 32 * 16, I_GL = 16 * 8, I_W1 = 8 * 32, I_W2 = 2 * 4;
        constexpr int NIT = I_IN + I_O + I_GL + 2 * I_W1 + 2 * I_W2;
        for (int it = gw; it < NIT; it += NGW) {
            int r = it;
            if (r < I_IN) {
                const int ci = r / 16, kb = r % 16, n0 = 32 * ci, pn = n0 >> 8, bj = (n0 >> 7) & 1, wc = (n0 >> 5) & 3, L0 = 256 * pn + 64 * wc + 32 * bj;
                int oc, nv; if (L0 < 1792) { oc = L0; nv = 32; } else if (L0 < 2816) { oc = L0 + 24; nv = 32; } else if (L0 == 2816) { oc = 1792; nv = 24; } else { oc = 0; nv = 0; }
                tr_item(p.in[I_WIN], INW, 1024, 64 * kb, oc, nv, (bf16_t*)(ws + WS_WIN), n0, scr, lane); continue; }
            r -= I_IN;
            if (r < I_O) { tr_item(p.in[I_WOUT], 1024, 1024, 64 * (r % 16), 32 * (r / 16), 32, (bf16_t*)(ws + WS_WO), 32 * (r / 16), scr, lane); continue; }
            r -= I_O;
            if (r < I_GL) { tr_item(p.in[I_GLUW], 512, 512, 64 * (r % 8), 32 * (r / 8), 32, (bf16_t*)(ws + WS_WGLU), 32 * (r / 8), scr, lane); continue; }
            r -= I_GL;
            if (r < I_W1) { tr_item(p.in[I_W1K], 256, 2048, 64 * (r % 32), 32 * (r / 32), 32, (bf16_t*)(ws + WS_W1K), 32 * (r / 32), scr, lane, true); continue; }
            r -= I_W1;
            if (r < I_W1) { tr_item(p.in[I_W1V], 256, 2048, 64 * (r % 32), 32 * (r / 32), 32, (bf16_t*)(ws + WS_W1V), 32 * (r / 32), scr, lane, true); continue; }
            r -= I_W1;
            if (r < I_W2) { tr_item(p.in[I_W2K], 64, 256, 64 * (r % 4), 32 * (r / 4), 32, (bf16_t*)(ws + WS_W2K), 32 * (r / 4), scr, lane); continue; }
            r -= I_W2;
            tr_item(p.in[I_W2V], 64, 256, 64 * (r % 4), 32 * (r / 4), 32, (bf16_t*)(ws + WS_W2V), 32 * (r / 4), scr, lane);
        }
    }
    {
        const float H1[32] = {2.037182617e+01f, 1.527673340e+01f, 1.145593262e+01f, 8.590698242e+00f, 6.442138672e+00f, 4.830932617e+00f, 3.622680664e+00f, 2.716613770e+00f, 2.037170410e+00f, 1.527679443e+00f, 1.145599365e+00f, 8.590698242e-01f, 6.442108154e-01f, 4.830932617e-01f, 3.622665405e-01f, 2.716636658e-01f, 2.037181854e-01f, 1.527671814e-01f, 1.145591736e-01f, 8.590698242e-02f, 6.442165375e-02f, 4.830932617e-02f, 3.622674942e-02f, 2.716636658e-02f, 2.037191391e-02f, 1.527667046e-02f, 1.145589352e-02f, 8.590698242e-03f, 6.442129612e-03f, 4.830896854e-03f, 3.622680902e-03f, 2.716630697e-03f};
        const float L1[32] = {6.543887594e-06f, -1.416575378e-05f, -9.063650396e-06f, 3.259562436e-05f, 4.341966076e-07f, -9.333384696e-06f, 3.694024997e-07f, 1.383195467e-05f, 1.289177635e-05f, -7.611160072e-06f, -7.100949915e-06f, 3.214027856e-06f, 3.140712124e-06f, -1.001640385e-06f, 1.570408244e-06f, -8.980337611e-07f, 1.371793559e-07f, 1.700163388e-08f, 6.043357104e-08f, 3.195055172e-07f, -2.581333831e-07f, -9.542085166e-08f, 6.167339706e-08f, -9.075201035e-08f, -8.022654185e-08f, 4.843524337e-08f, 2.941089683e-08f, 3.325492770e-08f, 9.949448376e-09f, 2.627999152e-08f, 1.475850692e-10f, -2.996157100e-09f};
        const float H2[32] = {1.591548920e-01f, 1.193494797e-01f, 8.949947357e-02f, 6.711483002e-02f, 5.032920837e-02f, 3.774166107e-02f, 2.830219269e-02f, 2.122354507e-02f, 1.591539383e-02f, 1.193499565e-02f, 8.949995041e-03f, 6.711483002e-03f, 5.032896996e-03f, 3.774166107e-03f, 2.830207348e-03f, 2.122372389e-03f, 1.591548324e-03f, 1.193493605e-03f, 8.949935436e-04f, 6.711483002e-04f, 5.032941699e-04f, 3.774166107e-04f, 2.830214798e-04f, 2.122372389e-04f, 1.591555774e-04f, 1.193489879e-04f, 8.949916810e-05f, 6.711483002e-05f, 5.032913759e-05f, 3.774138168e-05f, 2.830219455e-05f, 2.122367732e-05f};
        const float L2[32] = {5.112412182e-08f, -1.106699514e-07f, -7.080976872e-08f, 2.546533153e-07f, 3.392160997e-09f, -7.291706794e-08f, 2.885957029e-09f, 1.080621459e-07f, 1.007170027e-07f, -5.946218806e-08f, -5.547617121e-08f, 2.510959263e-08f, 2.453681347e-08f, -7.825315507e-09f, 1.226881441e-08f, -7.015888759e-09f, 1.071713718e-09f, 1.328252647e-10f, 4.721372737e-10f, 2.496136853e-09f, -2.016667056e-09f, -7.454754036e-10f, 4.818234145e-10f, -7.090000809e-10f, -6.267698582e-10f, 3.784003388e-10f, 2.297726315e-10f, 2.598041227e-10f, 7.773006544e-11f, 2.053124337e-10f, 1.153008353e-12f, -2.340747735e-11f};
        float* rc = (float*)(ws + WS_ROPE); float* rs = rc + (size_t)T_ * 32;
        for (int i = vcu * 512 + tid; i < T_ * 32; i += G * 512) {
            const int t = i >> 5, d = i & 31; const float th = (float)(t >> 7), tl = (float)(t & 127);
            const float a = th * H1[d], c = tl * H2[d];
            float rev = (a - floorf(a)) + (c - floorf(c)) + (th * L1[d] + tl * L2[d]);
            rev -= floorf(rev);
#ifdef CPU_EMU
            rc[i] = cosf(6.283185307179586f * rev); rs[i] = sinf(6.283185307179586f * rev);
#else
            rc[i] = __builtin_amdgcn_cosf(rev); rs[i] = __builtin_amdgcn_sinf(rev);
#endif
        }
    }
    __syncthreads();
    {
        f32x2* lp = (f32x2*)lds;
        f32x2* bb = lp + 64;
        f32x2* cc = bb + 1024;
        f32x2* ee = cc + 1024;
        for (int it = vcu; it < 32 * 13 + 32; it += G) {
            if (it >= 32 * 13) {
                const int r = it - 32 * 13, kv = r >> 4, ks = r & 15; const float* pos = p.in[kv ? I_POSV : I_POSK]; const float* w1 = p.in[kv ? I_W1V : I_W1K];
                const int j = tid & 255, i0 = 128 * ks + 64 * (tid >> 8); float a = 0.f;
#pragma unroll 16
                for (int i = i0; i < i0 + 64; ++i) a += pos[i] * w1[(size_t)i * 256 + j];
                atomicAdd((unsigned*)(ws + WS_CPOS) + kv * 256 + j, (unsigned)(int)__builtin_rintf(a * 16777216.0f));
                continue;
            }
            const int g = it / 13, nb = it % 13;
            const float dt = expf(p.in[I_LOGDT][g]);
            for (int e = tid; e < 1024; e += 512) {
                const int pp = e >> 4, ci = e & 15;
                const float ar = p.in[I_ARE][g * 64 + pp], ai = p.in[I_AIM][g * 64 + pp], x = ar * dt, y = ai * dt;
                const float em1 = expm1f(x), ex = em1 + 1.0f, cy = cosf(y), sy = sinf(y), sh = sinf(0.5f * y);
                const float lr = em1 * cy - 2.0f * sh * sh, li = ex * sy;
                const float den = ar * ar + ai * ai, fr_ = (lr * ar + li * ai) / den, fi_ = (li * ar - lr * ai) / den;
                const float br = p.in[I_BRE][(g * 64 + pp) * 16 + ci], bi = p.in[I_BIM][(g * 64 + pp) * 16 + ci];
                bb[e] = (f32x2){fr_ * br - fi_ * bi, fr_ * bi + fi_ * br};
                const int co = e >> 6, p2 = e & 63;
                cc[e] = (f32x2){p.in[I_CRE][(g * 16 + co) * 64 + p2], p.in[I_CIM][(g * 16 + co) * 64 + p2]};
            }
            for (int n = 5 * nb; n < 5 * nb + 5; ++n) {
                if (tid < 64) {
                    const float ar = p.in[I_ARE][g * 64 + tid], ai = p.in[I_AIM][g * 64 + tid];
                    const float mag = expf(ar * dt * (float)n), ang = ai * dt * (float)n;
                    lp[tid] = (f32x2){mag * cosf(ang), mag * sinf(ang)};
                }
                __syncthreads();
                for (int e = tid; e < 1024; e += 512) { const f32x2 l = lp[e >> 4], b = bb[e]; ee[e] = (f32x2){l.x * b.x - l.y * b.y, l.x * b.y + l.y * b.x}; }
                __syncthreads();
                if (n < 64) {
                    bf16_t* KT = (bf16_t*)(ws + WS_KT) + (size_t)g * 65 * 256;
                    if (tid < 256) {
                        const int co = tid >> 4, ci = tid & 15; float a = 0.f;
                        for (int pp = 0; pp < 64; ++pp) { const f32x2 c = cc[co * 64 + pp], e = ee[pp * 16 + ci]; a += c.x * e.x - c.y * e.y; }
                        KT[(n + 1) * 256 + tid] = (bf16_t)f2bf(a);
                        if (n == 0) KT[tid] = 0;
                    }
                    bf16_t* WST = (bf16_t*)(ws + WS_WST) + (size_t)g * 128 * 1024; const int sidx = 63 - n;
                    for (int e = tid; e < 1024; e += 512) { const int pp = e >> 4, ci = e & 15; const f32x2 v = ee[e];
                        WST[frag_idx(pp, sidx * 16 + ci, 1024)] = (bf16_t)f2bf(v.x); WST[frag_idx(64 + pp, sidx * 16 + ci, 1024)] = (bf16_t)f2bf(v.y); }
                }
                if (n >= 1) {
                    bf16_t* WO = (bf16_t*)(ws + WS_WOUTS) + (size_t)g * 1024 * 128; const int t = n - 1;
                    for (int e = tid; e < 1024; e += 512) { const int co = e >> 6, pp = e & 63; const f32x2 c = cc[e], l = lp[pp];
                        WO[frag_idx(t * 16 + co, pp, 128)] = (bf16_t)f2bf(c.x * l.x - c.y * l.y); WO[frag_idx(t * 16 + co, 64 + pp, 128)] = (bf16_t)f2bf(-(c.x * l.y + c.y * l.x)); }
                }
                if (n == 64 && tid < 64) ((f32x2*)(ws + WS_LAM64))[g * 64 + tid] = lp[tid];
                __syncthreads();
            }
        }
    }
}

DEV void p1_norm(const Params& p, int vcu, int G, int wave, int lane) {
    const float* x = p.in[I_X]; const float* ng = p.in[I_NORMG]; const float* mod = (const float*)(p.ws + WS_MOD); bf16_t* HN = (bf16_t*)(p.ws + WS_HN);
    const int gw = vcu * 8 + wave, NGW = G * 8;
    constexpr int RB = 32;
    for (int it = gw; it < M_ / RB; it += NGW) {
        const int r0 = it * RB, b = r0 / T_;
        f32x4 cs[4], sh[4];
#pragma unroll
        for (int j = 0; j < 4; ++j) { const int k = 4 * lane + 256 * j; const f32x4 g = *(const f32x4*)(ng + k), sc = *(const f32x4*)(mod + (size_t)b * 3072 + 1024 + k);
            cs[j] = g * (sc + 1.0f); sh[j] = *(const f32x4*)(mod + (size_t)b * 3072 + k); }
        for (int r = r0; r < r0 + RB; ++r) {
            const f32x4* xr = (const f32x4*)(x + (size_t)r * 1024) + lane; f32x4 v[4]; float s = 0.f;
#pragma unroll
            for (int j = 0; j < 4; ++j) { v[j] = xr[64 * j]; s += (v[j].x * v[j].x + v[j].y * v[j].y) + (v[j].z * v[j].z + v[j].w * v[j].w); }
            const float rinv = rsqrtf(wave_sum(s) * (1.0f / 1024.0f) + EPS_);
            u32x2* o = (u32x2*)(HN + (size_t)r * 1024) + lane;
#pragma unroll
            for (int j = 0; j < 4; ++j) { const f32x4 h = v[j] * rinv * cs[j] + sh[j]; o[64 * j] = (u32x2){pk2(h.x, h.y), pk2(h.z, h.w)}; }
        }
#ifndef CPU_EMU
        asm volatile("s_waitcnt vmcnt(0)" ::: "memory");
#else
        emu_wave_sync();
#endif
        gates_rows(p.ws, (size_t)r0, lane);
    }
}

constexpr int UL_CH = 2064;
constexpr int SSM_UL = 0, SSM_KT = 32 * UL_CH, SSM_SLOC = SSM_KT + 65 * 256 * 2, SSM_CBT = SSM_SLOC + 128 * 32 * 4, SSM_END = SSM_CBT + 32 * 272;
static_assert(SSM_END <= RING_BYTES, "ssm lds");
DEV void ssm_unit(const Params& p, unsigned char* lds, int unit, int tid, int wave, int lane) {
    const int b = unit / SSM_NG, g = unit % SSM_NG; const int l16 = lane & 15, q4 = lane >> 4;
    unsigned char* ws = p.ws;
    const bf16_t* U = (const bf16_t*)(ws + WS_U); bf16_t* YG = (bf16_t*)(ws + WS_YG);
    const bf16_t* WST = (const bf16_t*)(ws + WS_WST) + (size_t)g * 128 * 1024; const bf16_t* WO = (const bf16_t*)(ws + WS_WOUTS) + (size_t)g * 1024 * 128;
    unsigned char* ul = lds + SSM_UL; bf16_t* ktl = (bf16_t*)(lds + SSM_KT); float* sloc = (float*)(lds + SSM_SLOC); bf16_t* cbt = (bf16_t*)(lds + SSM_CBT);
    { const u32x4* src = (const u32x4*)((const bf16_t*)(ws + WS_KT) + (size_t)g * 65 * 256); u32x4* dstv = (u32x4*)ktl; for (int i = tid; i < 65 * 256 * 2 / 16; i += 512) dstv[i] = src[i]; }
    float sre = 0.f, sim = 0.f; f32x2 lam = {0.f, 0.f};
    if (wave == 0) lam = ((const f32x2*)(ws + WS_LAM64))[g * 64 + lane];
    f32x4 dsk = *(const f32x4*)(p.in[I_SSMD] + 16 * g + 4 * q4);
    for (int cg = 0; cg < SSM_NCG; ++cg) {
        const size_t tokbase = (size_t)b * T_ + (size_t)cg * 2048;
#pragma unroll
        for (int i = 0; i < 8; ++i) { const int idx = tid + 512 * i, tok = idx >> 1, hf = idx & 1;
            *(u32x4*)(ul + (tok >> 6) * UL_CH + (tok & 63) * 32 + hf * 16) = *(const u32x4*)(U + (tokbase + tok) * 512 + 16 * g + 8 * hf); }
        __syncthreads();
        {
            f32x4 a1[2] = {(f32x4){0.f, 0.f, 0.f, 0.f}, (f32x4){0.f, 0.f, 0.f, 0.f}};
            const bf16_t* ap = WST + ((size_t)wave * 32 * 64 + lane) * 8;
            const unsigned char* bp = ul + l16 * UL_CH + (q4 >> 1) * 32 + (q4 & 1) * 16;
            bf16x8 aa[2][4];
#pragma unroll
            for (int q = 0; q < 4; ++q) aa[0][q] = ld8(ap + 512 * q);
#pragma unroll
            for (int kb = 0; kb < 8; ++kb) {
                if (kb < 7) {
#pragma unroll
                    for (int q = 0; q < 4; ++q) aa[(kb + 1) & 1][q] = ld8(ap + 512 * (4 * kb + 4 + q));
                }
                SCHED_FENCE();
#pragma unroll
                for (int q = 0; q < 4; ++q) { const int ks = 4 * kb + q;
                    const bf16x8 b0 = *(const bf16x8*)(bp + ks * 64), b1 = *(const bf16x8*)(bp + 16 * UL_CH + ks * 64);
                    a1[0] = mfma16(aa[kb & 1][q], b0, a1[0]); a1[1] = mfma16(aa[kb & 1][q], b1, a1[1]); }
                SCHED_FENCE();
            }
#pragma unroll
            for (int ct = 0; ct < 2; ++ct)
#pragma unroll
                for (int r = 0; r < 4; ++r) sloc[(16 * wave + 4 * q4 + r) * 32 + 16 * ct + l16] = a1[ct][r];
        }
        __syncthreads();
        if (wave == 0) {
            for (int c = 0; c < 32; ++c) {
                cbt[c * 136 + lane] = (bf16_t)f2bf(sre); cbt[c * 136 + 64 + lane] = (bf16_t)f2bf(sim);
                const float lr = sloc[lane * 32 + c], li = sloc[(64 + lane) * 32 + c];
                const float nr = lam.x * sre - lam.y * sim + lr, ni = lam.x * sim + lam.y * sre + li; sre = nr; sim = ni;
            }
        }
        __syncthreads();
        for (int i = 0; i < 8; ++i) {
            const int t = wave + 8 * i;
            f32x4 a3[2] = {(f32x4){0.f, 0.f, 0.f, 0.f}, (f32x4){0.f, 0.f, 0.f, 0.f}};
            const unsigned char* bp = ul + l16 * UL_CH + (q4 >> 1) * 32 + (q4 & 1) * 16;
            const bf16_t* kp = ktl + (t - (q4 >> 1) + 1) * 256 + l16 * 16 + 8 * (q4 & 1);
            const int nks = (t >> 1) + 1;
            const bf16_t* wp = WO + ((size_t)t * 4 * 64 + lane) * 8;
            bf16x8 wa[4];
#pragma unroll
            for (int ks = 0; ks < 4; ++ks) wa[ks] = ld8(wp + 512 * ks);
            {
                bf16x8 an = ld8(kp), b0n = *(const bf16x8*)(bp), b1n = *(const bf16x8*)(bp + 16 * UL_CH);
                for (int ks = 0; ks < nks; ++ks) {
                    const bf16x8 a = an, b0 = b0n, b1 = b1n;
                    const int kn = (ks + 1 < nks) ? ks + 1 : ks;
                    an = ld8(kp - kn * 512); b0n = *(const bf16x8*)(bp + kn * 64); b1n = *(const bf16x8*)(bp + 16 * UL_CH + kn * 64);
                    a3[0] = mfma16(a, b0, a3[0]); a3[1] = mfma16(a, b1, a3[1]);
                }
            }
#pragma unroll
            for (int ks = 0; ks < 4; ++ks) {
                const bf16x8 b0 = ld8(cbt + l16 * 136 + 32 * ks + 8 * q4), b1 = ld8(cbt + (16 + l16) * 136 + 32 * ks + 8 * q4);
                a3[0] = mfma16(wa[ks], b0, a3[0]); a3[1] = mfma16(wa[ks], b1, a3[1]);
            }
#pragma unroll
            for (int ct = 0; ct < 2; ++ct) {
                const int chunk = 16 * ct + l16; const size_t tok = tokbase + (size_t)chunk * 64 + t;
                const u32x2 uv = *(const u32x2*)(ul + chunk * UL_CH + t * 32 + 8 * q4);
                float y[4];
#pragma unroll
                for (int r = 0; r < 4; ++r) { const unsigned w = uv[r >> 1]; const float uu = bf2f((r & 1) ? (w >> 16) : (w & 0xffffu)); y[r] = gelu_tanh_f(a3[ct][r] + dsk[r] * uu); }
                *(u32x2*)(YG + tok * 512 + 16 * g + 4 * q4) = (u32x2){pk2(y[0], y[1]), pk2(y[2], y[3])};
            }
        }
        __syncthreads();
    }
}

constexpr int CMP_TOK = 0, CMP_H = 528 * 128, CMP_OUT = CMP_H + 32 * 528, CMP_END = CMP_OUT + 32 * 64 * 4;
static_assert(CMP_END <= RING_BYTES, "cmp lds");
constexpr int CMP_UNITS = 2 * B_ * NGRP * (NCP / 32);
DEV void compress_unit(const Params& p, unsigned char* lds, int unit, int tid, int wave, int lane) {
    int r = unit; const int nb = r % (NCP / 32); r /= (NCP / 32); const int g = r % NGRP; r /= NGRP; const int b = r % B_; const int kv = r / B_;
    const int l16 = lane & 15, q4 = lane >> 4; unsigned char* ws = p.ws;
    const bf16_t* CR = (const bf16_t*)(ws + WS_CR); const bf16_t* w1t = (const bf16_t*)(ws + (kv ? WS_W1V : WS_W1K)); const bf16_t* w2t = (const bf16_t*)(ws + (kv ? WS_W2V : WS_W2K));
    const float* cpos = (const float*)(ws + WS_CPOS) + kv * 256;
    unsigned char* tokl = lds + CMP_TOK; bf16_t* hl = (bf16_t*)(lds + CMP_H); float* outl = (float*)(lds + CMP_OUT);
    const int n0 = 32 * nb, tk0 = 16 * n0;
    for (int idx = tid; idx < 528 * 8; idx += 512) {
        const int tl = idx >> 3, ch = idx & 7; const int tok = tk0 + tl;
        u32x4 v = (u32x4){0u, 0u, 0u, 0u};
        if (tok < T_) v = *(const u32x4*)(CR + ((size_t)b * T_ + tok) * 256 + kv * 128 + g * 64 + 8 * ch);
        *(u32x4*)(tokl + (tl * 8 + (ch ^ ((tl >> 4) & 7))) * 16) = v;
    }
    __syncthreads();
    f32x4 acc[2][2];
#pragma unroll
    for (int a = 0; a < 2; ++a)
#pragma unroll
        for (int c = 0; c < 2; ++c) acc[a][c] = (f32x4){0.f, 0.f, 0.f, 0.f};
    const bf16_t* bp0 = w1t + ((size_t)(2 * wave) * 64 * 64 + lane) * 8; const bf16_t* bp1 = bp0 + (size_t)64 * 64 * 8;
    bf16x8 bb[2][4][2];
#pragma unroll
    for (int q = 0; q < 4; ++q) { bb[0][q][0] = ld8(bp0 + 512 * q); bb[0][q][1] = ld8(bp1 + 512 * q); }
#pragma unroll
    for (int kb = 0; kb < 16; ++kb) {
        if (kb < 15) {
#pragma unroll
            for (int q = 0; q < 4; ++q) { bb[(kb + 1) & 1][q][0] = ld8(bp0 + 512 * (4 * kb + 4 + q)); bb[(kb + 1) & 1][q][1] = ld8(bp1 + 512 * (4 * kb + 4 + q)); }
        }
        SCHED_FENCE();
#pragma unroll
        for (int q = 0; q < 4; ++q) { const int ks = 4 * kb + q;
            const int l = ks >> 1, chunk = 4 * (ks & 1) + q4;
            const int tl0 = 16 * l16 + l, tl1 = 16 * (16 + l16) + l;
            const bf16x8 a0 = *(const bf16x8*)(tokl + (tl0 * 8 + (chunk ^ ((tl0 >> 4) & 7))) * 16), a1 = *(const bf16x8*)(tokl + (tl1 * 8 + (chunk ^ ((tl1 >> 4) & 7))) * 16);
            const bf16x8 b0 = bb[kb & 1][q][0], b1 = bb[kb & 1][q][1];
            acc[0][0] = mfma16(a0, b0, acc[0][0]); acc[0][1] = mfma16(a0, b1, acc[0][1]); acc[1][0] = mfma16(a1, b0, acc[1][0]); acc[1][1] = mfma16(a1, b1, acc[1][1]); }
        SCHED_FENCE();
    }
#pragma unroll
    for (int rt = 0; rt < 2; ++rt)
#pragma unroll
        for (int ct = 0; ct < 2; ++ct) { const int j = 32 * wave + 16 * ct + l16; const float cp = (float)((const int*)cpos)[j] * (1.0f / 16777216.0f);
#pragma unroll
            for (int rr = 0; rr < 4; ++rr) hl[(16 * rt + 4 * q4 + rr) * 264 + j] = (bf16_t)f2bf(gelu_tanh_f(acc[rt][ct][rr] + cp)); }
    __syncthreads();
    {
        const int rt = wave >> 2, ct = wave & 3; f32x4 a2 = (f32x4){0.f, 0.f, 0.f, 0.f};
#pragma unroll
        for (int ks = 0; ks < 8; ++ks) { const bf16x8 a = ld8(hl + (16 * rt + l16) * 264 + 32 * ks + 8 * q4), bq = ld8(w2t + (size_t)(16 * ct + l16) * 256 + 32 * ks + 8 * q4); a2 = mfma16(a, bq, a2); }
#pragma unroll
        for (int rr = 0; rr < 4; ++rr) outl[(16 * rt + 4 * q4 + rr) * 64 + 16 * ct + l16] = a2[rr];
    }
    __syncthreads();
    {
        const int row = tid >> 4, c4 = tid & 15; f32x4 v = *(const f32x4*)(outl + row * 64 + 4 * c4);
        if (kv == 0) {
            float ss = v.x * v.x + v.y * v.y + v.z * v.z + v.w * v.w;
            ss += __shfl_xor(ss, 1); ss += __shfl_xor(ss, 2); ss += __shfl_xor(ss, 4); ss += __shfl_xor(ss, 8);
            const float rinv = rsqrtf(ss * (1.0f / 64.0f) + EPS_); const f32x4 gk = *(const f32x4*)(p.in[I_KCNG] + 4 * c4);
            v = v * rinv * gk;
        }
        const int n = n0 + row; if (n >= NCMP) v = (f32x4){0.f, 0.f, 0.f, 0.f};
        bf16_t* dst = (bf16_t*)(ws + (kv ? WS_VC : WS_KC)) + (((size_t)b * NCP + n) * NGRP + g) * 64 + 4 * c4;
        *(u32x2*)dst = (u32x2){pk2(v.x, v.y), pk2(v.z, v.w)};
    }
    __syncthreads();
}

constexpr int VT_UNITS = B_ * NGRP * (T_ / 64);
struct VtPre { u32x4 v, k; };
DEV void vt_fetch(const Params& p, int unit, int tid, VtPre& r) {
    const int tb = unit % (T_ / 64), bg = unit / (T_ / 64), b = bg / NGRP, g = bg % NGRP;
    const bf16_t* SLk = (const bf16_t*)(p.ws + WS_SL) + ((size_t)b * T_ + 64 * tb) * 256 + g * 64; const bf16_t* SLv = SLk + 128;
    { const int tok = tid >> 3, ch = tid & 7; r.v = *(const u32x4*)(SLv + (size_t)tok * 256 + 8 * ch); }
    {
      const int kt = tid >> 8, ks = (tid >> 6) & 3, h = (tid >> 5) & 1, r32 = tid & 31, kr = (r32 & ~12) | ((r32 & 8) >> 1) | ((r32 & 4) << 1);
      r.k = *(const u32x4*)(SLk + (size_t)(32 * kt + kr) * 256 + 16 * ks + 8 * h); }
}
DEV void vt_unit(const Params& p, unsigned char* lds, int unit, int tid, const VtPre& r) {
    const int tb = unit % (T_ / 64), bg = unit / (T_ / 64);
    bf16_t* VF = (bf16_t*)(p.ws + WS_VT) + ((size_t)bg * (T_ / 64) + tb) * 4096; bf16_t* KF = (bf16_t*)(p.ws + WS_KF) + ((size_t)bg * (T_ / 64) + tb) * 4096;
    bf16_t* tile = (bf16_t*)lds;
    { const int tok = tid >> 3, ch = tid & 7; *(u32x4*)(tile + tok * 72 + 8 * ch) = r.v; }
    *(u32x4*)(KF + tid * 8) = r.k;
    __syncthreads();
    { const int dim = tid >> 3, c8 = tid & 7; unsigned short e[8];
#pragma unroll
      for (int i = 0; i < 8; ++i) e[i] = tile[(8 * c8 + i) * 72 + dim];
      *(u32x4*)(VF + (((dim >> 5) * 4 + (c8 >> 1)) * 64 + 32 * (c8 & 1) + (dim & 31)) * 8) = (u32x4){(unsigned)e[0] | ((unsigned)e[1] << 16), (unsigned)e[2] | ((unsigned)e[3] << 16), (unsigned)e[4] | ((unsigned)e[5] << 16), (unsigned)e[6] | ((unsigned)e[7] << 16)}; }
    __syncthreads();
}

constexpr int AT_KB = 0, AT_VOFF = 128 * 160, AT_STAGE = 2 * AT_VOFF, AT_IA = 2 * AT_STAGE, AT_IB = AT_IA + 64 * 128 * 4, AT_SEL = AT_IB + 64 * 128 * 4, AT_TM = AT_SEL + 64 * 16, AT_END = AT_TM + 128 * 8;
constexpr int EN_QL = 0, EN_OL = 40960, EN_LL = EN_OL + 256 * 65 * 4, EN_END = EN_LL + 1024;
static_assert(EN_END + 16 * 512 * 4 <= AT_SEL && 256 * 72 * 2 <= EN_OL, "engine lds");
static_assert(AT_END <= MISC_OFF, "attn lds");
constexpr int AT_UNITS = B_ * NGRP * NSB;

#ifdef CPU_EMU
DEV int row16_sum(int v) { v += __shfl_xor(v, 8); v += __shfl_xor(v, 4); v += __shfl_xor(v, 2); v += __shfl_xor(v, 1); return v; }
DEV int row16_shr(int v, int n) { const int l = threadIdx.x & 63; const int r = __shfl(v, (l & 15) >= n ? l - n : l); return (l & 15) >= n ? r : 0; }
DEV float quad_sum(float v) { v += __shfl_xor(v, 1); v += __shfl_xor(v, 2); return v; }
DEV u32x2 lds_tr16(const bf16_t* p) {
    const int w = threadIdx.x >> 6, l = threadIdx.x & 63; const unsigned long long a = (unsigned long long)(uintptr_t)p;
    emu_xbuf[w][l][0] = (unsigned)a; emu_xbuf[w][l][1] = (unsigned)(a >> 32); emu_wave_sync();
    const int g = l >> 4, i = l & 15; unsigned short e[4];
    for (int q = 0; q < 4; ++q) { const int src = 16 * g + 4 * q + (i >> 2); const unsigned long long sa = (unsigned long long)emu_xbuf[w][src][0] | ((unsigned long long)emu_xbuf[w][src][1] << 32); e[q] = ((const unsigned short*)(uintptr_t)sa)[i & 3]; }
    emu_wave_sync();
    return (u32x2){(unsigned)e[0] | ((unsigned)e[1] << 16), (unsigned)e[2] | ((unsigned)e[3] << 16)};
}
#else
DEV int row16_sum(int v) {
    v += __builtin_amdgcn_update_dpp(0, v, 0x128, 0xF, 0xF, false); v += __builtin_amdgcn_update_dpp(0, v, 0x124, 0xF, 0xF, false);
    v += __builtin_amdgcn_update_dpp(0, v, 0x122, 0xF, 0xF, false); v += __builtin_amdgcn_update_dpp(0, v, 0x121, 0xF, 0xF, false); return v;
}
#define row16_shr(v, n) __builtin_amdgcn_update_dpp(0, (v), 0x110 + (n), 0xF, 0xF, true)
DEV float quad_sum(float v) {
    v += __builtin_bit_cast(float, __builtin_amdgcn_mov_dpp(__builtin_bit_cast(int, v), 0xB1, 0xF, 0xF, true));
    v += __builtin_bit_cast(float, __builtin_amdgcn_mov_dpp(__builtin_bit_cast(int, v), 0x4E, 0xF, 0xF, true));
    return v;
}
typedef short v4i16_t __attribute__((ext_vector_type(4)));
DEV u32x2 lds_tr16(const bf16_t* p) { return __builtin_bit_cast(u32x2, __builtin_amdgcn_ds_read_tr16_b64_v4i16((__attribute__((address_space(3))) v4i16_t*)p)); }
#endif

#ifdef PROBE_TIMING
#define TSTAMP(v) do { __builtin_amdgcn_sched_barrier(0); v = __builtin_amdgcn_s_memtime(); __builtin_amdgcn_s_waitcnt(0xC07F); __builtin_amdgcn_sched_barrier(0); } while (0)
#else
#define TSTAMP(v) do { } while (0)
#endif
#ifndef PROBE_MODE
#define PROBE_MODE -1
#endif
constexpr int ATS = 80;
template <int MODE>
DEV void attn_tile(const bf16_t* kb, const bf16_t* vb, int jt, const bf16x8 (&qf)[4], f32x16 (&oacc)[2], float& lsum, float linv, const f32x16& negm, int ttok,
                   unsigned long long slo, unsigned long long shi, int t0, int qb, float* impA, float* impB, int wave, int lane) {
    const float NINF = -INFINITY;
    const int c32 = lane & 31, h = lane >> 5, hg = lane & 3, tau = c32 >> 2;
    bool nm;
    if (MODE <= 1) nm = (16 * (64 * jt + 63) + 31 > t0);
    else if (MODE == 2) nm = (jt == qb);
    else nm = (jt == qb) || (jt + 8 == qb);
    f32x16 s[2];
    if (nm) {
        const float nm0 = negm[0];
        if (MODE == 3 && jt != qb) {
            const int d2 = ttok - 512 - 64 * jt - 4 * h;
#pragma unroll
            for (int kt = 0; kt < 2; ++kt) {
                f32x16 cm;
#pragma unroll
                for (int i = 0; i < 16; ++i) cm[i] = (32 * kt + (i & 3) + 8 * (i >> 2) > d2) ? nm0 : NINF;
                s[kt] = mfma32(ld8(kb + (32 * kt + c32) * ATS + 8 * h), qf[0], cm);
            }
        } else {
            const int d = ((MODE <= 1) ? ((ttok - 31) >> 4) : ttok) - 64 * jt - 4 * h;
#pragma unroll
            for (int kt = 0; kt < 2; ++kt) {
                f32x16 cm;
#pragma unroll
                for (int i = 0; i < 16; ++i) cm[i] = (32 * kt + (i & 3) + 8 * (i >> 2) <= d) ? nm0 : NINF;
                s[kt] = mfma32(ld8(kb + (32 * kt + c32) * ATS + 8 * h), qf[0], cm);
            }
        }
    } else {
#pragma unroll
        for (int kt = 0; kt < 2; ++kt) s[kt] = mfma32(ld8(kb + (32 * kt + c32) * ATS + 8 * h), qf[0], negm);
    }
#pragma unroll
    for (int kt = 0; kt < 2; ++kt)
#pragma unroll
        for (int ks = 1; ks < 4; ++ks) { const bf16x8 a = ld8(kb + (32 * kt + c32) * ATS + 16 * ks + 8 * h); s[kt] = mfma32(a, qf[ks], s[kt]); }
    float psum = 0.f;
#pragma unroll
    for (int kt = 0; kt < 2; ++kt)
#pragma unroll
        for (int i = 0; i < 16; ++i) { const float pv = exp2_fast(s[kt][i]); s[kt][i] = pv; psum += pv; }
    if (MODE != 1) lsum += psum;
    if (MODE == 1) {
#pragma unroll
        for (int kt = 0; kt < 2; ++kt)
#pragma unroll
            for (int gq = 0; gq < 4; ++gq) {
                const float a = quad_sum(2.0f * (s[kt][4 * gq] + s[kt][4 * gq + 1] + s[kt][4 * gq + 2]) + s[kt][4 * gq + 3]), bq = quad_sum(s[kt][4 * gq + 3]);
                if (hg == 0) { const int j = 16 * jt + 8 * kt + 2 * gq + h; const int tl = 8 * wave + tau; impA[tl * 128 + j] = a; impB[tl * 128 + j] = bq; }
            }
    }
    if (MODE != 0) {
        const int l15 = lane & 15, g1 = (lane >> 4) & 1;
#pragma unroll
        for (int kt = 0; kt < 2; ++kt)
#pragma unroll
            for (int sp = 0; sp < 2; ++sp) {
                u32x4 pw = (u32x4){pk2(s[kt][8 * sp], s[kt][8 * sp + 1]), pk2(s[kt][8 * sp + 2], s[kt][8 * sp + 3]), pk2(s[kt][8 * sp + 4], s[kt][8 * sp + 5]), pk2(s[kt][8 * sp + 6], s[kt][8 * sp + 7])};
                const bf16x8 pf = __builtin_bit_cast(bf16x8, pw);
                const bf16_t* vr = vb + (32 * kt + 16 * sp + 4 * h + (l15 >> 2)) * ATS + 16 * g1 + 4 * (l15 & 3);
#pragma unroll
                for (int dt = 0; dt < 2; ++dt) {
                    const u32x2 lo = lds_tr16(vr + 32 * dt), hi = lds_tr16(vr + 8 * ATS + 32 * dt);
                    oacc[dt] = mfma32(__builtin_bit_cast(bf16x8, (u32x4){lo.x, lo.y, hi.x, hi.y}), pf, oacc[dt]);
                }
            }
    }
}

DEV void at_preload(const bf16_t* Kg, const bf16_t* Vg, int pitch, int jlo, int jhi, int tid, u32x4 (&pk)[2], u32x4 (&pv)[2]) {
    const int key = tid >> 3, ch = tid & 7;
#pragma unroll
    for (int u = 0; u < 2; ++u) { const int jt = jlo + u; pk[u] = (u32x4){0u, 0u, 0u, 0u}; pv[u] = pk[u];
        if (jt <= jhi) { pk[u] = *(const u32x4*)(Kg + (size_t)(64 * jt + key) * pitch + 8 * ch); pv[u] = *(const u32x4*)(Vg + (size_t)(64 * jt + key) * pitch + 8 * ch); } }
}

template <int MODE, bool PRE = false>
DEV void attn_pass(const bf16_t* Kg, const bf16_t* Vg, int pitch, int jlo, int jhi, unsigned char* lds, const bf16x8 (&qf)[4], f32x16 (&oacc)[2], float& lsum, float linv,
                   float m0l, int ttok, unsigned long long slo, unsigned long long shi, int t0, int qb, int tid, int wave, int lane_, unsigned long long& tcomp, unsigned long long& tpass,
                   const u32x4* pk = nullptr, const u32x4* pv = nullptr) {
    unsigned long long tc0_ = 0, tc1_ = 0, tp0_ = 0, tp1_ = 0; TSTAMP(tp0_);
    LAUNDER_V(tid); const int lane = tid & 63; (void)lane_;
    const int key = tid >> 3, ch = tid & 7;
    float* impA = (float*)(lds + AT_IA); float* impB = (float*)(lds + AT_IB);
    const int nsteps = (jhi - jlo + 2) >> 1;
    const u32x4 Z4 = (u32x4){0u, 0u, 0u, 0u};
    f32x16 negm;
    float nm0_ = (MODE == 1) ? (log2_fast(linv) - m0l) : -m0l;
    LAUNDER_V(nm0_);
#pragma unroll
    for (int i = 0; i < 16; ++i) negm[i] = nm0_;
    u32x4 rk[2][2], rv[2][2];
#define AT_LOAD(set, st) do { _Pragma("unroll") for (int u_ = 0; u_ < 2; ++u_) { const int jt_ = jlo + 2 * (st) + u_; rk[set][u_] = Z4; rv[set][u_] = Z4; \
        if (jt_ <= jhi) { rk[set][u_] = *(const u32x4*)(Kg + (size_t)(64 * jt_ + key) * pitch + 8 * ch); if (MODE != 0) rv[set][u_] = *(const u32x4*)(Vg + (size_t)(64 * jt_ + key) * pitch + 8 * ch); } } } while (0)
#define AT_WRITE(set, stage) do { _Pragma("unroll") for (int u_ = 0; u_ < 2; ++u_) { *(u32x4*)(lds + AT_KB + (stage) * AT_STAGE + ((64 * u_ + key) * ATS + 8 * ch) * 2) = rk[set][u_]; \
        if (MODE != 0) *(u32x4*)(lds + AT_KB + (stage) * AT_STAGE + AT_VOFF + ((64 * u_ + key) * ATS + 8 * ch) * 2) = rv[set][u_]; } } while (0)
    if (PRE) { rk[0][0] = pk[0]; rk[0][1] = pk[1]; rv[0][0] = pv[0]; rv[0][1] = pv[1]; } else AT_LOAD(0, 0);
    AT_WRITE(0, 0);
    if (MODE != 2 && nsteps > 1) AT_LOAD(1, 1); else { rk[1][0] = Z4; rk[1][1] = Z4; rv[1][0] = Z4; rv[1][1] = Z4; }
    __syncthreads();
#define AT_COMPUTE(st) do { const int stage_ = (st) & 1; TSTAMP(tc0_); \
        _Pragma("unroll") for (int u = 0; u < 2; ++u) { const int jt = jlo + 2 * (st) + u; if (jt > jhi) break; \
            const bf16_t* kb = (const bf16_t*)(lds + AT_KB + stage_ * AT_STAGE) + 64 * ATS * u; const bf16_t* vb = (const bf16_t*)(lds + AT_KB + stage_ * AT_STAGE + AT_VOFF) + 64 * ATS * u; \
            attn_tile<MODE>(kb, vb, jt, qf, oacc, lsum, linv, negm, ttok, slo, shi, t0, qb, impA, impB, wave, lane); } TSTAMP(tc1_); if (MODE == PROBE_MODE) tcomp += tc1_ - tc0_; } while (0)
    for (int st = 0; st < nsteps; st += 2) {
        if (MODE != 2 && st + 2 < nsteps) AT_LOAD(0, st + 2);
        AT_COMPUTE(st);
        if (MODE != 2 && st + 1 < nsteps) AT_WRITE(1, 1);
        LDS_BARRIER();
        if (MODE == 2 || st + 1 >= nsteps) break;
        if (st + 3 < nsteps) AT_LOAD(1, st + 3);
        AT_COMPUTE(st + 1);
        if (st + 2 < nsteps) AT_WRITE(0, 0);
        LDS_BARRIER();
    }
#undef AT_LOAD
#undef AT_WRITE
#undef AT_COMPUTE
    TSTAMP(tp1_); if (MODE == PROBE_MODE) tpass += tp1_ - tp0_;
}

DEV unsigned char* en_tl(unsigned char* lds, int j) { return j <= 124 ? lds + AT_SEL + 64 * (j - 1) : lds + MISC_OFF + 160; }
static_assert(AT_SEL + 64 * 124 <= MISC_OFF, "token lists");

#ifndef SEL_KSH
#define SEL_KSH 14
#endif
DEV void attn_unit(const Params& p, unsigned char* lds, int b, int g, int qb, float m0c, float m0s, float m0w, int tid, int wave, int lane_) {
    LAUNDER_V(tid); const int lane = tid & 63; (void)lane_;
    unsigned char* ws = p.ws;
    const int c32 = lane & 31, h = lane >> 5, hg = lane & 3, tau = c32 >> 2; const int t0 = 64 * qb;
    const bf16_t* Q = (const bf16_t*)(ws + WS_Q); const bf16_t* QR = (const bf16_t*)(ws + WS_QR);
    const bf16_t* KC = (const bf16_t*)(ws + WS_KC) + (size_t)b * NCP * 128 + g * 64; const bf16_t* VC = (const bf16_t*)(ws + WS_VC) + (size_t)b * NCP * 128 + g * 64;
    const bf16_t* SL = (const bf16_t*)(ws + WS_SL) + (size_t)b * T_ * 256 + g * 64; const bf16_t* WN = (const bf16_t*)(ws + WS_WN) + (size_t)b * T_ * 256 + g * 64;
    const float* G = (const float*)(ws + WS_G);
    constexpr float LOG2E = 1.4426950408889634f;
    const int ttok = t0 + 8 * wave + tau; const size_t rowg = (size_t)b * T_ + ttok;
    const int hd = 4 * g + hg;
    bf16x8 qf[4]; f32x16 oacc[2], outa[2]; float lsum = 0.f, linv = 0.f; unsigned long long tcomp = 0, tpass = 0;
    unsigned long long slo = 0ull, shi = 0ull;
#pragma unroll
    for (int dt = 0; dt < 2; ++dt)
#pragma unroll
        for (int i = 0; i < 16; ++i) { oacc[dt][i] = 0.f; outa[dt][i] = 0.f; }
#pragma unroll
    for (int ks = 0; ks < 4; ++ks) qf[ks] = ld8(Q + rowg * 512 + hd * 64 + 16 * ks + 8 * h);
    const int ncmp = 4 * qb + 3;
    const int jhc = (ncmp - 1) >> 6;
#ifndef REP_CMP
#define REP_CMP 1
#endif
    for (int rep_ = 0; rep_ < REP_CMP; ++rep_) { lsum = 0.f;
    attn_pass<0>(KC, VC, 128, 0, jhc, lds, qf, oacc, lsum, linv, m0c * LOG2E, ttok, slo, shi, t0, qb, tid, wave, lane, tcomp, tpass); }
    { float L = lsum; L += __shfl_xor(L, 32); linv = L > 0.f ? 1.0f / L : 0.f; lsum = 0.f; }
    attn_pass<1>(KC, VC, 128, 0, jhc, lds, qf, oacc, lsum, linv, m0c * LOG2E, ttok, slo, shi, t0, qb, tid, wave, lane, tcomp, tpass);
    { const float gt = G[rowg * 32 + 3 * hd + 0];
#pragma unroll
        for (int dt = 0; dt < 2; ++dt)
#pragma unroll
            for (int i = 0; i < 16; ++i) { outa[dt][i] = oacc[dt][i] * gt; oacc[dt][i] = 0.f; } }
    {
        const float* impA = (const float*)(lds + AT_IA); const float* impB = (const float*)(lds + AT_IB); unsigned long long* sel = (unsigned long long*)(lds + AT_SEL);
        unsigned char* sel8 = (unsigned char*)sel;
        const int row16 = lane >> 4, i16 = lane & 15;
        {
            unsigned k[2][8], th[2] = {0u, 0u};
#pragma unroll
            for (int rnd = 0; rnd < 2; ++rnd) {
                const int tl = 8 * wave + 4 * rnd + row16; const float* ia = impA + tl * 128; const float* ib = impB + tl * 128;
                const f32x4 a0 = *(const f32x4*)(ia + 8 * i16), a1 = *(const f32x4*)(ia + 8 * i16 + 4), b0 = *(const f32x4*)(ib + 8 * i16), b1 = *(const f32x4*)(ib + 8 * i16 + 4);
                const float bm1 = ib[8 * i16 - 1];
#pragma unroll
                for (int c = 0; c < 8; ++c) { const int j = 8 * i16 + c;
                    const float av = c < 4 ? a0[c & 3] : a1[c & 3], bv = (c == 0) ? bm1 : (c <= 4 ? b0[(c - 1) & 3] : b1[(c - 5) & 3]);
                    const unsigned kv = (__builtin_bit_cast(unsigned, av + bv) >> SEL_KSH) + 1u;
                    k[rnd][c] = (j > qb) ? 0u : ((j == 0 || j == qb || j == qb - 1) ? (0x7f800000u >> SEL_KSH) + 1u : kv); }
            }
#pragma unroll 1
            for (int bit = 30 - SEL_KSH; bit >= 0; --bit) {
                const unsigned bm = 1u << bit;
#pragma unroll
                for (int rnd = 0; rnd < 2; ++rnd) {
                    const unsigned cand = th[rnd] | bm;
                    const int c01 = ((k[rnd][0] >= cand) ? 1 : 0) + ((k[rnd][1] >= cand) ? 1 : 0), c23 = ((k[rnd][2] >= cand) ? 1 : 0) + ((k[rnd][3] >= cand) ? 1 : 0);
                    const int c45 = ((k[rnd][4] >= cand) ? 1 : 0) + ((k[rnd][5] >= cand) ? 1 : 0), c67 = ((k[rnd][6] >= cand) ? 1 : 0) + ((k[rnd][7] >= cand) ? 1 : 0);
                    const int cnt = row16_sum((c01 + c23) + (c45 + c67));
                    th[rnd] = (cnt >= 16) ? cand : th[rnd];
                }
            }
#pragma unroll
            for (int rnd = 0; rnd < 2; ++rnd) {
                const int tl = 8 * wave + 4 * rnd + row16;
                int gt = 0, eq = 0;
#pragma unroll
                for (int c = 0; c < 8; ++c) { gt += (k[rnd][c] > th[rnd]) ? 1 : 0; eq += (k[rnd][c] == th[rnd]) ? 1 : 0; }
                const int need = (th[rnd] == 0u) ? 0 : 16 - row16_sum(gt);
                int pre = eq;
                { int t_ = row16_shr(pre, 1); pre += t_; t_ = row16_shr(pre, 2); pre += t_; t_ = row16_shr(pre, 4); pre += t_; t_ = row16_shr(pre, 8); pre += t_; }
                int run = pre - eq; unsigned bits = 0u;
#pragma unroll
                for (int c = 0; c < 8; ++c) {
                    if (k[rnd][c] > th[rnd]) bits |= 1u << c;
                    else if (k[rnd][c] == th[rnd]) { if (run < need) bits |= 1u << c; ++run; }
                }
                sel8[tl * 16 + i16] = (unsigned char)bits;
            }
        }
    }
    __syncthreads();
    {
        const unsigned long long* sel = (const unsigned long long*)(lds + AT_SEL);
        const unsigned long long mylo = sel[lane * 2], myhi = sel[lane * 2 + 1];
        __syncthreads();
        for (int jj = 0; jj < 16; ++jj) { const int j = 16 * wave + jj; if (j < 1 || j > 125) continue;
            const int bit = (int)(((j < 64) ? (mylo >> j) : (myhi >> (j - 64))) & 1ull); const unsigned long long m = __ballot(bit);
            unsigned char* tl = en_tl(lds, j);
            const int pos = __builtin_popcountll(m & ((1ull << lane) - 1ull)), cnt = __builtin_popcountll(m);
            if (bit) tl[pos] = (unsigned char)lane;
            if (lane < 16 && cnt + lane < 64) tl[cnt + lane] = 0xFFu; }
    }
    float* outl = (float*)(lds + AT_IA) + tid;
#pragma unroll
    for (int dt = 0; dt < 2; ++dt)
#pragma unroll
        for (int i = 0; i < 16; ++i) outl[(dt * 16 + i) * 512] = outa[dt][i];
#pragma unroll
    for (int ks = 0; ks < 4; ++ks) qf[ks] = ld8(QR + rowg * 512 + hd * 64 + 16 * ks + 8 * h);
#ifndef REP_WIN
#define REP_WIN 1
#endif
    for (int rep_ = 0; rep_ < REP_WIN; ++rep_)
    attn_pass<3>(WN, WN + 128, 256, qb >= 8 ? qb - 8 : 0, qb, lds, qf, oacc, lsum, linv, m0w * LOG2E, ttok, slo, shi, t0, qb, tid, wave, lane, tcomp, tpass);
    { float L = lsum; L += __shfl_xor(L, 32); const float sc = (L > 0.f ? 1.0f / L : 0.f) * G[rowg * 32 + 3 * hd + 2]; lsum = 0.f;
#pragma unroll
        for (int dt = 0; dt < 2; ++dt)
#pragma unroll
            for (int i = 0; i < 16; ++i) { outa[dt][i] = outl[(dt * 16 + i) * 512] + oacc[dt][i] * sc; oacc[dt][i] = 0.f; } }
    __syncthreads();
    {
        bf16_t* QL = (bf16_t*)(lds + EN_QL); float* OL = (float*)(lds + EN_OL); float* LL = (float*)(lds + EN_LL);
        float* outp = (float*)(lds + EN_END) + tid;
#pragma unroll
        for (int i = 0; i < 16; ++i) outp[i * 512] = outa[1][i];
        for (int i = tid; i < (EN_LL + 1024 - EN_OL) / 16; i += 512) ((u32x4*)(lds + EN_OL))[i] = (u32x4){0u, 0u, 0u, 0u};
        unsigned* qcnt = (unsigned*)(lds + MISC_OFF + 128);
        if (tid == 0) *qcnt = 0u;
#pragma unroll
        for (int k = 0; k < 4; ++k) { const int idx = tid + 512 * k, tok = idx >> 5, c = idx & 31;
            *(u32x4*)(QL + (tok * 4 + (c >> 3)) * 72 + (c & 7) * 8) = *(const u32x4*)(QR + ((size_t)b * T_ + t0 + tok) * 512 + g * 256 + c * 8); }
        __syncthreads();
        const bf16_t* VT = (const bf16_t*)(ws + WS_VT) + (size_t)(b * NGRP + g) * (T_ / 64) * 4096; const bf16_t* KF = (const bf16_t*)(ws + WS_KF) + (size_t)(b * NGRP + g) * (T_ / 64) * 4096;
        const int r32 = lane & 31, kr = (r32 & ~12) | ((r32 & 8) >> 1) | ((r32 & 4) << 1);
        const float cs0 = 17.0f - m0s * LOG2E;
#ifndef REP_SLC
#define REP_SLC 1
#endif
        for (;;) {
            unsigned tk_ = 0u; if (lane == 0) tk_ = atomicAdd(qcnt, 1u);
            tk_ = (unsigned)__shfl((int)tk_, 0);
#ifndef CPU_EMU
            tk_ = (unsigned)__builtin_amdgcn_readfirstlane((int)tk_);
#endif
            const int j = 1 + (int)tk_; if (j > qb - 2) break;
            const unsigned char* tl = en_tl(lds, j);
            int first = tl[0];
#ifndef CPU_EMU
            first = __builtin_amdgcn_readfirstlane(first);
#endif
            if (first == 0xFF) continue;
            bf16x8 kfr[2][4], vfr[2][4];
#pragma unroll
            for (int kt = 0; kt < 2; ++kt)
#pragma unroll
                for (int ks = 0; ks < 4; ++ks) kfr[kt][ks] = ld8(KF + (size_t)j * 4096 + ((kt * 4 + ks) * 64 + lane) * 8);
#pragma unroll
            for (int dt = 0; dt < 2; ++dt)
#pragma unroll
                for (int q = 0; q < 4; ++q) vfr[dt][q] = ld8(VT + (size_t)j * 4096 + ((dt * 4 + q) * 64 + lane) * 8);
            for (int gi = 0; gi < 8; ++gi) {
                const int tokidx = tl[8 * gi + tau];
                const bool valid = tokidx != 0xFF;
                if (!__any(valid)) break;
                const int ti = valid ? tokidx : 0; const int row = ti * 4 + hg;
                bf16x8 qg[4];
#pragma unroll
                for (int ks = 0; ks < 4; ++ks) qg[ks] = ld8(QL + row * 72 + 16 * ks + 8 * h);
                f32x16 s2[2];
#pragma unroll
                for (int kt = 0; kt < 2; ++kt) {
#pragma unroll
                    for (int i = 0; i < 16; ++i) s2[kt][i] = cs0;
#pragma unroll
                    for (int ks = 0; ks < 4; ++ks) s2[kt] = mfma32(kfr[kt][ks], qg[ks], s2[kt]);
                }
                float psum = 0.f;
#pragma unroll
                for (int kt = 0; kt < 2; ++kt)
#pragma unroll
                    for (int i = 0; i < 16; ++i) { const float pv = exp2_fast(s2[kt][i]); s2[kt][i] = pv; psum += pv; }
                u32x4 pw[4];
#pragma unroll
                for (int q = 0; q < 4; ++q) { const int kt = q >> 1, sp = q & 1;
                    pw[q] = (u32x4){pk2(s2[kt][8 * sp], s2[kt][8 * sp + 1]), pk2(s2[kt][8 * sp + 2], s2[kt][8 * sp + 3]), pk2(s2[kt][8 * sp + 4], s2[kt][8 * sp + 5]), pk2(s2[kt][8 * sp + 6], s2[kt][8 * sp + 7])}; }
                if (!__all(valid)) {
                    const unsigned pm = valid ? 0xffffffffu : 0u;
#pragma unroll
                    for (int q = 0; q < 4; ++q) { pw[q].x &= pm; pw[q].y &= pm; pw[q].z &= pm; pw[q].w &= pm; }
                }
                f32x16 o2[2];
#pragma unroll
                for (int dt = 0; dt < 2; ++dt) {
#pragma unroll
                    for (int i = 0; i < 16; ++i) o2[dt][i] = 0.f;
#pragma unroll
                    for (int q = 0; q < 4; ++q) o2[dt] = mfma32(vfr[dt][q], __builtin_bit_cast(bf16x8, pw[q]), o2[dt]);
                }
                psum += __shfl_xor(psum, 32);
                if (valid) {
                    unsigned* orow = (unsigned*)(OL + row * 65 + 4 * h);
#pragma unroll
                    for (int dt = 0; dt < 2; ++dt)
#pragma unroll
                        for (int i = 0; i < 16; ++i) atomicAdd(orow + 32 * dt + (i & 3) + 8 * (i >> 2), (unsigned)f2i_rn(o2[dt][i]));
                    if (h == 0) atomicAdd((unsigned*)(LL + row), (unsigned)f2i_rn(psum));
                }
            }
        }
        {
            const int key = tid >> 3, ch = tid & 7;
            const int nft = qb >= 2 ? 3 : qb + 1;
            u32x4 fk[3], fv[3];
#pragma unroll
            for (int u = 0; u < 3; ++u) { const int jt = (u == 0) ? 0 : (qb >= 2 ? qb - 2 + u : u); fk[u] = (u32x4){0u, 0u, 0u, 0u}; fv[u] = fk[u];
                if (u < nft) { fk[u] = *(const u32x4*)(SL + (size_t)(64 * jt + key) * 256 + 8 * ch); fv[u] = *(const u32x4*)(SL + 128 + (size_t)(64 * jt + key) * 256 + 8 * ch); } }
#pragma unroll
            for (int ks = 0; ks < 4; ++ks) qf[ks] = ld8(QR + rowg * 512 + hd * 64 + 16 * ks + 8 * h);
            __syncthreads();
            const int row = (8 * wave + tau) * 4 + hg;
            float Lf = (h == 0) ? (float)((const int*)LL)[row] : 0.f;
            f32x16 of[2];
            { const int* orow = (const int*)(OL + row * 65 + 4 * h);
#pragma unroll
              for (int dt = 0; dt < 2; ++dt)
#pragma unroll
                  for (int i = 0; i < 16; ++i) of[dt][i] = (float)orow[32 * dt + (i & 3) + 8 * (i >> 2)]; }
            __syncthreads();
#pragma unroll
            for (int u = 0; u < 3; ++u) { unsigned char* slot = lds + AT_KB + (u >> 1) * AT_STAGE + ((64 * (u & 1) + key) * ATS + 8 * ch) * 2;
                *(u32x4*)slot = fk[u]; *(u32x4*)(slot + AT_VOFF) = fv[u]; }
            f32x16 negm; float nm0_ = 17.0f - m0s * LOG2E; LAUNDER_V(nm0_);
#pragma unroll
            for (int i = 0; i < 16; ++i) negm[i] = nm0_;
            __syncthreads();
#pragma unroll 1
            for (int u = 0; u < nft; ++u) { const int jt = (u == 0) ? 0 : (qb >= 2 ? qb - 2 + u : u);
                const bf16_t* kb = (const bf16_t*)(lds + AT_KB + (u >> 1) * AT_STAGE) + 64 * ATS * (u & 1);
                attn_tile<2>(kb, kb + AT_VOFF / 2, jt, qf, of, Lf, linv, negm, ttok, 0ull, 0ull, t0, qb, (float*)(lds + AT_IA), (float*)(lds + AT_IB), wave, lane); }
            Lf += __shfl_xor(Lf, 32);
            const float sc = (Lf > 0.f ? 1.0f / Lf : 0.f) * G[rowg * 32 + 3 * hd + 1];
#pragma unroll
            for (int dt = 0; dt < 2; ++dt)
#pragma unroll
                for (int i = 0; i < 16; ++i) outa[dt][i] = (dt == 1 ? outp[i * 512] : outa[dt][i]) + of[dt][i] * sc;
        }
    }
    {
        const bf16_t* ZA = (const bf16_t*)(ws + WS_ZA); bf16_t* MIX = (bf16_t*)(ws + WS_MIX);
        unsigned char* stg = lds + EN_END + wave * 256;
        const int rr = lane >> 3, pc = lane & 7;
        u32x4 zr[4];
#pragma unroll
        for (int j = 0; j < 4; ++j) { const int r = 8 * j + rr; const size_t grow = (size_t)b * T_ + t0 + 8 * wave + (r >> 2);
            zr[j] = *(const u32x4*)(ZA + grow * 512 + (4 * g + (r & 3)) * 64 + 8 * pc); }
        WAVE_SYNC();
#pragma unroll
        for (int j = 0; j < 4; ++j) { const int r = 8 * j + rr; *(u32x4*)(stg + (r >> 1) * 2048 + (r & 1) * 128 + 16 * pc) = zr[j]; }
        WAVE_SYNC();
        unsigned char* myrow = stg + (c32 >> 1) * 2048 + (c32 & 1) * 128;
#pragma unroll
        for (int dt = 0; dt < 2; ++dt)
#pragma unroll
            for (int gq = 0; gq < 4; ++gq) {
                u32x2* slot = (u32x2*)(myrow + (32 * dt + 8 * gq + 4 * h) * 2); const u32x2 zv = *slot;
                float o[4];
#pragma unroll
                for (int r = 0; r < 4; ++r) { const unsigned w = zv[r >> 1]; o[r] = outa[dt][4 * gq + r] * bf2f((r & 1) ? (w >> 16) : (w & 0xffffu)); }
                *slot = (u32x2){pk2(o[0], o[1]), pk2(o[2], o[3])};
            }
        WAVE_SYNC();
#pragma unroll
        for (int j = 0; j < 4; ++j) { const int r = 8 * j + rr; const size_t grow = (size_t)b * T_ + t0 + 8 * wave + (r >> 2);
            *(u32x4*)(MIX + grow * 1024 + (4 * g + (r & 3)) * 64 + 8 * pc) = *(const u32x4*)(stg + (r >> 1) * 2048 + (r & 1) * 128 + 16 * pc); }
    }
    __syncthreads();
#ifdef PROBE_TIMING
    if (b == PROBE_B && g == 0 && qb == PROBE_QB && tid == PROBE_TID) { float* tr = (float*)(ws + WS_CTL + 32768); tr[0] = (float)tcomp; tr[1] = (float)tpass; }
#endif
}

DEV void p4_attention(const Params& p, unsigned char* lds, int vcu, int G, int tid, int wave, int lane) {
    const float gq = wave_max(fabsf(p.in[I_QNG][lane])), gc = wave_max(fabsf(p.in[I_KCNG][lane])), gs = wave_max(fabsf(p.in[I_KSNG][lane])), gw = wave_max(fabsf(p.in[I_KWNG][lane]));
    const float m0c = 8.2f * gq * gc, m0s = 8.2f * gq * gs, m0w = 8.2f * gq * gw;
    for (int i = 0;; ++i) {
        const long L = (long)i * G + vcu; if (L >= AT_UNITS) break;
        int bg, qb;
        if (G == 256 && B_ * NGRP == 16 && NSB == 128) {
            const int xcd = vcu >> 5, c = vcu & 31, r = i & 3;
            bg = 2 * xcd + (i >> 2); qb = (r == 0) ? c : (r == 1) ? 63 - c : (r == 2) ? 64 + c : 127 - c;
        } else {
            const int per = B_ * NGRP * 16;
            const int k = (int)(L / per), v = (int)(L % per), s = v & 15;
            bg = v >> 4; qb = 32 * (k >> 1) + ((k & 1) ? 31 - s : s);
        }
        attn_unit(p, lds, bg / NGRP, bg % NGRP, qb, m0c, m0s, m0w, tid, wave, lane);
    }
}

#ifndef CPU_EMU
#define GAS __attribute__((address_space(1)))
#define LAS __attribute__((address_space(3)))
#define XB_TMO      128
#define XB_XCNT(j)  (256  + 64 * (j))
#define XB_XSUB(j)  (1280 + 64 * (j))
#define XB_XGEN(j)  (2304 + 64 * (j))
#define XB_TOP      3328
#define XB_TOPGEN   3392
#define XCD_BAR_WORDS 3456
#define XB_SPIN_CAP (1u << 20)
__device__ __forceinline__ unsigned xb_ld(unsigned* p)              { return __hip_atomic_load(p, __ATOMIC_RELAXED, __HIP_MEMORY_SCOPE_AGENT); }
__device__ __forceinline__ unsigned xb_add(unsigned* p, unsigned v) { return __hip_atomic_fetch_add(p, v, __ATOMIC_RELAXED, __HIP_MEMORY_SCOPE_AGENT); }
__device__ __forceinline__ unsigned xb_xcc_id() { return (unsigned)__builtin_amdgcn_s_getreg((3 << 11) | 20) & 0xFu; }
#define XB_SPIN(cond, bar) do { unsigned _sp = 0; while (cond) { __builtin_amdgcn_s_sleep(1); \
    if ((++_sp & 255u) == 0u) { if (xb_ld(&(bar)[XB_TMO])) break; if (_sp > XB_SPIN_CAP) { atomicAdd(&(bar)[XB_TMO], 1u); break; } } } } while (0)
struct XcdBarrier { unsigned* bar; unsigned x; volatile LAS unsigned* st; };
__device__ __forceinline__ XcdBarrier xcd_barrier_post(unsigned* bar, volatile LAS unsigned* st) {
    XcdBarrier b; b.bar = bar; b.x = xb_xcc_id(); b.st = st;
    if (threadIdx.x == 0) (void)xb_add(&bar[XB_XCNT(b.x)], 1u);
    return b;
}
__device__ __forceinline__ void xcd_barrier_complete(unsigned* bar, unsigned x, unsigned& nloc, unsigned& nx) {
    const unsigned G = gridDim.x * gridDim.y * gridDim.z;
    unsigned sum, cnt, mine, sp = 0u;
    for (;;) {
        sum = 0u; cnt = 0u; mine = 0u;
#pragma unroll
        for (unsigned j = 0; j < 16; ++j) { const unsigned c = xb_ld(&bar[XB_XCNT(j)]); sum += c; cnt += (c > 0u) ? 1u : 0u; mine = (j == x) ? c : mine; }
        if (sum == G) break;
        __builtin_amdgcn_s_sleep(1);
        if ((++sp & 255u) == 0u) { if (xb_ld(&bar[XB_TMO])) break; if (sp > XB_SPIN_CAP) { atomicAdd(&bar[XB_TMO], 1u); break; } }
    }
    nloc = mine > 0u ? mine : 1u; nx = cnt > 0u ? cnt : 1u;
}
__device__ __forceinline__ void xcd_barrier(const XcdBarrier& b) {
    asm volatile("s_waitcnt vmcnt(0)" ::: "memory");
    __syncthreads();
    if (threadIdx.x == 0) {
        unsigned* bar = b.bar;
        __builtin_amdgcn_s_waitcnt(0);
        unsigned nloc = b.st[0], nx = b.st[1];
        if (nloc == 0u) { xcd_barrier_complete(bar, b.x, nloc, nx); b.st[0] = nloc; b.st[1] = nx; }
        const unsigned old = xb_add(&bar[XB_XSUB(b.x)], 1u);
        const unsigned gen = old / nloc;
        if (old + 1u == (gen + 1u) * nloc) {
            __builtin_amdgcn_fence(__ATOMIC_RELEASE, "agent");
            asm volatile("s_waitcnt vmcnt(0)" ::: "memory");
            const unsigned og = xb_add(&bar[XB_TOP], 1u);
            const unsigned tg = og / nx;
            if (og + 1u == (tg + 1u) * nx) xb_add(&bar[XB_TOPGEN], 1u);
            else XB_SPIN(xb_ld(&bar[XB_TOPGEN]) == tg, bar);
            __builtin_amdgcn_fence(__ATOMIC_ACQUIRE, "agent");
            xb_add(&bar[XB_XGEN(b.x)], 1u);
            asm volatile("s_waitcnt vmcnt(0)" ::: "memory");
        } else {
            XB_SPIN(xb_ld(&bar[XB_XGEN(b.x)]) == gen, bar);
            __builtin_amdgcn_fence(__ATOMIC_ACQUIRE, "agent");
            asm volatile("s_waitcnt vmcnt(0)" ::: "memory");
        }
    }
    __syncthreads();
}
#endif

#ifndef CPU_EMU
__device__ __forceinline__ void group_barrier(unsigned* cnt, unsigned target) {
    asm volatile("s_waitcnt vmcnt(0)" ::: "memory");
    __syncthreads();
    if (threadIdx.x == 0) {
        __builtin_amdgcn_fence(__ATOMIC_RELEASE, "agent");
        asm volatile("s_waitcnt vmcnt(0)" ::: "memory");
        (void)xb_add(cnt, 1u);
        unsigned sp = 0u;
        while (xb_ld(cnt) < target) { __builtin_amdgcn_s_sleep(1); if (++sp > (XB_SPIN_CAP << 4)) break; }
        __builtin_amdgcn_fence(__ATOMIC_ACQUIRE, "agent");
        asm volatile("s_waitcnt vmcnt(0)" ::: "memory");
    }
    __syncthreads();
}
constexpr size_t WS_GBAR = WS_CTL + 20480;
static_assert(WS_CTL + 4096 + XCD_BAR_WORDS * 4 <= WS_GBAR && WS_GBAR + 8 * 256 <= WS_CPOS, "group barrier words");
static_assert(WS_CTL + 4096 + XCD_BAR_WORDS * 4 <= WS_CPOS && WS_CPOS + 2048 <= WS_CTL + 32768 && 32768 + 64 <= CTL_ZERO_BYTES, "barrier words vs cpos");
#endif
constexpr int N_PHASES = 6;
__global__ void __launch_bounds__(512, 2) fwd_kernel(Params p) {
#ifdef CPU_EMU
    unsigned char* lds = emu_smem;
#else
    extern __shared__ __attribute__((aligned(16))) unsigned char lds[];
#endif
    const int tid = threadIdx.x, lane = tid & 63, wave = WAVE_ID();
    const int G = gridDim.x; const int bx = blockIdx.x; const int vcu = (G % 8 == 0) ? (bx % 8) * (G / 8) + bx / 8 : bx;
#ifndef CPU_EMU
    for (int u = tid; u < 64; u += 512) ((LAS unsigned*)(lds + MISC_OFF))[u] = 0u;
    __syncthreads();
    XcdBarrier bar; bar.bar = (unsigned*)(p.ws + WS_CTL) + 1024 + p.li * XCD_BAR_WORDS; bar.x = 0; bar.st = nullptr;
    if (p.ph_hi - p.ph_lo > 1) bar = xcd_barrier_post(bar.bar, (volatile LAS unsigned*)(lds + MISC_OFF) + 8);
#define GRID_BAR() xcd_barrier(bar)
    const bool grp_ok = (G == 256 && B_ == 8 && T_ == 8192);
    unsigned* gcnt = (unsigned*)(p.ws + WS_GBAR) + 64 * (bx & 7); unsigned gtgt = 0u;
#define GROUP_BAR() do { if (grp_ok) { gtgt += 32u; group_barrier(gcnt, gtgt); } else { xcd_barrier(bar); } } while (0)
#else
#define GRID_BAR() do { } while (0)
#define GROUP_BAR() do { } while (0)
#endif
    const int lo = p.ph_lo, hi = p.ph_hi;
#ifndef PHASE_MASK
#define PHASE_MASK 63
#endif
#define IN(k) (((PHASE_MASK >> (k)) & 1) && lo <= (k) && (k) < hi)
#define BOTH(k) (IN(k) && IN((k) + 1))
#ifndef REP_PHASE
#define REP_PHASE -1
#endif
#define REPS(k) for (int rep_ = 0; rep_ < ((k) == REP_PHASE ? 2 : 1); ++rep_)
    if (IN(0)) { REPS(0) { p0_prologue(p, lds, vcu, G, tid, wave, lane); __syncthreads(); } if (BOTH(0)) GRID_BAR(); }
    if (IN(1)) { REPS(1) p1_norm(p, vcu, G, wave, lane); if (BOTH(1)) GROUP_BAR(); }
    if (IN(2)) {
        constexpr int INGEMM = 2816;
#ifdef REP_INPROJ
        struct RepOrder { pg8::StaticOrder S; int cnt; __device__ bool next(int i, pg8::Unit& u) const { return S.next(i < cnt ? i : i - cnt, u) && i < 2 * cnt; } __device__ void a_ready(const pg8::Unit&) const {} __device__ void done(const pg8::Unit&) const {} };
        pg8::Gemm g{(const bf16_t*)(p.ws + WS_HN), (const bf16_t*)(p.ws + WS_WIN), M_, INGEMM, 1024}; RepOrder S; S.S.init(M_, INGEMM, G, bx); S.cnt = (S.S.nwg - bx + G - 1) / G;
#define INPROJ_ORDER RepOrder
#else
        pg8::Gemm g{(const bf16_t*)(p.ws + WS_HN), (const bf16_t*)(p.ws + WS_WIN), M_, INGEMM, 1024}; pg8::StaticOrder S; S.init(M_, INGEMM, G, bx);
#define INPROJ_ORDER pg8::StaticOrder
#endif
        EpiInProj E{p.ws, p.in[I_QNG], p.in[I_KSNG], p.in[I_KWNG]};
        pg8::gemm_phase<EpiInProj, INPROJ_ORDER, true, true>(PG8_PTR(lds), g, S, E);
        if (BOTH(2)) GROUP_BAR();
    }
    if (IN(3)) {
        REPS(3) for (int u = vcu; u < B_ * SSM_NG; u += G) ssm_unit(p, lds, u, tid, wave, lane);
        REPS(6) for (int u = vcu; u < CMP_UNITS; u += G) compress_unit(p, lds, u, tid, wave, lane);
        {
            const bool local = (G == 256 && B_ == 8);
            auto vt_of = [&](int k) -> int { if (local) { if (k >= VT_UNITS / 256) return -1; const int loc = (vcu & 31) + 32 * k; return ((vcu >> 5) * NGRP + (loc >> 7)) * (T_ / 64) + (loc & 127); }
                                               const int u = vcu + k * G; return u < VT_UNITS ? u : -1; };
            VtPre cur, nxt; int u = vt_of(0);
            if (u >= 0) vt_fetch(p, u, tid, cur);
            for (int k = 0; u >= 0; ++k) {
                const int un = vt_of(k + 1); nxt = cur;
                if (un >= 0) vt_fetch(p, un, tid, nxt);
                vt_unit(p, lds, u, tid, cur);
                cur = nxt; u = un;
            }
        }
        if (BOTH(3)) GROUP_BAR();
    }
    if (IN(4)) {
        REPS(4) p4_attention(p, lds, vcu, G, tid, wave, lane);
        pg8::Gemm g{(const bf16_t*)(p.ws + WS_YG), (const bf16_t*)(p.ws + WS_WGLU), M_, 512, 512}; pg8::StaticOrder S; S.init(M_, 512, G, bx);
        EpiGlu E{(const bf16_t*)(p.ws + WS_YG), (const bf16_t*)(p.ws + WS_ZS), (bf16_t*)(p.ws + WS_MIX), p.in[I_GLUB]};
        REPS(7) pg8::gemm_phase<EpiGlu, pg8::StaticOrder, true, true>(PG8_PTR(lds), g, S, E);
        if (BOTH(4)) GROUP_BAR();
    }
    if (IN(5)) {
        pg8::Gemm g{(const bf16_t*)(p.ws + WS_MIX), (const bf16_t*)(p.ws + WS_WO), M_, 1024, 1024}; pg8::StaticOrder S; S.init(M_, 1024, G, bx);
        EpiOut E{p.in[I_X], p.out, (const float*)(p.ws + WS_MOD)};
        REPS(5) pg8::gemm_phase<EpiOut, pg8::StaticOrder, true, true>(PG8_PTR(lds), g, S, E);
#ifdef PROBE_TIMING
        GRID_BAR();
        if (bx == 0 && tid == 0) { const float* tr = (const float*)(p.ws + WS_CTL + 32768); p.out[0] += tr[PROBE_WHICH] * 1e-3f; }
#endif
    }
#undef IN
#undef BOTH
}

extern "C" void kernel_launch(void* const* d_in, const int* in_sizes, int n_in, void* d_out, int out_size, void* d_ws, size_t ws_size, hipStream_t stream) {
    static int grid = 0;
    if (grid == 0) {
        if (n_in != N_IN || out_size != M_ * D_ || ws_size < WS_END) { fprintf(stderr, "kernel_launch: unexpected shapes (n_in %d out %d ws %zu need %zu)\n", n_in, out_size, ws_size, (size_t)WS_END); grid = -1; return; }
#ifdef CPU_EMU
        grid = EMU_GRID;
#else
        int dev = 0, cus = 0, per_cu = 0;
        if (hipGetDevice(&dev) != hipSuccess || hipDeviceGetAttribute(&cus, hipDeviceAttributeMultiprocessorCount, dev) != hipSuccess) { grid = -1; return; }
        if (hipFuncSetAttribute((const void*)fwd_kernel, hipFuncAttributeMaxDynamicSharedMemorySize, LDS_BYTES) != hipSuccess) { fprintf(stderr, "kernel_launch: hipFuncSetAttribute failed\n"); grid = -1; return; }
        if (hipOccupancyMaxActiveBlocksPerMultiprocessor(&per_cu, (const void*)fwd_kernel, 512, LDS_BYTES) != hipSuccess || per_cu < 1) { fprintf(stderr, "kernel_launch: occupancy query says %d blocks per CU\n", per_cu); per_cu = 1; }
        (void)hipGetLastError();
        grid = cus;
#endif
    }
    if (grid < 0) return;
    (void)hipMemsetAsync((char*)d_ws + WS_CTL, 0, CTL_ZERO_BYTES, stream);
    Params a{};
    for (int i = 0; i < N_IN; ++i) a.in[i] = (const float*)d_in[i];
    a.out = (float*)d_out; a.ws = (unsigned char*)d_ws;
    for (int li = 0; li < N_LAUNCH; ++li) {
        a.ph_lo = (N_LAUNCH == 1) ? 0 : li; a.ph_hi = (N_LAUNCH == 1) ? N_PHASES : li + 1; a.li = 0;
#ifdef CPU_EMU
        emu_launch((unsigned)grid, 512u, [&]() { fwd_kernel(a); });
#else
        hipLaunchKernelGGL(fwd_kernel, dim3(grid), dim3(512), LDS_BYTES, stream, a);
#endif
    }
}
```

```cpp
#ifndef CPU_EMU
#include <hip/hip_runtime.h>
#endif
#include <cstdio>
#include <cstdint>
#include <cmath>

#ifndef BATCH_N
#define BATCH_N 8
#endif
#ifndef SEQ_LEN
#define SEQ_LEN 8192
#endif
#ifndef N_LAUNCH
#define N_LAUNCH 1
#endif
#define DEV __device__ __forceinline__

typedef unsigned short bf16_t;
typedef short bf16x8 __attribute__((ext_vector_type(8)));
typedef float f32x4 __attribute__((ext_vector_type(4)));
typedef float f32x16 __attribute__((ext_vector_type(16)));
typedef float f32x2 __attribute__((ext_vector_type(2)));
typedef unsigned u32x4 __attribute__((ext_vector_type(4)));
typedef unsigned u32x2 __attribute__((ext_vector_type(2)));

constexpr int B_ = BATCH_N, T_ = SEQ_LEN, D_ = 1024, M_ = B_ * T_;
constexpr int NH = 8, HD = 64, NGRP = 2;
constexpr int NCMP = (T_ - 32) / 16 + 1;
constexpr int NCP = T_ / 16;
constexpr int NSB = T_ / 64;
constexpr int INW = 2840, INP = 3072;
constexpr int SSM_NG = 32, SSM_P = 64, SSM_C = 16, SSM_W = 512;
constexpr int SSM_L = 64;
constexpr int SSM_CG = 32;
constexpr int SSM_NCG = T_ / (SSM_L * SSM_CG);
constexpr float EPS_ = 1e-6f;
static_assert(T_ % 2048 == 0 && NSB <= 128, "shape assumptions");

enum { I_X = 0, I_C, I_WADA, I_BADA, I_NORMG, I_WIN, I_QNG, I_KCNG, I_KSNG, I_KWNG, I_POSK, I_POSV, I_W1K, I_W2K, I_W1V, I_W2V,
       I_ARE, I_AIM, I_LOGDT, I_BRE, I_BIM, I_CRE, I_CIM, I_SSMD, I_GLUW, I_GLUB, I_WOUT, N_IN };

constexpr size_t MiB = 1u << 20;
constexpr size_t al(size_t x) { return (x + MiB - 1) / MiB * MiB; }
constexpr size_t WS_CTL = 0, CTL_ZERO_BYTES = 64 * 1024;
constexpr size_t WS_MOD = 1 * MiB;
constexpr size_t WS_ROPE = WS_MOD + al((size_t)B_ * 3072 * 4);
constexpr size_t WS_CPOS = WS_CTL + 24576;
constexpr size_t WS_LAM64 = WS_ROPE + al((size_t)T_ * 64 * 4);
constexpr size_t WS_KT = WS_LAM64 + MiB;
constexpr size_t WS_WST = WS_KT + al((size_t)32 * 65 * 256 * 2);
constexpr size_t WS_WOUTS = WS_WST + al((size_t)32 * 128 * 1024 * 2);
constexpr size_t WS_WIN = WS_WOUTS + al((size_t)32 * 1024 * 128 * 2);
constexpr size_t WS_WO = WS_WIN + al((size_t)INP * 1024 * 2);
constexpr size_t WS_WGLU = WS_WO + al((size_t)1024 * 1024 * 2);
constexpr size_t WS_W1K = WS_WGLU + MiB, WS_W1V = WS_W1K + MiB;
constexpr size_t WS_W2K = WS_W1V + MiB, WS_W2V = WS_W2K + 64 * 1024;
constexpr size_t WS_KC = WS_W2K + MiB;
constexpr size_t WS_VC = WS_KC + al((size_t)B_ * NCP * 128 * 2);
constexpr size_t WS_G = WS_VC + al((size_t)B_ * NCP * 128 * 2);
constexpr size_t WS_HN = WS_G + al((size_t)M_ * 32 * 4);
constexpr size_t WS_Q = WS_HN + al((size_t)M_ * 1024 * 2);
constexpr size_t WS_QR = WS_Q + al((size_t)M_ * 512 * 2);
constexpr size_t WS_CR = WS_QR + al((size_t)M_ * 512 * 2);
constexpr size_t WS_SL = WS_CR + al((size_t)M_ * 256 * 2);
constexpr size_t WS_WN = WS_SL + al((size_t)M_ * 256 * 2);
constexpr size_t WS_ZA = WS_WN + al((size_t)M_ * 256 * 2);
constexpr size_t WS_U = WS_ZA + al((size_t)M_ * 512 * 2);
constexpr size_t WS_ZS = WS_U + al((size_t)M_ * 512 * 2);
constexpr size_t WS_YG = WS_ZS + al((size_t)M_ * 512 * 2);
constexpr size_t WS_MIX = WS_YG + al((size_t)M_ * 512 * 2);
constexpr size_t WS_VT = WS_MIX + al((size_t)M_ * 1024 * 2);
constexpr size_t WS_KF = WS_VT + al((size_t)M_ * 128 * 2);
constexpr size_t WS_END = WS_KF + al((size_t)M_ * 128 * 2);

constexpr int RING_BYTES = 131072;
constexpr int LDS_BYTES = 155648;
constexpr int MISC_OFF = LDS_BYTES - 256;

DEV unsigned f2bf(float f) { unsigned u = __builtin_bit_cast(unsigned, f); return (u + 0x7fffu + ((u >> 16) & 1u)) >> 16; }
DEV float bf2f(unsigned h) { return __builtin_bit_cast(float, h << 16); }
#ifdef CPU_EMU
DEV unsigned pk2(float lo, float hi) { return f2bf(lo) | (f2bf(hi) << 16); }
DEV float exp2_fast(float x) { return exp2f(x); }
DEV float rcp_fast(float x) { return 1.0f / x; }
DEV float log2_fast(float x) { return log2f(x); }
DEV int f2i_rn(float x) { return (int)floorf(x + 0.5f); }
DEV f32x4 mfma16(bf16x8 a, bf16x8 b, f32x4 c) { return emu_mfma16(a, b, c); }
DEV f32x16 mfma32(bf16x8 a, bf16x8 b, f32x16 c) { return emu_mfma32(a, b, c); }
#define WAVE_ID() ((int)(threadIdx.x >> 6))
#else
typedef __bf16 bf16x2_t __attribute__((ext_vector_type(2)));
DEV unsigned pk2(float lo, float hi) { f32x2 v = {lo, hi}; bf16x2_t b = __builtin_convertvector(v, bf16x2_t); return __builtin_bit_cast(unsigned, b); }
DEV float exp2_fast(float x) { return __builtin_amdgcn_exp2f(x); }
DEV float rcp_fast(float x) { return __builtin_amdgcn_rcpf(x); }
DEV float log2_fast(float x) { return __builtin_amdgcn_logf(x); }
DEV int f2i_rn(float x) { int r; asm("v_cvt_rpi_i32_f32 %0, %1" : "=v"(r) : "v"(x)); return r; }
DEV f32x4 mfma16(bf16x8 a, bf16x8 b, f32x4 c) { return __builtin_amdgcn_mfma_f32_16x16x32_bf16(a, b, c, 0, 0, 0); }
DEV f32x16 mfma32(bf16x8 a, bf16x8 b, f32x16 c) { return __builtin_amdgcn_mfma_f32_32x32x16_bf16(a, b, c, 0, 0, 0); }
#define WAVE_ID() (__builtin_amdgcn_readfirstlane((int)(threadIdx.x >> 6)))
#endif
#ifdef CPU_EMU
#define EXPF(x) expf(x)
#else
#define EXPF(x) __expf(x)
#endif
DEV float silu_f(float v) { return v * rcp_fast(1.0f + EXPF(-v)); }
DEV float sigmoid_f(float v) { return rcp_fast(1.0f + EXPF(-v)); }
DEV float gelu_tanh_f(float v) { const float u = 0.7978845608028654f * (v + 0.044715f * v * v * v); const float e = EXPF(2.0f * u); return v * (1.0f - rcp_fast(e + 1.0f)); }
DEV float wave_sum(float v) {
#pragma unroll
    for (int o = 1; o < 64; o <<= 1) v += __shfl_xor(v, o);
    return v;
}
DEV float wave_max(float v) {
#pragma unroll
    for (int o = 1; o < 64; o <<= 1) v = fmaxf(v, __shfl_xor(v, o));
    return v;
}
DEV bf16x8 ld8(const bf16_t* p) { return *(const bf16x8*)p; }
namespace pg8 {
#define PG8_LAS __attribute__((address_space(3)))
typedef unsigned short bf16_t;
typedef short bf16x8 __attribute__((ext_vector_type(8)));
typedef float f32x4 __attribute__((ext_vector_type(4)));
typedef unsigned u32x4 __attribute__((ext_vector_type(4)));
constexpr int BM = 256, BK = 64, HALF = 128, HTB = HALF * BK * 2  , STAGE_BYTES = 8 * HTB, NXCD = 8, WGM = 8;

__host__ __device__ __forceinline__ int lds_byte(int r, int c) { const int st = (r >> 4) * 2 + (c >> 5), rr = r & 15, cc = c & 31, ob = rr * 64 + cc * 2; return st * 1024 + (ob ^ (((ob >> 9) & 1) << 5)); }
__host__ __device__ __forceinline__ void stage_rc(int b, int& R, int& C) { const int st = b / 1024, sb = b % 1024, swz = sb ^ (((sb >> 9) & 1) << 5); R = (st >> 1) * 16 + swz / 64; C = (st & 1) * 32 + (swz % 64) / 2; }
__host__ __device__ __forceinline__ int perm32(int rho) { const int n = rho >> 4, i = rho & 15; return 8 * (i >> 2) + 4 * n + (i & 3); }

struct Unit { int pm, pn; };
struct Gemm { const bf16_t* A; const bf16_t* Bt; int M, N, K; };

struct StaticOrder {
    int nM, nN, nwg, G, c;
    __host__ __device__ void init(int M, int N, int G_, int c_) { nM = M / BM; nN = N / BM; nwg = nM * nN; G = G_; c = c_; }
    __host__ __device__ bool next(int i, Unit& u) const {
        const long L = (long)i * G + c; if (L >= nwg) return false;
        int wgid = (int)L; { const int q = nwg / NXCD, r = nwg % NXCD, xcd = wgid % NXCD, off = wgid / NXCD; wgid = (xcd < r ? xcd * (q + 1) : r * (q + 1) + (xcd - r) * q) + off; }
        const int nig = WGM * nN, gid = wgid / nig, fm = gid * WGM, gsz = (nM - fm) < WGM ? (nM - fm) : WGM;
        u.pm = fm + ((wgid % nig) % gsz); u.pn = (wgid % nig) / gsz; return true;
    }
    __device__ __forceinline__ void a_ready(const Unit&) const {}
    __device__ __forceinline__ void done(const Unit&) const {}
};

#ifndef CPU_EMU
__device__ __forceinline__ unsigned cvt_pk_bf16(float lo, float hi) { unsigned r; asm volatile("v_cvt_pk_bf16_f32 %0, %1, %2" : "=v"(r) : "v"(lo), "v"(hi)); return r; }
template <class Epi, class Sched, bool ALIGN_EPI = false, bool SP2 = false>
__device__ __forceinline__ void gemm_phase(PG8_LAS unsigned char* lds, const Gemm g, const Sched& S, const Epi& E) {
    const int tid = threadIdx.x, wid = __builtin_amdgcn_readfirstlane(tid >> 6), lane = tid & 63, wr = wid >> 2, wc = wid & 3, fr = lane & 15, fq = lane >> 4;
    const int K = g.K, nt = K / BK;
    unsigned voffA[2], voffB[2];
#pragma unroll
    for (int i = 0; i < 2; ++i) { int R, C; stage_rc(tid * 16 + i * 8192, R, C); const int Rb = Epi::PERM ? ((R & ~31) + perm32(R & 31)) : R;
        voffA[i] = (unsigned)(R * K + C) * 2u; voffB[i] = (unsigned)(Rb * K + C) * 2u; }
    const size_t kstep = (size_t)(BK * 2);
    const size_t hstep = (size_t)HALF * K * 2;
    const size_t tstep = 2 * hstep;
    const unsigned ldsw = (unsigned)wid * 1024u;
    const int aoff = lds_byte(wr * 64 + fr, fq * 8), boff = lds_byte(wc * 32 + fr, fq * 8);
#define PG8_SA(b, h) (((b) * 2 + (h)) * HTB)
#define PG8_SB(b, h) ((4 + (b) * 2 + (h)) * HTB)
#define PG8_STAGE(bufoff, gbase, voff) do { _Pragma("unroll") for (int _i = 0; _i < 2; ++_i) \
        __builtin_amdgcn_global_load_lds((const unsigned*)((const char*)(gbase) + (voff)[_i]), (PG8_LAS unsigned*)(lds + (bufoff) + ldsw + _i * 8192), 16, 0, 0); } while (0)
#define PG8_LDA(dst, b, h) do { _Pragma("unroll") for (int m = 0; m < 4; ++m) _Pragma("unroll") for (int k = 0; k < 2; ++k) dst[m][k] = *(const PG8_LAS bf16x8*)(lds + PG8_SA(b, h) + aoff + m * 2048 + k * 1024); } while (0)
#define PG8_LDB(dst, b, h) do { _Pragma("unroll") for (int n = 0; n < 2; ++n) _Pragma("unroll") for (int k = 0; k < 2; ++k) dst[n][k] = *(const PG8_LAS bf16x8*)(lds + PG8_SB(b, h) + boff + n * 2048 + k * 1024); } while (0)
#define PG8_MMA(ai, bj, At, Bt) do { __builtin_amdgcn_s_setprio(1); _Pragma("unroll") for (int m = 0; m < 4; ++m) _Pragma("unroll") for (int n = 0; n < 2; ++n) _Pragma("unroll") for (int k = 0; k < 2; ++k) \
        acc[ai][bj][m][n] = __builtin_amdgcn_mfma_f32_16x16x32_bf16(Bt[n][k], At[m][k], acc[ai][bj][m][n], 0, 0, 0); __builtin_amdgcn_s_setprio(0); } while (0)
#define PG8_WAIT_V(n) asm volatile("s_waitcnt vmcnt(" #n ")" ::: "memory")
#define PG8_WAIT_L(n) asm volatile("s_waitcnt lgkmcnt(" #n ")" ::: "memory")
#define PG8_BAR __builtin_amdgcn_s_barrier()
#define PG8_SCHED __builtin_amdgcn_sched_barrier(0)
    Unit cur, nxt; int ui = 0;
    if (!S.next(0, cur)) return;
    f32x4 acc[2][2][4][2];
#pragma unroll
    for (int a = 0; a < 2; ++a)
#pragma unroll
        for (int b = 0; b < 2; ++b)
#pragma unroll
            for (int m = 0; m < 4; ++m)
#pragma unroll
                for (int n = 0; n < 2; ++n) acc[a][b][m][n] = (f32x4){0.f, 0.f, 0.f, 0.f};
    bf16x8 At[4][2], B0[2][2], B1[2][2];
    const char* cA = (const char*)g.A + (size_t)cur.pm * tstep; const char* cB = (const char*)g.Bt + (size_t)cur.pn * tstep;
    S.a_ready(cur);
    if constexpr (SP2) {
        PG8_STAGE(PG8_SB(0, 0), cB, voffB); PG8_STAGE(PG8_SB(0, 1), cB + hstep, voffB); PG8_STAGE(PG8_SA(0, 0), cA, voffA); PG8_STAGE(PG8_SA(0, 1), cA + hstep, voffA);
        if (wr == 1) PG8_BAR;
        PG8_WAIT_V(2); PG8_BAR;
        PG8_STAGE(PG8_SB(1, 0), cB + kstep, voffB); PG8_STAGE(PG8_SA(1, 0), cA + kstep, voffA); PG8_STAGE(PG8_SB(1, 1), cB + hstep + kstep, voffB);
        PG8_WAIT_V(6); PG8_BAR;
    } else {
        PG8_STAGE(PG8_SB(0, 0), cB, voffB); PG8_STAGE(PG8_SA(0, 0), cA, voffA); PG8_STAGE(PG8_SB(0, 1), cB + hstep, voffB); PG8_STAGE(PG8_SA(0, 1), cA + hstep, voffA);
        if (wr == 1) PG8_BAR;
        PG8_WAIT_V(4); PG8_BAR;
        PG8_STAGE(PG8_SB(1, 0), cB + kstep, voffB); PG8_STAGE(PG8_SA(1, 0), cA + kstep, voffA); PG8_STAGE(PG8_SB(1, 1), cB + hstep + kstep, voffB);
        PG8_WAIT_V(6); PG8_BAR;
    }
    for (;;) {
        const bool has_next = S.next(ui + 1, nxt);
        const char* nA = has_next ? (const char*)g.A + (size_t)nxt.pm * tstep : cA; const char* nB = has_next ? (const char*)g.Bt + (size_t)nxt.pn * tstep : cB;
        for (int t = 0; t < nt; t += 2) {
            const bool last = (t == nt - 2);
            const char* a1 = cA + (size_t)(t + 1) * kstep;
            const char* a2 = last ? nA : cA + (size_t)(t + 2) * kstep; const char* b2 = last ? nB : cB + (size_t)(t + 2) * kstep;
            const char* a3 = a2 + kstep; const char* b3 = b2 + kstep;
            if (last && has_next) S.a_ready(nxt);
            if constexpr (SP2) {
            PG8_LDB(B0, 0, 0); PG8_LDB(B1, 0, 1); PG8_SCHED; PG8_LDA(At, 0, 0); PG8_STAGE(PG8_SA(1, 1), a1 + hstep, voffA);
            PG8_WAIT_V(8); PG8_WAIT_L(0); PG8_BAR; PG8_MMA(0, 0, At, B0); PG8_MMA(0, 1, At, B1); PG8_BAR; PG8_SCHED;
            PG8_LDA(At, 0, 1); PG8_STAGE(PG8_SB(0, 0), b2, voffB); PG8_STAGE(PG8_SB(0, 1), b2 + hstep, voffB); PG8_STAGE(PG8_SA(0, 0), a2, voffA);
            PG8_WAIT_V(8); PG8_WAIT_L(0); PG8_BAR; PG8_MMA(1, 0, At, B0); PG8_MMA(1, 1, At, B1); PG8_BAR; PG8_SCHED;
            PG8_LDB(B0, 1, 0); PG8_LDB(B1, 1, 1); PG8_SCHED; PG8_LDA(At, 1, 0); PG8_STAGE(PG8_SA(0, 1), a2 + hstep, voffA);
            PG8_WAIT_V(8); PG8_WAIT_L(0); PG8_BAR; PG8_MMA(0, 0, At, B0); PG8_MMA(0, 1, At, B1); PG8_BAR; PG8_SCHED;
            PG8_LDA(At, 1, 1); PG8_STAGE(PG8_SB(1, 0), b3, voffB); PG8_STAGE(PG8_SB(1, 1), b3 + hstep, voffB); PG8_STAGE(PG8_SA(1, 0), a3, voffA);
            PG8_WAIT_V(8); PG8_WAIT_L(0); PG8_BAR; PG8_MMA(1, 0, At, B0); PG8_MMA(1, 1, At, B1); PG8_BAR; PG8_SCHED;
            } else {
            PG8_LDB(B0, 0, 0); PG8_SCHED; PG8_LDA(At, 0, 0); PG8_STAGE(PG8_SA(1, 1), a1 + hstep, voffA);
            PG8_WAIT_L(8); PG8_BAR; PG8_WAIT_L(0); PG8_MMA(0, 0, At, B0); PG8_BAR; PG8_SCHED;
            PG8_LDB(B1, 0, 1); PG8_STAGE(PG8_SB(0, 0), b2, voffB);
            PG8_BAR; PG8_WAIT_L(0); PG8_MMA(0, 1, At, B1); PG8_BAR;
            PG8_LDA(At, 0, 1); PG8_STAGE(PG8_SA(0, 0), a2, voffA);
            PG8_BAR; PG8_WAIT_L(0); PG8_MMA(1, 0, At, B0); PG8_BAR; PG8_SCHED;
            PG8_STAGE(PG8_SB(0, 1), b2 + hstep, voffB);
            PG8_WAIT_V(6); PG8_BAR; PG8_MMA(1, 1, At, B1); PG8_BAR;
            PG8_LDB(B0, 1, 0); PG8_SCHED; PG8_LDA(At, 1, 0); PG8_STAGE(PG8_SA(0, 1), a2 + hstep, voffA);
            PG8_WAIT_L(8); PG8_BAR; PG8_WAIT_L(0); PG8_MMA(0, 0, At, B0); PG8_BAR; PG8_SCHED;
            PG8_LDB(B1, 1, 1); PG8_STAGE(PG8_SB(1, 0), b3, voffB);
            PG8_BAR; PG8_WAIT_L(0); PG8_MMA(0, 1, At, B1); PG8_BAR;
            PG8_LDA(At, 1, 1); PG8_STAGE(PG8_SA(1, 0), a3, voffA);
            PG8_BAR; PG8_WAIT_L(0); PG8_MMA(1, 0, At, B0); PG8_BAR; PG8_SCHED;
            PG8_STAGE(PG8_SB(1, 1), b3 + hstep, voffB);
            PG8_WAIT_V(6); PG8_BAR; PG8_MMA(1, 1, At, B1); PG8_BAR;
            }
        }
        if constexpr (ALIGN_EPI) { if (wr == 0) PG8_BAR; }
        if constexpr (!Epi::AFTER_DRAIN) { E(acc, cur, wr, wc, fr, fq); S.done(cur); }
        if (!has_next) break;
#pragma unroll
        for (int a = 0; a < 2; ++a)
#pragma unroll
            for (int b = 0; b < 2; ++b)
#pragma unroll
                for (int m = 0; m < 4; ++m)
#pragma unroll
                    for (int n = 0; n < 2; ++n) acc[a][b][m][n] = (f32x4){0.f, 0.f, 0.f, 0.f};
        cur = nxt; cA = nA; cB = nB; ++ui;
        if constexpr (ALIGN_EPI) { if (wr == 1) PG8_BAR; }
    }
    PG8_WAIT_V(0);
    if constexpr (!ALIGN_EPI) { if (wr == 0) PG8_BAR; }
    PG8_BAR;
    if constexpr (Epi::AFTER_DRAIN) { E.fused(acc, cur, wr, wc, fr, fq, lds, wid, lane); S.done(cur); }
#undef PG8_SA
#undef PG8_SB
#undef PG8_STAGE
#undef PG8_LDA
#undef PG8_LDB
#undef PG8_MMA
#undef PG8_WAIT_V
#undef PG8_WAIT_L
#undef PG8_BAR
#undef PG8_SCHED
}
}
#define PG8_PTR(x) ((__attribute__((address_space(3))) unsigned char*)(x))
#else
template <class Epi, class Sched, bool ALIGN_EPI = false, bool SP2 = false>
inline void gemm_phase(unsigned char* lds, const Gemm g, const Sched& S, const Epi& E) {
    const int tid = threadIdx.x, wid = tid >> 6, lane = tid & 63, wr = wid >> 2, wc = wid & 3, fr = lane & 15, fq = lane >> 4;
    Unit cur;
    for (int ui = 0; S.next(ui, cur); ++ui) {
        f32x4 acc[2][2][4][2];
        for (int ai = 0; ai < 2; ++ai) for (int bj = 0; bj < 2; ++bj) for (int m = 0; m < 4; ++m) for (int n = 0; n < 2; ++n) for (int i = 0; i < 4; ++i) {
            const int row = 256 * cur.pm + 128 * ai + 64 * wr + 16 * m + fr;
            const int col = 256 * cur.pn + 128 * bj + 32 * wc + (Epi::PERM ? 8 * fq + 4 * n + i : 16 * n + 4 * fq + i);
            const bf16_t* a = g.A + (size_t)row * g.K; const bf16_t* b = g.Bt + (size_t)col * g.K; float s = 0.f;
            for (int k = 0; k < g.K; ++k) s += emu_bf2f(a[k]) * emu_bf2f(b[k]);
            acc[ai][bj][m][n][i] = s; }
        E(acc, cur, wr, wc, fr, fq);
    }
}
}
#define PG8_PTR(x) (x)
#endif
#ifdef CPU_EMU
#define WAVE_SYNC() emu_wave_sync()
#define SCHED_FENCE() do { } while (0)
#define LAUNDER_V(x) do { } while (0)
#define LDS_BARRIER() __syncthreads()
#else
#define LDS_BARRIER() do { asm volatile("s_waitcnt lgkmcnt(0)" ::: "memory"); __builtin_amdgcn_s_barrier(); asm volatile("" ::: "memory"); } while (0)
#define LAUNDER_V(x) asm volatile("" : "+v"(x))
#define WAVE_SYNC() asm volatile("s_waitcnt lgkmcnt(0)" ::: "memory")
#define SCHED_FENCE() __builtin_amdgcn_sched_barrier(0)
#endif

struct Params { const float* in[N_IN]; float* out; unsigned char* ws; int ph_lo, ph_hi, li, pad; };

constexpr float QSCALE = 0.125f * 1.4426950408889634f;
DEV void gates_rows(unsigned char* ws, size_t row0, int lane) {
    const int r = lane & 15, kq = lane >> 4;
    const bf16_t* HN = (const bf16_t*)(ws + WS_HN) + (row0 + r) * 1024 + 8 * kq;
    const bf16_t* WG = (const bf16_t*)(ws + WS_WIN) + (size_t)(2816 + r) * 1024 + 8 * kq;
    f32x4 acc[2][2];
#pragma unroll
    for (int rb = 0; rb < 2; ++rb)
#pragma unroll
        for (int cb = 0; cb < 2; ++cb) acc[rb][cb] = (f32x4){0.f, 0.f, 0.f, 0.f};
    bf16x8 hb[2][4][2], wb[2][4][2];
#define GU_LOAD(bt) do { _Pragma("unroll") for (int q = 0; q < 4; ++q) { const int s_ = 4 * (bt) + q; hb[(bt) & 1][q][0] = ld8(HN + 32 * s_); hb[(bt) & 1][q][1] = ld8(HN + 16 * 1024 + 32 * s_); \
        wb[(bt) & 1][q][0] = ld8(WG + 32 * s_); wb[(bt) & 1][q][1] = ld8(WG + 16 * 1024 + 32 * s_); } } while (0)
    GU_LOAD(0);
#pragma unroll
    for (int bt = 0; bt < 8; ++bt) {
        if (bt < 7) GU_LOAD(bt + 1);
        SCHED_FENCE();
#pragma unroll
        for (int q = 0; q < 4; ++q) {
            const bf16x8 h0 = hb[bt & 1][q][0], h1 = hb[bt & 1][q][1], w0 = wb[bt & 1][q][0], w1 = wb[bt & 1][q][1];
            acc[0][0] = mfma16(w0, h0, acc[0][0]); acc[0][1] = mfma16(w1, h0, acc[0][1]);
            acc[1][0] = mfma16(w0, h1, acc[1][0]); acc[1][1] = mfma16(w1, h1, acc[1][1]);
        }
        SCHED_FENCE();
    }
#undef GU_LOAD
    float* Gp = (float*)(ws + WS_G);
#pragma unroll
    for (int rb = 0; rb < 2; ++rb)
#pragma unroll
        for (int cb = 0; cb < 2; ++cb) { f32x4 o;
#pragma unroll
            for (int i = 0; i < 4; ++i) o[i] = sigmoid_f(acc[rb][cb][i]);
            *(f32x4*)(Gp + (row0 + 16 * rb + r) * 32 + 16 * cb + 4 * kq) = o; }
}

struct EpiInProj {
    static constexpr bool PERM = true, AFTER_DRAIN = false;
    unsigned char* ws; const float* qng; const float* ksng; const float* kwng;
    DEV void operator()(const f32x4 (&acc)[2][2][4][2], const pg8::Unit& u, int wr, int wc, int fr, int fq) const {
        const int pn = u.pn; const int row0 = u.pm * 256 + wr * 64 + fr;
        int kind; bf16_t* dst = nullptr; bf16_t* dst2 = nullptr; int pitch = 512, colb = 0; const float* gv = nullptr;
        if (pn < 2) { kind = 2; dst = (bf16_t*)(ws + WS_Q); dst2 = (bf16_t*)(ws + WS_QR); colb = (4 * pn + wc) * 64; gv = qng; }
        else if (pn == 2) { kind = 0; dst = (bf16_t*)(ws + WS_CR); pitch = 256; colb = wc * 64; }
        else if (pn == 3) { kind = wc < 2 ? 1 : 0; dst = (bf16_t*)(ws + WS_SL); pitch = 256; colb = wc * 64; gv = ksng; }
        else if (pn == 4) { kind = wc < 2 ? 1 : 0; dst = (bf16_t*)(ws + WS_WN); pitch = 256; colb = wc * 64; gv = kwng; }
        else if (pn < 7) { kind = 3; dst = (bf16_t*)(ws + WS_ZA); colb = (4 * (pn - 5) + wc) * 64; }
        else if (pn < 9) { kind = 0; dst = (bf16_t*)(ws + WS_U); colb = (4 * (pn - 7) + wc) * 64; }
        else if (pn < 11) { kind = 3; dst = (bf16_t*)(ws + WS_ZS); colb = (4 * (pn - 9) + wc) * 64; }
        else { kind = (wc == 0) ? 4 : 5; }
        if (kind == 5) return;
        float g1[8], g2[8];
        if (kind == 1 || kind == 2) {
#pragma unroll
            for (int i = 0; i < 8; ++i) { const float qs = (kind == 2) ? QSCALE : 1.0f; g1[i] = gv[8 * fq + i] * qs; g2[i] = gv[32 + 8 * fq + i] * qs; }
        }
        const float* rope = (const float*)(ws + WS_ROPE);
#pragma unroll
        for (int ai = 0; ai < 2; ++ai)
#pragma unroll
            for (int m = 0; m < 4; ++m) {
                const int row = row0 + ai * 128 + m * 16;
                float x1[8], x2[8];
#pragma unroll
                for (int i = 0; i < 4; ++i) { x1[i] = acc[ai][0][m][0][i]; x1[4 + i] = acc[ai][0][m][1][i]; x2[i] = acc[ai][1][m][0][i]; x2[4 + i] = acc[ai][1][m][1][i]; }
                if (kind == 4) {
                    float* G = (float*)(ws + WS_G) + (size_t)row * 32 + 8 * fq;
                    f32x4 o0, o1;
#pragma unroll
                    for (int i = 0; i < 4; ++i) { o0[i] = sigmoid_f(x1[i]); o1[i] = sigmoid_f(x1[4 + i]); }
                    *(f32x4*)G = o0; *(f32x4*)(G + 4) = o1;
                    continue;
                }
                if (kind == 1 || kind == 2) {
                    float ss = 0.f;
#pragma unroll
                    for (int i = 0; i < 8; ++i) ss += x1[i] * x1[i] + x2[i] * x2[i];
                    ss += __shfl_xor(ss, 16); ss += __shfl_xor(ss, 32);
                    const float rinv = rsqrtf(ss * (1.0f / 64.0f) + EPS_);
#pragma unroll
                    for (int i = 0; i < 8; ++i) { x1[i] = x1[i] * rinv * g1[i]; x2[i] = x2[i] * rinv * g2[i]; }
                    if (kind == 2) {
                        bf16_t* o = dst + (size_t)row * pitch + colb + 8 * fq;
                        *(u32x4*)o = (u32x4){pk2(x1[0], x1[1]), pk2(x1[2], x1[3]), pk2(x1[4], x1[5]), pk2(x1[6], x1[7])};
                        *(u32x4*)(o + 32) = (u32x4){pk2(x2[0], x2[1]), pk2(x2[2], x2[3]), pk2(x2[4], x2[5]), pk2(x2[6], x2[7])};
                    }
                    const int t = row % T_;
                    const float* cs = rope + (size_t)t * 32 + 8 * fq; const float* sn = cs + (size_t)T_ * 32;
                    const f32x4 c0 = *(const f32x4*)cs, c1 = *(const f32x4*)(cs + 4), s0 = *(const f32x4*)sn, s1 = *(const f32x4*)(sn + 4);
#pragma unroll
                    for (int i = 0; i < 8; ++i) { const float c = i < 4 ? c0[i & 3] : c1[i & 3], s = i < 4 ? s0[i & 3] : s1[i & 3]; const float a = x1[i], b = x2[i]; x1[i] = a * c - b * s; x2[i] = b * c + a * s; }
                } else if (kind == 3) {
#pragma unroll
                    for (int i = 0; i < 8; ++i) { x1[i] = silu_f(x1[i]); x2[i] = silu_f(x2[i]); }
                }
                bf16_t* o = (kind == 2 ? dst2 : dst) + (size_t)row * pitch + colb + 8 * fq;
                *(u32x4*)o = (u32x4){pk2(x1[0], x1[1]), pk2(x1[2], x1[3]), pk2(x1[4], x1[5]), pk2(x1[6], x1[7])};
                *(u32x4*)(o + 32) = (u32x4){pk2(x2[0], x2[1]), pk2(x2[2], x2[3]), pk2(x2[4], x2[5]), pk2(x2[6], x2[7])};
            }
    }
};

struct EpiGlu {
    static constexpr bool PERM = true, AFTER_DRAIN = false;
    const bf16_t* YG; const bf16_t* ZS; bf16_t* MIX; const float* glub;
    DEV void operator()(const f32x4 (&acc)[2][2][4][2], const pg8::Unit& u, int wr, int wc, int fr, int fq) const {
        const int row0 = u.pm * 256 + wr * 64 + fr, col0 = u.pn * 256 + wc * 32 + 8 * fq;
        f32x4 bv[2][2]; u32x4 ya[2][2], za[2][2];
#pragma unroll
        for (int bj = 0; bj < 2; ++bj) { bv[bj][0] = *(const f32x4*)(glub + col0 + bj * 128); bv[bj][1] = *(const f32x4*)(glub + col0 + bj * 128 + 4); }
#define EG_ROW(grp, mm) (row0 + (((grp) >> 1) & 1) * 128 + (2 * ((grp) & 1) + (mm)) * 16)
#define EG_COL(grp) (col0 + ((grp) >> 2) * 128)
#define EG_LOAD(grp) do { _Pragma("unroll") for (int mm = 0; mm < 2; ++mm) { ya[(grp) & 1][mm] = *(const u32x4*)(YG + (size_t)EG_ROW(grp, mm) * 512 + EG_COL(grp)); za[(grp) & 1][mm] = *(const u32x4*)(ZS + (size_t)EG_ROW(grp, mm) * 512 + EG_COL(grp)); } } while (0)
        EG_LOAD(0);
#pragma unroll
        for (int grp = 0; grp < 8; ++grp) {
            const int bj = grp >> 2, ai = (grp >> 1) & 1;
            if (grp < 7) EG_LOAD(grp + 1);
            SCHED_FENCE();
#pragma unroll
            for (int mm = 0; mm < 2; ++mm) {
                const int m = 2 * (grp & 1) + mm; const u32x4 yv = ya[grp & 1][mm], zv = za[grp & 1][mm];
                float o[8];
#pragma unroll
                for (int i = 0; i < 8; ++i) {
                    const float a = (i < 4 ? acc[ai][bj][m][0][i & 3] : acc[ai][bj][m][1][i & 3]) + (i < 4 ? bv[bj][0][i & 3] : bv[bj][1][i & 3]);
                    const unsigned yw = yv[i >> 1], zw = zv[i >> 1];
                    const float y = bf2f((i & 1) ? (yw >> 16) : (yw & 0xffffu)), z = bf2f((i & 1) ? (zw >> 16) : (zw & 0xffffu));
                    o[i] = y * sigmoid_f(a) * z;
                }
                *(u32x4*)(MIX + (size_t)EG_ROW(grp, mm) * 1024 + 512 + EG_COL(grp)) = (u32x4){pk2(o[0], o[1]), pk2(o[2], o[3]), pk2(o[4], o[5]), pk2(o[6], o[7])};
            }
            SCHED_FENCE();
        }
#undef EG_ROW
#undef EG_COL
#undef EG_LOAD
    }
};

struct EpiOut {
    static constexpr bool PERM = true, AFTER_DRAIN = false;
    const float* x; float* out; const float* mod;
    DEV void operator()(const f32x4 (&acc)[2][2][4][2], const pg8::Unit& u, int wr, int wc, int fr, int fq) const {
        const int row0 = u.pm * 256 + wr * 64 + fr, col0 = u.pn * 256 + wc * 32 + 8 * fq; const int b = (u.pm * 256) / T_;
        f32x4 gv[2][2], xa[2][2][2];
#pragma unroll
        for (int bj = 0; bj < 2; ++bj) { gv[bj][0] = *(const f32x4*)(mod + (size_t)b * 3072 + 2048 + col0 + bj * 128); gv[bj][1] = *(const f32x4*)(mod + (size_t)b * 3072 + 2048 + col0 + bj * 128 + 4); }
#define EO_OFF(grp, mm) ((size_t)(row0 + (((grp) >> 1) & 1) * 128 + (2 * ((grp) & 1) + (mm)) * 16) * 1024 + col0 + ((grp) >> 2) * 128)
#define EO_LOAD(grp) do { _Pragma("unroll") for (int mm = 0; mm < 2; ++mm) { xa[(grp) & 1][mm][0] = *(const f32x4*)(x + EO_OFF(grp, mm)); xa[(grp) & 1][mm][1] = *(const f32x4*)(x + EO_OFF(grp, mm) + 4); } } while (0)
        EO_LOAD(0);
#pragma unroll
        for (int grp = 0; grp < 8; ++grp) {
            const int bj = grp >> 2, ai = (grp >> 1) & 1;
            if (grp < 7) EO_LOAD(grp + 1);
            SCHED_FENCE();
#pragma unroll
            for (int mm = 0; mm < 2; ++mm) {
                const int m = 2 * (grp & 1) + mm;
                *(f32x4*)(out + EO_OFF(grp, mm)) = xa[grp & 1][mm][0] + gv[bj][0] * acc[ai][bj][m][0];
                *(f32x4*)(out + EO_OFF(grp, mm) + 4) = xa[grp & 1][mm][1] + gv[bj][1] * acc[ai][bj][m][1];
            }
            SCHED_FENCE();
        }
#undef EO_OFF
#undef EO_LOAD
    }
};

DEV size_t frag_idx(int row, int k, int K) { return ((size_t)((row >> 4) * (K >> 5) + (k >> 5)) * 64 + 16 * ((k >> 3) & 3) + (row & 15)) * 8 + (k & 7); }
DEV void tr_item(const float* W, int Nsrc, int K, int k0, int col0, int nvalid, bf16_t* WT, int drow0, float* scr, int lane, bool frag = false) {
    const int c = lane & 31;
#pragma unroll 8
    for (int i = 0; i < 32; ++i) { const int kk = 2 * i + (lane >> 5); scr[kk * 33 + c] = (c < nvalid) ? W[(size_t)(k0 + kk) * Nsrc + col0 + c] : 0.f; }
    WAVE_SYNC();
    const int c8 = lane & 7;
#pragma unroll
    for (int j = 0; j < 4; ++j) { const int n = (lane >> 3) + 8 * j; const float* s = scr + (8 * c8) * 33 + n;
        u32x4 o; o.x = pk2(s[0 * 33], s[1 * 33]); o.y = pk2(s[2 * 33], s[3 * 33]); o.z = pk2(s[4 * 33], s[5 * 33]); o.w = pk2(s[6 * 33], s[7 * 33]);
        const int row = drow0 + n, k8 = (k0 >> 3) + c8;
        *(u32x4*)(WT + (frag ? ((size_t)((row >> 4) * (K >> 5) + (k8 >> 2)) * 64 + 16 * (k8 & 3) + (row & 15)) * 8 : (size_t)row * K + k0 + 8 * c8)) = o; }
    WAVE_SYNC();
}

DEV void p0_prologue(const Params& p, unsigned char* lds, int vcu, int G, int tid, int wave, int lane) {
    unsigned char* ws = p.ws;
    {
        const float* c = p.in[I_C]; const float* w = p.in[I_WADA]; const float* ba = p.in[I_BADA]; float* mod = (float*)(ws + WS_MOD);
        for (int cb = vcu; cb < 256; cb += G)
            for (int b = wave; b < B_; b += 8) {
                float a[12];
#pragma unroll
                for (int j = 0; j < 12; ++j) a[j] = 0.f;
#pragma unroll 8
                for (int i = 0; i < 16; ++i) {
                    const int k = lane + 64 * i; const float s = silu_f(c[b * 1024 + k]);
                    const f32x4* wp = (const f32x4*)(w + (size_t)k * 3072 + 12 * cb); const f32x4 w0 = wp[0], w1 = wp[1], w2 = wp[2];
#pragma unroll
                    for (int j = 0; j < 4; ++j) { a[j] += s * w0[j]; a[4 + j] += s * w1[j]; a[8 + j] += s * w2[j]; }
                }
#pragma unroll
                for (int j = 0; j < 12; ++j) a[j] = wave_sum(a[j]);
                if (lane == 0) {
#pragma unroll
                    for (int j = 0; j < 12; ++j) mod[b * 3072 + 12 * cb + j] = a[j] + ba[12 * cb + j];
                }
            }
    }
    {
        float* scr = (float*)(lds + wave * 16384);
        const int gw = vcu * 8 + wave, NGW = G * 8;
        constexpr int I_IN = 96 * 16, I_O = 32 * 16, I_GL = 16 * 8, I_W1 = 8 * 32, I_W2 = 2 * 4;
        constexpr int NIT = I_IN + I_O + I_GL + 2 * I_W1 + 2 * I_W2;
        for (int it = gw; it < NIT; it += NGW) {
            int r = it;
            if (r < I_IN) {
                const int ci = r / 16, kb = r % 16, n0 = 32 * ci, pn = n0 >> 8, bj = (n0 >> 7) & 1, wc = (n0 >> 5) & 3, L0 = 256 * pn + 64 * wc + 32 * bj;
                int oc, nv; if (L0 < 1792) { oc = L0; nv = 32; } else if (L0 < 2816) { oc = L0 + 24; nv = 32; } else if (L0 == 2816) { oc = 1792; nv = 24; } else { oc = 0; nv = 0; }
                tr_item(p.in[I_WIN], INW, 1024, 64 * kb, oc, nv, (bf16_t*)(ws + WS_WIN), n0, scr, lane); continue; }
            r -= I_IN;
            if (r < I_O) { tr_item(p.in[I_WOUT], 1024, 1024, 64 * (r % 16), 32 * (r / 16), 32, (bf16_t*)(ws + WS_WO), 32 * (r / 16), scr, lane); continue; }
            r -= I_O;
            if (r < I_GL) { tr_item(p.in[I_GLUW], 512, 512, 64 * (r % 8), 32 * (r / 8), 32, (bf16_t*)(ws + WS_WGLU), 32 * (r / 8), scr, lane); continue; }
            r -= I_GL;
            if (r < I_W1) { tr_item(p.in[I_W1K], 256, 2048, 64 * (r % 32), 32 * (r / 32), 32, (bf16_t*)(ws + WS_W1K), 32 * (r / 32), scr, lane, true); continue; }
            r -= I_W1;
            if (r < I_W1) { tr_item(p.in[I_W1V], 256, 2048, 64 * (r % 32), 32 * (r / 32), 32, (bf16_t*)(ws + WS_W1V), 32 * (r / 32), scr, lane, true); continue; }
            r -= I_W1;
            if (r < I_W2) { tr_item(p.in[I_W2K], 64, 256, 64 * (r % 4), 32 * (r / 4), 32, (bf16_t*)(ws + WS_W2K), 32 * (r / 4), scr, lane); continue; }
            r -= I_W2;
            tr_item(p.in[I_W2V], 64, 256, 64 * (r % 4), 32 * (r / 4), 32, (bf16_t*)(ws + WS_W2V), 32 * (r / 4), scr, lane);
        }
    }
    {
        const float H1[32] = {2.037182617e+01f, 1.527673340e+01f, 1.145593262e+01f, 8.590698242e+00f, 6.442138672e+00f, 4.830932617e+00f, 3.622680664e+00f, 2.716613770e+00f, 2.037170410e+00f, 1.527679443e+00f, 1.145599365e+00f, 8.590698242e-01f, 6.442108154e-01f, 4.830932617e-01f, 3.622665405e-01f, 2.716636658e-01f, 2.037181854e-01f, 1.527671814e-01f, 1.145591736e-01f, 8.590698242e-02f, 6.442165375e-02f, 4.830932617e-02f, 3.622674942e-02f, 2.716636658e-02f, 2.037191391e-02f, 1.527667046e-02f, 1.145589352e-02f, 8.590698242e-03f, 6.442129612e-03f, 4.830896854e-03f, 3.622680902e-03f, 2.716630697e-03f};
        const float L1[32] = {6.543887594e-06f, -1.416575378e-05f, -9.063650396e-06f, 3.259562436e-05f, 4.341966076e-07f, -9.333384696e-06f, 3.694024997e-07f, 1.383195467e-05f, 1.289177635e-05f, -7.611160072e-06f, -7.100949915e-06f, 3.214027856e-06f, 3.140712124e-06f, -1.001640385e-06f, 1.570408244e-06f, -8.980337611e-07f, 1.371793559e-07f, 1.700163388e-08f, 6.043357104e-08f, 3.195055172e-07f, -2.581333831e-07f, -9.542085166e-08f, 6.167339706e-08f, -9.075201035e-08f, -8.022654185e-08f, 4.843524337e-08f, 2.941089683e-08f, 3.325492770e-08f, 9.949448376e-09f, 2.627999152e-08f, 1.475850692e-10f, -2.996157100e-09f};
        const float H2[32] = {1.591548920e-01f, 1.193494797e-01f, 8.949947357e-02f, 6.711483002e-02f, 5.032920837e-02f, 3.774166107e-02f, 2.830219269e-02f, 2.122354507e-02f, 1.591539383e-02f, 1.193499565e-02f, 8.949995041e-03f, 6.711483002e-03f, 5.032896996e-03f, 3.774166107e-03f, 2.830207348e-03f, 2.122372389e-03f, 1.591548324e-03f, 1.193493605e-03f, 8.949935436e-04f, 6.711483002e-04f, 5.032941699e-04f, 3.774166107e-04f, 2.830214798e-04f, 2.122372389e-04f, 1.591555774e-04f, 1.193489879e-04f, 8.949916810e-05f, 6.711483002e-05f, 5.032913759e-05f, 3.774138168e-05f, 2.830219455e-05f, 2.122367732e-05f};
        const float L2[32] = {5.112412182e-08f, -1.106699514e-07f, -7.080976872e-08f, 2.546533153e-07f, 3.392160997e-09f, -7.291706794e-08f, 2.885957029e-09f, 1.080621459e-07f, 1.007170027e-07f, -5.946218806e-08f, -5.547617121e-08f, 2.510959263e-08f, 2.453681347e-08f, -7.825315507e-09f, 1.226881441e-08f, -7.015888759e-09f, 1.071713718e-09f, 1.328252647e-10f, 4.721372737e-10f, 2.496136853e-09f, -2.016667056e-09f, -7.454754036e-10f, 4.818234145e-10f, -7.090000809e-10f, -6.267698582e-10f, 3.784003388e-10f, 2.297726315e-10f, 2.598041227e-10f, 7.773006544e-11f, 2.053124337e-10f, 1.153008353e-12f, -2.340747735e-11f};
        float* rc = (float*)(ws + WS_ROPE); float* rs = rc + (size_t)T_ * 32;
        for (int i = vcu * 512 + tid; i < T_ * 32; i += G * 512) {
            const int t = i >> 5, d = i & 31; const float th = (float)(t >> 7), tl = (float)(t & 127);
            const float a = th * H1[d], c = tl * H2[d];
            float rev = (a - floorf(a)) + (c - floorf(c)) + (th * L1[d] + tl * L2[d]);
            rev -= floorf(rev);
#ifdef CPU_EMU
            rc[i] = cosf(6.283185307179586f * rev); rs[i] = sinf(6.283185307179586f * rev);
#else
            rc[i] = __builtin_amdgcn_cosf(rev); rs[i] = __builtin_amdgcn_sinf(rev);
#endif
        }
    }
    __syncthreads();
    {
        f32x2* lp = (f32x2*)lds;
        f32x2* bb = lp + 64;
        f32x2* cc = bb + 1024;
        f32x2* ee = cc + 1024;
        for (int it = vcu; it < 32 * 13 + 32; it += G) {
            if (it >= 32 * 13) {
                const int r = it - 32 * 13, kv = r >> 4, ks = r & 15; const float* pos = p.in[kv ? I_POSV : I_POSK]; const float* w1 = p.in[kv ? I_W1V : I_W1K];
                const int j = tid & 255, i0 = 128 * ks + 64 * (tid >> 8); float a = 0.f;
#pragma unroll 16
                for (int i = i0; i < i0 + 64; ++i) a += pos[i] * w1[(size_t)i * 256 + j];
                atomicAdd((unsigned*)(ws + WS_CPOS) + kv * 256 + j, (unsigned)(int)__builtin_rintf(a * 16777216.0f));
                continue;
            }
            const int g = it / 13, nb = it % 13;
            const float dt = expf(p.in[I_LOGDT][g]);
            for (int e = tid; e < 1024; e += 512) {
                const int pp = e >> 4, ci = e & 15;
                const float ar = p.in[I_ARE][g * 64 + pp], ai = p.in[I_AIM][g * 64 + pp], x = ar * dt, y = ai * dt;
                const float em1 = expm1f(x), ex = em1 + 1.0f, cy = cosf(y), sy = sinf(y), sh = sinf(0.5f * y);
                const float lr = em1 * cy - 2.0f * sh * sh, li = ex * sy;
                const float den = ar * ar + ai * ai, fr_ = (lr * ar + li * ai) / den, fi_ = (li * ar - lr * ai) / den;
                const float br = p.in[I_BRE][(g * 64 + pp) * 16 + ci], bi = p.in[I_BIM][(g * 64 + pp) * 16 + ci];
                bb[e] = (f32x2){fr_ * br - fi_ * bi, fr_ * bi + fi_ * br};
                const int co = e >> 6, p2 = e & 63;
                cc[e] = (f32x2){p.in[I_CRE][(g * 16 + co) * 64 + p2], p.in[I_CIM][(g * 16 + co) * 64 + p2]};
            }
            for (int n = 5 * nb; n < 5 * nb + 5; ++n) {
                if (tid < 64) {
                    const float ar = p.in[I_ARE][g * 64 + tid], ai = p.in[I_AIM][g * 64 + tid];
                    const float mag = expf(ar * dt * (float)n), ang = ai * dt * (float)n;
                    lp[tid] = (f32x2){mag * cosf(ang), mag * sinf(ang)};
                }
                __syncthreads();
                for (int e = tid; e < 1024; e += 512) { const f32x2 l = lp[e >> 4], b = bb[e]; ee[e] = (f32x2){l.x * b.x - l.y * b.y, l.x * b.y + l.y * b.x}; }
                __syncthreads();
                if (n < 64) {
                    bf16_t* KT = (bf16_t*)(ws + WS_KT) + (size_t)g * 65 * 256;
                    if (tid < 256) {
                        const int co = tid >> 4, ci = tid & 15; float a = 0.f;
                        for (int pp = 0; pp < 64; ++pp) { const f32x2 c = cc[co * 64 + pp], e = ee[pp * 16 + ci]; a += c.x * e.x - c.y * e.y; }
                        KT[(n + 1) * 256 + tid] = (bf16_t)f2bf(a);
                        if (n == 0) KT[tid] = 0;
                    }
                    bf16_t* WST = (bf16_t*)(ws + WS_WST) + (size_t)g * 128 * 1024; const int sidx = 63 - n;
                    for (int e = tid; e < 1024; e += 512) { const int pp = e >> 4, ci = e & 15; const f32x2 v = ee[e];
                        WST[frag_idx(pp, sidx * 16 + ci, 1024)] = (bf16_t)f2bf(v.x); WST[frag_idx(64 + pp, sidx * 16 + ci, 1024)] = (bf16_t)f2bf(v.y); }
                }
                if (n >= 1) {
                    bf16_t* WO = (bf16_t*)(ws + WS_WOUTS) + (size_t)g * 1024 * 128; const int t = n - 1;
                    for (int e = tid; e < 1024; e += 512) { const int co = e >> 6, pp = e & 63; const f32x2 c = cc[e], l = lp[pp];
                        WO[frag_idx(t * 16 + co, pp, 128)] = (bf16_t)f2bf(c.x * l.x - c.y * l.y); WO[frag_idx(t * 16 + co, 64 + pp, 128)] = (bf16_t)f2bf(-(c.x * l.y + c.y * l.x)); }
                }
                if (n == 64 && tid < 64) ((f32x2*)(ws + WS_LAM64))[g * 64 + tid] = lp[tid];
                __syncthreads();
            }
        }
    }
}

DEV void p1_norm(const Params& p, int vcu, int G, int wave, int lane) {
    const float* x = p.in[I_X]; const float* ng = p.in[I_NORMG]; const float* mod = (const float*)(p.ws + WS_MOD); bf16_t* HN = (bf16_t*)(p.ws + WS_HN);
    const int gw = vcu * 8 + wave, NGW = G * 8;
    constexpr int RB = 32;
    for (int it = gw; it < M_ / RB; it += NGW) {
        const int r0 = it * RB, b = r0 / T_;
        f32x4 cs[4], sh[4];
#pragma unroll
        for (int j = 0; j < 4; ++j) { const int k = 4 * lane + 256 * j; const f32x4 g = *(const f32x4*)(ng + k), sc = *(const f32x4*)(mod + (size_t)b * 3072 + 1024 + k);
            cs[j] = g * (sc + 1.0f); sh[j] = *(const f32x4*)(mod + (size_t)b * 3072 + k); }
        for (int r = r0; r < r0 + RB; ++r) {
            const f32x4* xr = (const f32x4*)(x + (size_t)r * 1024) + lane; f32x4 v[4]; float s = 0.f;
#pragma unroll
            for (int j = 0; j < 4; ++j) { v[j] = xr[64 * j]; s += (v[j].x * v[j].x + v[j].y * v[j].y) + (v[j].z * v[j].z + v[j].w * v[j].w); }
            const float rinv = rsqrtf(wave_sum(s) * (1.0f / 1024.0f) + EPS_);
            u32x2* o = (u32x2*)(HN + (size_t)r * 1024) + lane;
#pragma unroll
            for (int j = 0; j < 4; ++j) { const f32x4 h = v[j] * rinv * cs[j] + sh[j]; o[64 * j] = (u32x2){pk2(h.x, h.y), pk2(h.z, h.w)}; }
        }
#ifndef CPU_EMU
        asm volatile("s_waitcnt vmcnt(0)" ::: "memory");
#else
        emu_wave_sync();
#endif
        gates_rows(p.ws, (size_t)r0, lane);
    }
}

constexpr int UL_CH = 2064;
constexpr int SSM_UL = 0, SSM_KT = 32 * UL_CH, SSM_SLOC = SSM_KT + 65 * 256 * 2, SSM_CBT = SSM_SLOC + 128 * 32 * 4, SSM_END = SSM_CBT + 32 * 272;
static_assert(SSM_END <= RING_BYTES, "ssm lds");
DEV void ssm_unit(const Params& p, unsigned char* lds, int unit, int tid, int wave, int lane) {
    const int b = unit / SSM_NG, g = unit % SSM_NG; const int l16 = lane & 15, q4 = lane >> 4;
    unsigned char* ws = p.ws;
    const bf16_t* U = (const bf16_t*)(ws + WS_U); bf16_t* YG = (bf16_t*)(ws + WS_YG);
    const bf16_t* WST = (const bf16_t*)(ws + WS_WST) + (size_t)g * 128 * 1024; const bf16_t* WO = (const bf16_t*)(ws + WS_WOUTS) + (size_t)g * 1024 * 128;
    unsigned char* ul = lds + SSM_UL; bf16_t* ktl = (bf16_t*)(lds + SSM_KT); float* sloc = (float*)(lds + SSM_SLOC); bf16_t* cbt = (bf16_t*)(lds + SSM_CBT);
    { const u32x4* src = (const u32x4*)((const bf16_t*)(ws + WS_KT) + (size_t)g * 65 * 256); u32x4* dstv = (u32x4*)ktl; for (int i = tid; i < 65 * 256 * 2 / 16; i += 512) dstv[i] = src[i]; }
    float sre = 0.f, sim = 0.f; f32x2 lam = {0.f, 0.f};
    if (wave == 0) lam = ((const f32x2*)(ws + WS_LAM64))[g * 64 + lane];
    f32x4 dsk = *(const f32x4*)(p.in[I_SSMD] + 16 * g + 4 * q4);
    for (int cg = 0; cg < SSM_NCG; ++cg) {
        const size_t tokbase = (size_t)b * T_ + (size_t)cg * 2048;
#pragma unroll
        for (int i = 0; i < 8; ++i) { const int idx = tid + 512 * i, tok = idx >> 1, hf = idx & 1;
            *(u32x4*)(ul + (tok >> 6) * UL_CH + (tok & 63) * 32 + hf * 16) = *(const u32x4*)(U + (tokbase + tok) * 512 + 16 * g + 8 * hf); }
        __syncthreads();
        {
            f32x4 a1[2] = {(f32x4){0.f, 0.f, 0.f, 0.f}, (f32x4){0.f, 0.f, 0.f, 0.f}};
            const bf16_t* ap = WST + ((size_t)wave * 32 * 64 + lane) * 8;
            const unsigned char* bp = ul + l16 * UL_CH + (q4 >> 1) * 32 + (q4 & 1) * 16;
            bf16x8 aa[2][4];
#pragma unroll
            for (int q = 0; q < 4; ++q) aa[0][q] = ld8(ap + 512 * q);
#pragma unroll
            for (int kb = 0; kb < 8; ++kb) {
                if (kb < 7) {
#pragma unroll
                    for (int q = 0; q < 4; ++q) aa[(kb + 1) & 1][q] = ld8(ap + 512 * (4 * kb + 4 + q));
                }
                SCHED_FENCE();
#pragma unroll
                for (int q = 0; q < 4; ++q) { const int ks = 4 * kb + q;
                    const bf16x8 b0 = *(const bf16x8*)(bp + ks * 64), b1 = *(const bf16x8*)(bp + 16 * UL_CH + ks * 64);
                    a1[0] = mfma16(aa[kb & 1][q], b0, a1[0]); a1[1] = mfma16(aa[kb & 1][q], b1, a1[1]); }
                SCHED_FENCE();
            }
#pragma unroll
            for (int ct = 0; ct < 2; ++ct)
#pragma unroll
                for (int r = 0; r < 4; ++r) sloc[(16 * wave + 4 * q4 + r) * 32 + 16 * ct + l16] = a1[ct][r];
        }
        __syncthreads();
        if (wave == 0) {
            for (int c = 0; c < 32; ++c) {
                cbt[c * 136 + lane] = (bf16_t)f2bf(sre); cbt[c * 136 + 64 + lane] = (bf16_t)f2bf(sim);
                const float lr = sloc[lane * 32 + c], li = sloc[(64 + lane) * 32 + c];
                const float nr = lam.x * sre - lam.y * sim + lr, ni = lam.x * sim + lam.y * sre + li; sre = nr; sim = ni;
            }
        }
        __syncthreads();
        for (int i = 0; i < 8; ++i) {
            const int t = wave + 8 * i;
            f32x4 a3[2] = {(f32x4){0.f, 0.f, 0.f, 0.f}, (f32x4){0.f, 0.f, 0.f, 0.f}};
            const unsigned char* bp = ul + l16 * UL_CH + (q4 >> 1) * 32 + (q4 & 1) * 16;
            const bf16_t* kp = ktl + (t - (q4 >> 1) + 1) * 256 + l16 * 16 + 8 * (q4 & 1);
            const int nks = (t >> 1) + 1;
            const bf16_t* wp = WO + ((size_t)t * 4 * 64 + lane) * 8;
            bf16x8 wa[4];
#pragma unroll
            for (int ks = 0; ks < 4; ++ks) wa[ks] = ld8(wp + 512 * ks);
            {
                bf16x8 an = ld8(kp), b0n = *(const bf16x8*)(bp), b1n = *(const bf16x8*)(bp + 16 * UL_CH);
                for (int ks = 0; ks < nks; ++ks) {
                    const bf16x8 a = an, b0 = b0n, b1 = b1n;
                    const int kn = (ks + 1 < nks) ? ks + 1 : ks;
                    an = ld8(kp - kn * 512); b0n = *(const bf16x8*)(bp + kn * 64); b1n = *(const bf16x8*)(bp + 16 * UL_CH + kn * 64);
                    a3[0] = mfma16(a, b0, a3[0]); a3[1] = mfma16(a, b1, a3[1]);
                }
            }
#pragma unroll
            for (int ks = 0; ks < 4; ++ks) {
                const bf16x8 b0 = ld8(cbt + l16 * 136 + 32 * ks + 8 * q4), b1 = ld8(cbt + (16 + l16) * 136 + 32 * ks + 8 * q4);
                a3[0] = mfma16(wa[ks], b0, a3[0]); a3[1] = mfma16(wa[ks], b1, a3[1]);
            }
#pragma unroll
            for (int ct = 0; ct < 2; ++ct) {
                const int chunk = 16 * ct + l16; const size_t tok = tokbase + (size_t)chunk * 64 + t;
                const u32x2 uv = *(const u32x2*)(ul + chunk * UL_CH + t * 32 + 8 * q4);
                float y[4];
#pragma unroll
                for (int r = 0; r < 4; ++r) { const unsigned w = uv[r >> 1]; const float uu = bf2f((r & 1) ? (w >> 16) : (w & 0xffffu)); y[r] = gelu_tanh_f(a3[ct][r] + dsk[r] * uu); }
                *(u32x2*)(YG + tok * 512 + 16 * g + 4 * q4) = (u32x2){pk2(y[0], y[1]), pk2(y[2], y[3])};
            }
        }
        __syncthreads();
    }
}

constexpr int CMP_TOK = 0, CMP_H = 528 * 128, CMP_OUT = CMP_H + 32 * 528, CMP_END = CMP_OUT + 32 * 64 * 4;
static_assert(CMP_END <= RING_BYTES, "cmp lds");
constexpr int CMP_UNITS = 2 * B_ * NGRP * (NCP / 32);
DEV void compress_unit(const Params& p, unsigned char* lds, int unit, int tid, int wave, int lane) {
    int r = unit; const int nb = r % (NCP / 32); r /= (NCP / 32); const int g = r % NGRP; r /= NGRP; const int b = r % B_; const int kv = r / B_;
    const int l16 = lane & 15, q4 = lane >> 4; unsigned char* ws = p.ws;
    const bf16_t* CR = (const bf16_t*)(ws + WS_CR); const bf16_t* w1t = (const bf16_t*)(ws + (kv ? WS_W1V : WS_W1K)); const bf16_t* w2t = (const bf16_t*)(ws + (kv ? WS_W2V : WS_W2K));
    const float* cpos = (const float*)(ws + WS_CPOS) + kv * 256;
    unsigned char* tokl = lds + CMP_TOK; bf16_t* hl = (bf16_t*)(lds + CMP_H); float* outl = (float*)(lds + CMP_OUT);
    const int n0 = 32 * nb, tk0 = 16 * n0;
    for (int idx = tid; idx < 528 * 8; idx += 512) {
        const int tl = idx >> 3, ch = idx & 7; const int tok = tk0 + tl;
        u32x4 v = (u32x4){0u, 0u, 0u, 0u};
        if (tok < T_) v = *(const u32x4*)(CR + ((size_t)b * T_ + tok) * 256 + kv * 128 + g * 64 + 8 * ch);
        *(u32x4*)(tokl + (tl * 8 + (ch ^ ((tl >> 4) & 7))) * 16) = v;
    }
    __syncthreads();
    f32x4 acc[2][2];
#pragma unroll
    for (int a = 0; a < 2; ++a)
#pragma unroll
        for (int c = 0; c < 2; ++c) acc[a][c] = (f32x4){0.f, 0.f, 0.f, 0.f};
    const bf16_t* bp0 = w1t + ((size_t)(2 * wave) * 64 * 64 + lane) * 8; const bf16_t* bp1 = bp0 + (size_t)64 * 64 * 8;
    bf16x8 bb[2][4][2];
#pragma unroll
    for (int q = 0; q < 4; ++q) { bb[0][q][0] = ld8(bp0 + 512 * q); bb[0][q][1] = ld8(bp1 + 512 * q); }
#pragma unroll
    for (int kb = 0; kb < 16; ++kb) {
        if (kb < 15) {
#pragma unroll
            for (int q = 0; q < 4; ++q) { bb[(kb + 1) & 1][q][0] = ld8(bp0 + 512 * (4 * kb + 4 + q)); bb[(kb + 1) & 1][q][1] = ld8(bp1 + 512 * (4 * kb + 4 + q)); }
        }
        SCHED_FENCE();
#pragma unroll
        for (int q = 0; q < 4; ++q) { const int ks = 4 * kb + q;
            const int l = ks >> 1, chunk = 4 * (ks & 1) + q4;
            const int tl0 = 16 * l16 + l, tl1 = 16 * (16 + l16) + l;
            const bf16x8 a0 = *(const bf16x8*)(tokl + (tl0 * 8 + (chunk ^ ((tl0 >> 4) & 7))) * 16), a1 = *(const bf16x8*)(tokl + (tl1 * 8 + (chunk ^ ((tl1 >> 4) & 7))) * 16);
            const bf16x8 b0 = bb[kb & 1][q][0], b1 = bb[kb & 1][q][1];
            acc[0][0] = mfma16(a0, b0, acc[0][0]); acc[0][1] = mfma16(a0, b1, acc[0][1]); acc[1][0] = mfma16(a1, b0, acc[1][0]); acc[1][1] = mfma16(a1, b1, acc[1][1]); }
        SCHED_FENCE();
    }
#pragma unroll
    for (int rt = 0; rt < 2; ++rt)
#pragma unroll
        for (int ct = 0; ct < 2; ++ct) { const int j = 32 * wave + 16 * ct + l16; const float cp = (float)((const int*)cpos)[j] * (1.0f / 16777216.0f);
#pragma unroll
            for (int rr = 0; rr < 4; ++rr) hl[(16 * rt + 4 * q4 + rr) * 264 + j] = (bf16_t)f2bf(gelu_tanh_f(acc[rt][ct][rr] + cp)); }
    __syncthreads();
    {
        const int rt = wave >> 2, ct = wave & 3; f32x4 a2 = (f32x4){0.f, 0.f, 0.f, 0.f};
#pragma unroll
        for (int ks = 0; ks < 8; ++ks) { const bf16x8 a = ld8(hl + (16 * rt + l16) * 264 + 32 * ks + 8 * q4), bq = ld8(w2t + (size_t)(16 * ct + l16) * 256 + 32 * ks + 8 * q4); a2 = mfma16(a, bq, a2); }
#pragma unroll
        for (int rr = 0; rr < 4; ++rr) outl[(16 * rt + 4 * q4 + rr) * 64 + 16 * ct + l16] = a2[rr];
    }
    __syncthreads();
    {
        const int row = tid >> 4, c4 = tid & 15; f32x4 v = *(const f32x4*)(outl + row * 64 + 4 * c4);
        if (kv == 0) {
            float ss = v.x * v.x + v.y * v.y + v.z * v.z + v.w * v.w;
            ss += __shfl_xor(ss, 1); ss += __shfl_xor(ss, 2); ss += __shfl_xor(ss, 4); ss += __shfl_xor(ss, 8);
            const float rinv = rsqrtf(ss * (1.0f / 64.0f) + EPS_); const f32x4 gk = *(const f32x4*)(p.in[I_KCNG] + 4 * c4);
            v = v * rinv * gk;
        }
        const int n = n0 + row; if (n >= NCMP) v = (f32x4){0.f, 0.f, 0.f, 0.f};
        bf16_t* dst = (bf16_t*)(ws + (kv ? WS_VC : WS_KC)) + (((size_t)b * NCP + n) * NGRP + g) * 64 + 4 * c4;
        *(u32x2*)dst = (u32x2){pk2(v.x, v.y), pk2(v.z, v.w)};
    }
    __syncthreads();
}

constexpr int VT_UNITS = B_ * NGRP * (T_ / 64);
struct VtPre { u32x4 v, k; };
DEV void vt_fetch(const Params& p, int unit, int tid, VtPre& r) {
    const int tb = unit % (T_ / 64), bg = unit / (T_ / 64), b = bg / NGRP, g = bg % NGRP;
    const bf16_t* SLk = (const bf16_t*)(p.ws + WS_SL) + ((size_t)b * T_ + 64 * tb) * 256 + g * 64; const bf16_t* SLv = SLk + 128;
    { const int tok = tid >> 3, ch = tid & 7; r.v = *(const u32x4*)(SLv + (size_t)tok * 256 + 8 * ch); }
    {
      const int kt = tid >> 8, ks = (tid >> 6) & 3, h = (tid >> 5) & 1, r32 = tid & 31, kr = (r32 & ~12) | ((r32 & 8) >> 1) | ((r32 & 4) << 1);
      r.k = *(const u32x4*)(SLk + (size_t)(32 * kt + kr) * 256 + 16 * ks + 8 * h); }
}
DEV void vt_unit(const Params& p, unsigned char* lds, int unit, int tid, const VtPre& r) {
    const int tb = unit % (T_ / 64), bg = unit / (T_ / 64);
    bf16_t* VF = (bf16_t*)(p.ws + WS_VT) + ((size_t)bg * (T_ / 64) + tb) * 4096; bf16_t* KF = (bf16_t*)(p.ws + WS_KF) + ((size_t)bg * (T_ / 64) + tb) * 4096;
    bf16_t* tile = (bf16_t*)lds;
    { const int tok = tid >> 3, ch = tid & 7; *(u32x4*)(tile + tok * 72 + 8 * ch) = r.v; }
    *(u32x4*)(KF + tid * 8) = r.k;
    __syncthreads();
    { const int dim = tid >> 3, c8 = tid & 7; unsigned short e[8];
#pragma unroll
      for (int i = 0; i < 8; ++i) e[i] = tile[(8 * c8 + i) * 72 + dim];
      *(u32x4*)(VF + (((dim >> 5) * 4 + (c8 >> 1)) * 64 + 32 * (c8 & 1) + (dim & 31)) * 8) = (u32x4){(unsigned)e[0] | ((unsigned)e[1] << 16), (unsigned)e[2] | ((unsigned)e[3] << 16), (unsigned)e[4] | ((unsigned)e[5] << 16), (unsigned)e[6] | ((unsigned)e[7] << 16)}; }
    __syncthreads();
}

constexpr int AT_KB = 0, AT_VOFF = 128 * 160, AT_STAGE = 2 * AT_VOFF, AT_IA = 2 * AT_STAGE, AT_IB = AT_IA + 64 * 128 * 4, AT_SEL = AT_IB + 64 * 128 * 4, AT_TM = AT_SEL + 64 * 16, AT_END = AT_TM + 128 * 8;
constexpr int EN_QL = 0, EN_OL = 40960, EN_LL = EN_OL + 256 * 65 * 4, EN_END = EN_LL + 1024;
static_assert(EN_END + 16 * 512 * 4 <= AT_SEL && 256 * 72 * 2 <= EN_OL, "engine lds");
static_assert(AT_END <= MISC_OFF, "attn lds");
constexpr int AT_UNITS = B_ * NGRP * NSB;

#ifdef CPU_EMU
DEV int row16_sum(int v) { v += __shfl_xor(v, 8); v += __shfl_xor(v, 4); v += __shfl_xor(v, 2); v += __shfl_xor(v, 1); return v; }
DEV int row16_shr(int v, int n) { const int l = threadIdx.x & 63; const int r = __shfl(v, (l & 15) >= n ? l - n : l); return (l & 15) >= n ? r : 0; }
DEV float quad_sum(float v) { v += __shfl_xor(v, 1); v += __shfl_xor(v, 2); return v; }
DEV u32x2 lds_tr16(const bf16_t* p) {
    const int w = threadIdx.x >> 6, l = threadIdx.x & 63; const unsigned long long a = (unsigned long long)(uintptr_t)p;
    emu_xbuf[w][l][0] = (unsigned)a; emu_xbuf[w][l][1] = (unsigned)(a >> 32); emu_wave_sync();
    const int g = l >> 4, i = l & 15; unsigned short e[4];
    for (int q = 0; q < 4; ++q) { const int src = 16 * g + 4 * q + (i >> 2); const unsigned long long sa = (unsigned long long)emu_xbuf[w][src][0] | ((unsigned long long)emu_xbuf[w][src][1] << 32); e[q] = ((const unsigned short*)(uintptr_t)sa)[i & 3]; }
    emu_wave_sync();
    return (u32x2){(unsigned)e[0] | ((unsigned)e[1] << 16), (unsigned)e[2] | ((unsigned)e[3] << 16)};
}
#else
DEV int row16_sum(int v) {
    v += __builtin_amdgcn_update_dpp(0, v, 0x128, 0xF, 0xF, false); v += __builtin_amdgcn_update_dpp(0, v, 0x124, 0xF, 0xF, false);
    v += __builtin_amdgcn_update_dpp(0, v, 0x122, 0xF, 0xF, false); v += __builtin_amdgcn_update_dpp(0, v, 0x121, 0xF, 0xF, false); return v;
}
#define row16_shr(v, n) __builtin_amdgcn_update_dpp(0, (v), 0x110 + (n), 0xF, 0xF, true)
DEV float quad_sum(float v) {
    v += __builtin_bit_cast(float, __builtin_amdgcn_mov_dpp(__builtin_bit_cast(int, v), 0xB1, 0xF, 0xF, true));
    v += __builtin_bit_cast(float, __builtin_amdgcn_mov_dpp(__builtin_bit_cast(int, v), 0x4E, 0xF, 0xF, true));
    return v;
}
typedef short v4i16_t __attribute__((ext_vector_type(4)));
DEV u32x2 lds_tr16(const bf16_t* p) { return __builtin_bit_cast(u32x2, __builtin_amdgcn_ds_read_tr16_b64_v4i16((__attribute__((address_space(3))) v4i16_t*)p)); }
#endif

#ifdef PROBE_TIMING
#define TSTAMP(v) do { __builtin_amdgcn_sched_barrier(0); v = __builtin_amdgcn_s_memtime(); __builtin_amdgcn_s_waitcnt(0xC07F); __builtin_amdgcn_sched_barrier(0); } while (0)
#else
#define TSTAMP(v) do { } while (0)
#endif
#ifndef PROBE_MODE
#define PROBE_MODE -1
#endif
constexpr int ATS = 80;
template <int MODE>
DEV void attn_tile(const bf16_t* kb, const bf16_t* vb, int jt, const bf16x8 (&qf)[4], f32x16 (&oacc)[2], float& lsum, float linv, const f32x16& negm, int ttok,
                   unsigned long long slo, unsigned long long shi, int t0, int qb, float* impA, float* impB, int wave, int lane) {
    const float NINF = -INFINITY;
    const int c32 = lane & 31, h = lane >> 5, hg = lane & 3, tau = c32 >> 2;
    bool nm;
    if (MODE <= 1) nm = (16 * (64 * jt + 63) + 31 > t0);
    else if (MODE == 2) nm = (jt == qb);
    else nm = (jt == qb) || (jt + 8 == qb);
    f32x16 s[2];
    if (nm) {
        const float nm0 = negm[0];
        if (MODE == 3 && jt != qb) {
            const int d2 = ttok - 512 - 64 * jt - 4 * h;
#pragma unroll
            for (int kt = 0; kt < 2; ++kt) {
                f32x16 cm;
#pragma unroll
                for (int i = 0; i < 16; ++i) cm[i] = (32 * kt + (i & 3) + 8 * (i >> 2) > d2) ? nm0 : NINF;
                s[kt] = mfma32(ld8(kb + (32 * kt + c32) * ATS + 8 * h), qf[0], cm);
            }
        } else {
            const int d = ((MODE <= 1) ? ((ttok - 31) >> 4) : ttok) - 64 * jt - 4 * h;
#pragma unroll
            for (int kt = 0; kt < 2; ++kt) {
                f32x16 cm;
#pragma unroll
                for (int i = 0; i < 16; ++i) cm[i] = (32 * kt + (i & 3) + 8 * (i >> 2) <= d) ? nm0 : NINF;
                s[kt] = mfma32(ld8(kb + (32 * kt + c32) * ATS + 8 * h), qf[0], cm);
            }
        }
    } else {
#pragma unroll
        for (int kt = 0; kt < 2; ++kt) s[kt] = mfma32(ld8(kb + (32 * kt + c32) * ATS + 8 * h), qf[0], negm);
    }
    if (MODE >= 2) {
        const int l15 = lane & 15, g1 = (lane >> 4) & 1;
        float psum = 0.f;
#pragma unroll
        for (int ks = 1; ks < 4; ++ks) { const bf16x8 a = ld8(kb + c32 * ATS + 16 * ks + 8 * h); s[0] = mfma32(a, qf[ks], s[0]); }
        SCHED_FENCE();
#pragma unroll
        for (int ks = 1; ks < 4; ++ks) {
            const bf16x8 a = ld8(kb + (32 + c32) * ATS + 16 * ks + 8 * h); s[1] = mfma32(a, qf[ks], s[1]);
            const int i0 = (ks == 1) ? 0 : (ks == 2 ? 6 : 11), i1 = (ks == 1) ? 6 : (ks == 2 ? 11 : 16);
#pragma unroll
            for (int i = i0; i < i1; ++i) { float pv = exp2_fast(s[0][i]); LAUNDER_V(pv); s[0][i] = pv; psum += pv; }
            SCHED_FENCE();
        }
        u32x4 pw0[2];
#pragma unroll
        for (int sp = 0; sp < 2; ++sp) pw0[sp] = (u32x4){pk2(s[0][8 * sp], s[0][8 * sp + 1]), pk2(s[0][8 * sp + 2], s[0][8 * sp + 3]), pk2(s[0][8 * sp + 4], s[0][8 * sp + 5]), pk2(s[0][8 * sp + 6], s[0][8 * sp + 7])};
        SCHED_FENCE();
#pragma unroll
        for (int n = 0; n < 4; ++n) {
            const int sp = n >> 1, dt = n & 1;
            const bf16_t* vr = vb + (16 * sp + 4 * h + (l15 >> 2)) * ATS + 16 * g1 + 4 * (l15 & 3);
            const u32x2 lo = lds_tr16(vr + 32 * dt), hi = lds_tr16(vr + 8 * ATS + 32 * dt);
            oacc[dt] = mfma32(__builtin_bit_cast(bf16x8, (u32x4){lo.x, lo.y, hi.x, hi.y}), __builtin_bit_cast(bf16x8, pw0[sp]), oacc[dt]);
#pragma unroll
            for (int i = 4 * n; i < 4 * n + 4; ++i) { float pv = exp2_fast(s[1][i]); LAUNDER_V(pv); s[1][i] = pv; psum += pv; }
            SCHED_FENCE();
        }
        lsum += psum;
#pragma unroll
        for (int sp = 0; sp < 2; ++sp) {
            const u32x4 pw = (u32x4){pk2(s[1][8 * sp], s[1][8 * sp + 1]), pk2(s[1][8 * sp + 2], s[1][8 * sp + 3]), pk2(s[1][8 * sp + 4], s[1][8 * sp + 5]), pk2(s[1][8 * sp + 6], s[1][8 * sp + 7])};
            const bf16_t* vr = vb + (32 + 16 * sp + 4 * h + (l15 >> 2)) * ATS + 16 * g1 + 4 * (l15 & 3);
#pragma unroll
            for (int dt = 0; dt < 2; ++dt) {
                const u32x2 lo = lds_tr16(vr + 32 * dt), hi = lds_tr16(vr + 8 * ATS + 32 * dt);
                oacc[dt] = mfma32(__builtin_bit_cast(bf16x8, (u32x4){lo.x, lo.y, hi.x, hi.y}), __builtin_bit_cast(bf16x8, pw), oacc[dt]);
            }
        }
        return;
    }
#pragma unroll
    for (int kt = 0; kt < 2; ++kt)
#pragma unroll
        for (int ks = 1; ks < 4; ++ks) { const bf16x8 a = ld8(kb + (32 * kt + c32) * ATS + 16 * ks + 8 * h); s[kt] = mfma32(a, qf[ks], s[kt]); }
    float psum = 0.f;
#pragma unroll
    for (int kt = 0; kt < 2; ++kt)
#pragma unroll
        for (int i = 0; i < 16; ++i) { const float pv = exp2_fast(s[kt][i]); s[kt][i] = pv; psum += pv; }
    if (MODE != 1) lsum += psum;
    if (MODE == 1) {
#pragma unroll
        for (int kt = 0; kt < 2; ++kt)
#pragma unroll
            for (int gq = 0; gq < 4; ++gq) {
                const float a = quad_sum(2.0f * (s[kt][4 * gq] + s[kt][4 * gq + 1] + s[kt][4 * gq + 2]) + s[kt][4 * gq + 3]), bq = quad_sum(s[kt][4 * gq + 3]);
                if (hg == 0) { const int j = 16 * jt + 8 * kt + 2 * gq + h; const int tl = 8 * wave + tau; impA[tl * 128 + j] = a; impB[tl * 128 + j] = bq; }
            }
    }
    if (MODE != 0) {
        const int l15 = lane & 15, g1 = (lane >> 4) & 1;
#pragma unroll
        for (int kt = 0; kt < 2; ++kt)
#pragma unroll
            for (int sp = 0; sp < 2; ++sp) {
                u32x4 pw = (u32x4){pk2(s[kt][8 * sp], s[kt][8 * sp + 1]), pk2(s[kt][8 * sp + 2], s[kt][8 * sp + 3]), pk2(s[kt][8 * sp + 4], s[kt][8 * sp + 5]), pk2(s[kt][8 * sp + 6], s[kt][8 * sp + 7])};
                const bf16x8 pf = __builtin_bit_cast(bf16x8, pw);
                const bf16_t* vr = vb + (32 * kt + 16 * sp + 4 * h + (l15 >> 2)) * ATS + 16 * g1 + 4 * (l15 & 3);
#pragma unroll
                for (int dt = 0; dt < 2; ++dt) {
                    const u32x2 lo = lds_tr16(vr + 32 * dt), hi = lds_tr16(vr + 8 * ATS + 32 * dt);
                    oacc[dt] = mfma32(__builtin_bit_cast(bf16x8, (u32x4){lo.x, lo.y, hi.x, hi.y}), pf, oacc[dt]);
                }
            }
    }
}

DEV void at_preload(const bf16_t* Kg, const bf16_t* Vg, int pitch, int jlo, int jhi, int tid, u32x4 (&pk)[2], u32x4 (&pv)[2]) {
    const int key = tid >> 3, ch = tid & 7;
#pragma unroll
    for (int u = 0; u < 2; ++u) { const int jt = jlo + u; pk[u] = (u32x4){0u, 0u, 0u, 0u}; pv[u] = pk[u];
        if (jt <= jhi) { pk[u] = *(const u32x4*)(Kg + (size_t)(64 * jt + key) * pitch + 8 * ch); pv[u] = *(const u32x4*)(Vg + (size_t)(64 * jt + key) * pitch + 8 * ch); } }
}

template <int MODE, bool PRE = false>
DEV void attn_pass(const bf16_t* Kg, const bf16_t* Vg, int pitch, int jlo, int jhi, unsigned char* lds, const bf16x8 (&qf)[4], f32x16 (&oacc)[2], float& lsum, float linv,
                   float m0l, int ttok, unsigned long long slo, unsigned long long shi, int t0, int qb, int tid, int wave, int lane_, unsigned long long& tcomp, unsigned long long& tpass,
                   const u32x4* pk = nullptr, const u32x4* pv = nullptr) {
    unsigned long long tc0_ = 0, tc1_ = 0, tp0_ = 0, tp1_ = 0; TSTAMP(tp0_);
    LAUNDER_V(tid); const int lane = tid & 63; (void)lane_;
    const int key = tid >> 3, ch = tid & 7;
    float* impA = (float*)(lds + AT_IA); float* impB = (float*)(lds + AT_IB);
    const int nsteps = (jhi - jlo + 2) >> 1;
    const u32x4 Z4 = (u32x4){0u, 0u, 0u, 0u};
    f32x16 negm;
    float nm0_ = (MODE == 1) ? (log2_fast(linv) - m0l) : -m0l;
    LAUNDER_V(nm0_);
#pragma unroll
    for (int i = 0; i < 16; ++i) negm[i] = nm0_;
    u32x4 rk[2][2], rv[2][2];
#define AT_LOAD(set, st) do { _Pragma("unroll") for (int u_ = 0; u_ < 2; ++u_) { const int jt_ = jlo + 2 * (st) + u_; rk[set][u_] = Z4; rv[set][u_] = Z4; \
        if (jt_ <= jhi) { rk[set][u_] = *(const u32x4*)(Kg + (size_t)(64 * jt_ + key) * pitch + 8 * ch); if (MODE != 0) rv[set][u_] = *(const u32x4*)(Vg + (size_t)(64 * jt_ + key) * pitch + 8 * ch); } } } while (0)
#define AT_WRITE(set, stage) do { _Pragma("unroll") for (int u_ = 0; u_ < 2; ++u_) { *(u32x4*)(lds + AT_KB + (stage) * AT_STAGE + ((64 * u_ + key) * ATS + 8 * ch) * 2) = rk[set][u_]; \
        if (MODE != 0) *(u32x4*)(lds + AT_KB + (stage) * AT_STAGE + AT_VOFF + ((64 * u_ + key) * ATS + 8 * ch) * 2) = rv[set][u_]; } } while (0)
    if (PRE) { rk[0][0] = pk[0]; rk[0][1] = pk[1]; rv[0][0] = pv[0]; rv[0][1] = pv[1]; } else AT_LOAD(0, 0);
    AT_WRITE(0, 0);
    if (MODE != 2 && nsteps > 1) AT_LOAD(1, 1); else { rk[1][0] = Z4; rk[1][1] = Z4; rv[1][0] = Z4; rv[1][1] = Z4; }
    __syncthreads();
#define AT_COMPUTE(st) do { const int stage_ = (st) & 1; TSTAMP(tc0_); \
        _Pragma("unroll") for (int u = 0; u < 2; ++u) { const int jt = jlo + 2 * (st) + u; if (jt > jhi) break; \
            const bf16_t* kb = (const bf16_t*)(lds + AT_KB + stage_ * AT_STAGE) + 64 * ATS * u; const bf16_t* vb = (const bf16_t*)(lds + AT_KB + stage_ * AT_STAGE + AT_VOFF) + 64 * ATS * u; \
            attn_tile<MODE>(kb, vb, jt, qf, oacc, lsum, linv, negm, ttok, slo, shi, t0, qb, impA, impB, wave, lane); } TSTAMP(tc1_); if (MODE == PROBE_MODE) tcomp += tc1_ - tc0_; } while (0)
    for (int st = 0; st < nsteps; st += 2) {
        if (MODE != 2 && st + 2 < nsteps) AT_LOAD(0, st + 2);
        AT_COMPUTE(st);
        if (MODE != 2 && st + 1 < nsteps) AT_WRITE(1, 1);
        LDS_BARRIER();
        if (MODE == 2 || st + 1 >= nsteps) break;
        if (st + 3 < nsteps) AT_LOAD(1, st + 3);
        AT_COMPUTE(st + 1);
        if (st + 2 < nsteps) AT_WRITE(0, 0);
        LDS_BARRIER();
    }
#undef AT_LOAD
#undef AT_WRITE
#undef AT_COMPUTE
    TSTAMP(tp1_); if (MODE == PROBE_MODE) tpass += tp1_ - tp0_;
}

DEV unsigned char* en_tl(unsigned char* lds, int j) { return j <= 124 ? lds + AT_SEL + 64 * (j - 1) : lds + MISC_OFF + 160; }
static_assert(AT_SEL + 64 * 124 <= MISC_OFF, "token lists");

#ifndef SEL_KSH
#define SEL_KSH 12
#endif
DEV void attn_unit(const Params& p, unsigned char* lds, int b, int g, int qb, float m0c, float m0s, float m0w, int tid, int wave, int lane_) {
    LAUNDER_V(tid); const int lane = tid & 63; (void)lane_;
    unsigned char* ws = p.ws;
    const int c32 = lane & 31, h = lane >> 5, hg = lane & 3, tau = c32 >> 2; const int t0 = 64 * qb;
    const bf16_t* Q = (const bf16_t*)(ws + WS_Q); const bf16_t* QR = (const bf16_t*)(ws + WS_QR);
    const bf16_t* KC = (const bf16_t*)(ws + WS_KC) + (size_t)b * NCP * 128 + g * 64; const bf16_t* VC = (const bf16_t*)(ws + WS_VC) + (size_t)b * NCP * 128 + g * 64;
    const bf16_t* SL = (const bf16_t*)(ws + WS_SL) + (size_t)b * T_ * 256 + g * 64; const bf16_t* WN = (const bf16_t*)(ws + WS_WN) + (size_t)b * T_ * 256 + g * 64;
    const float* G = (const float*)(ws + WS_G);
    constexpr float LOG2E = 1.4426950408889634f;
    const int ttok = t0 + 8 * wave + tau; const size_t rowg = (size_t)b * T_ + ttok;
    const int hd = 4 * g + hg;
    bf16x8 qf[4]; f32x16 oacc[2], outa[2]; float lsum = 0.f, linv = 0.f; unsigned long long tcomp = 0, tpass = 0;
    unsigned long long slo = 0ull, shi = 0ull;
#pragma unroll
    for (int dt = 0; dt < 2; ++dt)
#pragma unroll
        for (int i = 0; i < 16; ++i) { oacc[dt][i] = 0.f; outa[dt][i] = 0.f; }
#pragma unroll
    for (int ks = 0; ks < 4; ++ks) qf[ks] = ld8(Q + rowg * 512 + hd * 64 + 16 * ks + 8 * h);
    const int ncmp = 4 * qb + 3;
    const int jhc = (ncmp - 1) >> 6;
#ifndef REP_CMP
#define REP_CMP 1
#endif
    for (int rep_ = 0; rep_ < REP_CMP; ++rep_) { lsum = 0.f;
    attn_pass<0>(KC, VC, 128, 0, jhc, lds, qf, oacc, lsum, linv, m0c * LOG2E, ttok, slo, shi, t0, qb, tid, wave, lane, tcomp, tpass); }
    { float L = lsum; L += __shfl_xor(L, 32); linv = L > 0.f ? 1.0f / L : 0.f; lsum = 0.f; }
    attn_pass<1>(KC, VC, 128, 0, jhc, lds, qf, oacc, lsum, linv, m0c * LOG2E, ttok, slo, shi, t0, qb, tid, wave, lane, tcomp, tpass);
    { const float gt = G[rowg * 32 + 3 * hd + 0];
#pragma unroll
        for (int dt = 0; dt < 2; ++dt)
#pragma unroll
            for (int i = 0; i < 16; ++i) { outa[dt][i] = oacc[dt][i] * gt; oacc[dt][i] = 0.f; } }
    {
        const float* impA = (const float*)(lds + AT_IA); const float* impB = (const float*)(lds + AT_IB); unsigned long long* sel = (unsigned long long*)(lds + AT_SEL);
        unsigned char* sel8 = (unsigned char*)sel;
        const int row16 = lane >> 4, i16 = lane & 15;
        {
            unsigned k[2][8], th[2] = {0u, 0u};
#pragma unroll
            for (int rnd = 0; rnd < 2; ++rnd) {
                const int tl = 8 * wave + 4 * rnd + row16; const float* ia = impA + tl * 128; const float* ib = impB + tl * 128;
                const f32x4 a0 = *(const f32x4*)(ia + 8 * i16), a1 = *(const f32x4*)(ia + 8 * i16 + 4), b0 = *(const f32x4*)(ib + 8 * i16), b1 = *(const f32x4*)(ib + 8 * i16 + 4);
                const float bm1 = ib[8 * i16 - 1];
#pragma unroll
                for (int c = 0; c < 8; ++c) { const int j = 8 * i16 + c;
                    const float av = c < 4 ? a0[c & 3] : a1[c & 3], bv = (c == 0) ? bm1 : (c <= 4 ? b0[(c - 1) & 3] : b1[(c - 5) & 3]);
                    const unsigned kv = (__builtin_bit_cast(unsigned, av + bv) >> SEL_KSH) + 1u;
                    k[rnd][c] = (j > qb) ? 0u : ((j == 0 || j == qb || j == qb - 1) ? (0x7f800000u >> SEL_KSH) + 1u : kv); }
            }
#pragma unroll 1
            for (int bit = 30 - SEL_KSH; bit >= 0; --bit) {
                const unsigned bm = 1u << bit;
#pragma unroll
                for (int rnd = 0; rnd < 2; ++rnd) {
                    const unsigned cand = th[rnd] | bm;
                    const int c01 = ((k[rnd][0] >= cand) ? 1 : 0) + ((k[rnd][1] >= cand) ? 1 : 0), c23 = ((k[rnd][2] >= cand) ? 1 : 0) + ((k[rnd][3] >= cand) ? 1 : 0);
                    const int c45 = ((k[rnd][4] >= cand) ? 1 : 0) + ((k[rnd][5] >= cand) ? 1 : 0), c67 = ((k[rnd][6] >= cand) ? 1 : 0) + ((k[rnd][7] >= cand) ? 1 : 0);
                    const int cnt = row16_sum((c01 + c23) + (c45 + c67));
                    th[rnd] = (cnt >= 16) ? cand : th[rnd];
                }
            }
#pragma unroll
            for (int rnd = 0; rnd < 2; ++rnd) {
                const int tl = 8 * wave + 4 * rnd + row16;
                int gt = 0, eq = 0;
#pragma unroll
                for (int c = 0; c < 8; ++c) { gt += (k[rnd][c] > th[rnd]) ? 1 : 0; eq += (k[rnd][c] == th[rnd]) ? 1 : 0; }
                const int need = (th[rnd] == 0u) ? 0 : 16 - row16_sum(gt);
                int pre = eq;
                { int t_ = row16_shr(pre, 1); pre += t_; t_ = row16_shr(pre, 2); pre += t_; t_ = row16_shr(pre, 4); pre += t_; t_ = row16_shr(pre, 8); pre += t_; }
                int run = pre - eq; unsigned bits = 0u;
#pragma unroll
                for (int c = 0; c < 8; ++c) {
                    if (k[rnd][c] > th[rnd]) bits |= 1u << c;
                    else if (k[rnd][c] == th[rnd]) { if (run < need) bits |= 1u << c; ++run; }
                }
                sel8[tl * 16 + i16] = (unsigned char)bits;
            }
        }
    }
    __syncthreads();
    {
        const unsigned long long* sel = (const unsigned long long*)(lds + AT_SEL);
        const unsigned long long mylo = sel[lane * 2], myhi = sel[lane * 2 + 1];
        __syncthreads();
        for (int jj = 0; jj < 16; ++jj) { const int j = 16 * wave + jj; if (j < 1 || j > 125) continue;
            const int bit = (int)(((j < 64) ? (mylo >> j) : (myhi >> (j - 64))) & 1ull); const unsigned long long m = __ballot(bit);
            unsigned char* tl = en_tl(lds, j);
            const int pos = __builtin_popcountll(m & ((1ull << lane) - 1ull)), cnt = __builtin_popcountll(m);
            if (bit) tl[pos] = (unsigned char)lane;
            if (lane < 16 && cnt + lane < 64) tl[cnt + lane] = 0xFFu; }
    }
    float* outl = (float*)(lds + AT_IA) + tid;
#pragma unroll
    for (int dt = 0; dt < 2; ++dt)
#pragma unroll
        for (int i = 0; i < 16; ++i) outl[(dt * 16 + i) * 512] = outa[dt][i];
#pragma unroll
    for (int ks = 0; ks < 4; ++ks) qf[ks] = ld8(QR + rowg * 512 + hd * 64 + 16 * ks + 8 * h);
#ifndef REP_WIN
#define REP_WIN 1
#endif
    for (int rep_ = 0; rep_ < REP_WIN; ++rep_)
    attn_pass<3>(WN, WN + 128, 256, qb >= 8 ? qb - 8 : 0, qb, lds, qf, oacc, lsum, linv, m0w * LOG2E, ttok, slo, shi, t0, qb, tid, wave, lane, tcomp, tpass);
    { float L = lsum; L += __shfl_xor(L, 32); const float sc = (L > 0.f ? 1.0f / L : 0.f) * G[rowg * 32 + 3 * hd + 2]; lsum = 0.f;
#pragma unroll
        for (int dt = 0; dt < 2; ++dt)
#pragma unroll
            for (int i = 0; i < 16; ++i) { outa[dt][i] = outl[(dt * 16 + i) * 512] + oacc[dt][i] * sc; oacc[dt][i] = 0.f; } }
    __syncthreads();
    {
        bf16_t* QL = (bf16_t*)(lds + EN_QL); float* OL = (float*)(lds + EN_OL); float* LL = (float*)(lds + EN_LL);
        float* outp = (float*)(lds + EN_END) + tid;
#pragma unroll
        for (int i = 0; i < 16; ++i) outp[i * 512] = outa[1][i];
        for (int i = tid; i < (EN_LL + 1024 - EN_OL) / 16; i += 512) ((u32x4*)(lds + EN_OL))[i] = (u32x4){0u, 0u, 0u, 0u};
        unsigned* qcnt = (unsigned*)(lds + MISC_OFF + 128);
        if (tid == 0) *qcnt = 0u;
#pragma unroll
        for (int k = 0; k < 4; ++k) { const int idx = tid + 512 * k, tok = idx >> 5, c = idx & 31;
            *(u32x4*)(QL + (tok * 4 + (c >> 3)) * 72 + (c & 7) * 8) = *(const u32x4*)(QR + ((size_t)b * T_ + t0 + tok) * 512 + g * 256 + c * 8); }
        __syncthreads();
        const bf16_t* VT = (const bf16_t*)(ws + WS_VT) + (size_t)(b * NGRP + g) * (T_ / 64) * 4096; const bf16_t* KF = (const bf16_t*)(ws + WS_KF) + (size_t)(b * NGRP + g) * (T_ / 64) * 4096;
        const int r32 = lane & 31, kr = (r32 & ~12) | ((r32 & 8) >> 1) | ((r32 & 4) << 1);
        const float cs0 = 17.0f - m0s * LOG2E;
#ifndef REP_SLC
#define REP_SLC 1
#endif
        for (;;) {
            unsigned tk_ = 0u; if (lane == 0) tk_ = atomicAdd(qcnt, 1u);
            tk_ = (unsigned)__shfl((int)tk_, 0);
#ifndef CPU_EMU
            tk_ = (unsigned)__builtin_amdgcn_readfirstlane((int)tk_);
#endif
            const int j = 1 + (int)tk_; if (j > qb - 2) break;
            const unsigned char* tl = en_tl(lds, j);
            int first = tl[0];
#ifndef CPU_EMU
            first = __builtin_amdgcn_readfirstlane(first);
#endif
            if (first == 0xFF) continue;
            bf16x8 kfr[2][4], vfr[2][4];
#pragma unroll
            for (int kt = 0; kt < 2; ++kt)
#pragma unroll
                for (int ks = 0; ks < 4; ++ks) kfr[kt][ks] = ld8(KF + (size_t)j * 4096 + ((kt * 4 + ks) * 64 + lane) * 8);
#pragma unroll
            for (int dt = 0; dt < 2; ++dt)
#pragma unroll
                for (int q = 0; q < 4; ++q) vfr[dt][q] = ld8(VT + (size_t)j * 4096 + ((dt * 4 + q) * 64 + lane) * 8);
            for (int gi = 0; gi < 8; ++gi) {
                const int tokidx = tl[8 * gi + tau];
                const bool valid = tokidx != 0xFF;
                if (!__any(valid)) break;
                const int ti = valid ? tokidx : 0; const int row = ti * 4 + hg;
                bf16x8 qg[4];
#pragma unroll
                for (int ks = 0; ks < 4; ++ks) qg[ks] = ld8(QL + row * 72 + 16 * ks + 8 * h);
                f32x16 s2[2];
#pragma unroll
                for (int kt = 0; kt < 2; ++kt) {
#pragma unroll
                    for (int i = 0; i < 16; ++i) s2[kt][i] = cs0;
#pragma unroll
                    for (int ks = 0; ks < 4; ++ks) s2[kt] = mfma32(kfr[kt][ks], qg[ks], s2[kt]);
                }
                float psum = 0.f;
#pragma unroll
                for (int kt = 0; kt < 2; ++kt)
#pragma unroll
                    for (int i = 0; i < 16; ++i) { const float pv = exp2_fast(s2[kt][i]); s2[kt][i] = pv; psum += pv; }
                u32x4 pw[4];
#pragma unroll
                for (int q = 0; q < 4; ++q) { const int kt = q >> 1, sp = q & 1;
                    pw[q] = (u32x4){pk2(s2[kt][8 * sp], s2[kt][8 * sp + 1]), pk2(s2[kt][8 * sp + 2], s2[kt][8 * sp + 3]), pk2(s2[kt][8 * sp + 4], s2[kt][8 * sp + 5]), pk2(s2[kt][8 * sp + 6], s2[kt][8 * sp + 7])}; }
                if (!__all(valid)) {
                    const unsigned pm = valid ? 0xffffffffu : 0u;
#pragma unroll
                    for (int q = 0; q < 4; ++q) { pw[q].x &= pm; pw[q].y &= pm; pw[q].z &= pm; pw[q].w &= pm; }
                }
                f32x16 o2[2];
#pragma unroll
                for (int dt = 0; dt < 2; ++dt) {
#pragma unroll
                    for (int i = 0; i < 16; ++i) o2[dt][i] = 0.f;
#pragma unroll
                    for (int q = 0; q < 4; ++q) o2[dt] = mfma32(vfr[dt][q], __builtin_bit_cast(bf16x8, pw[q]), o2[dt]);
                }
                psum += __shfl_xor(psum, 32);
                if (valid) {
                    unsigned* orow = (unsigned*)(OL + row * 65 + 4 * h);
#pragma unroll
                    for (int dt = 0; dt < 2; ++dt)
#pragma unroll
                        for (int i = 0; i < 16; ++i) atomicAdd(orow + 32 * dt + (i & 3) + 8 * (i >> 2), (unsigned)f2i_rn(o2[dt][i]));
                    if (h == 0) atomicAdd((unsigned*)(LL + row), (unsigned)f2i_rn(psum));
                }
            }
        }
        {
            const int key = tid >> 3, ch = tid & 7;
            const int nft = qb >= 2 ? 3 : qb + 1;
            u32x4 fk[3], fv[3];
#pragma unroll
            for (int u = 0; u < 3; ++u) { const int jt = (u == 0) ? 0 : (qb >= 2 ? qb - 2 + u : u); fk[u] = (u32x4){0u, 0u, 0u, 0u}; fv[u] = fk[u];
                if (u < nft) { fk[u] = *(const u32x4*)(SL + (size_t)(64 * jt + key) * 256 + 8 * ch); fv[u] = *(const u32x4*)(SL + 128 + (size_t)(64 * jt + key) * 256 + 8 * ch); } }
#pragma unroll
            for (int ks = 0; ks < 4; ++ks) qf[ks] = ld8(QR + rowg * 512 + hd * 64 + 16 * ks + 8 * h);
            __syncthreads();
            const int row = (8 * wave + tau) * 4 + hg;
            float Lf = (h == 0) ? (float)((const int*)LL)[row] : 0.f;
            f32x16 of[2];
            { const int* orow = (const int*)(OL + row * 65 + 4 * h);
#pragma unroll
              for (int dt = 0; dt < 2; ++dt)
#pragma unroll
                  for (int i = 0; i < 16; ++i) of[dt][i] = (float)orow[32 * dt + (i & 3) + 8 * (i >> 2)]; }
            __syncthreads();
#pragma unroll
            for (int u = 0; u < 3; ++u) { unsigned char* slot = lds + AT_KB + (u >> 1) * AT_STAGE + ((64 * (u & 1) + key) * ATS + 8 * ch) * 2;
                *(u32x4*)slot = fk[u]; *(u32x4*)(slot + AT_VOFF) = fv[u]; }
            f32x16 negm; float nm0_ = 17.0f - m0s * LOG2E; LAUNDER_V(nm0_);
#pragma unroll
            for (int i = 0; i < 16; ++i) negm[i] = nm0_;
            __syncthreads();
#pragma unroll 1
            for (int u = 0; u < nft; ++u) { const int jt = (u == 0) ? 0 : (qb >= 2 ? qb - 2 + u : u);
                const bf16_t* kb = (const bf16_t*)(lds + AT_KB + (u >> 1) * AT_STAGE) + 64 * ATS * (u & 1);
                attn_tile<2>(kb, kb + AT_VOFF / 2, jt, qf, of, Lf, linv, negm, ttok, 0ull, 0ull, t0, qb, (float*)(lds + AT_IA), (float*)(lds + AT_IB), wave, lane); }
            Lf += __shfl_xor(Lf, 32);
            const float sc = (Lf > 0.f ? 1.0f / Lf : 0.f) * G[rowg * 32 + 3 * hd + 1];
#pragma unroll
            for (int dt = 0; dt < 2; ++dt)
#pragma unroll
                for (int i = 0; i < 16; ++i) outa[dt][i] = (dt == 1 ? outp[i * 512] : outa[dt][i]) + of[dt][i] * sc;
        }
    }
    {
        const bf16_t* ZA = (const bf16_t*)(ws + WS_ZA); bf16_t* MIX = (bf16_t*)(ws + WS_MIX);
        unsigned char* stg = lds + EN_END + wave * 256;
        const int rr = lane >> 3, pc = lane & 7;
        u32x4 zr[4];
#pragma unroll
        for (int j = 0; j < 4; ++j) { const int r = 8 * j + rr; const size_t grow = (size_t)b * T_ + t0 + 8 * wave + (r >> 2);
            zr[j] = *(const u32x4*)(ZA + grow * 512 + (4 * g + (r & 3)) * 64 + 8 * pc); }
        WAVE_SYNC();
#pragma unroll
        for (int j = 0; j < 4; ++j) { const int r = 8 * j + rr; *(u32x4*)(stg + (r >> 1) * 2048 + (r & 1) * 128 + 16 * pc) = zr[j]; }
        WAVE_SYNC();
        unsigned char* myrow = stg + (c32 >> 1) * 2048 + (c32 & 1) * 128;
#pragma unroll
        for (int dt = 0; dt < 2; ++dt)
#pragma unroll
            for (int gq = 0; gq < 4; ++gq) {
                u32x2* slot = (u32x2*)(myrow + (32 * dt + 8 * gq + 4 * h) * 2); const u32x2 zv = *slot;
                float o[4];
#pragma unroll
                for (int r = 0; r < 4; ++r) { const unsigned w = zv[r >> 1]; o[r] = outa[dt][4 * gq + r] * bf2f((r & 1) ? (w >> 16) : (w & 0xffffu)); }
                *slot = (u32x2){pk2(o[0], o[1]), pk2(o[2], o[3])};
            }
        WAVE_SYNC();
#pragma unroll
        for (int j = 0; j < 4; ++j) { const int r = 8 * j + rr; const size_t grow = (size_t)b * T_ + t0 + 8 * wave + (r >> 2);
            *(u32x4*)(MIX + grow * 1024 + (4 * g + (r & 3)) * 64 + 8 * pc) = *(const u32x4*)(stg + (r >> 1) * 2048 + (r & 1) * 128 + 16 * pc); }
    }
    __syncthreads();
#ifdef PROBE_TIMING
    if (b == PROBE_B && g == 0 && qb == PROBE_QB && tid == PROBE_TID) { float* tr = (float*)(ws + WS_CTL + 32768); tr[0] = (float)tcomp; tr[1] = (float)tpass; }
#endif
}

DEV void p4_attention(const Params& p, unsigned char* lds, int vcu, int G, int tid, int wave, int lane) {
    const float gq = wave_max(fabsf(p.in[I_QNG][lane])), gc = wave_max(fabsf(p.in[I_KCNG][lane])), gs = wave_max(fabsf(p.in[I_KSNG][lane])), gw = wave_max(fabsf(p.in[I_KWNG][lane]));
    const float m0c = 8.2f * gq * gc, m0s = 8.2f * gq * gs, m0w = 8.2f * gq * gw;
    for (int i = 0;; ++i) {
        const long L = (long)i * G + vcu; if (L >= AT_UNITS) break;
        int bg, qb;
        if (G == 256 && B_ * NGRP == 16 && NSB == 128) {
            const int xcd = vcu >> 5, c = vcu & 31, r = i & 3;
            bg = 2 * xcd + (i >> 2); qb = (r == 0) ? c : (r == 1) ? 63 - c : (r == 2) ? 64 + c : 127 - c;
        } else {
            const int per = B_ * NGRP * 16;
            const int k = (int)(L / per), v = (int)(L % per), s = v & 15;
            bg = v >> 4; qb = 32 * (k >> 1) + ((k & 1) ? 31 - s : s);
        }
        attn_unit(p, lds, bg / NGRP, bg % NGRP, qb, m0c, m0s, m0w, tid, wave, lane);
    }
}

#ifndef CPU_EMU
#define GAS __attribute__((address_space(1)))
#define LAS __attribute__((address_space(3)))
#define XB_TMO      128
#define XB_XCNT(j)  (256  + 64 * (j))
#define XB_XSUB(j)  (1280 + 64 * (j))
#define XB_XGEN(j)  (2304 + 64 * (j))
#define XB_TOP      3328
#define XB_TOPGEN   3392
#define XCD_BAR_WORDS 3456
#define XB_SPIN_CAP (1u << 20)
__device__ __forceinline__ unsigned xb_ld(unsigned* p)              { return __hip_atomic_load(p, __ATOMIC_RELAXED, __HIP_MEMORY_SCOPE_AGENT); }
__device__ __forceinline__ unsigned xb_add(unsigned* p, unsigned v) { return __hip_atomic_fetch_add(p, v, __ATOMIC_RELAXED, __HIP_MEMORY_SCOPE_AGENT); }
__device__ __forceinline__ unsigned xb_xcc_id() { return (unsigned)__builtin_amdgcn_s_getreg((3 << 11) | 20) & 0xFu; }
#define XB_SPIN(cond, bar) do { unsigned _sp = 0; while (cond) { __builtin_amdgcn_s_sleep(1); \
    if ((++_sp & 255u) == 0u) { if (xb_ld(&(bar)[XB_TMO])) break; if (_sp > XB_SPIN_CAP) { atomicAdd(&(bar)[XB_TMO], 1u); break; } } } } while (0)
struct XcdBarrier { unsigned* bar; unsigned x; volatile LAS unsigned* st; };
__device__ __forceinline__ XcdBarrier xcd_barrier_post(unsigned* bar, volatile LAS unsigned* st) {
    XcdBarrier b; b.bar = bar; b.x = xb_xcc_id(); b.st = st;
    if (threadIdx.x == 0) (void)xb_add(&bar[XB_XCNT(b.x)], 1u);
    return b;
}
__device__ __forceinline__ void xcd_barrier_complete(unsigned* bar, unsigned x, unsigned& nloc, unsigned& nx) {
    const unsigned G = gridDim.x * gridDim.y * gridDim.z;
    unsigned sum, cnt, mine, sp = 0u;
    for (;;) {
        sum = 0u; cnt = 0u; mine = 0u;
#pragma unroll
        for (unsigned j = 0; j < 16; ++j) { const unsigned c = xb_ld(&bar[XB_XCNT(j)]); sum += c; cnt += (c > 0u) ? 1u : 0u; mine = (j == x) ? c : mine; }
        if (sum == G) break;
        __builtin_amdgcn_s_sleep(1);
        if ((++sp & 255u) == 0u) { if (xb_ld(&bar[XB_TMO])) break; if (sp > XB_SPIN_CAP) { atomicAdd(&bar[XB_TMO], 1u); break; } }
    }
    nloc = mine > 0u ? mine : 1u; nx = cnt > 0u ? cnt : 1u;
}
__device__ __forceinline__ void xcd_barrier(const XcdBarrier& b) {
    asm volatile("s_waitcnt vmcnt(0)" ::: "memory");
    __syncthreads();
    if (threadIdx.x == 0) {
        unsigned* bar = b.bar;
        __builtin_amdgcn_s_waitcnt(0);
        unsigned nloc = b.st[0], nx = b.st[1];
        if (nloc == 0u) { xcd_barrier_complete(bar, b.x, nloc, nx); b.st[0] = nloc; b.st[1] = nx; }
        const unsigned old = xb_add(&bar[XB_XSUB(b.x)], 1u);
        const unsigned gen = old / nloc;
        if (old + 1u == (gen + 1u) * nloc) {
            __builtin_amdgcn_fence(__ATOMIC_RELEASE, "agent");
            asm volatile("s_waitcnt vmcnt(0)" ::: "memory");
            const unsigned og = xb_add(&bar[XB_TOP], 1u);
            const unsigned tg = og / nx;
            if (og + 1u == (tg + 1u) * nx) xb_add(&bar[XB_TOPGEN], 1u);
            else XB_SPIN(xb_ld(&bar[XB_TOPGEN]) == tg, bar);
            __builtin_amdgcn_fence(__ATOMIC_ACQUIRE, "agent");
            xb_add(&bar[XB_XGEN(b.x)], 1u);
            asm volatile("s_waitcnt vmcnt(0)" ::: "memory");
        } else {
            XB_SPIN(xb_ld(&bar[XB_XGEN(b.x)]) == gen, bar);
            __builtin_amdgcn_fence(__ATOMIC_ACQUIRE, "agent");
            asm volatile("s_waitcnt vmcnt(0)" ::: "memory");
        }
    }
    __syncthreads();
}
#endif

#ifndef CPU_EMU
__device__ __forceinline__ void group_barrier(unsigned* cnt, unsigned target) {
    asm volatile("s_waitcnt vmcnt(0)" ::: "memory");
    __syncthreads();
    if (threadIdx.x == 0) {
        __builtin_amdgcn_fence(__ATOMIC_RELEASE, "agent");
        asm volatile("s_waitcnt vmcnt(0)" ::: "memory");
        (void)xb_add(cnt, 1u);
        unsigned sp = 0u;
        while (xb_ld(cnt) < target) { __builtin_amdgcn_s_sleep(1); if (++sp > (XB_SPIN_CAP << 4)) break; }
        __builtin_amdgcn_fence(__ATOMIC_ACQUIRE, "agent");
        asm volatile("s_waitcnt vmcnt(0)" ::: "memory");
    }
    __syncthreads();
}
constexpr size_t WS_GBAR = WS_CTL + 20480;
static_assert(WS_CTL + 4096 + XCD_BAR_WORDS * 4 <= WS_GBAR && WS_GBAR + 8 * 256 <= WS_CPOS, "group barrier words");
static_assert(WS_CTL + 4096 + XCD_BAR_WORDS * 4 <= WS_CPOS && WS_CPOS + 2048 <= WS_CTL + 32768 && 32768 + 64 <= CTL_ZERO_BYTES, "barrier words vs cpos");
#endif
constexpr int N_PHASES = 6;
__global__ void __launch_bounds__(512, 2) fwd_kernel(Params p) {
#ifdef CPU_EMU
    unsigned char* lds = emu_smem;
#else
    extern __shared__ __attribute__((aligned(16))) unsigned char lds[];
#endif
    const int tid = threadIdx.x, lane = tid & 63, wave = WAVE_ID();
    const int G = gridDim.x; const int bx = blockIdx.x; const int vcu = (G % 8 == 0) ? (bx % 8) * (G / 8) + bx / 8 : bx;
#ifndef CPU_EMU
    for (int u = tid; u < 64; u += 512) ((LAS unsigned*)(lds + MISC_OFF))[u] = 0u;
    __syncthreads();
    XcdBarrier bar; bar.bar = (unsigned*)(p.ws + WS_CTL) + 1024 + p.li * XCD_BAR_WORDS; bar.x = 0; bar.st = nullptr;
    if (p.ph_hi - p.ph_lo > 1) bar = xcd_barrier_post(bar.bar, (volatile LAS unsigned*)(lds + MISC_OFF) + 8);
#define GRID_BAR() xcd_barrier(bar)
    const bool grp_ok = (G == 256 && B_ == 8 && T_ == 8192);
    unsigned* gcnt = (unsigned*)(p.ws + WS_GBAR) + 64 * (bx & 7); unsigned gtgt = 0u;
#define GROUP_BAR() do { if (grp_ok) { gtgt += 32u; group_barrier(gcnt, gtgt); } else { xcd_barrier(bar); } } while (0)
#else
#define GRID_BAR() do { } while (0)
#define GROUP_BAR() do { } while (0)
#endif
    const int lo = p.ph_lo, hi = p.ph_hi;
#ifndef PHASE_MASK
#define PHASE_MASK 63
#endif
#define IN(k) (((PHASE_MASK >> (k)) & 1) && lo <= (k) && (k) < hi)
#define BOTH(k) (IN(k) && IN((k) + 1))
#ifndef REP_PHASE
#define REP_PHASE -1
#endif
#define REPS(k) for (int rep_ = 0; rep_ < ((k) == REP_PHASE ? 2 : 1); ++rep_)
    if (IN(0)) { REPS(0) { p0_prologue(p, lds, vcu, G, tid, wave, lane); __syncthreads(); } if (BOTH(0)) GRID_BAR(); }
    if (IN(1)) { REPS(1) p1_norm(p, vcu, G, wave, lane); if (BOTH(1)) GROUP_BAR(); }
    if (IN(2)) {
        constexpr int INGEMM = 2816;
#ifdef REP_INPROJ
        struct RepOrder { pg8::StaticOrder S; int cnt; __device__ bool next(int i, pg8::Unit& u) const { return S.next(i < cnt ? i : i - cnt, u) && i < 2 * cnt; } __device__ void a_ready(const pg8::Unit&) const {} __device__ void done(const pg8::Unit&) const {} };
        pg8::Gemm g{(const bf16_t*)(p.ws + WS_HN), (const bf16_t*)(p.ws + WS_WIN), M_, INGEMM, 1024}; RepOrder S; S.S.init(M_, INGEMM, G, bx); S.cnt = (S.S.nwg - bx + G - 1) / G;
#define INPROJ_ORDER RepOrder
#else
        pg8::Gemm g{(const bf16_t*)(p.ws + WS_HN), (const bf16_t*)(p.ws + WS_WIN), M_, INGEMM, 1024}; pg8::StaticOrder S; S.init(M_, INGEMM, G, bx);
#define INPROJ_ORDER pg8::StaticOrder
#endif
        EpiInProj E{p.ws, p.in[I_QNG], p.in[I_KSNG], p.in[I_KWNG]};
        pg8::gemm_phase<EpiInProj, INPROJ_ORDER, true, true>(PG8_PTR(lds), g, S, E);
        if (BOTH(2)) GROUP_BAR();
    }
    if (IN(3)) {
        REPS(3) for (int u = vcu; u < B_ * SSM_NG; u += G) ssm_unit(p, lds, u, tid, wave, lane);
        REPS(6) for (int u = vcu; u < CMP_UNITS; u += G) compress_unit(p, lds, u, tid, wave, lane);
        {
            const bool local = (G == 256 && B_ == 8);
            auto vt_of = [&](int k) -> int { if (local) { if (k >= VT_UNITS / 256) return -1; const int loc = (vcu & 31) + 32 * k; return ((vcu >> 5) * NGRP + (loc >> 7)) * (T_ / 64) + (loc & 127); }
                                               const int u = vcu + k * G; return u < VT_UNITS ? u : -1; };
            VtPre cur, nxt; int u = vt_of(0);
            if (u >= 0) vt_fetch(p, u, tid, cur);
            for (int k = 0; u >= 0; ++k) {
                const int un = vt_of(k + 1); nxt = cur;
                if (un >= 0) vt_fetch(p, un, tid, nxt);
                vt_unit(p, lds, u, tid, cur);
                cur = nxt; u = un;
            }
        }
        if (BOTH(3)) GROUP_BAR();
    }
    if (IN(4)) {
        REPS(4) p4_attention(p, lds, vcu, G, tid, wave, lane);
        pg8::Gemm g{(const bf16_t*)(p.ws + WS_YG), (const bf16_t*)(p.ws + WS_WGLU), M_, 512, 512}; pg8::StaticOrder S; S.init(M_, 512, G, bx);
        EpiGlu E{(const bf16_t*)(p.ws + WS_YG), (const bf16_t*)(p.ws + WS_ZS), (bf16_t*)(p.ws + WS_MIX), p.in[I_GLUB]};
        REPS(7) pg8::gemm_phase<EpiGlu, pg8::StaticOrder, true, true>(PG8_PTR(lds), g, S, E);
        if (BOTH(4)) GROUP_BAR();
    }
    if (IN(5)) {
        pg8::Gemm g{(const bf16_t*)(p.ws + WS_MIX), (const bf16_t*)(p.ws + WS_WO), M_, 1024, 1024}; pg8::StaticOrder S; S.init(M_, 1024, G, bx);
        EpiOut E{p.in[I_X], p.out, (const float*)(p.ws + WS_MOD)};
        REPS(5) pg8::gemm_phase<EpiOut, pg8::StaticOrder, true, true>(PG8_PTR(lds), g, S, E);
#ifdef PROBE_TIMING
        GRID_BAR();
        if (bx == 0 && tid == 0) { const float* tr = (const float*)(p.ws + WS_CTL + 32768); p.out[0] += tr[PROBE_WHICH] * 1e-3f; }
#endif
    }
#undef IN
#undef BOTH
}

extern "C" void kernel_launch(void* const* d_in, const int* in_sizes, int n_in, void* d_out, int out_size, void* d_ws, size_t ws_size, hipStream_t stream) {
    static int grid = 0;
    if (grid == 0) {
        if (n_in != N_IN || out_size != M_ * D_ || ws_size < WS_END) { fprintf(stderr, "kernel_launch: unexpected shapes (n_in %d out %d ws %zu need %zu)\n", n_in, out_size, ws_size, (size_t)WS_END); grid = -1; return; }
#ifdef CPU_EMU
        grid = EMU_GRID;
#else
        int dev = 0, cus = 0, per_cu = 0;
        if (hipGetDevice(&dev) != hipSuccess || hipDeviceGetAttribute(&cus, hipDeviceAttributeMultiprocessorCount, dev) != hipSuccess) { grid = -1; return; }
        if (hipFuncSetAttribute((const void*)fwd_kernel, hipFuncAttributeMaxDynamicSharedMemorySize, LDS_BYTES) != hipSuccess) { fprintf(stderr, "kernel_launch: hipFuncSetAttribute failed\n"); grid = -1; return; }
        if (hipOccupancyMaxActiveBlocksPerMultiprocessor(&per_cu, (const void*)fwd_kernel, 512, LDS_BYTES) != hipSuccess || per_cu < 1) { fprintf(stderr, "kernel_launch: occupancy query says %d blocks per CU\n", per_cu); per_cu = 1; }
        (void)hipGetLastError();
        grid = cus;
#endif
    }
    if (grid < 0) return;
    (void)hipMemsetAsync((char*)d_ws + WS_CTL, 0, CTL_ZERO_BYTES, stream);
    Params a{};
    for (int i = 0; i < N_IN; ++i) a.in[i] = (const float*)d_in[i];
    a.out = (float*)d_out; a.ws = (unsigned char*)d_ws;
    for (int li = 0; li < N_LAUNCH; ++li) {
        a.ph_lo = (N_LAUNCH == 1) ? 0 : li; a.ph_hi = (N_LAUNCH == 1) ? N_PHASES : li + 1; a.li = 0;
#ifdef CPU_EMU
        emu_launch((unsigned)grid, 512u, [&]() { fwd_kernel(a); });
#else
        hipLaunchKernelGGL(fwd_kernel, dim3(grid), dim3(512), LDS_BYTES, stream, a);
#endif
    }
}
```

```cpp
#ifndef CPU_EMU
#include <hip/hip_runtime.h>
#endif
#include <cstdio>
#include <cstdint>
#include <cmath>

#ifndef BATCH_N
#define BATCH_N 8
#endif
#ifndef SEQ_LEN
#define SEQ_LEN 8192
#endif
#ifndef N_LAUNCH
#define N_LAUNCH 1
#endif
#define DEV __device__ __forceinline__

typedef unsigned short bf16_t;
typedef short bf16x8 __attribute__((ext_vector_type(8)));
typedef float f32x4 __attribute__((ext_vector_type(4)));
typedef float f32x16 __attribute__((ext_vector_type(16)));
typedef float f32x2 __attribute__((ext_vector_type(2)));
typedef unsigned u32x4 __attribute__((ext_vector_type(4)));
typedef unsigned u32x2 __attribute__((ext_vector_type(2)));

constexpr int B_ = BATCH_N, T_ = SEQ_LEN, D_ = 1024, M_ = B_ * T_;
constexpr int NH = 8, HD = 64, NGRP = 2;
constexpr int NCMP = (T_ - 32) / 16 + 1;
constexpr int NCP = T_ / 16;
constexpr int NSB = T_ / 64;
constexpr int INW = 2840, INP = 3072;
constexpr int SSM_NG = 32, SSM_P = 64, SSM_C = 16, SSM_W = 512;
constexpr int SSM_L = 64;
constexpr int SSM_CG = 32;
constexpr int SSM_NCG = T_ / (SSM_L * SSM_CG);
constexpr float EPS_ = 1e-6f;
static_assert(T_ % 2048 == 0 && NSB <= 128, "shape assumptions");

enum { I_X = 0, I_C, I_WADA, I_BADA, I_NORMG, I_WIN, I_QNG, I_KCNG, I_KSNG, I_KWNG, I_POSK, I_POSV, I_W1K, I_W2K, I_W1V, I_W2V,
       I_ARE, I_AIM, I_LOGDT, I_BRE, I_BIM, I_CRE, I_CIM, I_SSMD, I_GLUW, I_GLUB, I_WOUT, N_IN };

constexpr size_t MiB = 1u << 20;
constexpr size_t al(size_t x) { return (x + MiB - 1) / MiB * MiB; }
constexpr size_t WS_CTL = 0, CTL_ZERO_BYTES = 64 * 1024;
constexpr size_t WS_MOD = 1 * MiB;
constexpr size_t WS_ROPE = WS_MOD + al((size_t)B_ * 3072 * 4);
constexpr size_t WS_CPOS = WS_CTL + 24576;
constexpr size_t WS_LAM64 = WS_ROPE + al((size_t)T_ * 64 * 4);
constexpr size_t WS_KT = WS_LAM64 + MiB;
constexpr size_t WS_WST = WS_KT + al((size_t)32 * 65 * 256 * 2);
constexpr size_t WS_WOUTS = WS_WST + al((size_t)32 * 128 * 1024 * 2);
constexpr size_t WS_WIN = WS_WOUTS + al((size_t)32 * 1024 * 128 * 2);
constexpr size_t WS_WO = WS_WIN + al((size_t)INP * 1024 * 2);
constexpr size_t WS_WGLU = WS_WO + al((size_t)1024 * 1024 * 2);
constexpr size_t WS_W1K = WS_WGLU + MiB, WS_W1V = WS_W1K + MiB;
constexpr size_t WS_W2K = WS_W1V + MiB, WS_W2V = WS_W2K + 64 * 1024;
constexpr size_t WS_KC = WS_W2K + MiB;
constexpr size_t WS_VC = WS_KC + al((size_t)B_ * NCP * 128 * 2);
constexpr size_t WS_G = WS_VC + al((size_t)B_ * NCP * 128 * 2);
constexpr size_t WS_HN = WS_G + al((size_t)M_ * 32 * 4);
constexpr size_t WS_Q = WS_HN + al((size_t)M_ * 1024 * 2);
constexpr size_t WS_QR = WS_Q + al((size_t)M_ * 512 * 2);
constexpr size_t WS_CR = WS_QR + al((size_t)M_ * 512 * 2);
constexpr size_t WS_SL = WS_CR + al((size_t)M_ * 256 * 2);
constexpr size_t WS_WN = WS_SL + al((size_t)M_ * 256 * 2);
constexpr size_t WS_ZA = WS_WN + al((size_t)M_ * 256 * 2);
constexpr size_t WS_U = WS_ZA + al((size_t)M_ * 512 * 2);
constexpr size_t WS_ZS = WS_U + al((size_t)M_ * 512 * 2);
constexpr size_t WS_YG = WS_ZS + al((size_t)M_ * 512 * 2);
constexpr size_t WS_MIX = WS_YG + al((size_t)M_ * 512 * 2);
constexpr size_t WS_VT = WS_MIX + al((size_t)M_ * 1024 * 2);
constexpr size_t WS_KF = WS_VT + al((size_t)M_ * 128 * 2);
constexpr size_t WS_END = WS_KF + al((size_t)M_ * 128 * 2);

constexpr int RING_BYTES = 131072;
constexpr int LDS_BYTES = 155648;
constexpr int MISC_OFF = LDS_BYTES - 256;

DEV unsigned f2bf(float f) { unsigned u = __builtin_bit_cast(unsigned, f); return (u + 0x7fffu + ((u >> 16) & 1u)) >> 16; }
DEV float bf2f(unsigned h) { return __builtin_bit_cast(float, h << 16); }
#ifdef CPU_EMU
DEV unsigned pk2(float lo, float hi) { return f2bf(lo) | (f2bf(hi) << 16); }
DEV float exp2_fast(float x) { return exp2f(x); }
DEV float rcp_fast(float x) { return 1.0f / x; }
DEV float log2_fast(float x) { return log2f(x); }
DEV int f2i_rn(float x) { return (int)floorf(x + 0.5f); }
DEV f32x4 mfma16(bf16x8 a, bf16x8 b, f32x4 c) { return emu_mfma16(a, b, c); }
DEV f32x16 mfma32(bf16x8 a, bf16x8 b, f32x16 c) { return emu_mfma32(a, b, c); }
#define WAVE_ID() ((int)(threadIdx.x >> 6))
#else
typedef __bf16 bf16x2_t __attribute__((ext_vector_type(2)));
DEV unsigned pk2(float lo, float hi) { f32x2 v = {lo, hi}; bf16x2_t b = __builtin_convertvector(v, bf16x2_t); return __builtin_bit_cast(unsigned, b); }
DEV float exp2_fast(float x) { return __builtin_amdgcn_exp2f(x); }
DEV float rcp_fast(float x) { return __builtin_amdgcn_rcpf(x); }
DEV float log2_fast(float x) { return __builtin_amdgcn_logf(x); }
DEV int f2i_rn(float x) { int r; asm("v_cvt_rpi_i32_f32 %0, %1" : "=v"(r) : "v"(x)); return r; }
DEV f32x4 mfma16(bf16x8 a, bf16x8 b, f32x4 c) { return __builtin_amdgcn_mfma_f32_16x16x32_bf16(a, b, c, 0, 0, 0); }
DEV f32x16 mfma32(bf16x8 a, bf16x8 b, f32x16 c) { return __builtin_amdgcn_mfma_f32_32x32x16_bf16(a, b, c, 0, 0, 0); }
#define WAVE_ID() (__builtin_amdgcn_readfirstlane((int)(threadIdx.x >> 6)))
#endif
#ifdef CPU_EMU
#define EXPF(x) expf(x)
#else
#define EXPF(x) __expf(x)
#endif
DEV float silu_f(float v) { return v * rcp_fast(1.0f + EXPF(-v)); }
DEV float sigmoid_f(float v) { return rcp_fast(1.0f + EXPF(-v)); }
DEV float gelu_tanh_f(float v) { const float u = 0.7978845608028654f * (v + 0.044715f * v * v * v); const float e = EXPF(2.0f * u); return v * (1.0f - rcp_fast(e + 1.0f)); }
DEV float wave_sum(float v) {
#pragma unroll
    for (int o = 1; o < 64; o <<= 1) v += __shfl_xor(v, o);
    return v;
}
DEV float wave_max(float v) {
#pragma unroll
    for (int o = 1; o < 64; o <<= 1) v = fmaxf(v, __shfl_xor(v, o));
    return v;
}
DEV bf16x8 ld8(const bf16_t* p) { return *(const bf16x8*)p; }
namespace pg8 {
#define PG8_LAS __attribute__((address_space(3)))
typedef unsigned short bf16_t;
typedef short bf16x8 __attribute__((ext_vector_type(8)));
typedef float f32x4 __attribute__((ext_vector_type(4)));
typedef unsigned u32x4 __attribute__((ext_vector_type(4)));
constexpr int BM = 256, BK = 64, HALF = 128, HTB = HALF * BK * 2  , STAGE_BYTES = 8 * HTB, NXCD = 8, WGM = 8;

__host__ __device__ __forceinline__ int lds_byte(int r, int c) { const int st = (r >> 4) * 2 + (c >> 5), rr = r & 15, cc = c & 31, ob = rr * 64 + cc * 2; return st * 1024 + (ob ^ (((ob >> 9) & 1) << 5)); }
__host__ __device__ __forceinline__ void stage_rc(int b, int& R, int& C) { const int st = b / 1024, sb = b % 1024, swz = sb ^ (((sb >> 9) & 1) << 5); R = (st >> 1) * 16 + swz / 64; C = (st & 1) * 32 + (swz % 64) / 2; }
__host__ __device__ __forceinline__ int perm32(int rho) { const int n = rho >> 4, i = rho & 15; return 8 * (i >> 2) + 4 * n + (i & 3); }

struct Unit { int pm, pn; };
struct Gemm { const bf16_t* A; const bf16_t* Bt; int M, N, K; };

struct StaticOrder {
    int nM, nN, nwg, G, c;
    __host__ __device__ void init(int M, int N, int G_, int c_) { nM = M / BM; nN = N / BM; nwg = nM * nN; G = G_; c = c_; }
    __host__ __device__ bool next(int i, Unit& u) const {
        const long L = (long)i * G + c; if (L >= nwg) return false;
        int wgid = (int)L; { const int q = nwg / NXCD, r = nwg % NXCD, xcd = wgid % NXCD, off = wgid / NXCD; wgid = (xcd < r ? xcd * (q + 1) : r * (q + 1) + (xcd - r) * q) + off; }
        const int nig = WGM * nN, gid = wgid / nig, fm = gid * WGM, gsz = (nM - fm) < WGM ? (nM - fm) : WGM;
        u.pm = fm + ((wgid % nig) % gsz); u.pn = (wgid % nig) / gsz; return true;
    }
    __device__ __forceinline__ void a_ready(const Unit&) const {}
    __device__ __forceinline__ void done(const Unit&) const {}
};

#ifndef CPU_EMU
__device__ __forceinline__ unsigned cvt_pk_bf16(float lo, float hi) { unsigned r; asm volatile("v_cvt_pk_bf16_f32 %0, %1, %2" : "=v"(r) : "v"(lo), "v"(hi)); return r; }
template <class Epi, class Sched, bool ALIGN_EPI = false, bool SP2 = false>
__device__ __forceinline__ void gemm_phase(PG8_LAS unsigned char* lds, const Gemm g, const Sched& S, const Epi& E) {
    const int tid = threadIdx.x, wid = __builtin_amdgcn_readfirstlane(tid >> 6), lane = tid & 63, wr = wid >> 2, wc = wid & 3, fr = lane & 15, fq = lane >> 4;
    const int K = g.K, nt = K / BK;
    unsigned voffA[2], voffB[2];
#pragma unroll
    for (int i = 0; i < 2; ++i) { int R, C; stage_rc(tid * 16 + i * 8192, R, C); const int Rb = Epi::PERM ? ((R & ~31) + perm32(R & 31)) : R;
        voffA[i] = (unsigned)(R * K + C) * 2u; voffB[i] = (unsigned)(Rb * K + C) * 2u; }
    const size_t kstep = (size_t)(BK * 2);
    const size_t hstep = (size_t)HALF * K * 2;
    const size_t tstep = 2 * hstep;
    const unsigned ldsw = (unsigned)wid * 1024u;
    const int aoff = lds_byte(wr * 64 + fr, fq * 8), boff = lds_byte(wc * 32 + fr, fq * 8);
#define PG8_SA(b, h) (((b) * 2 + (h)) * HTB)
#define PG8_SB(b, h) ((4 + (b) * 2 + (h)) * HTB)
#define PG8_STAGE(bufoff, gbase, voff) do { _Pragma("unroll") for (int _i = 0; _i < 2; ++_i) \
        __builtin_amdgcn_global_load_lds((const unsigned*)((const char*)(gbase) + (voff)[_i]), (PG8_LAS unsigned*)(lds + (bufoff) + ldsw + _i * 8192), 16, 0, 0); } while (0)
#define PG8_LDA(dst, b, h) do { _Pragma("unroll") for (int m = 0; m < 4; ++m) _Pragma("unroll") for (int k = 0; k < 2; ++k) dst[m][k] = *(const PG8_LAS bf16x8*)(lds + PG8_SA(b, h) + aoff + m * 2048 + k * 1024); } while (0)
#define PG8_LDB(dst, b, h) do { _Pragma("unroll") for (int n = 0; n < 2; ++n) _Pragma("unroll") for (int k = 0; k < 2; ++k) dst[n][k] = *(const PG8_LAS bf16x8*)(lds + PG8_SB(b, h) + boff + n * 2048 + k * 1024); } while (0)
#define PG8_MMA(ai, bj, At, Bt) do { __builtin_amdgcn_s_setprio(1); _Pragma("unroll") for (int m = 0; m < 4; ++m) _Pragma("unroll") for (int n = 0; n < 2; ++n) _Pragma("unroll") for (int k = 0; k < 2; ++k) \
        acc[ai][bj][m][n] = __builtin_amdgcn_mfma_f32_16x16x32_bf16(Bt[n][k], At[m][k], acc[ai][bj][m][n], 0, 0, 0); __builtin_amdgcn_s_setprio(0); } while (0)
#define PG8_WAIT_V(n) asm volatile("s_waitcnt vmcnt(" #n ")" ::: "memory")
#define PG8_WAIT_L(n) asm volatile("s_waitcnt lgkmcnt(" #n ")" ::: "memory")
#define PG8_BAR __builtin_amdgcn_s_barrier()
#define PG8_SCHED __builtin_amdgcn_sched_barrier(0)
    Unit cur, nxt; int ui = 0;
    if (!S.next(0, cur)) return;
    f32x4 acc[2][2][4][2];
#pragma unroll
    for (int a = 0; a < 2; ++a)
#pragma unroll
        for (int b = 0; b < 2; ++b)
#pragma unroll
            for (int m = 0; m < 4; ++m)
#pragma unroll
                for (int n = 0; n < 2; ++n) acc[a][b][m][n] = (f32x4){0.f, 0.f, 0.f, 0.f};
    bf16x8 At[4][2], B0[2][2], B1[2][2];
    const char* cA = (const char*)g.A + (size_t)cur.pm * tstep; const char* cB = (const char*)g.Bt + (size_t)cur.pn * tstep;
    S.a_ready(cur);
    if constexpr (SP2) {
        PG8_STAGE(PG8_SB(0, 0), cB, voffB); PG8_STAGE(PG8_SB(0, 1), cB + hstep, voffB); PG8_STAGE(PG8_SA(0, 0), cA, voffA); PG8_STAGE(PG8_SA(0, 1), cA + hstep, voffA);
        if (wr == 1) PG8_BAR;
        PG8_WAIT_V(2); PG8_BAR;
        PG8_STAGE(PG8_SB(1, 0), cB + kstep, voffB); PG8_STAGE(PG8_SA(1, 0), cA + kstep, voffA); PG8_STAGE(PG8_SB(1, 1), cB + hstep + kstep, voffB);
        PG8_WAIT_V(6); PG8_BAR;
    } else {
        PG8_STAGE(PG8_SB(0, 0), cB, voffB); PG8_STAGE(PG8_SA(0, 0), cA, voffA); PG8_STAGE(PG8_SB(0, 1), cB + hstep, voffB); PG8_STAGE(PG8_SA(0, 1), cA + hstep, voffA);
        if (wr == 1) PG8_BAR;
        PG8_WAIT_V(4); PG8_BAR;
        PG8_STAGE(PG8_SB(1, 0), cB + kstep, voffB); PG8_STAGE(PG8_SA(1, 0), cA + kstep, voffA); PG8_STAGE(PG8_SB(1, 1), cB + hstep + kstep, voffB);
        PG8_WAIT_V(6); PG8_BAR;
    }
    for (;;) {
        const bool has_next = S.next(ui + 1, nxt);
        const char* nA = has_next ? (const char*)g.A + (size_t)nxt.pm * tstep : cA; const char* nB = has_next ? (const char*)g.Bt + (size_t)nxt.pn * tstep : cB;
        for (int t = 0; t < nt; t += 2) {
            const bool last = (t == nt - 2);
            const char* a1 = cA + (size_t)(t + 1) * kstep;
            const char* a2 = last ? nA : cA + (size_t)(t + 2) * kstep; const char* b2 = last ? nB : cB + (size_t)(t + 2) * kstep;
            const char* a3 = a2 + kstep; const char* b3 = b2 + kstep;
            if (last && has_next) S.a_ready(nxt);
            if constexpr (SP2) {
            PG8_LDB(B0, 0, 0); PG8_LDB(B1, 0, 1); PG8_SCHED; PG8_LDA(At, 0, 0); PG8_STAGE(PG8_SA(1, 1), a1 + hstep, voffA);
            PG8_WAIT_V(8); PG8_WAIT_L(0); PG8_BAR; PG8_MMA(0, 0, At, B0); PG8_MMA(0, 1, At, B1); PG8_BAR; PG8_SCHED;
            PG8_LDA(At, 0, 1); PG8_STAGE(PG8_SB(0, 0), b2, voffB); PG8_STAGE(PG8_SB(0, 1), b2 + hstep, voffB); PG8_STAGE(PG8_SA(0, 0), a2, voffA);
            PG8_WAIT_V(8); PG8_WAIT_L(0); PG8_BAR; PG8_MMA(1, 0, At, B0); PG8_MMA(1, 1, At, B1); PG8_BAR; PG8_SCHED;
            PG8_LDB(B0, 1, 0); PG8_LDB(B1, 1, 1); PG8_SCHED; PG8_LDA(At, 1, 0); PG8_STAGE(PG8_SA(0, 1), a2 + hstep, voffA);
            PG8_WAIT_V(8); PG8_WAIT_L(0); PG8_BAR; PG8_MMA(0, 0, At, B0); PG8_MMA(0, 1, At, B1); PG8_BAR; PG8_SCHED;
            PG8_LDA(At, 1, 1); PG8_STAGE(PG8_SB(1, 0), b3, voffB); PG8_STAGE(PG8_SB(1, 1), b3 + hstep, voffB); PG8_STAGE(PG8_SA(1, 0), a3, voffA);
            PG8_WAIT_V(8); PG8_WAIT_L(0); PG8_BAR; PG8_MMA(1, 0, At, B0); PG8_MMA(1, 1, At, B1); PG8_BAR; PG8_SCHED;
            } else {
            PG8_LDB(B0, 0, 0); PG8_SCHED; PG8_LDA(At, 0, 0); PG8_STAGE(PG8_SA(1, 1), a1 + hstep, voffA);
            PG8_WAIT_L(8); PG8_BAR; PG8_WAIT_L(0); PG8_MMA(0, 0, At, B0); PG8_BAR; PG8_SCHED;
            PG8_LDB(B1, 0, 1); PG8_STAGE(PG8_SB(0, 0), b2, voffB);
            PG8_BAR; PG8_WAIT_L(0); PG8_MMA(0, 1, At, B1); PG8_BAR;
            PG8_LDA(At, 0, 1); PG8_STAGE(PG8_SA(0, 0), a2, voffA);
            PG8_BAR; PG8_WAIT_L(0); PG8_MMA(1, 0, At, B0); PG8_BAR; PG8_SCHED;
            PG8_STAGE(PG8_SB(0, 1), b2 + hstep, voffB);
            PG8_WAIT_V(6); PG8_BAR; PG8_MMA(1, 1, At, B1); PG8_BAR;
            PG8_LDB(B0, 1, 0); PG8_SCHED; PG8_LDA(At, 1, 0); PG8_STAGE(PG8_SA(0, 1), a2 + hstep, voffA);
            PG8_WAIT_L(8); PG8_BAR; PG8_WAIT_L(0); PG8_MMA(0, 0, At, B0); PG8_BAR; PG8_SCHED;
            PG8_LDB(B1, 1, 1); PG8_STAGE(PG8_SB(1, 0), b3, voffB);
            PG8_BAR; PG8_WAIT_L(0); PG8_MMA(0, 1, At, B1); PG8_BAR;
            PG8_LDA(At, 1, 1); PG8_STAGE(PG8_SA(1, 0), a3, voffA);
            PG8_BAR; PG8_WAIT_L(0); PG8_MMA(1, 0, At, B0); PG8_BAR; PG8_SCHED;
            PG8_STAGE(PG8_SB(1, 1), b3 + hstep, voffB);
            PG8_WAIT_V(6); PG8_BAR; PG8_MMA(1, 1, At, B1); PG8_BAR;
            }
        }
        if constexpr (ALIGN_EPI) { if (wr == 0) PG8_BAR; }
        if constexpr (!Epi::AFTER_DRAIN) { E(acc, cur, wr, wc, fr, fq); S.done(cur); }
        if (!has_next) break;
#pragma unroll
        for (int a = 0; a < 2; ++a)
#pragma unroll
            for (int b = 0; b < 2; ++b)
#pragma unroll
                for (int m = 0; m < 4; ++m)
#pragma unroll
                    for (int n = 0; n < 2; ++n) acc[a][b][m][n] = (f32x4){0.f, 0.f, 0.f, 0.f};
        cur = nxt; cA = nA; cB = nB; ++ui;
        if constexpr (ALIGN_EPI) { if (wr == 1) PG8_BAR; }
    }
    PG8_WAIT_V(0);
    if constexpr (!ALIGN_EPI) { if (wr == 0) PG8_BAR; }
    PG8_BAR;
    if constexpr (Epi::AFTER_DRAIN) { E.fused(acc, cur, wr, wc, fr, fq, lds, wid, lane); S.done(cur); }
#undef PG8_SA
#undef PG8_SB
#undef PG8_STAGE
#undef PG8_LDA
#undef PG8_LDB
#undef PG8_MMA
#undef PG8_WAIT_V
#undef PG8_WAIT_L
#undef PG8_BAR
#undef PG8_SCHED
}
}
#define PG8_PTR(x) ((__attribute__((address_space(3))) unsigned char*)(x))
#else
template <class Epi, class Sched, bool ALIGN_EPI = false, bool SP2 = false>
inline void gemm_phase(unsigned char* lds, const Gemm g, const Sched& S, const Epi& E) {
    const int tid = threadIdx.x, wid = tid >> 6, lane = tid & 63, wr = wid >> 2, wc = wid & 3, fr = lane & 15, fq = lane >> 4;
    Unit cur;
    for (int ui = 0; S.next(ui, cur); ++ui) {
        f32x4 acc[2][2][4][2];
        for (int ai = 0; ai < 2; ++ai) for (int bj = 0; bj < 2; ++bj) for (int m = 0; m < 4; ++m) for (int n = 0; n < 2; ++n) for (int i = 0; i < 4; ++i) {
            const int row = 256 * cur.pm + 128 * ai + 64 * wr + 16 * m + fr;
            const int col = 256 * cur.pn + 128 * bj + 32 * wc + (Epi::PERM ? 8 * fq + 4 * n + i : 16 * n + 4 * fq + i);
            const bf16_t* a = g.A + (size_t)row * g.K; const bf16_t* b = g.Bt + (size_t)col * g.K; float s = 0.f;
            for (int k = 0; k < g.K; ++k) s += emu_bf2f(a[k]) * emu_bf2f(b[k]);
            acc[ai][bj][m][n][i] = s; }
        E(acc, cur, wr, wc, fr, fq);
    }
}
}
#define PG8_PTR(x) (x)
#endif
#ifdef CPU_EMU
#define WAVE_SYNC() emu_wave_sync()
#define SCHED_FENCE() do { } while (0)
#define LAUNDER_V(x) do { } while (0)
#define LDS_BARRIER() __syncthreads()
#else
#define LDS_BARRIER() do { asm volatile("s_waitcnt lgkmcnt(0)" ::: "memory"); __builtin_amdgcn_s_barrier(); asm volatile("" ::: "memory"); } while (0)
#define LAUNDER_V(x) asm volatile("" : "+v"(x))
#define WAVE_SYNC() asm volatile("s_waitcnt lgkmcnt(0)" ::: "memory")
#define SCHED_FENCE() __builtin_amdgcn_sched_barrier(0)
#endif

struct Params { const float* in[N_IN]; float* out; unsigned char* ws; int ph_lo, ph_hi, li, pad; };

constexpr float QSCALE = 0.125f * 1.4426950408889634f;
DEV void gates_rows(unsigned char* ws, size_t row0, int lane) {
    const int r = lane & 15, kq = lane >> 4;
    const bf16_t* HN = (const bf16_t*)(ws + WS_HN) + (row0 + r) * 1024 + 8 * kq;
    const bf16_t* WG = (const bf16_t*)(ws + WS_WIN) + (size_t)(2816 + r) * 1024 + 8 * kq;
    f32x4 acc[2][2];
#pragma unroll
    for (int rb = 0; rb < 2; ++rb)
#pragma unroll
        for (int cb = 0; cb < 2; ++cb) acc[rb][cb] = (f32x4){0.f, 0.f, 0.f, 0.f};
    bf16x8 hb[2][4][2], wb[2][4][2];
#define GU_LOAD(bt) do { _Pragma("unroll") for (int q = 0; q < 4; ++q) { const int s_ = 4 * (bt) + q; hb[(bt) & 1][q][0] = ld8(HN + 32 * s_); hb[(bt) & 1][q][1] = ld8(HN + 16 * 1024 + 32 * s_); \
        wb[(bt) & 1][q][0] = ld8(WG + 32 * s_); wb[(bt) & 1][q][1] = ld8(WG + 16 * 1024 + 32 * s_); } } while (0)
    GU_LOAD(0);
#pragma unroll
    for (int bt = 0; bt < 8; ++bt) {
        if (bt < 7) GU_LOAD(bt + 1);
        SCHED_FENCE();
#pragma unroll
        for (int q = 0; q < 4; ++q) {
            const bf16x8 h0 = hb[bt & 1][q][0], h1 = hb[bt & 1][q][1], w0 = wb[bt & 1][q][0], w1 = wb[bt & 1][q][1];
            acc[0][0] = mfma16(w0, h0, acc[0][0]); acc[0][1] = mfma16(w1, h0, acc[0][1]);
            acc[1][0] = mfma16(w0, h1, acc[1][0]); acc[1][1] = mfma16(w1, h1, acc[1][1]);
        }
        SCHED_FENCE();
    }
#undef GU_LOAD
    float* Gp = (float*)(ws + WS_G);
#pragma unroll
    for (int rb = 0; rb < 2; ++rb)
#pragma unroll
        for (int cb = 0; cb < 2; ++cb) { f32x4 o;
#pragma unroll
            for (int i = 0; i < 4; ++i) o[i] = sigmoid_f(acc[rb][cb][i]);
            *(f32x4*)(Gp + (row0 + 16 * rb + r) * 32 + 16 * cb + 4 * kq) = o; }
}

struct EpiInProj {
    static constexpr bool PERM = true, AFTER_DRAIN = false;
    unsigned char* ws; const float* qng; const float* ksng; const float* kwng;
    DEV void operator()(const f32x4 (&acc)[2][2][4][2], const pg8::Unit& u, int wr, int wc, int fr, int fq) const {
        const int pn = u.pn; const int row0 = u.pm * 256 + wr * 64 + fr;
        int kind; bf16_t* dst = nullptr; bf16_t* dst2 = nullptr; int pitch = 512, colb = 0; const float* gv = nullptr;
        if (pn < 2) { kind = 2; dst = (bf16_t*)(ws + WS_Q); dst2 = (bf16_t*)(ws + WS_QR); colb = (4 * pn + wc) * 64; gv = qng; }
        else if (pn == 2) { kind = 0; dst = (bf16_t*)(ws + WS_CR); pitch = 256; colb = wc * 64; }
        else if (pn == 3) { kind = wc < 2 ? 1 : 0; dst = (bf16_t*)(ws + WS_SL); pitch = 256; colb = wc * 64; gv = ksng; }
        else if (pn == 4) { kind = wc < 2 ? 1 : 0; dst = (bf16_t*)(ws + WS_WN); pitch = 256; colb = wc * 64; gv = kwng; }
        else if (pn < 7) { kind = 3; dst = (bf16_t*)(ws + WS_ZA); colb = (4 * (pn - 5) + wc) * 64; }
        else if (pn < 9) { kind = 0; dst = (bf16_t*)(ws + WS_U); colb = (4 * (pn - 7) + wc) * 64; }
        else if (pn < 11) { kind = 3; dst = (bf16_t*)(ws + WS_ZS); colb = (4 * (pn - 9) + wc) * 64; }
        else { kind = (wc == 0) ? 4 : 5; }
        if (kind == 5) return;
        float g1[8], g2[8];
        if (kind == 1 || kind == 2) {
#pragma unroll
            for (int i = 0; i < 8; ++i) { const float qs = (kind == 2) ? QSCALE : 1.0f; g1[i] = gv[8 * fq + i] * qs; g2[i] = gv[32 + 8 * fq + i] * qs; }
        }
        const float* rope = (const float*)(ws + WS_ROPE);
#pragma unroll
        for (int ai = 0; ai < 2; ++ai)
#pragma unroll
            for (int m = 0; m < 4; ++m) {
                const int row = row0 + ai * 128 + m * 16;
                float x1[8], x2[8];
#pragma unroll
                for (int i = 0; i < 4; ++i) { x1[i] = acc[ai][0][m][0][i]; x1[4 + i] = acc[ai][0][m][1][i]; x2[i] = acc[ai][1][m][0][i]; x2[4 + i] = acc[ai][1][m][1][i]; }
                if (kind == 4) {
                    float* G = (float*)(ws + WS_G) + (size_t)row * 32 + 8 * fq;
                    f32x4 o0, o1;
#pragma unroll
                    for (int i = 0; i < 4; ++i) { o0[i] = sigmoid_f(x1[i]); o1[i] = sigmoid_f(x1[4 + i]); }
                    *(f32x4*)G = o0; *(f32x4*)(G + 4) = o1;
                    continue;
                }
                if (kind == 1 || kind == 2) {
                    float ss = 0.f;
#pragma unroll
                    for (int i = 0; i < 8; ++i) ss += x1[i] * x1[i] + x2[i] * x2[i];
                    ss += __shfl_xor(ss, 16); ss += __shfl_xor(ss, 32);
                    const float rinv = rsqrtf(ss * (1.0f / 64.0f) + EPS_);
#pragma unroll
                    for (int i = 0; i < 8; ++i) { x1[i] = x1[i] * rinv * g1[i]; x2[i] = x2[i] * rinv * g2[i]; }
                    if (kind == 2) {
                        bf16_t* o = dst + (size_t)row * pitch + colb + 8 * fq;
                        *(u32x4*)o = (u32x4){pk2(x1[0], x1[1]), pk2(x1[2], x1[3]), pk2(x1[4], x1[5]), pk2(x1[6], x1[7])};
                        *(u32x4*)(o + 32) = (u32x4){pk2(x2[0], x2[1]), pk2(x2[2], x2[3]), pk2(x2[4], x2[5]), pk2(x2[6], x2[7])};
                    }
                    const int t = row % T_;
                    const float* cs = rope + (size_t)t * 32 + 8 * fq; const float* sn = cs + (size_t)T_ * 32;
                    const f32x4 c0 = *(const f32x4*)cs, c1 = *(const f32x4*)(cs + 4), s0 = *(const f32x4*)sn, s1 = *(const f32x4*)(sn + 4);
#pragma unroll
                    for (int i = 0; i < 8; ++i) { const float c = i < 4 ? c0[i & 3] : c1[i & 3], s = i < 4 ? s0[i & 3] : s1[i & 3]; const float a = x1[i], b = x2[i]; x1[i] = a * c - b * s; x2[i] = b * c + a * s; }
                } else if (kind == 3) {
#pragma unroll
                    for (int i = 0; i < 8; ++i) { x1[i] = silu_f(x1[i]); x2[i] = silu_f(x2[i]); }
                }
                bf16_t* o = (kind == 2 ? dst2 : dst) + (size_t)row * pitch + colb + 8 * fq;
                *(u32x4*)o = (u32x4){pk2(x1[0], x1[1]), pk2(x1[2], x1[3]), pk2(x1[4], x1[5]), pk2(x1[6], x1[7])};
                *(u32x4*)(o + 32) = (u32x4){pk2(x2[0], x2[1]), pk2(x2[2], x2[3]), pk2(x2[4], x2[5]), pk2(x2[6], x2[7])};
            }
    }
};

struct EpiGlu {
    static constexpr bool PERM = true, AFTER_DRAIN = false;
    const bf16_t* YG; const bf16_t* ZS; bf16_t* MIX; const float* glub;
    DEV void operator()(const f32x4 (&acc)[2][2][4][2], const pg8::Unit& u, int wr, int wc, int fr, int fq) const {
        const int row0 = u.pm * 256 + wr * 64 + fr, col0 = u.pn * 256 + wc * 32 + 8 * fq;
        f32x4 bv[2][2]; u32x4 ya[2][2], za[2][2];
#pragma unroll
        for (int bj = 0; bj < 2; ++bj) { bv[bj][0] = *(const f32x4*)(glub + col0 + bj * 128); bv[bj][1] = *(const f32x4*)(glub + col0 + bj * 128 + 4); }
#define EG_ROW(grp, mm) (row0 + (((grp) >> 1) & 1) * 128 + (2 * ((grp) & 1) + (mm)) * 16)
#define EG_COL(grp) (col0 + ((grp) >> 2) * 128)
#define EG_LOAD(grp) do { _Pragma("unroll") for (int mm = 0; mm < 2; ++mm) { ya[(grp) & 1][mm] = *(const u32x4*)(YG + (size_t)EG_ROW(grp, mm) * 512 + EG_COL(grp)); za[(grp) & 1][mm] = *(const u32x4*)(ZS + (size_t)EG_ROW(grp, mm) * 512 + EG_COL(grp)); } } while (0)
        EG_LOAD(0);
#pragma unroll
        for (int grp = 0; grp < 8; ++grp) {
            const int bj = grp >> 2, ai = (grp >> 1) & 1;
            if (grp < 7) EG_LOAD(grp + 1);
            SCHED_FENCE();
#pragma unroll
            for (int mm = 0; mm < 2; ++mm) {
                const int m = 2 * (grp & 1) + mm; const u32x4 yv = ya[grp & 1][mm], zv = za[grp & 1][mm];
                float o[8];
#pragma unroll
                for (int i = 0; i < 8; ++i) {
                    const float a = (i < 4 ? acc[ai][bj][m][0][i & 3] : acc[ai][bj][m][1][i & 3]) + (i < 4 ? bv[bj][0][i & 3] : bv[bj][1][i & 3]);
                    const unsigned yw = yv[i >> 1], zw = zv[i >> 1];
                    const float y = bf2f((i & 1) ? (yw >> 16) : (yw & 0xffffu)), z = bf2f((i & 1) ? (zw >> 16) : (zw & 0xffffu));
                    o[i] = y * sigmoid_f(a) * z;
                }
                *(u32x4*)(MIX + (size_t)EG_ROW(grp, mm) * 1024 + 512 + EG_COL(grp)) = (u32x4){pk2(o[0], o[1]), pk2(o[2], o[3]), pk2(o[4], o[5]), pk2(o[6], o[7])};
            }
            SCHED_FENCE();
        }
#undef EG_ROW
#undef EG_COL
#undef EG_LOAD
    }
};

struct EpiOut {
    static constexpr bool PERM = true, AFTER_DRAIN = false;
    const float* x; float* out; const float* mod;
    DEV void operator()(const f32x4 (&acc)[2][2][4][2], const pg8::Unit& u, int wr, int wc, int fr, int fq) const {
        const int row0 = u.pm * 256 + wr * 64 + fr, col0 = u.pn * 256 + wc * 32 + 8 * fq; const int b = (u.pm * 256) / T_;
        f32x4 gv[2][2], xa[2][2][2];
#pragma unroll
        for (int bj = 0; bj < 2; ++bj) { gv[bj][0] = *(const f32x4*)(mod + (size_t)b * 3072 + 2048 + col0 + bj * 128); gv[bj][1] = *(const f32x4*)(mod + (size_t)b * 3072 + 2048 + col0 + bj * 128 + 4); }
#define EO_OFF(grp, mm) ((size_t)(row0 + (((grp) >> 1) & 1) * 128 + (2 * ((grp) & 1) + (mm)) * 16) * 1024 + col0 + ((grp) >> 2) * 128)
#define EO_LOAD(grp) do { _Pragma("unroll") for (int mm = 0; mm < 2; ++mm) { xa[(grp) & 1][mm][0] = *(const f32x4*)(x + EO_OFF(grp, mm)); xa[(grp) & 1][mm][1] = *(const f32x4*)(x + EO_OFF(grp, mm) + 4); } } while (0)
        EO_LOAD(0);
#pragma unroll
        for (int grp = 0; grp < 8; ++grp) {
            const int bj = grp >> 2, ai = (grp >> 1) & 1;
            if (grp < 7) EO_LOAD(grp + 1);
            SCHED_FENCE();
#pragma unroll
            for (int mm = 0; mm < 2; ++mm) {
                const int m = 2 * (grp & 1) + mm;
                *(f32x4*)(out + EO_OFF(grp, mm)) = xa[grp & 1][mm][0] + gv[bj][0] * acc[ai][bj][m][0];
                *(f32x4*)(out + EO_OFF(grp, mm) + 4) = xa[grp & 1][mm][1] + gv[bj][1] * acc[ai][bj][m][1];
            }
            SCHED_FENCE();
        }
#undef EO_OFF
#undef EO_LOAD
    }
};

DEV size_t frag_idx(int row, int k, int K) { return ((size_t)((row >> 4) * (K >> 5) + (k >> 5)) * 64 + 16 * ((k >> 3) & 3) + (row & 15)) * 8 + (k & 7); }
DEV void tr_item(const float* W, int Nsrc, int K, int k0, int col0, int nvalid, bf16_t* WT, int drow0, float* scr, int lane, bool frag = false) {
    const int c = lane & 31;
#pragma unroll 8
    for (int i = 0; i < 32; ++i) { const int kk = 2 * i + (lane >> 5); scr[kk * 33 + c] = (c < nvalid) ? W[(size_t)(k0 + kk) * Nsrc + col0 + c] : 0.f; }
    WAVE_SYNC();
    const int c8 = lane & 7;
#pragma unroll
    for (int j = 0; j < 4; ++j) { const int n = (lane >> 3) + 8 * j; const float* s = scr + (8 * c8) * 33 + n;
        u32x4 o; o.x = pk2(s[0 * 33], s[1 * 33]); o.y = pk2(s[2 * 33], s[3 * 33]); o.z = pk2(s[4 * 33], s[5 * 33]); o.w = pk2(s[6 * 33], s[7 * 33]);
        const int row = drow0 + n, k8 = (k0 >> 3) + c8;
        *(u32x4*)(WT + (frag ? ((size_t)((row >> 4) * (K >> 5) + (k8 >> 2)) * 64 + 16 * (k8 & 3) + (row & 15)) * 8 : (size_t)row * K + k0 + 8 * c8)) = o; }
    WAVE_SYNC();
}

DEV void p0_prologue(const Params& p, unsigned char* lds, int vcu, int G, int tid, int wave, int lane) {
    unsigned char* ws = p.ws;
    {
        const float* c = p.in[I_C]; const float* w = p.in[I_WADA]; const float* ba = p.in[I_BADA]; float* mod = (float*)(ws + WS_MOD);
        for (int cb = vcu; cb < 256; cb += G)
            for (int b = wave; b < B_; b += 8) {
                float a[12];
#pragma unroll
                for (int j = 0; j < 12; ++j) a[j] = 0.f;
#pragma unroll 8
                for (int i = 0; i < 16; ++i) {
                    const int k = lane + 64 * i; const float s = silu_f(c[b * 1024 + k]);
                    const f32x4* wp = (const f32x4*)(w + (size_t)k * 3072 + 12 * cb); const f32x4 w0 = wp[0], w1 = wp[1], w2 = wp[2];
#pragma unroll
                    for (int j = 0; j < 4; ++j) { a[j] += s * w0[j]; a[4 + j] += s * w1[j]; a[8 + j] += s * w2[j]; }
                }
#pragma unroll
                for (int j = 0; j < 12; ++j) a[j] = wave_sum(a[j]);
                if (lane == 0) {
#pragma unroll
                    for (int j = 0; j < 12; ++j) mod[b * 3072 + 12 * cb + j] = a[j] + ba[12 * cb + j];
                }
            }
    }
    {
        float* scr = (float*)(lds + wave * 16384);
        const int gw = vcu * 8 + wave, NGW = G * 8;
        constexpr int I_IN = 96 * 16, I_O = 32 * 16, I_GL = 16 * 8, I_W1 = 8 * 32, I_W2 = 2 * 4;
        constexpr int NIT = I_IN + I_O + I_GL + 2 * I_W1 + 2 * I_W2;
        for (int it = gw; it < NIT; it += NGW) {
            int r = it;
            if (r < I_IN) {
                const int ci = r / 16, kb = r % 16, n0 = 32 * ci, pn = n0 >> 8, bj = (n0 >> 7) & 1, wc = (n0 >> 5) & 3, L0 = 256 * pn + 64 * wc + 32 * bj;
                int oc, nv; if (L0 < 1792) { oc = L0; nv = 32; } else if (L0 < 2816) { oc = L0 + 24; nv = 32; } else if (L0 == 2816) { oc = 1792; nv = 24; } else { oc = 0; nv = 0; }
                tr_item(p.in[I_WIN], INW, 1024, 64 * kb, oc, nv, (bf16_t*)(ws + WS_WIN), n0, scr, lane); continue; }
            r -= I_IN;
            if (r < I_O) { tr_item(p.in[I_WOUT], 1024, 1024, 64 * (r % 16), 32 * (r / 16), 32, (bf16_t*)(ws + WS_WO), 32 * (r / 16), scr, lane); continue; }
            r -= I_O;
            if (r < I_GL) { tr_item(p.in[I_GLUW], 512, 512, 64 * (r % 8), 32 * (r / 8), 32, (bf16_t*)(ws + WS_WGLU), 32 * (r / 8), scr, lane); continue; }
            r -= I_GL;
            if (r < I_W1) { tr_item(p.in[I_W1K], 256, 2048, 64 * (r % 32), 32 * (r / 32), 32, (bf16_t*)(ws + WS_W1K), 32 * (r / 32), scr, lane, true); continue; }
            r -= I_W1;
            if (r < I_W1) { tr_item(p.in[I_W1V], 256, 2048, 64 * (r % 32), 32 * (r / 32), 32, (bf16_t*)(ws + WS_W1V), 32 * (r / 32), scr, lane, true); continue; }
            r -= I_W1;
            if (r < I_W2) { tr_item(p.in[I_W2K], 64, 256, 64 * (r % 4), 32 * (r / 4), 32, (bf16_t*)(ws + WS_W2K), 32 * (r / 4), scr, lane); continue; }
            r -= I_W2;
            tr_item(p.in[I_W2V], 64, 256, 64 * (r % 4), 32 * (r / 4), 32, (bf16_t*)(ws + WS_W2V), 32 * (r / 4), scr, lane);
        }
    }
    {
        const float H1[32] = {2.037182617e+01f, 1.527673340e+01f, 1.145593262e+01f, 8.590698242e+00f, 6.442138672e+00f, 4.830932617e+00f, 3.622680664e+00f, 2.716613770e+00f, 2.037170410e+00f, 1.527679443e+00f, 1.145599365e+00f, 8.590698242e-01f, 6.442108154e-01f, 4.830932617e-01f, 3.622665405e-01f, 2.716636658e-01f, 2.037181854e-01f, 1.527671814e-01f, 1.145591736e-01f, 8.590698242e-02f, 6.442165375e-02f, 4.830932617e-02f, 3.622674942e-02f, 2.716636658e-02f, 2.037191391e-02f, 1.527667046e-02f, 1.145589352e-02f, 8.590698242e-03f, 6.442129612e-03f, 4.830896854e-03f, 3.622680902e-03f, 2.716630697e-03f};
        const float L1[32] = {6.543887594e-06f, -1.416575378e-05f, -9.063650396e-06f, 3.259562436e-05f, 4.341966076e-07f, -9.333384696e-06f, 3.694024997e-07f, 1.383195467e-05f, 1.289177635e-05f, -7.611160072e-06f, -7.100949915e-06f, 3.214027856e-06f, 3.140712124e-06f, -1.001640385e-06f, 1.570408244e-06f, -8.980337611e-07f, 1.371793559e-07f, 1.700163388e-08f, 6.043357104e-08f, 3.195055172e-07f, -2.581333831e-07f, -9.542085166e-08f, 6.167339706e-08f, -9.075201035e-08f, -8.022654185e-08f, 4.843524337e-08f, 2.941089683e-08f, 3.325492770e-08f, 9.949448376e-09f, 2.627999152e-08f, 1.475850692e-10f, -2.996157100e-09f};
        const float H2[32] = {1.591548920e-01f, 1.193494797e-01f, 8.949947357e-02f, 6.711483002e-02f, 5.032920837e-02f, 3.774166107e-02f, 2.830219269e-02f, 2.122354507e-02f, 1.591539383e-02f, 1.193499565e-02f, 8.949995041e-03f, 6.711483002e-03f, 5.032896996e-03f, 3.774166107e-03f, 2.830207348e-03f, 2.122372389e-03f, 1.591548324e-03f, 1.193493605e-03f, 8.949935436e-04f, 6.711483002e-04f, 5.032941699e-04f, 3.774166107e-04f, 2.830214798e-04f, 2.122372389e-04f, 1.591555774e-04f, 1.193489879e-04f, 8.949916810e-05f, 6.711483002e-05f, 5.032913759e-05f, 3.774138168e-05f, 2.830219455e-05f, 2.122367732e-05f};
        const float L2[32] = {5.112412182e-08f, -1.106699514e-07f, -7.080976872e-08f, 2.546533153e-07f, 3.392160997e-09f, -7.291706794e-08f, 2.885957029e-09f, 1.080621459e-07f, 1.007170027e-07f, -5.946218806e-08f, -5.547617121e-08f, 2.510959263e-08f, 2.453681347e-08f, -7.825315507e-09f, 1.226881441e-08f, -7.015888759e-09f, 1.071713718e-09f, 1.328252647e-10f, 4.721372737e-10f, 2.496136853e-09f, -2.016667056e-09f, -7.454754036e-10f, 4.818234145e-10f, -7.090000809e-10f, -6.267698582e-10f, 3.784003388e-10f, 2.297726315e-10f, 2.598041227e-10f, 7.773006544e-11f, 2.053124337e-10f, 1.153008353e-12f, -2.340747735e-11f};
        float* rc = (float*)(ws + WS_ROPE); float* rs = rc + (size_t)T_ * 32;
        for (int i = vcu * 512 + tid; i < T_ * 32; i += G * 512) {
            const int t = i >> 5, d = i & 31; const float th = (float)(t >> 7), tl = (float)(t & 127);
            const float a = th * H1[d], c = tl * H2[d];
            float rev = (a - floorf(a)) + (c - floorf(c)) + (th * L1[d] + tl * L2[d]);
            rev -= floorf(rev);
#ifdef CPU_EMU
            rc[i] = cosf(6.283185307179586f * rev); rs[i] = sinf(6.283185307179586f * rev);
#else
            rc[i] = __builtin_amdgcn_cosf(rev); rs[i] = __builtin_amdgcn_sinf(rev);
#endif
        }
    }
    __syncthreads();
    {
        f32x2* lp = (f32x2*)lds;
        f32x2* bb = lp + 64;
        f32x2* cc = bb + 1024;
        f32x2* ee = cc + 1024;
        for (int it = vcu; it < 32 * 13 + 32; it += G) {
            if (it >= 32 * 13) {
                const int r = it - 32 * 13, kv = r >> 4, ks = r & 15; const float* pos = p.in[kv ? I_POSV : I_POSK]; const float* w1 = p.in[kv ? I_W1V : I_W1K];
                const int j = tid & 255, i0 = 128 * ks + 64 * (tid >> 8); float a = 0.f;
#pragma unroll 16
                for (int i = i0; i < i0 + 64; ++i) a += pos[i] * w1[(size_t)i * 256 + j];
                atomicAdd((unsigned*)(ws + WS_CPOS) + kv * 256 + j, (unsigned)(int)__builtin_rintf(a * 16777216.0f));
                continue;
            }
            const int g = it / 13, nb = it % 13;
            const float dt = expf(p.in[I_LOGDT][g]);
            for (int e = tid; e < 1024; e += 512) {
                const int pp = e >> 4, ci = e & 15;
                const float ar = p.in[I_ARE][g * 64 + pp], ai = p.in[I_AIM][g * 64 + pp], x = ar * dt, y = ai * dt;
                const float em1 = expm1f(x), ex = em1 + 1.0f, cy = cosf(y), sy = sinf(y), sh = sinf(0.5f * y);
                const float lr = em1 * cy - 2.0f * sh * sh, li = ex * sy;
                const float den = ar * ar + ai * ai, fr_ = (lr * ar + li * ai) / den, fi_ = (li * ar - lr * ai) / den;
                const float br = p.in[I_BRE][(g * 64 + pp) * 16 + ci], bi = p.in[I_BIM][(g * 64 + pp) * 16 + ci];
                bb[e] = (f32x2){fr_ * br - fi_ * bi, fr_ * bi + fi_ * br};
                const int co = e >> 6, p2 = e & 63;
                cc[e] = (f32x2){p.in[I_CRE][(g * 16 + co) * 64 + p2], p.in[I_CIM][(g * 16 + co) * 64 + p2]};
            }
            for (int n = 5 * nb; n < 5 * nb + 5; ++n) {
                if (tid < 64) {
                    const float ar = p.in[I_ARE][g * 64 + tid], ai = p.in[I_AIM][g * 64 + tid];
                    const float mag = expf(ar * dt * (float)n), ang = ai * dt * (float)n;
                    lp[tid] = (f32x2){mag * cosf(ang), mag * sinf(ang)};
                }
                __syncthreads();
                for (int e = tid; e < 1024; e += 512) { const f32x2 l = lp[e >> 4], b = bb[e]; ee[e] = (f32x2){l.x * b.x - l.y * b.y, l.x * b.y + l.y * b.x}; }
                __syncthreads();
                if (n < 64) {
                    bf16_t* KT = (bf16_t*)(ws + WS_KT) + (size_t)g * 65 * 256;
                    if (tid < 256) {
                        const int co = tid >> 4, ci = tid & 15; float a = 0.f;
                        for (int pp = 0; pp < 64; ++pp) { const f32x2 c = cc[co * 64 + pp], e = ee[pp * 16 + ci]; a += c.x * e.x - c.y * e.y; }
                        KT[(n + 1) * 256 + tid] = (bf16_t)f2bf(a);
                        if (n == 0) KT[tid] = 0;
                    }
                    bf16_t* WST = (bf16_t*)(ws + WS_WST) + (size_t)g * 128 * 1024; const int sidx = 63 - n;
                    for (int e = tid; e < 1024; e += 512) { const int pp = e >> 4, ci = e & 15; const f32x2 v = ee[e];
                        WST[frag_idx(pp, sidx * 16 + ci, 1024)] = (bf16_t)f2bf(v.x); WST[frag_idx(64 + pp, sidx * 16 + ci, 1024)] = (bf16_t)f2bf(v.y); }
                }
                if (n >= 1) {
                    bf16_t* WO = (bf16_t*)(ws + WS_WOUTS) + (size_t)g * 1024 * 128; const int t = n - 1;
                    for (int e = tid; e < 1024; e += 512) { const int co = e >> 6, pp = e & 63; const f32x2 c = cc[e], l = lp[pp];
                        WO[frag_idx(t * 16 + co, pp, 128)] = (bf16_t)f2bf(c.x * l.x - c.y * l.y); WO[frag_idx(t * 16 + co, 64 + pp, 128)] = (bf16_t)f2bf(-(c.x * l.y + c.y * l.x)); }
                }
                if (n == 64 && tid < 64) ((f32x2*)(ws + WS_LAM64))[g * 64 + tid] = lp[tid];
                __syncthreads();
            }
        }
    }
}

DEV void p1_norm(const Params& p, int vcu, int G, int wave, int lane) {
    const float* x = p.in[I_X]; const float* ng = p.in[I_NORMG]; const float* mod = (const float*)(p.ws + WS_MOD); bf16_t* HN = (bf16_t*)(p.ws + WS_HN);
    const int gw = vcu * 8 + wave, NGW = G * 8;
    constexpr int RB = 32;
    for (int it = gw; it < M_ / RB; it += NGW) {
        const int r0 = it * RB, b = r0 / T_;
        f32x4 cs[4], sh[4];
#pragma unroll
        for (int j = 0; j < 4; ++j) { const int k = 4 * lane + 256 * j; const f32x4 g = *(const f32x4*)(ng + k), sc = *(const f32x4*)(mod + (size_t)b * 3072 + 1024 + k);
            cs[j] = g * (sc + 1.0f); sh[j] = *(const f32x4*)(mod + (size_t)b * 3072 + k); }
        for (int r = r0; r < r0 + RB; ++r) {
            const f32x4* xr = (const f32x4*)(x + (size_t)r * 1024) + lane; f32x4 v[4]; float s = 0.f;
#pragma unroll
            for (int j = 0; j < 4; ++j) { v[j] = xr[64 * j]; s += (v[j].x * v[j].x + v[j].y * v[j].y) + (v[j].z * v[j].z + v[j].w * v[j].w); }
            const float rinv = rsqrtf(wave_sum(s) * (1.0f / 1024.0f) + EPS_);
            u32x2* o = (u32x2*)(HN + (size_t)r * 1024) + lane;
#pragma unroll
            for (int j = 0; j < 4; ++j) { const f32x4 h = v[j] * rinv * cs[j] + sh[j]; o[64 * j] = (u32x2){pk2(h.x, h.y), pk2(h.z, h.w)}; }
        }
#ifndef CPU_EMU
        asm volatile("s_waitcnt vmcnt(0)" ::: "memory");
#else
        emu_wave_sync();
#endif
        gates_rows(p.ws, (size_t)r0, lane);
    }
}

constexpr int UL_CH = 2064;
constexpr int SSM_UL = 0, SSM_KT = 32 * UL_CH, SSM_SLOC = SSM_KT + 65 * 256 * 2, SSM_CBT = SSM_SLOC + 128 * 32 * 4, SSM_END = SSM_CBT + 32 * 272;
static_assert(SSM_END <= RING_BYTES, "ssm lds");
DEV void ssm_unit(const Params& p, unsigned char* lds, int unit, int tid, int wave, int lane) {
    const int b = unit / SSM_NG, g = unit % SSM_NG; const int l16 = lane & 15, q4 = lane >> 4;
    unsigned char* ws = p.ws;
    const bf16_t* U = (const bf16_t*)(ws + WS_U); bf16_t* YG = (bf16_t*)(ws + WS_YG);
    const bf16_t* WST = (const bf16_t*)(ws + WS_WST) + (size_t)g * 128 * 1024; const bf16_t* WO = (const bf16_t*)(ws + WS_WOUTS) + (size_t)g * 1024 * 128;
    unsigned char* ul = lds + SSM_UL; bf16_t* ktl = (bf16_t*)(lds + SSM_KT); float* sloc = (float*)(lds + SSM_SLOC); bf16_t* cbt = (bf16_t*)(lds + SSM_CBT);
    { const u32x4* src = (const u32x4*)((const bf16_t*)(ws + WS_KT) + (size_t)g * 65 * 256); u32x4* dstv = (u32x4*)ktl; for (int i = tid; i < 65 * 256 * 2 / 16; i += 512) dstv[i] = src[i]; }
    float sre = 0.f, sim = 0.f; f32x2 lam = {0.f, 0.f};
    if (wave == 0) lam = ((const f32x2*)(ws + WS_LAM64))[g * 64 + lane];
    f32x4 dsk = *(const f32x4*)(p.in[I_SSMD] + 16 * g + 4 * q4);
    for (int cg = 0; cg < SSM_NCG; ++cg) {
        const size_t tokbase = (size_t)b * T_ + (size_t)cg * 2048;
#pragma unroll
        for (int i = 0; i < 8; ++i) { const int idx = tid + 512 * i, tok = idx >> 1, hf = idx & 1;
            *(u32x4*)(ul + (tok >> 6) * UL_CH + (tok & 63) * 32 + hf * 16) = *(const u32x4*)(U + (tokbase + tok) * 512 + 16 * g + 8 * hf); }
        __syncthreads();
        {
            f32x4 a1[2] = {(f32x4){0.f, 0.f, 0.f, 0.f}, (f32x4){0.f, 0.f, 0.f, 0.f}};
            const bf16_t* ap = WST + ((size_t)wave * 32 * 64 + lane) * 8;
            const unsigned char* bp = ul + l16 * UL_CH + (q4 >> 1) * 32 + (q4 & 1) * 16;
            bf16x8 aa[2][4];
#pragma unroll
            for (int q = 0; q < 4; ++q) aa[0][q] = ld8(ap + 512 * q);
#pragma unroll
            for (int kb = 0; kb < 8; ++kb) {
                if (kb < 7) {
#pragma unroll
                    for (int q = 0; q < 4; ++q) aa[(kb + 1) & 1][q] = ld8(ap + 512 * (4 * kb + 4 + q));
                }
                SCHED_FENCE();
#pragma unroll
                for (int q = 0; q < 4; ++q) { const int ks = 4 * kb + q;
                    const bf16x8 b0 = *(const bf16x8*)(bp + ks * 64), b1 = *(const bf16x8*)(bp + 16 * UL_CH + ks * 64);
                    a1[0] = mfma16(aa[kb & 1][q], b0, a1[0]); a1[1] = mfma16(aa[kb & 1][q], b1, a1[1]); }
                SCHED_FENCE();
            }
#pragma unroll
            for (int ct = 0; ct < 2; ++ct)
#pragma unroll
                for (int r = 0; r < 4; ++r) sloc[(16 * wave + 4 * q4 + r) * 32 + 16 * ct + l16] = a1[ct][r];
        }
        __syncthreads();
        if (wave == 0) {
            for (int c = 0; c < 32; ++c) {
                cbt[c * 136 + lane] = (bf16_t)f2bf(sre); cbt[c * 136 + 64 + lane] = (bf16_t)f2bf(sim);
                const float lr = sloc[lane * 32 + c], li = sloc[(64 + lane) * 32 + c];
                const float nr = lam.x * sre - lam.y * sim + lr, ni = lam.x * sim + lam.y * sre + li; sre = nr; sim = ni;
            }
        }
        __syncthreads();
        for (int i = 0; i < 8; ++i) {
            const int t = wave + 8 * i;
            f32x4 a3[2] = {(f32x4){0.f, 0.f, 0.f, 0.f}, (f32x4){0.f, 0.f, 0.f, 0.f}};
            const unsigned char* bp = ul + l16 * UL_CH + (q4 >> 1) * 32 + (q4 & 1) * 16;
            const bf16_t* kp = ktl + (t - (q4 >> 1) + 1) * 256 + l16 * 16 + 8 * (q4 & 1);
            const int nks = (t >> 1) + 1;
            const bf16_t* wp = WO + ((size_t)t * 4 * 64 + lane) * 8;
            bf16x8 wa[4];
#pragma unroll
            for (int ks = 0; ks < 4; ++ks) wa[ks] = ld8(wp + 512 * ks);
            {
                bf16x8 an = ld8(kp), b0n = *(const bf16x8*)(bp), b1n = *(const bf16x8*)(bp + 16 * UL_CH);
                for (int ks = 0; ks < nks; ++ks) {
                    const bf16x8 a = an, b0 = b0n, b1 = b1n;
                    const int kn = (ks + 1 < nks) ? ks + 1 : ks;
                    an = ld8(kp - kn * 512); b0n = *(const bf16x8*)(bp + kn * 64); b1n = *(const bf16x8*)(bp + 16 * UL_CH + kn * 64);
                    a3[0] = mfma16(a, b0, a3[0]); a3[1] = mfma16(a, b1, a3[1]);
                }
            }
#pragma unroll
            for (int ks = 0; ks < 4; ++ks) {
                const bf16x8 b0 = ld8(cbt + l16 * 136 + 32 * ks + 8 * q4), b1 = ld8(cbt + (16 + l16) * 136 + 32 * ks + 8 * q4);
                a3[0] = mfma16(wa[ks], b0, a3[0]); a3[1] = mfma16(wa[ks], b1, a3[1]);
            }
#pragma unroll
            for (int ct = 0; ct < 2; ++ct) {
                const int chunk = 16 * ct + l16; const size_t tok = tokbase + (size_t)chunk * 64 + t;
                const u32x2 uv = *(const u32x2*)(ul + chunk * UL_CH + t * 32 + 8 * q4);
                float y[4];
#pragma unroll
                for (int r = 0; r < 4; ++r) { const unsigned w = uv[r >> 1]; const float uu = bf2f((r & 1) ? (w >> 16) : (w & 0xffffu)); y[r] = gelu_tanh_f(a3[ct][r] + dsk[r] * uu); }
                *(u32x2*)(YG + tok * 512 + 16 * g + 4 * q4) = (u32x2){pk2(y[0], y[1]), pk2(y[2], y[3])};
            }
        }
        __syncthreads();
    }
}

constexpr int CMP_TOK = 0, CMP_H = 528 * 128, CMP_OUT = CMP_H + 32 * 528, CMP_END = CMP_OUT + 32 * 64 * 4;
static_assert(CMP_END <= RING_BYTES, "cmp lds");
constexpr int CMP_UNITS = 2 * B_ * NGRP * (NCP / 32);
DEV void compress_unit(const Params& p, unsigned char* lds, int unit, int tid, int wave, int lane) {
    int r = unit; const int nb = r % (NCP / 32); r /= (NCP / 32); const int g = r % NGRP; r /= NGRP; const int b = r % B_; const int kv = r / B_;
    const int l16 = lane & 15, q4 = lane >> 4; unsigned char* ws = p.ws;
    const bf16_t* CR = (const bf16_t*)(ws + WS_CR); const bf16_t* w1t = (const bf16_t*)(ws + (kv ? WS_W1V : WS_W1K)); const bf16_t* w2t = (const bf16_t*)(ws + (kv ? WS_W2V : WS_W2K));
    const float* cpos = (const float*)(ws + WS_CPOS) + kv * 256;
    unsigned char* tokl = lds + CMP_TOK; bf16_t* hl = (bf16_t*)(lds + CMP_H); float* outl = (float*)(lds + CMP_OUT);
    const int n0 = 32 * nb, tk0 = 16 * n0;
    for (int idx = tid; idx < 528 * 8; idx += 512) {
        const int tl = idx >> 3, ch = idx & 7; const int tok = tk0 + tl;
        u32x4 v = (u32x4){0u, 0u, 0u, 0u};
        if (tok < T_) v = *(const u32x4*)(CR + ((size_t)b * T_ + tok) * 256 + kv * 128 + g * 64 + 8 * ch);
        *(u32x4*)(tokl + (tl * 8 + (ch ^ ((tl >> 4) & 7))) * 16) = v;
    }
    __syncthreads();
    f32x4 acc[2][2];
#pragma unroll
    for (int a = 0; a < 2; ++a)
#pragma unroll
        for (int c = 0; c < 2; ++c) acc[a][c] = (f32x4){0.f, 0.f, 0.f, 0.f};
    const bf16_t* bp0 = w1t + ((size_t)(2 * wave) * 64 * 64 + lane) * 8; const bf16_t* bp1 = bp0 + (size_t)64 * 64 * 8;
    bf16x8 bb[2][4][2];
#pragma unroll
    for (int q = 0; q < 4; ++q) { bb[0][q][0] = ld8(bp0 + 512 * q); bb[0][q][1] = ld8(bp1 + 512 * q); }
#pragma unroll
    for (int kb = 0; kb < 16; ++kb) {
        if (kb < 15) {
#pragma unroll
            for (int q = 0; q < 4; ++q) { bb[(kb + 1) & 1][q][0] = ld8(bp0 + 512 * (4 * kb + 4 + q)); bb[(kb + 1) & 1][q][1] = ld8(bp1 + 512 * (4 * kb + 4 + q)); }
        }
        SCHED_FENCE();
#pragma unroll
        for (int q = 0; q < 4; ++q) { const int ks = 4 * kb + q;
            const int l = ks >> 1, chunk = 4 * (ks & 1) + q4;
            const int tl0 = 16 * l16 + l, tl1 = 16 * (16 + l16) + l;
            const bf16x8 a0 = *(const bf16x8*)(tokl + (tl0 * 8 + (chunk ^ ((tl0 >> 4) & 7))) * 16), a1 = *(const bf16x8*)(tokl + (tl1 * 8 + (chunk ^ ((tl1 >> 4) & 7))) * 16);
            const bf16x8 b0 = bb[kb & 1][q][0], b1 = bb[kb & 1][q][1];
            acc[0][0] = mfma16(a0, b0, acc[0][0]); acc[0][1] = mfma16(a0, b1, acc[0][1]); acc[1][0] = mfma16(a1, b0, acc[1][0]); acc[1][1] = mfma16(a1, b1, acc[1][1]); }
        SCHED_FENCE();
    }
#pragma unroll
    for (int rt = 0; rt < 2; ++rt)
#pragma unroll
        for (int ct = 0; ct < 2; ++ct) { const int j = 32 * wave + 16 * ct + l16; const float cp = (float)((const int*)cpos)[j] * (1.0f / 16777216.0f);
#pragma unroll
            for (int rr = 0; rr < 4; ++rr) hl[(16 * rt + 4 * q4 + rr) * 264 + j] = (bf16_t)f2bf(gelu_tanh_f(acc[rt][ct][rr] + cp)); }
    __syncthreads();
    {
        const int rt = wave >> 2, ct = wave & 3; f32x4 a2 = (f32x4){0.f, 0.f, 0.f, 0.f};
#pragma unroll
        for (int ks = 0; ks < 8; ++ks) { const bf16x8 a = ld8(hl + (16 * rt + l16) * 264 + 32 * ks + 8 * q4), bq = ld8(w2t + (size_t)(16 * ct + l16) * 256 + 32 * ks + 8 * q4); a2 = mfma16(a, bq, a2); }
#pragma unroll
        for (int rr = 0; rr < 4; ++rr) outl[(16 * rt + 4 * q4 + rr) * 64 + 16 * ct + l16] = a2[rr];
    }
    __syncthreads();
    {
        const int row = tid >> 4, c4 = tid & 15; f32x4 v = *(const f32x4*)(outl + row * 64 + 4 * c4);
        if (kv == 0) {
            float ss = v.x * v.x + v.y * v.y + v.z * v.z + v.w * v.w;
            ss += __shfl_xor(ss, 1); ss += __shfl_xor(ss, 2); ss += __shfl_xor(ss, 4); ss += __shfl_xor(ss, 8);
            const float rinv = rsqrtf(ss * (1.0f / 64.0f) + EPS_); const f32x4 gk = *(const f32x4*)(p.in[I_KCNG] + 4 * c4);
            v = v * rinv * gk;
        }
        const int n = n0 + row; if (n >= NCMP) v = (f32x4){0.f, 0.f, 0.f, 0.f};
        bf16_t* dst = (bf16_t*)(ws + (kv ? WS_VC : WS_KC)) + (((size_t)b * NCP + n) * NGRP + g) * 64 + 4 * c4;
        *(u32x2*)dst = (u32x2){pk2(v.x, v.y), pk2(v.z, v.w)};
    }
    __syncthreads();
}

constexpr int VT_UNITS = B_ * NGRP * (T_ / 64);
struct VtPre { u32x4 v, k; };
DEV void vt_fetch(const Params& p, int unit, int tid, VtPre& r) {
    const int tb = unit % (T_ / 64), bg = unit / (T_ / 64), b = bg / NGRP, g = bg % NGRP;
    const bf16_t* SLk = (const bf16_t*)(p.ws + WS_SL) + ((size_t)b * T_ + 64 * tb) * 256 + g * 64; const bf16_t* SLv = SLk + 128;
    { const int tok = tid >> 3, ch = tid & 7; r.v = *(const u32x4*)(SLv + (size_t)tok * 256 + 8 * ch); }
    {
      const int kt = tid >> 8, ks = (tid >> 6) & 3, h = (tid >> 5) & 1, r32 = tid & 31, kr = (r32 & ~12) | ((r32 & 8) >> 1) | ((r32 & 4) << 1);
      r.k = *(const u32x4*)(SLk + (size_t)(32 * kt + kr) * 256 + 16 * ks + 8 * h); }
}
DEV void vt_unit(const Params& p, unsigned char* lds, int unit, int tid, const VtPre& r) {
    const int tb = unit % (T_ / 64), bg = unit / (T_ / 64);
    bf16_t* VF = (bf16_t*)(p.ws + WS_VT) + ((size_t)bg * (T_ / 64) + tb) * 4096; bf16_t* KF = (bf16_t*)(p.ws + WS_KF) + ((size_t)bg * (T_ / 64) + tb) * 4096;
    bf16_t* tile = (bf16_t*)lds;
    { const int tok = tid >> 3, ch = tid & 7; *(u32x4*)(tile + tok * 72 + 8 * ch) = r.v; }
    *(u32x4*)(KF + tid * 8) = r.k;
    __syncthreads();
    { const int dim = tid >> 3, c8 = tid & 7; unsigned short e[8];
#pragma unroll
      for (int i = 0; i < 8; ++i) e[i] = tile[(8 * c8 + i) * 72 + dim];
      *(u32x4*)(VF + (((dim >> 5) * 4 + (c8 >> 1)) * 64 + 32 * (c8 & 1) + (dim & 31)) * 8) = (u32x4){(unsigned)e[0] | ((unsigned)e[1] << 16), (unsigned)e[2] | ((unsigned)e[3] << 16), (unsigned)e[4] | ((unsigned)e[5] << 16), (unsigned)e[6] | ((unsigned)e[7] << 16)}; }
    __syncthreads();
}

constexpr int AT_KB = 0, AT_VOFF = 128 * 160, AT_STAGE = 2 * AT_VOFF, AT_IA = 2 * AT_STAGE, AT_IB = AT_IA + 64 * 128 * 4, AT_SEL = AT_IB + 64 * 128 * 4, AT_TM = AT_SEL + 64 * 16, AT_END = AT_TM + 128 * 8;
constexpr int EN_QL = 0, EN_OL = 40960, EN_LL = EN_OL + 256 * 65 * 4, EN_END = EN_LL + 1024;
static_assert(EN_END + 16 * 512 * 4 <= AT_SEL && 256 * 72 * 2 <= EN_OL, "engine lds");
static_assert(AT_END <= MISC_OFF, "attn lds");
constexpr int AT_UNITS = B_ * NGRP * NSB;

#ifdef CPU_EMU
DEV int row16_sum(int v) { v += __shfl_xor(v, 8); v += __shfl_xor(v, 4); v += __shfl_xor(v, 2); v += __shfl_xor(v, 1); return v; }
DEV int row16_shr(int v, int n) { const int l = threadIdx.x & 63; const int r = __shfl(v, (l & 15) >= n ? l - n : l); return (l & 15) >= n ? r : 0; }
DEV float quad_sum(float v) { v += __shfl_xor(v, 1); v += __shfl_xor(v, 2); return v; }
DEV u32x2 lds_tr16(const bf16_t* p) {
    const int w = threadIdx.x >> 6, l = threadIdx.x & 63; const unsigned long long a = (unsigned long long)(uintptr_t)p;
    emu_xbuf[w][l][0] = (unsigned)a; emu_xbuf[w][l][1] = (unsigned)(a >> 32); emu_wave_sync();
    const int g = l >> 4, i = l & 15; unsigned short e[4];
    for (int q = 0; q < 4; ++q) { const int src = 16 * g + 4 * q + (i >> 2); const unsigned long long sa = (unsigned long long)emu_xbuf[w][src][0] | ((unsigned long long)emu_xbuf[w][src][1] << 32); e[q] = ((const unsigned short*)(uintptr_t)sa)[i & 3]; }
    emu_wave_sync();
    return (u32x2){(unsigned)e[0] | ((unsigned)e[1] << 16), (unsigned)e[2] | ((unsigned)e[3] << 16)};
}
#else
DEV int row16_sum(int v) {
    v += __builtin_amdgcn_update_dpp(0, v, 0x128, 0xF, 0xF, false); v += __builtin_amdgcn_update_dpp(0, v, 0x124, 0xF, 0xF, false);
    v += __builtin_amdgcn_update_dpp(0, v, 0x122, 0xF, 0xF, false); v += __builtin_amdgcn_update_dpp(0, v, 0x121, 0xF, 0xF, false); return v;
}
#define row16_shr(v, n) __builtin_amdgcn_update_dpp(0, (v), 0x110 + (n), 0xF, 0xF, true)
DEV float quad_sum(float v) {
    v += __builtin_bit_cast(float, __builtin_amdgcn_mov_dpp(__builtin_bit_cast(int, v), 0xB1, 0xF, 0xF, true));
    v += __builtin_bit_cast(float, __builtin_amdgcn_mov_dpp(__builtin_bit_cast(int, v), 0x4E, 0xF, 0xF, true));
    return v;
}
typedef short v4i16_t __attribute__((ext_vector_type(4)));
DEV u32x2 lds_tr16(const bf16_t* p) { return __builtin_bit_cast(u32x2, __builtin_amdgcn_ds_read_tr16_b64_v4i16((__attribute__((address_space(3))) v4i16_t*)p)); }
#endif

#ifdef PROBE_TIMING
#define TSTAMP(v) do { __builtin_amdgcn_sched_barrier(0); v = __builtin_amdgcn_s_memtime(); __builtin_amdgcn_s_waitcnt(0xC07F); __builtin_amdgcn_sched_barrier(0); } while (0)
#else
#define TSTAMP(v) do { } while (0)
#endif
#ifndef PROBE_MODE
#define PROBE_MODE -1
#endif
constexpr int ATS = 80;
template <int MODE>
DEV void attn_tile(const bf16_t* kb, const bf16_t* vb, int jt, const bf16x8 (&qf)[4], f32x16 (&oacc)[2], float& lsum, float linv, const f32x16& negm, int ttok,
                   unsigned long long slo, unsigned long long shi, int t0, int qb, float* impA, float* impB, int wave, int lane) {
    const float NINF = -INFINITY;
    const int c32 = lane & 31, h = lane >> 5, hg = lane & 3, tau = c32 >> 2;
    bool nm;
    if (MODE <= 1) nm = (16 * (64 * jt + 63) + 31 > t0);
    else if (MODE == 2) nm = (jt == qb);
    else nm = (jt == qb) || (jt + 8 == qb);
    f32x16 s[2];
    if (nm) {
        const float nm0 = negm[0];
        if (MODE == 3 && jt != qb) {
            const int d2 = ttok - 512 - 64 * jt - 4 * h;
#pragma unroll
            for (int kt = 0; kt < 2; ++kt) {
                f32x16 cm;
#pragma unroll
                for (int i = 0; i < 16; ++i) cm[i] = (32 * kt + (i & 3) + 8 * (i >> 2) > d2) ? nm0 : NINF;
                s[kt] = mfma32(ld8(kb + (32 * kt + c32) * ATS + 8 * h), qf[0], cm);
            }
        } else {
            const int d = ((MODE <= 1) ? ((ttok - 31) >> 4) : ttok) - 64 * jt - 4 * h;
#pragma unroll
            for (int kt = 0; kt < 2; ++kt) {
                f32x16 cm;
#pragma unroll
                for (int i = 0; i < 16; ++i) cm[i] = (32 * kt + (i & 3) + 8 * (i >> 2) <= d) ? nm0 : NINF;
                s[kt] = mfma32(ld8(kb + (32 * kt + c32) * ATS + 8 * h), qf[0], cm);
            }
        }
    } else {
#pragma unroll
        for (int kt = 0; kt < 2; ++kt) s[kt] = mfma32(ld8(kb + (32 * kt + c32) * ATS + 8 * h), qf[0], negm);
    }
#pragma unroll
    for (int kt = 0; kt < 2; ++kt)
#pragma unroll
        for (int ks = 1; ks < 4; ++ks) { const bf16x8 a = ld8(kb + (32 * kt + c32) * ATS + 16 * ks + 8 * h); s[kt] = mfma32(a, qf[ks], s[kt]); }
    float psum = 0.f;
#pragma unroll
    for (int kt = 0; kt < 2; ++kt)
#pragma unroll
        for (int i = 0; i < 16; ++i) { const float pv = exp2_fast(s[kt][i]); s[kt][i] = pv; psum += pv; }
    if (MODE != 1) lsum += psum;
    if (MODE == 1) {
#pragma unroll
        for (int kt = 0; kt < 2; ++kt)
#pragma unroll
            for (int gq = 0; gq < 4; ++gq) {
                const float a = quad_sum(2.0f * (s[kt][4 * gq] + s[kt][4 * gq + 1] + s[kt][4 * gq + 2]) + s[kt][4 * gq + 3]), bq = quad_sum(s[kt][4 * gq + 3]);
                if (hg == 0) { const int j = 16 * jt + 8 * kt + 2 * gq + h; const int tl = 8 * wave + tau; impA[tl * 128 + j] = a; impB[tl * 128 + j] = bq; }
            }
    }
    if (MODE != 0) {
        const int l15 = lane & 15, g1 = (lane >> 4) & 1;
#pragma unroll
        for (int kt = 0; kt < 2; ++kt)
#pragma unroll
            for (int sp = 0; sp < 2; ++sp) {
                u32x4 pw = (u32x4){pk2(s[kt][8 * sp], s[kt][8 * sp + 1]), pk2(s[kt][8 * sp + 2], s[kt][8 * sp + 3]), pk2(s[kt][8 * sp + 4], s[kt][8 * sp + 5]), pk2(s[kt][8 * sp + 6], s[kt][8 * sp + 7])};
                const bf16x8 pf = __builtin_bit_cast(bf16x8, pw);
                const bf16_t* vr = vb + (32 * kt + 16 * sp + 4 * h + (l15 >> 2)) * ATS + 16 * g1 + 4 * (l15 & 3);
#pragma unroll
                for (int dt = 0; dt < 2; ++dt) {
                    const u32x2 lo = lds_tr16(vr + 32 * dt), hi = lds_tr16(vr + 8 * ATS + 32 * dt);
                    oacc[dt] = mfma32(__builtin_bit_cast(bf16x8, (u32x4){lo.x, lo.y, hi.x, hi.y}), pf, oacc[dt]);
                }
            }
    }
}

DEV void at_preload(const bf16_t* Kg, const bf16_t* Vg, int pitch, int jlo, int jhi, int tid, u32x4 (&pk)[2], u32x4 (&pv)[2]) {
    const int key = tid >> 3, ch = tid & 7;
#pragma unroll
    for (int u = 0; u < 2; ++u) { const int jt = jlo + u; pk[u] = (u32x4){0u, 0u, 0u, 0u}; pv[u] = pk[u];
        if (jt <= jhi) { pk[u] = *(const u32x4*)(Kg + (size_t)(64 * jt + key) * pitch + 8 * ch); pv[u] = *(const u32x4*)(Vg + (size_t)(64 * jt + key) * pitch + 8 * ch); } }
}

template <int MODE, bool PRE = false>
DEV void attn_pass(const bf16_t* Kg, const bf16_t* Vg, int pitch, int jlo, int jhi, unsigned char* lds, const bf16x8 (&qf)[4], f32x16 (&oacc)[2], float& lsum, float linv,
                   float m0l, int ttok, unsigned long long slo, unsigned long long shi, int t0, int qb, int tid, int wave, int lane_, unsigned long long& tcomp, unsigned long long& tpass,
                   const u32x4* pk = nullptr, const u32x4* pv = nullptr) {
    unsigned long long tc0_ = 0, tc1_ = 0, tp0_ = 0, tp1_ = 0; TSTAMP(tp0_);
    LAUNDER_V(tid); const int lane = tid & 63; (void)lane_;
    const int key = tid >> 3, ch = tid & 7;
    float* impA = (float*)(lds + AT_IA); float* impB = (float*)(lds + AT_IB);
    const int nsteps = (jhi - jlo + 2) >> 1;
    const u32x4 Z4 = (u32x4){0u, 0u, 0u, 0u};
    f32x16 negm;
    float nm0_ = (MODE == 1) ? (log2_fast(linv) - m0l) : -m0l;
    LAUNDER_V(nm0_);
#pragma unroll
    for (int i = 0; i < 16; ++i) negm[i] = nm0_;
    u32x4 rk[2][2], rv[2][2];
#define AT_LOAD(set, st) do { _Pragma("unroll") for (int u_ = 0; u_ < 2; ++u_) { const int jt_ = jlo + 2 * (st) + u_; rk[set][u_] = Z4; rv[set][u_] = Z4; \
        if (jt_ <= jhi) { rk[set][u_] = *(const u32x4*)(Kg + (size_t)(64 * jt_ + key) * pitch + 8 * ch); if (MODE != 0) rv[set][u_] = *(const u32x4*)(Vg + (size_t)(64 * jt_ + key) * pitch + 8 * ch); } } } while (0)
#define AT_WRITE(set, stage) do { _Pragma("unroll") for (int u_ = 0; u_ < 2; ++u_) { *(u32x4*)(lds + AT_KB + (stage) * AT_STAGE + ((64 * u_ + key) * ATS + 8 * ch) * 2) = rk[set][u_]; \
        if (MODE != 0) *(u32x4*)(lds + AT_KB + (stage) * AT_STAGE + AT_VOFF + ((64 * u_ + key) * ATS + 8 * ch) * 2) = rv[set][u_]; } } while (0)
    if (PRE) { rk[0][0] = pk[0]; rk[0][1] = pk[1]; rv[0][0] = pv[0]; rv[0][1] = pv[1]; } else AT_LOAD(0, 0);
    AT_WRITE(0, 0);
    if (MODE != 2 && nsteps > 1) AT_LOAD(1, 1); else { rk[1][0] = Z4; rk[1][1] = Z4; rv[1][0] = Z4; rv[1][1] = Z4; }
    __syncthreads();
#define AT_COMPUTE(st) do { const int stage_ = (st) & 1; TSTAMP(tc0_); \
        _Pragma("unroll") for (int u = 0; u < 2; ++u) { const int jt = jlo + 2 * (st) + u; if (jt > jhi) break; \
            const bf16_t* kb = (const bf16_t*)(lds + AT_KB + stage_ * AT_STAGE) + 64 * ATS * u; const bf16_t* vb = (const bf16_t*)(lds + AT_KB + stage_ * AT_STAGE + AT_VOFF) + 64 * ATS * u; \
            attn_tile<MODE>(kb, vb, jt, qf, oacc, lsum, linv, negm, ttok, slo, shi, t0, qb, impA, impB, wave, lane); } TSTAMP(tc1_); if (MODE == PROBE_MODE) tcomp += tc1_ - tc0_; } while (0)
    for (int st = 0; st < nsteps; st += 2) {
        if (MODE != 2 && st + 2 < nsteps) AT_LOAD(0, st + 2);
        AT_COMPUTE(st);
        if (MODE != 2 && st + 1 < nsteps) AT_WRITE(1, 1);
        LDS_BARRIER();
        if (MODE == 2 || st + 1 >= nsteps) break;
        if (st + 3 < nsteps) AT_LOAD(1, st + 3);
        AT_COMPUTE(st + 1);
        if (st + 2 < nsteps) AT_WRITE(0, 0);
        LDS_BARRIER();
    }
#undef AT_LOAD
#undef AT_WRITE
#undef AT_COMPUTE
    TSTAMP(tp1_); if (MODE == PROBE_MODE) tpass += tp1_ - tp0_;
}

DEV unsigned char* en_tl(unsigned char* lds, int j) { return j <= 124 ? lds + AT_SEL + 64 * (j - 1) : lds + MISC_OFF + 160; }
static_assert(AT_SEL + 64 * 124 <= MISC_OFF, "token lists");

#ifndef SEL_KSH
#define SEL_KSH 12
#endif
DEV void attn_unit(const Params& p, unsigned char* lds, int b, int g, int qb, float m0c, float m0s, float m0w, int tid, int wave, int lane_) {
    LAUNDER_V(tid); const int lane = tid & 63; (void)lane_;
    unsigned char* ws = p.ws;
    const int c32 = lane & 31, h = lane >> 5, hg = lane & 3, tau = c32 >> 2; const int t0 = 64 * qb;
    const bf16_t* Q = (const bf16_t*)(ws + WS_Q); const bf16_t* QR = (const bf16_t*)(ws + WS_QR);
    const bf16_t* KC = (const bf16_t*)(ws + WS_KC) + (size_t)b * NCP * 128 + g * 64; const bf16_t* VC = (const bf16_t*)(ws + WS_VC) + (size_t)b * NCP * 128 + g * 64;
    const bf16_t* SL = (const bf16_t*)(ws + WS_SL) + (size_t)b * T_ * 256 + g * 64; const bf16_t* WN = (const bf16_t*)(ws + WS_WN) + (size_t)b * T_ * 256 + g * 64;
    const float* G = (const float*)(ws + WS_G);
    constexpr float LOG2E = 1.4426950408889634f;
    const int ttok = t0 + 8 * wave + tau; const size_t rowg = (size_t)b * T_ + ttok;
    const int hd = 4 * g + hg;
    bf16x8 qf[4]; f32x16 oacc[2], outa[2]; float lsum = 0.f, linv = 0.f; unsigned long long tcomp = 0, tpass = 0;
    unsigned long long slo = 0ull, shi = 0ull;
#pragma unroll
    for (int dt = 0; dt < 2; ++dt)
#pragma unroll
        for (int i = 0; i < 16; ++i) { oacc[dt][i] = 0.f; outa[dt][i] = 0.f; }
#pragma unroll
    for (int ks = 0; ks < 4; ++ks) qf[ks] = ld8(Q + rowg * 512 + hd * 64 + 16 * ks + 8 * h);
    const int ncmp = 4 * qb + 3;
    const int jhc = (ncmp - 1) >> 6;
#ifndef REP_CMP
#define REP_CMP 1
#endif
    for (int rep_ = 0; rep_ < REP_CMP; ++rep_) { lsum = 0.f;
    attn_pass<0>(KC, VC, 128, 0, jhc, lds, qf, oacc, lsum, linv, m0c * LOG2E, ttok, slo, shi, t0, qb, tid, wave, lane, tcomp, tpass); }
    { float L = lsum; L += __shfl_xor(L, 32); linv = L > 0.f ? 1.0f / L : 0.f; lsum = 0.f; }
    attn_pass<1>(KC, VC, 128, 0, jhc, lds, qf, oacc, lsum, linv, m0c * LOG2E, ttok, slo, shi, t0, qb, tid, wave, lane, tcomp, tpass);
    { const float gt = G[rowg * 32 + 3 * hd + 0];
#pragma unroll
        for (int dt = 0; dt < 2; ++dt)
#pragma unroll
            for (int i = 0; i < 16; ++i) { outa[dt][i] = oacc[dt][i] * gt; oacc[dt][i] = 0.f; } }
    {
        const float* impA = (const float*)(lds + AT_IA); const float* impB = (const float*)(lds + AT_IB); unsigned long long* sel = (unsigned long long*)(lds + AT_SEL);
        unsigned char* sel8 = (unsigned char*)sel;
        const int row16 = lane >> 4, i16 = lane & 15;
        {
            unsigned k[2][8], th[2] = {0u, 0u};
#pragma unroll
            for (int rnd = 0; rnd < 2; ++rnd) {
                const int tl = 8 * wave + 4 * rnd + row16; const float* ia = impA + tl * 128; const float* ib = impB + tl * 128;
                const f32x4 a0 = *(const f32x4*)(ia + 8 * i16), a1 = *(const f32x4*)(ia + 8 * i16 + 4), b0 = *(const f32x4*)(ib + 8 * i16), b1 = *(const f32x4*)(ib + 8 * i16 + 4);
                const float bm1 = ib[8 * i16 - 1];
#pragma unroll
                for (int c = 0; c < 8; ++c) { const int j = 8 * i16 + c;
                    const float av = c < 4 ? a0[c & 3] : a1[c & 3], bv = (c == 0) ? bm1 : (c <= 4 ? b0[(c - 1) & 3] : b1[(c - 5) & 3]);
                    const unsigned kv = (__builtin_bit_cast(unsigned, av + bv) >> SEL_KSH) + 1u;
                    k[rnd][c] = (j > qb) ? 0u : ((j == 0 || j == qb || j == qb - 1) ? (0x7f800000u >> SEL_KSH) + 1u : kv); }
            }
#pragma unroll 1
            for (int bit = 30 - SEL_KSH; bit >= 0; --bit) {
                const unsigned bm = 1u << bit;
#pragma unroll
                for (int rnd = 0; rnd < 2; ++rnd) {
                    const unsigned cand = th[rnd] | bm;
                    const int c01 = ((k[rnd][0] >= cand) ? 1 : 0) + ((k[rnd][1] >= cand) ? 1 : 0), c23 = ((k[rnd][2] >= cand) ? 1 : 0) + ((k[rnd][3] >= cand) ? 1 : 0);
                    const int c45 = ((k[rnd][4] >= cand) ? 1 : 0) + ((k[rnd][5] >= cand) ? 1 : 0), c67 = ((k[rnd][6] >= cand) ? 1 : 0) + ((k[rnd][7] >= cand) ? 1 : 0);
                    const int cnt = row16_sum((c01 + c23) + (c45 + c67));
                    th[rnd] = (cnt >= 16) ? cand : th[rnd];
                }
            }
#pragma unroll
            for (int rnd = 0; rnd < 2; ++rnd) {
                const int tl = 8 * wave + 4 * rnd + row16;
                int gt = 0, eq = 0;
#pragma unroll
                for (int c = 0; c < 8; ++c) { gt += (k[rnd][c] > th[rnd]) ? 1 : 0; eq += (k[rnd][c] == th[rnd]) ? 1 : 0; }
                const int need = (th[rnd] == 0u) ? 0 : 16 - row16_sum(gt);
                int pre = eq;
                { int t_ = row16_shr(pre, 1); pre += t_; t_ = row16_shr(pre, 2); pre += t_; t_ = row16_shr(pre, 4); pre += t_; t_ = row16_shr(pre, 8); pre += t_; }
                int run = pre - eq; unsigned bits = 0u;
#pragma unroll
                for (int c = 0; c < 8; ++c) {
                    if (k[rnd][c] > th[rnd]) bits |= 1u << c;
                    else if (k[rnd][c] == th[rnd]) { if (run < need) bits |= 1u << c; ++run; }
                }
                sel8[tl * 16 + i16] = (unsigned char)bits;
            }
        }
    }
    __syncthreads();
    {
        const unsigned long long* sel = (const unsigned long long*)(lds + AT_SEL);
        const unsigned long long mylo = sel[lane * 2], myhi = sel[lane * 2 + 1];
        __syncthreads();
        for (int jj = 0; jj < 16; ++jj) { const int j = 16 * wave + jj; if (j < 1 || j > 125) continue;
            const int bit = (int)(((j < 64) ? (mylo >> j) : (myhi >> (j - 64))) & 1ull); const unsigned long long m = __ballot(bit);
            unsigned char* tl = en_tl(lds, j);
            const int pos = __builtin_popcountll(m & ((1ull << lane) - 1ull)), cnt = __builtin_popcountll(m);
            if (bit) tl[pos] = (unsigned char)lane;
            if (lane < 16 && cnt + lane < 64) tl[cnt + lane] = 0xFFu; }
    }
    float* outl = (float*)(lds + AT_IA) + tid;
#pragma unroll
    for (int dt = 0; dt < 2; ++dt)
#pragma unroll
        for (int i = 0; i < 16; ++i) outl[(dt * 16 + i) * 512] = outa[dt][i];
#pragma unroll
    for (int ks = 0; ks < 4; ++ks) qf[ks] = ld8(QR + rowg * 512 + hd * 64 + 16 * ks + 8 * h);
#ifndef REP_WIN
#define REP_WIN 1
#endif
    for (int rep_ = 0; rep_ < REP_WIN; ++rep_)
    attn_pass<3>(WN, WN + 128, 256, qb >= 8 ? qb - 8 : 0, qb, lds, qf, oacc, lsum, linv, m0w * LOG2E, ttok, slo, shi, t0, qb, tid, wave, lane, tcomp, tpass);
    { float L = lsum; L += __shfl_xor(L, 32); const float sc = (L > 0.f ? 1.0f / L : 0.f) * G[rowg * 32 + 3 * hd + 2]; lsum = 0.f;
#pragma unroll
        for (int dt = 0; dt < 2; ++dt)
#pragma unroll
            for (int i = 0; i < 16; ++i) { outa[dt][i] = outl[(dt * 16 + i) * 512] + oacc[dt][i] * sc; oacc[dt][i] = 0.f; } }
    __syncthreads();
    {
        bf16_t* QL = (bf16_t*)(lds + EN_QL); float* OL = (float*)(lds + EN_OL); float* LL = (float*)(lds + EN_LL);
        float* outp = (float*)(lds + EN_END) + tid;
#pragma unroll
        for (int i = 0; i < 16; ++i) outp[i * 512] = outa[1][i];
        for (int i = tid; i < (EN_LL + 1024 - EN_OL) / 16; i += 512) ((u32x4*)(lds + EN_OL))[i] = (u32x4){0u, 0u, 0u, 0u};
        unsigned* qcnt = (unsigned*)(lds + MISC_OFF + 128);
        if (tid == 0) *qcnt = 0u;
#pragma unroll
        for (int k = 0; k < 4; ++k) { const int idx = tid + 512 * k, tok = idx >> 5, c = idx & 31;
            *(u32x4*)(QL + (tok * 4 + (c >> 3)) * 72 + (c & 7) * 8) = *(const u32x4*)(QR + ((size_t)b * T_ + t0 + tok) * 512 + g * 256 + c * 8); }
        __syncthreads();
        const bf16_t* VT = (const bf16_t*)(ws + WS_VT) + (size_t)(b * NGRP + g) * (T_ / 64) * 4096; const bf16_t* KF = (const bf16_t*)(ws + WS_KF) + (size_t)(b * NGRP + g) * (T_ / 64) * 4096;
        const int r32 = lane & 31, kr = (r32 & ~12) | ((r32 & 8) >> 1) | ((r32 & 4) << 1);
        const float cs0 = 17.0f - m0s * LOG2E;
#ifndef REP_SLC
#define REP_SLC 1
#endif
        for (;;) {
            unsigned tk_ = 0u; if (lane == 0) tk_ = atomicAdd(qcnt, 1u);
            tk_ = (unsigned)__shfl((int)tk_, 0);
#ifndef CPU_EMU
            tk_ = (unsigned)__builtin_amdgcn_readfirstlane((int)tk_);
#endif
            const int j = 1 + (int)tk_; if (j > qb - 2) break;
            const unsigned char* tl = en_tl(lds, j);
            int first = tl[0];
#ifndef CPU_EMU
            first = __builtin_amdgcn_readfirstlane(first);
#endif
            if (first == 0xFF) continue;
            bf16x8 kfr[2][4], vfr[2][4];
#pragma unroll
            for (int kt = 0; kt < 2; ++kt)
#pragma unroll
                for (int ks = 0; ks < 4; ++ks) kfr[kt][ks] = ld8(KF + (size_t)j * 4096 + ((kt * 4 + ks) * 64 + lane) * 8);
#pragma unroll
            for (int dt = 0; dt < 2; ++dt)
#pragma unroll
                for (int q = 0; q < 4; ++q) vfr[dt][q] = ld8(VT + (size_t)j * 4096 + ((dt * 4 + q) * 64 + lane) * 8);
            for (int gi = 0; gi < 8; ++gi) {
                const int tokidx = tl[8 * gi + tau];
                const bool valid = tokidx != 0xFF;
                if (!__any(valid)) break;
                const int ti = valid ? tokidx : 0; const int row = ti * 4 + hg;
                bf16x8 qg[4];
#pragma unroll
                for (int ks = 0; ks < 4; ++ks) qg[ks] = ld8(QL + row * 72 + 16 * ks + 8 * h);
                f32x16 s2[2];
#pragma unroll
                for (int kt = 0; kt < 2; ++kt) {
#pragma unroll
                    for (int i = 0; i < 16; ++i) s2[kt][i] = cs0;
#pragma unroll
                    for (int ks = 0; ks < 4; ++ks) s2[kt] = mfma32(kfr[kt][ks], qg[ks], s2[kt]);
                }
                float psum = 0.f;
#pragma unroll
                for (int kt = 0; kt < 2; ++kt)
#pragma unroll
                    for (int i = 0; i < 16; ++i) { const float pv = exp2_fast(s2[kt][i]); s2[kt][i] = pv; psum += pv; }
                u32x4 pw[4];
#pragma unroll
                for (int q = 0; q < 4; ++q) { const int kt = q >> 1, sp = q & 1;
                    pw[q] = (u32x4){pk2(s2[kt][8 * sp], s2[kt][8 * sp + 1]), pk2(s2[kt][8 * sp + 2], s2[kt][8 * sp + 3]), pk2(s2[kt][8 * sp + 4], s2[kt][8 * sp + 5]), pk2(s2[kt][8 * sp + 6], s2[kt][8 * sp + 7])}; }
                if (!__all(valid)) {
                    const unsigned pm = valid ? 0xffffffffu : 0u;
#pragma unroll
                    for (int q = 0; q < 4; ++q) { pw[q].x &= pm; pw[q].y &= pm; pw[q].z &= pm; pw[q].w &= pm; }
                }
                f32x16 o2[2];
#pragma unroll
                for (int dt = 0; dt < 2; ++dt) {
#pragma unroll
                    for (int i = 0; i < 16; ++i) o2[dt][i] = 0.f;
#pragma unroll
                    for (int q = 0; q < 4; ++q) o2[dt] = mfma32(vfr[dt][q], __builtin_bit_cast(bf16x8, pw[q]), o2[dt]);
                }
                psum += __shfl_xor(psum, 32);
                if (valid) {
                    unsigned* orow = (unsigned*)(OL + row * 65 + 4 * h);
#pragma unroll
                    for (int dt = 0; dt < 2; ++dt)
#pragma unroll
                        for (int i = 0; i < 16; ++i) atomicAdd(orow + 32 * dt + (i & 3) + 8 * (i >> 2), (unsigned)f2i_rn(o2[dt][i]));
                    if (h == 0) atomicAdd((unsigned*)(LL + row), (unsigned)f2i_rn(psum));
                }
            }
        }
        {
            const int key = tid >> 3, ch = tid & 7;
            const int nft = qb >= 2 ? 3 : qb + 1;
            u32x4 fk[3], fv[3];
#pragma unroll
            for (int u = 0; u < 3; ++u) { const int jt = (u == 0) ? 0 : (qb >= 2 ? qb - 2 + u : u); fk[u] = (u32x4){0u, 0u, 0u, 0u}; fv[u] = fk[u];
                if (u < nft) { fk[u] = *(const u32x4*)(SL + (size_t)(64 * jt + key) * 256 + 8 * ch); fv[u] = *(const u32x4*)(SL + 128 + (size_t)(64 * jt + key) * 256 + 8 * ch); } }
#pragma unroll
            for (int ks = 0; ks < 4; ++ks) qf[ks] = ld8(QR + rowg * 512 + hd * 64 + 16 * ks + 8 * h);
            __syncthreads();
            const int row = (8 * wave + tau) * 4 + hg;
            float Lf = (h == 0) ? (float)((const int*)LL)[row] : 0.f;
            f32x16 of[2];
            { const int* orow = (const int*)(OL + row * 65 + 4 * h);
#pragma unroll
              for (int dt = 0; dt < 2; ++dt)
#pragma unroll
                  for (int i = 0; i < 16; ++i) of[dt][i] = (float)orow[32 * dt + (i & 3) + 8 * (i >> 2)]; }
            __syncthreads();
#pragma unroll
            for (int u = 0; u < 3; ++u) { unsigned char* slot = lds + AT_KB + (u >> 1) * AT_STAGE + ((64 * (u & 1) + key) * ATS + 8 * ch) * 2;
                *(u32x4*)slot = fk[u]; *(u32x4*)(slot + AT_VOFF) = fv[u]; }
            f32x16 negm; float nm0_ = 17.0f - m0s * LOG2E; LAUNDER_V(nm0_);
#pragma unroll
            for (int i = 0; i < 16; ++i) negm[i] = nm0_;
            __syncthreads();
#pragma unroll 1
            for (int u = 0; u < nft; ++u) { const int jt = (u == 0) ? 0 : (qb >= 2 ? qb - 2 + u : u);
                const bf16_t* kb = (const bf16_t*)(lds + AT_KB + (u >> 1) * AT_STAGE) + 64 * ATS * (u & 1);
                attn_tile<2>(kb, kb + AT_VOFF / 2, jt, qf, of, Lf, linv, negm, ttok, 0ull, 0ull, t0, qb, (float*)(lds + AT_IA), (float*)(lds + AT_IB), wave, lane); }
            Lf += __shfl_xor(Lf, 32);
            const float sc = (Lf > 0.f ? 1.0f / Lf : 0.f) * G[rowg * 32 + 3 * hd + 1];
#pragma unroll
            for (int dt = 0; dt < 2; ++dt)
#pragma unroll
                for (int i = 0; i < 16; ++i) outa[dt][i] = (dt == 1 ? outp[i * 512] : outa[dt][i]) + of[dt][i] * sc;
        }
    }
    {
        const bf16_t* ZA = (const bf16_t*)(ws + WS_ZA); bf16_t* MIX = (bf16_t*)(ws + WS_MIX);
        unsigned char* stg = lds + EN_END + wave * 256;
        const int rr = lane >> 3, pc = lane & 7;
        u32x4 zr[4];
#pragma unroll
        for (int j = 0; j < 4; ++j) { const int r = 8 * j + rr; const size_t grow = (size_t)b * T_ + t0 + 8 * wave + (r >> 2);
            zr[j] = *(const u32x4*)(ZA + grow * 512 + (4 * g + (r & 3)) * 64 + 8 * pc); }
        WAVE_SYNC();
#pragma unroll
        for (int j = 0; j < 4; ++j) { const int r = 8 * j + rr; *(u32x4*)(stg + (r >> 1) * 2048 + (r & 1) * 128 + 16 * pc) = zr[j]; }
        WAVE_SYNC();
        unsigned char* myrow = stg + (c32 >> 1) * 2048 + (c32 & 1) * 128;
#pragma unroll
        for (int dt = 0; dt < 2; ++dt)
#pragma unroll
            for (int gq = 0; gq < 4; ++gq) {
                u32x2* slot = (u32x2*)(myrow + (32 * dt + 8 * gq + 4 * h) * 2); const u32x2 zv = *slot;
                float o[4];
#pragma unroll
                for (int r = 0; r < 4; ++r) { const unsigned w = zv[r >> 1]; o[r] = outa[dt][4 * gq + r] * bf2f((r & 1) ? (w >> 16) : (w & 0xffffu)); }
                *slot = (u32x2){pk2(o[0], o[1]), pk2(o[2], o[3])};
            }
        WAVE_SYNC();
#pragma unroll
        for (int j = 0; j < 4; ++j) { const int r = 8 * j + rr; const size_t grow = (size_t)b * T_ + t0 + 8 * wave + (r >> 2);
            *(u32x4*)(MIX + grow * 1024 + (4 * g + (r & 3)) * 64 + 8 * pc) = *(const u32x4*)(stg + (r >> 1) * 2048 + (r & 1) * 128 + 16 * pc); }
    }
    __syncthreads();
#ifdef PROBE_TIMING
    if (b == PROBE_B && g == 0 && qb == PROBE_QB && tid == PROBE_TID) { float* tr = (float*)(ws + WS_CTL + 32768); tr[0] = (float)tcomp; tr[1] = (float)tpass; }
#endif
}

DEV void p4_attention(const Params& p, unsigned char* lds, int vcu, int G, int tid, int wave, int lane) {
    const float gq = wave_max(fabsf(p.in[I_QNG][lane])), gc = wave_max(fabsf(p.in[I_KCNG][lane])), gs = wave_max(fabsf(p.in[I_KSNG][lane])), gw = wave_max(fabsf(p.in[I_KWNG][lane]));
    const float m0c = 8.2f * gq * gc, m0s = 8.2f * gq * gs, m0w = 8.2f * gq * gw;
    for (int i = 0;; ++i) {
        const long L = (long)i * G + vcu; if (L >= AT_UNITS) break;
        int bg, qb;
        if (G == 256 && B_ * NGRP == 16 && NSB == 128) {
            const int xcd = vcu >> 5, c = vcu & 31, r = i & 3;
            bg = 2 * xcd + (i >> 2); qb = (r == 0) ? c : (r == 1) ? 63 - c : (r == 2) ? 64 + c : 127 - c;
        } else {
            const int per = B_ * NGRP * 16;
            const int k = (int)(L / per), v = (int)(L % per), s = v & 15;
            bg = v >> 4; qb = 32 * (k >> 1) + ((k & 1) ? 31 - s : s);
        }
        attn_unit(p, lds, bg / NGRP, bg % NGRP, qb, m0c, m0s, m0w, tid, wave, lane);
    }
}

#ifndef CPU_EMU
#define GAS __attribute__((address_space(1)))
#define LAS __attribute__((address_space(3)))
#define XB_TMO      128
#define XB_XCNT(j)  (256  + 64 * (j))
#define XB_XSUB(j)  (1280 + 64 * (j))
#define XB_XGEN(j)  (2304 + 64 * (j))
#define XB_TOP      3328
#define XB_TOPGEN   3392
#define XCD_BAR_WORDS 3456
#define XB_SPIN_CAP (1u << 20)
__device__ __forceinline__ unsigned xb_ld(unsigned* p)              { return __hip_atomic_load(p, __ATOMIC_RELAXED, __HIP_MEMORY_SCOPE_AGENT); }
__device__ __forceinline__ unsigned xb_add(unsigned* p, unsigned v) { return __hip_atomic_fetch_add(p, v, __ATOMIC_RELAXED, __HIP_MEMORY_SCOPE_AGENT); }
__device__ __forceinline__ unsigned xb_xcc_id() { return (unsigned)__builtin_amdgcn_s_getreg((3 << 11) | 20) & 0xFu; }
#define XB_SPIN(cond, bar) do { unsigned _sp = 0; while (cond) { __builtin_amdgcn_s_sleep(1); \
    if ((++_sp & 255u) == 0u) { if (xb_ld(&(bar)[XB_TMO])) break; if (_sp > XB_SPIN_CAP) { atomicAdd(&(bar)[XB_TMO], 1u); break; } } } } while (0)
struct XcdBarrier { unsigned* bar; unsigned x; volatile LAS unsigned* st; };
__device__ __forceinline__ XcdBarrier xcd_barrier_post(unsigned* bar, volatile LAS unsigned* st) {
    XcdBarrier b; b.bar = bar; b.x = xb_xcc_id(); b.st = st;
    if (threadIdx.x == 0) (void)xb_add(&bar[XB_XCNT(b.x)], 1u);
    return b;
}
__device__ __forceinline__ void xcd_barrier_complete(unsigned* bar, unsigned x, unsigned& nloc, unsigned& nx) {
    const unsigned G = gridDim.x * gridDim.y * gridDim.z;
    unsigned sum, cnt, mine, sp = 0u;
    for (;;) {
        sum = 0u; cnt = 0u; mine = 0u;
#pragma unroll
        for (unsigned j = 0; j < 16; ++j) { const unsigned c = xb_ld(&bar[XB_XCNT(j)]); sum += c; cnt += (c > 0u) ? 1u : 0u; mine = (j == x) ? c : mine; }
        if (sum == G) break;
        __builtin_amdgcn_s_sleep(1);
        if ((++sp & 255u) == 0u) { if (xb_ld(&bar[XB_TMO])) break; if (sp > XB_SPIN_CAP) { atomicAdd(&bar[XB_TMO], 1u); break; } }
    }
    nloc = mine > 0u ? mine : 1u; nx = cnt > 0u ? cnt : 1u;
}
__device__ __forceinline__ void xcd_barrier(const XcdBarrier& b) {
    asm volatile("s_waitcnt vmcnt(0)" ::: "memory");
    __syncthreads();
    if (threadIdx.x == 0) {
        unsigned* bar = b.bar;
        __builtin_amdgcn_s_waitcnt(0);
        unsigned nloc = b.st[0], nx = b.st[1];
        if (nloc == 0u) { xcd_barrier_complete(bar, b.x, nloc, nx); b.st[0] = nloc; b.st[1] = nx; }
        const unsigned old = xb_add(&bar[XB_XSUB(b.x)], 1u);
        const unsigned gen = old / nloc;
        if (old + 1u == (gen + 1u) * nloc) {
            __builtin_amdgcn_fence(__ATOMIC_RELEASE, "agent");
            asm volatile("s_waitcnt vmcnt(0)" ::: "memory");
            const unsigned og = xb_add(&bar[XB_TOP], 1u);
            const unsigned tg = og / nx;
            if (og + 1u == (tg + 1u) * nx) xb_add(&bar[XB_TOPGEN], 1u);
            else XB_SPIN(xb_ld(&bar[XB_TOPGEN]) == tg, bar);
            __builtin_amdgcn_fence(__ATOMIC_ACQUIRE, "agent");
            xb_add(&bar[XB_XGEN(b.x)], 1u);
            asm volatile("s_waitcnt vmcnt(0)" ::: "memory");
        } else {
            XB_SPIN(xb_ld(&bar[XB_XGEN(b.x)]) == gen, bar);
            __builtin_amdgcn_fence(__ATOMIC_ACQUIRE, "agent");
            asm volatile("s_waitcnt vmcnt(0)" ::: "memory");
        }
    }
    __syncthreads();
}
#endif

#ifndef CPU_EMU
__device__ __forceinline__ void group_barrier(unsigned* cnt, unsigned target) {
    asm volatile("s_waitcnt vmcnt(0)" ::: "memory");
    __syncthreads();
    if (threadIdx.x == 0) {
        __builtin_amdgcn_fence(__ATOMIC_RELEASE, "agent");
        asm volatile("s_waitcnt vmcnt(0)" ::: "memory");
        (void)xb_add(cnt, 1u);
        unsigned sp = 0u;
        while (xb_ld(cnt) < target) { __builtin_amdgcn_s_sleep(1); if (++sp > (XB_SPIN_CAP << 4)) break; }
        __builtin_amdgcn_fence(__ATOMIC_ACQUIRE, "agent");
        asm volatile("s_waitcnt vmcnt(0)" ::: "memory");
    }
    __syncthreads();
}
constexpr size_t WS_GBAR = WS_CTL + 20480;
static_assert(WS_CTL + 4096 + XCD_BAR_WORDS * 4 <= WS_GBAR && WS_GBAR + 8 * 256 <= WS_CPOS, "group barrier words");
static_assert(WS_CTL + 4096 + XCD_BAR_WORDS * 4 <= WS_CPOS && WS_CPOS + 2048 <= WS_CTL + 32768 && 32768 + 64 <= CTL_ZERO_BYTES, "barrier words vs cpos");
#endif
constexpr int N_PHASES = 6;
__global__ void __launch_bounds__(512, 2) fwd_kernel(Params p) {
#ifdef CPU_EMU
    unsigned char* lds = emu_smem;
#else
    extern __shared__ __attribute__((aligned(16))) unsigned char lds[];
#endif
    const int tid = threadIdx.x, lane = tid & 63, wave = WAVE_ID();
    const int G = gridDim.x; const int bx = blockIdx.x; const int vcu = (G % 8 == 0) ? (bx % 8) * (G / 8) + bx / 8 : bx;
#ifndef CPU_EMU
    for (int u = tid; u < 64; u += 512) ((LAS unsigned*)(lds + MISC_OFF))[u] = 0u;
    __syncthreads();
    XcdBarrier bar; bar.bar = (unsigned*)(p.ws + WS_CTL) + 1024 + p.li * XCD_BAR_WORDS; bar.x = 0; bar.st = nullptr;
    if (p.ph_hi - p.ph_lo > 1) bar = xcd_barrier_post(bar.bar, (volatile LAS unsigned*)(lds + MISC_OFF) + 8);
#define GRID_BAR() xcd_barrier(bar)
    const bool grp_ok = (G == 256 && B_ == 8 && T_ == 8192);
    unsigned* gcnt = (unsigned*)(p.ws + WS_GBAR) + 64 * (bx & 7); unsigned gtgt = 0u;
#define GROUP_BAR() do { if (grp_ok) { gtgt += 32u; group_barrier(gcnt, gtgt); } else { xcd_barrier(bar); } } while (0)
#else
#define GRID_BAR() do { } while (0)
#define GROUP_BAR() do { } while (0)
#endif
    const int lo = p.ph_lo, hi = p.ph_hi;
#ifndef PHASE_MASK
#define PHASE_MASK 63
#endif
#define IN(k) (((PHASE_MASK >> (k)) & 1) && lo <= (k) && (k) < hi)
#define BOTH(k) (IN(k) && IN((k) + 1))
#ifndef REP_PHASE
#define REP_PHASE -1
#endif
#define REPS(k) for (int rep_ = 0; rep_ < ((k) == REP_PHASE ? 2 : 1); ++rep_)
    if (IN(0)) { REPS(0) { p0_prologue(p, lds, vcu, G, tid, wave, lane); __syncthreads(); } if (BOTH(0)) GRID_BAR(); }
    if (IN(1)) { REPS(1) p1_norm(p, vcu, G, wave, lane); if (BOTH(1)) GROUP_BAR(); }
    if (IN(2)) {
        constexpr int INGEMM = 2816;
#ifdef REP_INPROJ
        struct RepOrder { pg8::StaticOrder S; int cnt; __device__ bool next(int i, pg8::Unit& u) const { return S.next(i < cnt ? i : i - cnt, u) && i < 2 * cnt; } __device__ void a_ready(const pg8::Unit&) const {} __device__ void done(const pg8::Unit&) const {} };
        pg8::Gemm g{(const bf16_t*)(p.ws + WS_HN), (const bf16_t*)(p.ws + WS_WIN), M_, INGEMM, 1024}; RepOrder S; S.S.init(M_, INGEMM, G, bx); S.cnt = (S.S.nwg - bx + G - 1) / G;
#define INPROJ_ORDER RepOrder
#else
        pg8::Gemm g{(const bf16_t*)(p.ws + WS_HN), (const bf16_t*)(p.ws + WS_WIN), M_, INGEMM, 1024}; pg8::StaticOrder S; S.init(M_, INGEMM, G, bx);
#define INPROJ_ORDER pg8::StaticOrder
#endif
        EpiInProj E{p.ws, p.in[I_QNG], p.in[I_KSNG], p.in[I_KWNG]};
        pg8::gemm_phase<EpiInProj, INPROJ_ORDER, true, true>(PG8_PTR(lds), g, S, E);
        if (BOTH(2)) GROUP_BAR();
    }
    if (IN(3)) {
        REPS(3) for (int u = vcu; u < B_ * SSM_NG; u += G) ssm_unit(p, lds, u, tid, wave, lane);
        REPS(6) for (int u = vcu; u < CMP_UNITS; u += G) compress_unit(p, lds, u, tid, wave, lane);
        {
            const bool local = (G == 256 && B_ == 8);
            auto vt_of = [&](int k) -> int { if (local) { if (k >= VT_UNITS / 256) return -1; const int loc = (vcu & 31) + 32 * k; return ((vcu >> 5) * NGRP + (loc >> 7)) * (T_ / 64) + (loc & 127); }
                                               const int u = vcu + k * G; return u < VT_UNITS ? u : -1; };
            VtPre cur, nxt; int u = vt_of(0);
            if (u >= 0) vt_fetch(p, u, tid, cur);
            for (int k = 0; u >= 0; ++k) {
                const int un = vt_of(k + 1); nxt = cur;
                if (un >= 0) vt_fetch(p, un, tid, nxt);
                vt_unit(p, lds, u, tid, cur);
                cur = nxt; u = un;
            }
        }
        if (BOTH(3)) GROUP_BAR();
    }
    if (IN(4)) {
        REPS(4) p4_attention(p, lds, vcu, G, tid, wave, lane);
        pg8::Gemm g{(const bf16_t*)(p.ws + WS_YG), (const bf16_t*)(p.ws + WS_WGLU), M_, 512, 512}; pg8::StaticOrder S; S.init(M_, 512, G, bx);
        EpiGlu E{(const bf16_t*)(p.ws + WS_YG), (const bf16_t*)(p.ws + WS_ZS), (bf16_t*)(p.ws + WS_MIX), p.in[I_GLUB]};
        REPS(7) pg8::gemm_phase<EpiGlu, pg8::StaticOrder, true, true>(PG8_PTR(lds), g, S, E);
        if (BOTH(4)) GROUP_BAR();
    }
    if (IN(5)) {
        pg8::Gemm g{(const bf16_t*)(p.ws + WS_MIX), (const bf16_t*)(p.ws + WS_WO), M_, 1024, 1024}; pg8::StaticOrder S; S.init(M_, 1024, G, bx);
        EpiOut E{p.in[I_X], p.out, (const float*)(p.ws + WS_MOD)};
        REPS(5) pg8::gemm_phase<EpiOut, pg8::StaticOrder, true, true>(PG8_PTR(lds), g, S, E);
#ifdef PROBE_TIMING
        GRID_BAR();
        if (bx == 0 && tid == 0) { const float* tr = (const float*)(p.ws + WS_CTL + 32768); p.out[0] += tr[PROBE_WHICH] * 1e-3f; }
#endif
    }
#undef IN
#undef BOTH
}

extern "C" void kernel_launch(void* const* d_in, const int* in_sizes, int n_in, void* d_out, int out_size, void* d_ws, size_t ws_size, hipStream_t stream) {
    static int grid = 0;
    if (grid == 0) {
        if (n_in != N_IN || out_size != M_ * D_ || ws_size < WS_END) { fprintf(stderr, "kernel_launch: unexpected shapes (n_in %d out %d ws %zu need %zu)\n", n_in, out_size, ws_size, (size_t)WS_END); grid = -1; return; }
#ifdef CPU_EMU
        grid = EMU_GRID;
#else
        int dev = 0, cus = 0, per_cu = 0;
        if (hipGetDevice(&dev) != hipSuccess || hipDeviceGetAttribute(&cus, hipDeviceAttributeMultiprocessorCount, dev) != hipSuccess) { grid = -1; return; }
        if (hipFuncSetAttribute((const void*)fwd_kernel, hipFuncAttributeMaxDynamicSharedMemorySize, LDS_BYTES) != hipSuccess) { fprintf(stderr, "kernel_launch: hipFuncSetAttribute failed\n"); grid = -1; return; }
        if (hipOccupancyMaxActiveBlocksPerMultiprocessor(&per_cu, (const void*)fwd_kernel, 512, LDS_BYTES) != hipSuccess || per_cu < 1) { fprintf(stderr, "kernel_launch: occupancy query says %d blocks per CU\n", per_cu); per_cu = 1; }
        (void)hipGetLastError();
        grid = cus;
#endif
    }
    if (grid < 0) return;
    (void)hipMemsetAsync((char*)d_ws + WS_CTL, 0, CTL_ZERO_BYTES, stream);
    Params a{};
    for (int i = 0; i < N_IN; ++i) a.in[i] = (const float*)d_in[i];
    a.out = (float*)d_out; a.ws = (unsigned char*)d_ws;
    for (int li = 0; li < N_LAUNCH; ++li) {
        a.ph_lo = (N_LAUNCH == 1) ? 0 : li; a.ph_hi = (N_LAUNCH == 1) ? N_PHASES : li + 1; a.li = 0;
#ifdef CPU_EMU
        emu_launch((unsigned)grid, 512u, [&]() { fwd_kernel(a); });
#else
        hipLaunchKernelGGL(fwd_kernel, dim3(grid), dim3(512), LDS_BYTES, stream, a);
#endif
    }
}
```

```cpp
#ifndef CPU_EMU
#include <hip/hip_runtime.h>
#endif
#include <cstdio>
#include <cstdint>
#include <cmath>

#ifndef BATCH_N
#define BATCH_N 8
#endif
#ifndef SEQ_LEN
#define SEQ_LEN 8192
#endif
#ifndef N_LAUNCH
#define N_LAUNCH 1
#endif
#define DEV __device__ __forceinline__

typedef unsigned short bf16_t;
typedef short bf16x8 __attribute__((ext_vector_type(8)));
typedef float f32x4 __attribute__((ext_vector_type(4)));
typedef float f32x16 __attribute__((ext_vector_type(16)));
typedef float f32x2 __attribute__((ext_vector_type(2)));
typedef unsigned u32x4 __attribute__((ext_vector_type(4)));
typedef unsigned u32x2 __attribute__((ext_vector_type(2)));

constexpr int B_ = BATCH_N, T_ = SEQ_LEN, D_ = 1024, M_ = B_ * T_;
constexpr int NH = 8, HD = 64, NGRP = 2;
constexpr int NCMP = (T_ - 32) / 16 + 1;
constexpr int NCP = T_ / 16;
constexpr int NSB = T_ / 64;
constexpr int INW = 2840, INP = 3072;
constexpr int SSM_NG = 32, SSM_P = 64, SSM_C = 16, SSM_W = 512;
constexpr int SSM_L = 64;
constexpr int SSM_CG = 32;
constexpr int SSM_NCG = T_ / (SSM_L * SSM_CG);
constexpr float EPS_ = 1e-6f;
static_assert(T_ % 2048 == 0 && NSB <= 128, "shape assumptions");

enum { I_X = 0, I_C, I_WADA, I_BADA, I_NORMG, I_WIN, I_QNG, I_KCNG, I_KSNG, I_KWNG, I_POSK, I_POSV, I_W1K, I_W2K, I_W1V, I_W2V,
       I_ARE, I_AIM, I_LOGDT, I_BRE, I_BIM, I_CRE, I_CIM, I_SSMD, I_GLUW, I_GLUB, I_WOUT, N_IN };

constexpr size_t MiB = 1u << 20;
constexpr size_t al(size_t x) { return (x + MiB - 1) / MiB * MiB; }
constexpr size_t WS_CTL = 0, CTL_ZERO_BYTES = 64 * 1024;
constexpr size_t WS_MOD = 1 * MiB;
constexpr size_t WS_ROPE = WS_MOD + al((size_t)B_ * 3072 * 4);
constexpr size_t WS_CPOS = WS_CTL + 24576;
constexpr size_t WS_LAM64 = WS_ROPE + al((size_t)T_ * 64 * 4);
constexpr size_t WS_KT = WS_LAM64 + MiB;
constexpr size_t WS_WST = WS_KT + al((size_t)32 * 65 * 256 * 2);
constexpr size_t WS_WOUTS = WS_WST + al((size_t)32 * 128 * 1024 * 2);
constexpr size_t WS_WIN = WS_WOUTS + al((size_t)32 * 1024 * 128 * 2);
constexpr size_t WS_WO = WS_WIN + al((size_t)INP * 1024 * 2);
constexpr size_t WS_WGLU = WS_WO + al((size_t)1024 * 1024 * 2);
constexpr size_t WS_W1K = WS_WGLU + MiB, WS_W1V = WS_W1K + MiB;
constexpr size_t WS_W2K = WS_W1V + MiB, WS_W2V = WS_W2K + 64 * 1024;
constexpr size_t WS_KC = WS_W2K + MiB;
constexpr size_t WS_VC = WS_KC + al((size_t)B_ * NCP * 128 * 2);
constexpr size_t WS_G = WS_VC + al((size_t)B_ * NCP * 128 * 2);
constexpr size_t WS_HN = WS_G + al((size_t)M_ * 32 * 4);
constexpr size_t WS_Q = WS_HN + al((size_t)M_ * 1024 * 2);
constexpr size_t WS_QR = WS_Q + al((size_t)M_ * 512 * 2);
constexpr size_t WS_CR = WS_QR + al((size_t)M_ * 512 * 2);
constexpr size_t WS_SL = WS_CR + al((size_t)M_ * 256 * 2);
constexpr size_t WS_WN = WS_SL + al((size_t)M_ * 256 * 2);
constexpr size_t WS_ZA = WS_WN + al((size_t)M_ * 256 * 2);
constexpr size_t WS_U = WS_ZA + al((size_t)M_ * 512 * 2);
constexpr size_t WS_ZS = WS_U + al((size_t)M_ * 512 * 2);
constexpr size_t WS_YG = WS_ZS + al((size_t)M_ * 512 * 2);
constexpr size_t WS_MIX = WS_YG + al((size_t)M_ * 512 * 2);
constexpr size_t WS_VT = WS_MIX + al((size_t)M_ * 1024 * 2);
constexpr size_t WS_KF = WS_VT + al((size_t)M_ * 128 * 2);
constexpr size_t WS_END = WS_KF + al((size_t)M_ * 128 * 2);

constexpr int RING_BYTES = 131072;
constexpr int LDS_BYTES = 155648;
constexpr int MISC_OFF = LDS_BYTES - 256;

DEV unsigned f2bf(float f) { unsigned u = __builtin_bit_cast(unsigned, f); return (u + 0x7fffu + ((u >> 16) & 1u)) >> 16; }
DEV float bf2f(unsigned h) { return __builtin_bit_cast(float, h << 16); }
#ifdef CPU_EMU
DEV unsigned pk2(float lo, float hi) { return f2bf(lo) | (f2bf(hi) << 16); }
DEV float exp2_fast(float x) { return exp2f(x); }
DEV float rcp_fast(float x) { return 1.0f / x; }
DEV float log2_fast(float x) { return log2f(x); }
DEV int f2i_rn(float x) { return (int)floorf(x + 0.5f); }
DEV f32x4 mfma16(bf16x8 a, bf16x8 b, f32x4 c) { return emu_mfma16(a, b, c); }
DEV f32x16 mfma32(bf16x8 a, bf16x8 b, f32x16 c) { return emu_mfma32(a, b, c); }
#define WAVE_ID() ((int)(threadIdx.x >> 6))
#else
typedef __bf16 bf16x2_t __attribute__((ext_vector_type(2)));
DEV unsigned pk2(float lo, float hi) { f32x2 v = {lo, hi}; bf16x2_t b = __builtin_convertvector(v, bf16x2_t); return __builtin_bit_cast(unsigned, b); }
DEV float exp2_fast(float x) { return __builtin_amdgcn_exp2f(x); }
DEV float rcp_fast(float x) { return __builtin_amdgcn_rcpf(x); }
DEV float log2_fast(float x) { return __builtin_amdgcn_logf(x); }
DEV int f2i_rn(float x) { int r; asm("v_cvt_rpi_i32_f32 %0, %1" : "=v"(r) : "v"(x)); return r; }
DEV f32x4 mfma16(bf16x8 a, bf16x8 b, f32x4 c) { return __builtin_amdgcn_mfma_f32_16x16x32_bf16(a, b, c, 0, 0, 0); }
DEV f32x16 mfma32(bf16x8 a, bf16x8 b, f32x16 c) { return __builtin_amdgcn_mfma_f32_32x32x16_bf16(a, b, c, 0, 0, 0); }
#define WAVE_ID() (__builtin_amdgcn_readfirstlane((int)(threadIdx.x >> 6)))
#endif
#ifdef CPU_EMU
#define EXPF(x) expf(x)
#else
#define EXPF(x) __expf(x)
#endif
DEV float silu_f(float v) { return v * rcp_fast(1.0f + EXPF(-v)); }
DEV float sigmoid_f(float v) { return rcp_fast(1.0f + EXPF(-v)); }
DEV float gelu_tanh_f(float v) { const float u = 0.7978845608028654f * (v + 0.044715f * v * v * v); const float e = EXPF(2.0f * u); return v * (1.0f - rcp_fast(e + 1.0f)); }
DEV float wave_sum(float v) {
#pragma unroll
    for (int o = 1; o < 64; o <<= 1) v += __shfl_xor(v, o);
    return v;
}
DEV float wave_max(float v) {
#pragma unroll
    for (int o = 1; o < 64; o <<= 1) v = fmaxf(v, __shfl_xor(v, o));
    return v;
}
DEV bf16x8 ld8(const bf16_t* p) { return *(const bf16x8*)p; }
namespace pg8 {
#define PG8_LAS __attribute__((address_space(3)))
typedef unsigned short bf16_t;
typedef short bf16x8 __attribute__((ext_vector_type(8)));
typedef float f32x4 __attribute__((ext_vector_type(4)));
typedef unsigned u32x4 __attribute__((ext_vector_type(4)));
constexpr int BM = 256, BK = 64, HALF = 128, HTB = HALF * BK * 2  , STAGE_BYTES = 8 * HTB, NXCD = 8, WGM = 8;

__host__ __device__ __forceinline__ int lds_byte(int r, int c) { const int st = (r >> 4) * 2 + (c >> 5), rr = r & 15, cc = c & 31, ob = rr * 64 + cc * 2; return st * 1024 + (ob ^ (((ob >> 9) & 1) << 5)); }
__host__ __device__ __forceinline__ void stage_rc(int b, int& R, int& C) { const int st = b / 1024, sb = b % 1024, swz = sb ^ (((sb >> 9) & 1) << 5); R = (st >> 1) * 16 + swz / 64; C = (st & 1) * 32 + (swz % 64) / 2; }
__host__ __device__ __forceinline__ int perm32(int rho) { const int n = rho >> 4, i = rho & 15; return 8 * (i >> 2) + 4 * n + (i & 3); }

struct Unit { int pm, pn; };
struct Gemm { const bf16_t* A; const bf16_t* Bt; int M, N, K; };

struct StaticOrder {
    int nM, nN, nwg, G, c;
    __host__ __device__ void init(int M, int N, int G_, int c_) { nM = M / BM; nN = N / BM; nwg = nM * nN; G = G_; c = c_; }
    __host__ __device__ bool next(int i, Unit& u) const {
        const long L = (long)i * G + c; if (L >= nwg) return false;
        int wgid = (int)L; { const int q = nwg / NXCD, r = nwg % NXCD, xcd = wgid % NXCD, off = wgid / NXCD; wgid = (xcd < r ? xcd * (q + 1) : r * (q + 1) + (xcd - r) * q) + off; }
        const int nig = WGM * nN, gid = wgid / nig, fm = gid * WGM, gsz = (nM - fm) < WGM ? (nM - fm) : WGM;
        u.pm = fm + ((wgid % nig) % gsz); u.pn = (wgid % nig) / gsz; return true;
    }
    __device__ __forceinline__ void a_ready(const Unit&) const {}
    __device__ __forceinline__ void done(const Unit&) const {}
};

#ifndef CPU_EMU
__device__ __forceinline__ unsigned cvt_pk_bf16(float lo, float hi) { unsigned r; asm volatile("v_cvt_pk_bf16_f32 %0, %1, %2" : "=v"(r) : "v"(lo), "v"(hi)); return r; }
template <class Epi, class Sched, bool ALIGN_EPI = false, bool SP2 = false>
__device__ __forceinline__ void gemm_phase(PG8_LAS unsigned char* lds, const Gemm g, const Sched& S, const Epi& E) {
    const int tid = threadIdx.x, wid = __builtin_amdgcn_readfirstlane(tid >> 6), lane = tid & 63, wr = wid >> 2, wc = wid & 3, fr = lane & 15, fq = lane >> 4;
    const int K = g.K, nt = K / BK;
    unsigned voffA[2], voffB[2];
#pragma unroll
    for (int i = 0; i < 2; ++i) { int R, C; stage_rc(tid * 16 + i * 8192, R, C); const int Rb = Epi::PERM ? ((R & ~31) + perm32(R & 31)) : R;
        voffA[i] = (unsigned)(R * K + C) * 2u; voffB[i] = (unsigned)(Rb * K + C) * 2u; }
    const size_t kstep = (size_t)(BK * 2);
    const size_t hstep = (size_t)HALF * K * 2;
    const size_t tstep = 2 * hstep;
    const unsigned ldsw = (unsigned)wid * 1024u;
    const int aoff = lds_byte(wr * 64 + fr, fq * 8), boff = lds_byte(wc * 32 + fr, fq * 8);
#define PG8_SA(b, h) (((b) * 2 + (h)) * HTB)
#define PG8_SB(b, h) ((4 + (b) * 2 + (h)) * HTB)
#define PG8_STAGE(bufoff, gbase, voff) do { _Pragma("unroll") for (int _i = 0; _i < 2; ++_i) \
        __builtin_amdgcn_global_load_lds((const unsigned*)((const char*)(gbase) + (voff)[_i]), (PG8_LAS unsigned*)(lds + (bufoff) + ldsw + _i * 8192), 16, 0, 0); } while (0)
#define PG8_LDA(dst, b, h) do { _Pragma("unroll") for (int m = 0; m < 4; ++m) _Pragma("unroll") for (int k = 0; k < 2; ++k) dst[m][k] = *(const PG8_LAS bf16x8*)(lds + PG8_SA(b, h) + aoff + m * 2048 + k * 1024); } while (0)
#define PG8_LDB(dst, b, h) do { _Pragma("unroll") for (int n = 0; n < 2; ++n) _Pragma("unroll") for (int k = 0; k < 2; ++k) dst[n][k] = *(const PG8_LAS bf16x8*)(lds + PG8_SB(b, h) + boff + n * 2048 + k * 1024); } while (0)
#define PG8_MMA(ai, bj, At, Bt) do { __builtin_amdgcn_s_setprio(1); _Pragma("unroll") for (int m = 0; m < 4; ++m) _Pragma("unroll") for (int n = 0; n < 2; ++n) _Pragma("unroll") for (int k = 0; k < 2; ++k) \
        acc[ai][bj][m][n] = __builtin_amdgcn_mfma_f32_16x16x32_bf16(Bt[n][k], At[m][k], acc[ai][bj][m][n], 0, 0, 0); __builtin_amdgcn_s_setprio(0); } while (0)
#define PG8_WAIT_V(n) asm volatile("s_waitcnt vmcnt(" #n ")" ::: "memory")
#define PG8_WAIT_L(n) asm volatile("s_waitcnt lgkmcnt(" #n ")" ::: "memory")
#define PG8_BAR __builtin_amdgcn_s_barrier()
#define PG8_SCHED __builtin_amdgcn_sched_barrier(0)
    Unit cur, nxt; int ui = 0;
    if (!S.next(0, cur)) return;
    f32x4 acc[2][2][4][2];
#pragma unroll
    for (int a = 0; a < 2; ++a)
#pragma unroll
        for (int b = 0; b < 2; ++b)
#pragma unroll
            for (int m = 0; m < 4; ++m)
#pragma unroll
                for (int n = 0; n < 2; ++n) acc[a][b][m][n] = (f32x4){0.f, 0.f, 0.f, 0.f};
    bf16x8 At[4][2], B0[2][2], B1[2][2];
    const char* cA = (const char*)g.A + (size_t)cur.pm * tstep; const char* cB = (const char*)g.Bt + (size_t)cur.pn * tstep;
    S.a_ready(cur);
    if constexpr (SP2) {
        PG8_STAGE(PG8_SB(0, 0), cB, voffB); PG8_STAGE(PG8_SB(0, 1), cB + hstep, voffB); PG8_STAGE(PG8_SA(0, 0), cA, voffA); PG8_STAGE(PG8_SA(0, 1), cA + hstep, voffA);
        if (wr == 1) PG8_BAR;
        PG8_WAIT_V(2); PG8_BAR;
        PG8_STAGE(PG8_SB(1, 0), cB + kstep, voffB); PG8_STAGE(PG8_SA(1, 0), cA + kstep, voffA); PG8_STAGE(PG8_SB(1, 1), cB + hstep + kstep, voffB);
        PG8_WAIT_V(6); PG8_BAR;
    } else {
        PG8_STAGE(PG8_SB(0, 0), cB, voffB); PG8_STAGE(PG8_SA(0, 0), cA, voffA); PG8_STAGE(PG8_SB(0, 1), cB + hstep, voffB); PG8_STAGE(PG8_SA(0, 1), cA + hstep, voffA);
        if (wr == 1) PG8_BAR;
        PG8_WAIT_V(4); PG8_BAR;
        PG8_STAGE(PG8_SB(1, 0), cB + kstep, voffB); PG8_STAGE(PG8_SA(1, 0), cA + kstep, voffA); PG8_STAGE(PG8_SB(1, 1), cB + hstep + kstep, voffB);
        PG8_WAIT_V(6); PG8_BAR;
    }
    for (;;) {
        const bool has_next = S.next(ui + 1, nxt);
        const char* nA = has_next ? (const char*)g.A + (size_t)nxt.pm * tstep : cA; const char* nB = has_next ? (const char*)g.Bt + (size_t)nxt.pn * tstep : cB;
        for (int t = 0; t < nt; t += 2) {
            const bool last = (t == nt - 2);
            const char* a1 = cA + (size_t)(t + 1) * kstep;
            const char* a2 = last ? nA : cA + (size_t)(t + 2) * kstep; const char* b2 = last ? nB : cB + (size_t)(t + 2) * kstep;
            const char* a3 = a2 + kstep; const char* b3 = b2 + kstep;
            if (last && has_next) S.a_ready(nxt);
            if constexpr (SP2) {
            PG8_LDB(B0, 0, 0); PG8_LDB(B1, 0, 1); PG8_SCHED; PG8_LDA(At, 0, 0); PG8_STAGE(PG8_SA(1, 1), a1 + hstep, voffA);
            PG8_WAIT_V(8); PG8_WAIT_L(0); PG8_BAR; PG8_MMA(0, 0, At, B0); PG8_MMA(0, 1, At, B1); PG8_BAR; PG8_SCHED;
            PG8_LDA(At, 0, 1); PG8_STAGE(PG8_SB(0, 0), b2, voffB); PG8_STAGE(PG8_SB(0, 1), b2 + hstep, voffB); PG8_STAGE(PG8_SA(0, 0), a2, voffA);
            PG8_WAIT_V(8); PG8_WAIT_L(0); PG8_BAR; PG8_MMA(1, 0, At, B0); PG8_MMA(1, 1, At, B1); PG8_BAR; PG8_SCHED;
            PG8_LDB(B0, 1, 0); PG8_LDB(B1, 1, 1); PG8_SCHED; PG8_LDA(At, 1, 0); PG8_STAGE(PG8_SA(0, 1), a2 + hstep, voffA);
            PG8_WAIT_V(8); PG8_WAIT_L(0); PG8_BAR; PG8_MMA(0, 0, At, B0); PG8_MMA(0, 1, At, B1); PG8_BAR; PG8_SCHED;
            PG8_LDA(At, 1, 1); PG8_STAGE(PG8_SB(1, 0), b3, voffB); PG8_STAGE(PG8_SB(1, 1), b3 + hstep, voffB); PG8_STAGE(PG8_SA(1, 0), a3, voffA);
            PG8_WAIT_V(8); PG8_WAIT_L(0); PG8_BAR; PG8_MMA(1, 0, At, B0); PG8_MMA(1, 1, At, B1); PG8_BAR; PG8_SCHED;
            } else {
            PG8_LDB(B0, 0, 0); PG8_SCHED; PG8_LDA(At, 0, 0); PG8_STAGE(PG8_SA(1, 1), a1 + hstep, voffA);
            PG8_WAIT_L(8); PG8_BAR; PG8_WAIT_L(0); PG8_MMA(0, 0, At, B0); PG8_BAR; PG8_SCHED;
            PG8_LDB(B1, 0, 1); PG8_STAGE(PG8_SB(0, 0), b2, voffB);
            PG8_BAR; PG8_WAIT_L(0); PG8_MMA(0, 1, At, B1); PG8_BAR;
            PG8_LDA(At, 0, 1); PG8_STAGE(PG8_SA(0, 0), a2, voffA);
            PG8_BAR; PG8_WAIT_L(0); PG8_MMA(1, 0, At, B0); PG8_BAR; PG8_SCHED;
            PG8_STAGE(PG8_SB(0, 1), b2 + hstep, voffB);
            PG8_WAIT_V(6); PG8_BAR; PG8_MMA(1, 1, At, B1); PG8_BAR;
            PG8_LDB(B0, 1, 0); PG8_SCHED; PG8_LDA(At, 1, 0); PG8_STAGE(PG8_SA(0, 1), a2 + hstep, voffA);
            PG8_WAIT_L(8); PG8_BAR; PG8_WAIT_L(0); PG8_MMA(0, 0, At, B0); PG8_BAR; PG8_SCHED;
            PG8_LDB(B1, 1, 1); PG8_STAGE(PG8_SB(1, 0), b3, voffB);
            PG8_BAR; PG8_WAIT_L(0); PG8_MMA(0, 1, At, B1); PG8_BAR;
            PG8_LDA(At, 1, 1); PG8_STAGE(PG8_SA(1, 0), a3, voffA);
            PG8_BAR; PG8_WAIT_L(0); PG8_MMA(1, 0, At, B0); PG8_BAR; PG8_SCHED;
            PG8_STAGE(PG8_SB(1, 1), b3 + hstep, voffB);
            PG8_WAIT_V(6); PG8_BAR; PG8_MMA(1, 1, At, B1); PG8_BAR;
            }
        }
        if constexpr (ALIGN_EPI) { if (wr == 0) PG8_BAR; }
        if constexpr (!Epi::AFTER_DRAIN) { E(acc, cur, wr, wc, fr, fq); S.done(cur); }
        if (!has_next) break;
#pragma unroll
        for (int a = 0; a < 2; ++a)
#pragma unroll
            for (int b = 0; b < 2; ++b)
#pragma unroll
                for (int m = 0; m < 4; ++m)
#pragma unroll
                    for (int n = 0; n < 2; ++n) acc[a][b][m][n] = (f32x4){0.f, 0.f, 0.f, 0.f};
        cur = nxt; cA = nA; cB = nB; ++ui;
        if constexpr (ALIGN_EPI) { if (wr == 1) PG8_BAR; }
    }
    PG8_WAIT_V(0);
    if constexpr (!ALIGN_EPI) { if (wr == 0) PG8_BAR; }
    PG8_BAR;
    if constexpr (Epi::AFTER_DRAIN) { E.fused(acc, cur, wr, wc, fr, fq, lds, wid, lane); S.done(cur); }
#undef PG8_SA
#undef PG8_SB
#undef PG8_STAGE
#undef PG8_LDA
#undef PG8_LDB
#undef PG8_MMA
#undef PG8_WAIT_V
#undef PG8_WAIT_L
#undef PG8_BAR
#undef PG8_SCHED
}
}
#define PG8_PTR(x) ((__attribute__((address_space(3))) unsigned char*)(x))
#else
template <class Epi, class Sched, bool ALIGN_EPI = false, bool SP2 = false>
inline void gemm_phase(unsigned char* lds, const Gemm g, const Sched& S, const Epi& E) {
    const int tid = threadIdx.x, wid = tid >> 6, lane = tid & 63, wr = wid >> 2, wc = wid & 3, fr = lane & 15, fq = lane >> 4;
    Unit cur;
    for (int ui = 0; S.next(ui, cur); ++ui) {
        f32x4 acc[2][2][4][2];
        for (int ai = 0; ai < 2; ++ai) for (int bj = 0; bj < 2; ++bj) for (int m = 0; m < 4; ++m) for (int n = 0; n < 2; ++n) for (int i = 0; i < 4; ++i) {
            const int row = 256 * cur.pm + 128 * ai + 64 * wr + 16 * m + fr;
            const int col = 256 * cur.pn + 128 * bj + 32 * wc + (Epi::PERM ? 8 * fq + 4 * n + i : 16 * n + 4 * fq + i);
            const bf16_t* a = g.A + (size_t)row * g.K; const bf16_t* b = g.Bt + (size_t)col * g.K; float s = 0.f;
            for (int k = 0; k < g.K; ++k) s += emu_bf2f(a[k]) * emu_bf2f(b[k]);
            acc[ai][bj][m][n][i] = s; }
        E(acc, cur, wr, wc, fr, fq);
    }
}
}
#define PG8_PTR(x) (x)
#endif
#ifdef CPU_EMU
#define WAVE_SYNC() emu_wave_sync()
#define SCHED_FENCE() do { } while (0)
#define LAUNDER_V(x) do { } while (0)
#define LDS_BARRIER() __syncthreads()
#else
#define LDS_BARRIER() do { asm volatile("s_waitcnt lgkmcnt(0)" ::: "memory"); __builtin_amdgcn_s_barrier(); asm volatile("" ::: "memory"); } while (0)
#define LAUNDER_V(x) asm volatile("" : "+v"(x))
#define WAVE_SYNC() asm volatile("s_waitcnt lgkmcnt(0)" ::: "memory")
#define SCHED_FENCE() __builtin_amdgcn_sched_barrier(0)
#endif

struct Params { const float* in[N_IN]; float* out; unsigned char* ws; int ph_lo, ph_hi, li, pad; };

constexpr float QSCALE = 0.125f * 1.4426950408889634f;
DEV void gates_rows(unsigned char* ws, size_t row0, int lane) {
    const int r = lane & 15, kq = lane >> 4;
    const bf16_t* HN = (const bf16_t*)(ws + WS_HN) + (row0 + r) * 1024 + 8 * kq;
    const bf16_t* WG = (const bf16_t*)(ws + WS_WIN) + (size_t)(2816 + r) * 1024 + 8 * kq;
    f32x4 acc[2][2];
#pragma unroll
    for (int rb = 0; rb < 2; ++rb)
#pragma unroll
        for (int cb = 0; cb < 2; ++cb) acc[rb][cb] = (f32x4){0.f, 0.f, 0.f, 0.f};
    bf16x8 hb[2][4][2], wb[2][4][2];
#define GU_LOAD(bt) do { _Pragma("unroll") for (int q = 0; q < 4; ++q) { const int s_ = 4 * (bt) + q; hb[(bt) & 1][q][0] = ld8(HN + 32 * s_); hb[(bt) & 1][q][1] = ld8(HN + 16 * 1024 + 32 * s_); \
        wb[(bt) & 1][q][0] = ld8(WG + 32 * s_); wb[(bt) & 1][q][1] = ld8(WG + 16 * 1024 + 32 * s_); } } while (0)
    GU_LOAD(0);
#pragma unroll
    for (int bt = 0; bt < 8; ++bt) {
        if (bt < 7) GU_LOAD(bt + 1);
        SCHED_FENCE();
#pragma unroll
        for (int q = 0; q < 4; ++q) {
            const bf16x8 h0 = hb[bt & 1][q][0], h1 = hb[bt & 1][q][1], w0 = wb[bt & 1][q][0], w1 = wb[bt & 1][q][1];
            acc[0][0] = mfma16(w0, h0, acc[0][0]); acc[0][1] = mfma16(w1, h0, acc[0][1]);
            acc[1][0] = mfma16(w0, h1, acc[1][0]); acc[1][1] = mfma16(w1, h1, acc[1][1]);
        }
        SCHED_FENCE();
    }
#undef GU_LOAD
    float* Gp = (float*)(ws + WS_G);
#pragma unroll
    for (int rb = 0; rb < 2; ++rb)
#pragma unroll
        for (int cb = 0; cb < 2; ++cb) { f32x4 o;
#pragma unroll
            for (int i = 0; i < 4; ++i) o[i] = sigmoid_f(acc[rb][cb][i]);
            *(f32x4*)(Gp + (row0 + 16 * rb + r) * 32 + 16 * cb + 4 * kq) = o; }
}

struct EpiInProj {
    static constexpr bool PERM = true, AFTER_DRAIN = false;
    unsigned char* ws; const float* qng; const float* ksng; const float* kwng;
    DEV void operator()(const f32x4 (&acc)[2][2][4][2], const pg8::Unit& u, int wr, int wc, int fr, int fq) const {
        const int pn = u.pn; const int row0 = u.pm * 256 + wr * 64 + fr;
        int kind; bf16_t* dst = nullptr; bf16_t* dst2 = nullptr; int pitch = 512, colb = 0; const float* gv = nullptr;
        if (pn < 2) { kind = 2; dst = (bf16_t*)(ws + WS_Q); dst2 = (bf16_t*)(ws + WS_QR); colb = (4 * pn + wc) * 64; gv = qng; }
        else if (pn == 2) { kind = 0; dst = (bf16_t*)(ws + WS_CR); pitch = 256; colb = wc * 64; }
        else if (pn == 3) { kind = wc < 2 ? 1 : 0; dst = (bf16_t*)(ws + WS_SL); pitch = 256; colb = wc * 64; gv = ksng; }
        else if (pn == 4) { kind = wc < 2 ? 1 : 0; dst = (bf16_t*)(ws + WS_WN); pitch = 256; colb = wc * 64; gv = kwng; }
        else if (pn < 7) { kind = 3; dst = (bf16_t*)(ws + WS_ZA); colb = (4 * (pn - 5) + wc) * 64; }
        else if (pn < 9) { kind = 0; dst = (bf16_t*)(ws + WS_U); colb = (4 * (pn - 7) + wc) * 64; }
        else if (pn < 11) { kind = 3; dst = (bf16_t*)(ws + WS_ZS); colb = (4 * (pn - 9) + wc) * 64; }
        else { kind = (wc == 0) ? 4 : 5; }
        if (kind == 5) return;
        float g1[8], g2[8];
        if (kind == 1 || kind == 2) {
#pragma unroll
            for (int i = 0; i < 8; ++i) { const float qs = (kind == 2) ? QSCALE : 1.0f; g1[i] = gv[8 * fq + i] * qs; g2[i] = gv[32 + 8 * fq + i] * qs; }
        }
        const float* rope = (const float*)(ws + WS_ROPE);
#pragma unroll
        for (int ai = 0; ai < 2; ++ai)
#pragma unroll
            for (int m = 0; m < 4; ++m) {
                const int row = row0 + ai * 128 + m * 16;
                float x1[8], x2[8];
#pragma unroll
                for (int i = 0; i < 4; ++i) { x1[i] = acc[ai][0][m][0][i]; x1[4 + i] = acc[ai][0][m][1][i]; x2[i] = acc[ai][1][m][0][i]; x2[4 + i] = acc[ai][1][m][1][i]; }
                if (kind == 4) {
                    float* G = (float*)(ws + WS_G) + (size_t)row * 32 + 8 * fq;
                    f32x4 o0, o1;
#pragma unroll
                    for (int i = 0; i < 4; ++i) { o0[i] = sigmoid_f(x1[i]); o1[i] = sigmoid_f(x1[4 + i]); }
                    *(f32x4*)G = o0; *(f32x4*)(G + 4) = o1;
                    continue;
                }
                if (kind == 1 || kind == 2) {
                    float ss = 0.f;
#pragma unroll
                    for (int i = 0; i < 8; ++i) ss += x1[i] * x1[i] + x2[i] * x2[i];
                    ss += __shfl_xor(ss, 16); ss += __shfl_xor(ss, 32);
                    const float rinv = rsqrtf(ss * (1.0f / 64.0f) + EPS_);
#pragma unroll
                    for (int i = 0; i < 8; ++i) { x1[i] = x1[i] * rinv * g1[i]; x2[i] = x2[i] * rinv * g2[i]; }
                    if (kind == 2) {
                        bf16_t* o = dst + (size_t)row * pitch + colb + 8 * fq;
                        *(u32x4*)o = (u32x4){pk2(x1[0], x1[1]), pk2(x1[2], x1[3]), pk2(x1[4], x1[5]), pk2(x1[6], x1[7])};
                        *(u32x4*)(o + 32) = (u32x4){pk2(x2[0], x2[1]), pk2(x2[2], x2[3]), pk2(x2[4], x2[5]), pk2(x2[6], x2[7])};
                    }
                    const int t = row % T_;
                    const float* cs = rope + (size_t)t * 32 + 8 * fq; const float* sn = cs + (size_t)T_ * 32;
                    const f32x4 c0 = *(const f32x4*)cs, c1 = *(const f32x4*)(cs + 4), s0 = *(const f32x4*)sn, s1 = *(const f32x4*)(sn + 4);
#pragma unroll
                    for (int i = 0; i < 8; ++i) { const float c = i < 4 ? c0[i & 3] : c1[i & 3], s = i < 4 ? s0[i & 3] : s1[i & 3]; const float a = x1[i], b = x2[i]; x1[i] = a * c - b * s; x2[i] = b * c + a * s; }
                } else if (kind == 3) {
#pragma unroll
                    for (int i = 0; i < 8; ++i) { x1[i] = silu_f(x1[i]); x2[i] = silu_f(x2[i]); }
                }
                bf16_t* o = (kind == 2 ? dst2 : dst) + (size_t)row * pitch + colb + 8 * fq;
                *(u32x4*)o = (u32x4){pk2(x1[0], x1[1]), pk2(x1[2], x1[3]), pk2(x1[4], x1[5]), pk2(x1[6], x1[7])};
                *(u32x4*)(o + 32) = (u32x4){pk2(x2[0], x2[1]), pk2(x2[2], x2[3]), pk2(x2[4], x2[5]), pk2(x2[6], x2[7])};
            }
    }
};

struct EpiGlu {
    static constexpr bool PERM = true, AFTER_DRAIN = false;
    const bf16_t* YG; const bf16_t* ZS; bf16_t* MIX; const float* glub;
    DEV void operator()(const f32x4 (&acc)[2][2][4][2], const pg8::Unit& u, int wr, int wc, int fr, int fq) const {
        const int row0 = u.pm * 256 + wr * 64 + fr, col0 = u.pn * 256 + wc * 32 + 8 * fq;
        f32x4 bv[2][2]; u32x4 ya[2][2], za[2][2];
#pragma unroll
        for (int bj = 0; bj < 2; ++bj) { bv[bj][0] = *(const f32x4*)(glub + col0 + bj * 128); bv[bj][1] = *(const f32x4*)(glub + col0 + bj * 128 + 4); }
#define EG_ROW(grp, mm) (row0 + (((grp) >> 1) & 1) * 128 + (2 * ((grp) & 1) + (mm)) * 16)
#define EG_COL(grp) (col0 + ((grp) >> 2) * 128)
#define EG_LOAD(grp) do { _Pragma("unroll") for (int mm = 0; mm < 2; ++mm) { ya[(grp) & 1][mm] = *(const u32x4*)(YG + (size_t)EG_ROW(grp, mm) * 512 + EG_COL(grp)); za[(grp) & 1][mm] = *(const u32x4*)(ZS + (size_t)EG_ROW(grp, mm) * 512 + EG_COL(grp)); } } while (0)
        EG_LOAD(0);
#pragma unroll
        for (int grp = 0; grp < 8; ++grp) {
            const int bj = grp >> 2, ai = (grp >> 1) & 1;
            if (grp < 7) EG_LOAD(grp + 1);
            SCHED_FENCE();
#pragma unroll
            for (int mm = 0; mm < 2; ++mm) {
                const int m = 2 * (grp & 1) + mm; const u32x4 yv = ya[grp & 1][mm], zv = za[grp & 1][mm];
                float o[8];
#pragma unroll
                for (int i = 0; i < 8; ++i) {
                    const float a = (i < 4 ? acc[ai][bj][m][0][i & 3] : acc[ai][bj][m][1][i & 3]) + (i < 4 ? bv[bj][0][i & 3] : bv[bj][1][i & 3]);
                    const unsigned yw = yv[i >> 1], zw = zv[i >> 1];
                    const float y = bf2f((i & 1) ? (yw >> 16) : (yw & 0xffffu)), z = bf2f((i & 1) ? (zw >> 16) : (zw & 0xffffu));
                    o[i] = y * sigmoid_f(a) * z;
                }
                *(u32x4*)(MIX + (size_t)EG_ROW(grp, mm) * 1024 + 512 + EG_COL(grp)) = (u32x4){pk2(o[0], o[1]), pk2(o[2], o[3]), pk2(o[4], o[5]), pk2(o[6], o[7])};
            }
            SCHED_FENCE();
        }
#undef EG_ROW
#undef EG_COL
#undef EG_LOAD
    }
};

struct EpiOut {
    static constexpr bool PERM = true, AFTER_DRAIN = false;
    const float* x; float* out; const float* mod;
    DEV void operator()(const f32x4 (&acc)[2][2][4][2], const pg8::Unit& u, int wr, int wc, int fr, int fq) const {
        const int row0 = u.pm * 256 + wr * 64 + fr, col0 = u.pn * 256 + wc * 32 + 8 * fq; const int b = (u.pm * 256) / T_;
        f32x4 gv[2][2], xa[2][2][2];
#pragma unroll
        for (int bj = 0; bj < 2; ++bj) { gv[bj][0] = *(const f32x4*)(mod + (size_t)b * 3072 + 2048 + col0 + bj * 128); gv[bj][1] = *(const f32x4*)(mod + (size_t)b * 3072 + 2048 + col0 + bj * 128 + 4); }
#define EO_OFF(grp, mm) ((size_t)(row0 + (((grp) >> 1) & 1) * 128 + (2 * ((grp) & 1) + (mm)) * 16) * 1024 + col0 + ((grp) >> 2) * 128)
#define EO_LOAD(grp) do { _Pragma("unroll") for (int mm = 0; mm < 2; ++mm) { xa[(grp) & 1][mm][0] = *(const f32x4*)(x + EO_OFF(grp, mm)); xa[(grp) & 1][mm][1] = *(const f32x4*)(x + EO_OFF(grp, mm) + 4); } } while (0)
        EO_LOAD(0);
#pragma unroll
        for (int grp = 0; grp < 8; ++grp) {
            const int bj = grp >> 2, ai = (grp >> 1) & 1;
            if (grp < 7) EO_LOAD(grp + 1);
            SCHED_FENCE();
#pragma unroll
            for (int mm = 0; mm < 2; ++mm) {
                const int m = 2 * (grp & 1) + mm;
                *(f32x4*)(out + EO_OFF(grp, mm)) = xa[grp & 1][mm][0] + gv[bj][0] * acc[ai][bj][m][0];
                *(f32x4*)(out + EO_OFF(grp, mm) + 4) = xa[grp & 1][mm][1] + gv[bj][1] * acc[ai][bj][m][1];
            }
            SCHED_FENCE();
        }
#undef EO_OFF
#undef EO_LOAD
    }
};

DEV size_t frag_idx(int row, int k, int K) { return ((size_t)((row >> 4) * (K >> 5) + (k >> 5)) * 64 + 16 * ((k >> 3) & 3) + (row & 15)) * 8 + (k & 7); }
DEV void tr_item(const float* W, int Nsrc, int K, int k0, int col0, int nvalid, bf16_t* WT, int drow0, float* scr, int lane, bool frag = false) {
    const int c = lane & 31;
    float v[32];
#pragma unroll
    for (int i = 0; i < 32; ++i) { const int kk = 2 * i + (lane >> 5); v[i] = (c < nvalid) ? W[(size_t)(k0 + kk) * Nsrc + col0 + c] : 0.f; }
#pragma unroll
    for (int i = 0; i < 32; ++i) { const int kk = 2 * i + (lane >> 5); scr[kk * 33 + c] = v[i]; }
    WAVE_SYNC();
    const int c8 = lane & 7;
#pragma unroll
    for (int j = 0; j < 4; ++j) { const int n = (lane >> 3) + 8 * j; const float* s = scr + (8 * c8) * 33 + n;
        u32x4 o; o.x = pk2(s[0 * 33], s[1 * 33]); o.y = pk2(s[2 * 33], s[3 * 33]); o.z = pk2(s[4 * 33], s[5 * 33]); o.w = pk2(s[6 * 33], s[7 * 33]);
        const int row = drow0 + n, k8 = (k0 >> 3) + c8;
        *(u32x4*)(WT + (frag ? ((size_t)((row >> 4) * (K >> 5) + (k8 >> 2)) * 64 + 16 * (k8 & 3) + (row & 15)) * 8 : (size_t)row * K + k0 + 8 * c8)) = o; }
    WAVE_SYNC();
}

DEV void p0_prologue(const Params& p, unsigned char* lds, int vcu, int G, int tid, int wave, int lane) {
    unsigned char* ws = p.ws;
    {
        const float* c = p.in[I_C]; const float* w = p.in[I_WADA]; const float* ba = p.in[I_BADA]; float* mod = (float*)(ws + WS_MOD);
        for (int cb = vcu; cb < 256; cb += G)
            for (int b = wave; b < B_; b += 8) {
                float a[12];
#pragma unroll
                for (int j = 0; j < 12; ++j) a[j] = 0.f;
#pragma unroll 8
                for (int i = 0; i < 16; ++i) {
                    const int k = lane + 64 * i; const float s = silu_f(c[b * 1024 + k]);
                    const f32x4* wp = (const f32x4*)(w + (size_t)k * 3072 + 12 * cb); const f32x4 w0 = wp[0], w1 = wp[1], w2 = wp[2];
#pragma unroll
                    for (int j = 0; j < 4; ++j) { a[j] += s * w0[j]; a[4 + j] += s * w1[j]; a[8 + j] += s * w2[j]; }
                }
#pragma unroll
                for (int j = 0; j < 12; ++j) a[j] = wave_sum(a[j]);
                if (lane == 0) {
#pragma unroll
                    for (int j = 0; j < 12; ++j) mod[b * 3072 + 12 * cb + j] = a[j] + ba[12 * cb + j];
                }
            }
    }
    {
        float* scr = (float*)(lds + wave * 16384);
        const int gw = vcu * 8 + wave, NGW = G * 8;
        constexpr int I_IN = 96 * 16, I_O = 32 * 16, I_GL = 16 * 8, I_W1 = 8 * 32, I_W2 = 2 * 4;
        constexpr int NIT = I_IN + I_O + I_GL + 2 * I_W1 + 2 * I_W2;
        for (int it = gw; it < NIT; it += NGW) {
            int r = it;
            if (r < I_IN) {
                const int ci = r / 16, kb = r % 16, n0 = 32 * ci, pn = n0 >> 8, bj = (n0 >> 7) & 1, wc = (n0 >> 5) & 3, L0 = 256 * pn + 64 * wc + 32 * bj;
                int oc, nv; if (L0 < 1792) { oc = L0; nv = 32; } else if (L0 < 2816) { oc = L0 + 24; nv = 32; } else if (L0 == 2816) { oc = 1792; nv = 24; } else { oc = 0; nv = 0; }
                tr_item(p.in[I_WIN], INW, 1024, 64 * kb, oc, nv, (bf16_t*)(ws + WS_WIN), n0, scr, lane); continue; }
            r -= I_IN;
            if (r < I_O) { tr_item(p.in[I_WOUT], 1024, 1024, 64 * (r % 16), 32 * (r / 16), 32, (bf16_t*)(ws + WS_WO), 32 * (r / 16), scr, lane); continue; }
            r -= I_O;
            if (r < I_GL) { tr_item(p.in[I_GLUW], 512, 512, 64 * (r % 8), 32 * (r / 8), 32, (bf16_t*)(ws + WS_WGLU), 32 * (r / 8), scr, lane); continue; }
            r -= I_GL;
            if (r < I_W1) { tr_item(p.in[I_W1K], 256, 2048, 64 * (r % 32), 32 * (r / 32), 32, (bf16_t*)(ws + WS_W1K), 32 * (r / 32), scr, lane, true); continue; }
            r -= I_W1;
            if (r < I_W1) { tr_item(p.in[I_W1V], 256, 2048, 64 * (r % 32), 32 * (r / 32), 32, (bf16_t*)(ws + WS_W1V), 32 * (r / 32), scr, lane, true); continue; }
            r -= I_W1;
            if (r < I_W2) { tr_item(p.in[I_W2K], 64, 256, 64 * (r % 4), 32 * (r / 4), 32, (bf16_t*)(ws + WS_W2K), 32 * (r / 4), scr, lane); continue; }
            r -= I_W2;
            tr_item(p.in[I_W2V], 64, 256, 64 * (r % 4), 32 * (r / 4), 32, (bf16_t*)(ws + WS_W2V), 32 * (r / 4), scr, lane);
        }
    }
    {
        const float H1[32] = {2.037182617e+01f, 1.527673340e+01f, 1.145593262e+01f, 8.590698242e+00f, 6.442138672e+00f, 4.830932617e+00f, 3.622680664e+00f, 2.716613770e+00f, 2.037170410e+00f, 1.527679443e+00f, 1.145599365e+00f, 8.590698242e-01f, 6.442108154e-01f, 4.830932617e-01f, 3.622665405e-01f, 2.716636658e-01f, 2.037181854e-01f, 1.527671814e-01f, 1.145591736e-01f, 8.590698242e-02f, 6.442165375e-02f, 4.830932617e-02f, 3.622674942e-02f, 2.716636658e-02f, 2.037191391e-02f, 1.527667046e-02f, 1.145589352e-02f, 8.590698242e-03f, 6.442129612e-03f, 4.830896854e-03f, 3.622680902e-03f, 2.716630697e-03f};
        const float L1[32] = {6.543887594e-06f, -1.416575378e-05f, -9.063650396e-06f, 3.259562436e-05f, 4.341966076e-07f, -9.333384696e-06f, 3.694024997e-07f, 1.383195467e-05f, 1.289177635e-05f, -7.611160072e-06f, -7.100949915e-06f, 3.214027856e-06f, 3.140712124e-06f, -1.001640385e-06f, 1.570408244e-06f, -8.980337611e-07f, 1.371793559e-07f, 1.700163388e-08f, 6.043357104e-08f, 3.195055172e-07f, -2.581333831e-07f, -9.542085166e-08f, 6.167339706e-08f, -9.075201035e-08f, -8.022654185e-08f, 4.843524337e-08f, 2.941089683e-08f, 3.325492770e-08f, 9.949448376e-09f, 2.627999152e-08f, 1.475850692e-10f, -2.996157100e-09f};
        const float H2[32] = {1.591548920e-01f, 1.193494797e-01f, 8.949947357e-02f, 6.711483002e-02f, 5.032920837e-02f, 3.774166107e-02f, 2.830219269e-02f, 2.122354507e-02f, 1.591539383e-02f, 1.193499565e-02f, 8.949995041e-03f, 6.711483002e-03f, 5.032896996e-03f, 3.774166107e-03f, 2.830207348e-03f, 2.122372389e-03f, 1.591548324e-03f, 1.193493605e-03f, 8.949935436e-04f, 6.711483002e-04f, 5.032941699e-04f, 3.774166107e-04f, 2.830214798e-04f, 2.122372389e-04f, 1.591555774e-04f, 1.193489879e-04f, 8.949916810e-05f, 6.711483002e-05f, 5.032913759e-05f, 3.774138168e-05f, 2.830219455e-05f, 2.122367732e-05f};
        const float L2[32] = {5.112412182e-08f, -1.106699514e-07f, -7.080976872e-08f, 2.546533153e-07f, 3.392160997e-09f, -7.291706794e-08f, 2.885957029e-09f, 1.080621459e-07f, 1.007170027e-07f, -5.946218806e-08f, -5.547617121e-08f, 2.510959263e-08f, 2.453681347e-08f, -7.825315507e-09f, 1.226881441e-08f, -7.015888759e-09f, 1.071713718e-09f, 1.328252647e-10f, 4.721372737e-10f, 2.496136853e-09f, -2.016667056e-09f, -7.454754036e-10f, 4.818234145e-10f, -7.090000809e-10f, -6.267698582e-10f, 3.784003388e-10f, 2.297726315e-10f, 2.598041227e-10f, 7.773006544e-11f, 2.053124337e-10f, 1.153008353e-12f, -2.340747735e-11f};
        float* rc = (float*)(ws + WS_ROPE); float* rs = rc + (size_t)T_ * 32;
        for (int i = vcu * 512 + tid; i < T_ * 32; i += G * 512) {
            const int t = i >> 5, d = i & 31; const float th = (float)(t >> 7), tl = (float)(t & 127);
            const float a = th * H1[d], c = tl * H2[d];
            float rev = (a - floorf(a)) + (c - floorf(c)) + (th * L1[d] + tl * L2[d]);
            rev -= floorf(rev);
#ifdef CPU_EMU
            rc[i] = cosf(6.283185307179586f * rev); rs[i] = sinf(6.283185307179586f * rev);
#else
            rc[i] = __builtin_amdgcn_cosf(rev); rs[i] = __builtin_amdgcn_sinf(rev);
#endif
        }
    }
    __syncthreads();
    {
        f32x2* lp = (f32x2*)lds;
        f32x2* bb = lp + 64;
        f32x2* cc = bb + 1024;
        f32x2* ee = cc + 1024;
        for (int it = vcu; it < 32 * 13 + 32; it += G) {
            if (it >= 32 * 13) {
                const int r = it - 32 * 13, kv = r >> 4, ks = r & 15; const float* pos = p.in[kv ? I_POSV : I_POSK]; const float* w1 = p.in[kv ? I_W1V : I_W1K];
                const int j = tid & 255, i0 = 128 * ks + 64 * (tid >> 8); float a = 0.f;
#pragma unroll 32
                for (int i = i0; i < i0 + 64; ++i) a += pos[i] * w1[(size_t)i * 256 + j];
                atomicAdd((unsigned*)(ws + WS_CPOS) + kv * 256 + j, (unsigned)(int)__builtin_rintf(a * 16777216.0f));
                continue;
            }
            const int g = it / 13, nb = it % 13;
            const float dt = expf(p.in[I_LOGDT][g]);
            for (int e = tid; e < 1024; e += 512) {
                const int pp = e >> 4, ci = e & 15;
                const float ar = p.in[I_ARE][g * 64 + pp], ai = p.in[I_AIM][g * 64 + pp], x = ar * dt, y = ai * dt;
                const float em1 = expm1f(x), ex = em1 + 1.0f, cy = cosf(y), sy = sinf(y), sh = sinf(0.5f * y);
                const float lr = em1 * cy - 2.0f * sh * sh, li = ex * sy;
                const float den = ar * ar + ai * ai, fr_ = (lr * ar + li * ai) / den, fi_ = (li * ar - lr * ai) / den;
                const float br = p.in[I_BRE][(g * 64 + pp) * 16 + ci], bi = p.in[I_BIM][(g * 64 + pp) * 16 + ci];
                bb[e] = (f32x2){fr_ * br - fi_ * bi, fr_ * bi + fi_ * br};
                const int co = e >> 6, p2 = e & 63;
                cc[e] = (f32x2){p.in[I_CRE][(g * 16 + co) * 64 + p2], p.in[I_CIM][(g * 16 + co) * 64 + p2]};
            }
            for (int n = 5 * nb; n < 5 * nb + 5; ++n) {
                if (tid < 64) {
                    const float ar = p.in[I_ARE][g * 64 + tid], ai = p.in[I_AIM][g * 64 + tid];
                    const float mag = expf(ar * dt * (float)n), ang = ai * dt * (float)n;
                    lp[tid] = (f32x2){mag * cosf(ang), mag * sinf(ang)};
                }
                __syncthreads();
                for (int e = tid; e < 1024; e += 512) { const f32x2 l = lp[e >> 4], b = bb[e]; ee[e] = (f32x2){l.x * b.x - l.y * b.y, l.x * b.y + l.y * b.x}; }
                __syncthreads();
                if (n < 64) {
                    bf16_t* KT = (bf16_t*)(ws + WS_KT) + (size_t)g * 65 * 256;
                    if (tid < 256) {
                        const int co = tid >> 4, ci = tid & 15; float a = 0.f;
                        for (int pp = 0; pp < 64; ++pp) { const f32x2 c = cc[co * 64 + pp], e = ee[pp * 16 + ci]; a += c.x * e.x - c.y * e.y; }
                        KT[(n + 1) * 256 + tid] = (bf16_t)f2bf(a);
                        if (n == 0) KT[tid] = 0;
                    }
                    bf16_t* WST = (bf16_t*)(ws + WS_WST) + (size_t)g * 128 * 1024; const int sidx = 63 - n;
                    for (int e = tid; e < 1024; e += 512) { const int pp = e >> 4, ci = e & 15; const f32x2 v = ee[e];
                        WST[frag_idx(pp, sidx * 16 + ci, 1024)] = (bf16_t)f2bf(v.x); WST[frag_idx(64 + pp, sidx * 16 + ci, 1024)] = (bf16_t)f2bf(v.y); }
                }
                if (n >= 1) {
                    bf16_t* WO = (bf16_t*)(ws + WS_WOUTS) + (size_t)g * 1024 * 128; const int t = n - 1;
                    for (int e = tid; e < 1024; e += 512) { const int co = e >> 6, pp = e & 63; const f32x2 c = cc[e], l = lp[pp];
                        WO[frag_idx(t * 16 + co, pp, 128)] = (bf16_t)f2bf(c.x * l.x - c.y * l.y); WO[frag_idx(t * 16 + co, 64 + pp, 128)] = (bf16_t)f2bf(-(c.x * l.y + c.y * l.x)); }
                }
                if (n == 64 && tid < 64) ((f32x2*)(ws + WS_LAM64))[g * 64 + tid] = lp[tid];
                __syncthreads();
            }
        }
    }
}

DEV void p1_norm(const Params& p, int vcu, int G, int wave, int lane) {
    const float* x = p.in[I_X]; const float* ng = p.in[I_NORMG]; const float* mod = (const float*)(p.ws + WS_MOD); bf16_t* HN = (bf16_t*)(p.ws + WS_HN);
    const int gw = vcu * 8 + wave, NGW = G * 8;
    constexpr int RB = 32;
    for (int it = gw; it < M_ / RB; it += NGW) {
        const int r0 = it * RB, b = r0 / T_;
        f32x4 cs[4], sh[4];
#pragma unroll
        for (int j = 0; j < 4; ++j) { const int k = 4 * lane + 256 * j; const f32x4 g = *(const f32x4*)(ng + k), sc = *(const f32x4*)(mod + (size_t)b * 3072 + 1024 + k);
            cs[j] = g * (sc + 1.0f); sh[j] = *(const f32x4*)(mod + (size_t)b * 3072 + k); }
        for (int r = r0; r < r0 + RB; ++r) {
            const f32x4* xr = (const f32x4*)(x + (size_t)r * 1024) + lane; f32x4 v[4]; float s = 0.f;
#pragma unroll
            for (int j = 0; j < 4; ++j) { v[j] = xr[64 * j]; s += (v[j].x * v[j].x + v[j].y * v[j].y) + (v[j].z * v[j].z + v[j].w * v[j].w); }
            const float rinv = rsqrtf(wave_sum(s) * (1.0f / 1024.0f) + EPS_);
            u32x2* o = (u32x2*)(HN + (size_t)r * 1024) + lane;
#pragma unroll
            for (int j = 0; j < 4; ++j) { const f32x4 h = v[j] * rinv * cs[j] + sh[j]; o[64 * j] = (u32x2){pk2(h.x, h.y), pk2(h.z, h.w)}; }
        }
#ifndef CPU_EMU
        asm volatile("s_waitcnt vmcnt(0)" ::: "memory");
#else
        emu_wave_sync();
#endif
        gates_rows(p.ws, (size_t)r0, lane);
    }
}

constexpr int UL_CH = 2064;
constexpr int SSM_UL = 0, SSM_KT = 32 * UL_CH, SSM_SLOC = SSM_KT + 65 * 256 * 2, SSM_CBT = SSM_SLOC + 128 * 32 * 4, SSM_END = SSM_CBT + 32 * 272;
static_assert(SSM_END <= RING_BYTES, "ssm lds");
DEV void ssm_unit(const Params& p, unsigned char* lds, int unit, int tid, int wave, int lane) {
    const int b = unit / SSM_NG, g = unit % SSM_NG; const int l16 = lane & 15, q4 = lane >> 4;
    unsigned char* ws = p.ws;
    const bf16_t* U = (const bf16_t*)(ws + WS_U); bf16_t* YG = (bf16_t*)(ws + WS_YG);
    const bf16_t* WST = (const bf16_t*)(ws + WS_WST) + (size_t)g * 128 * 1024; const bf16_t* WO = (const bf16_t*)(ws + WS_WOUTS) + (size_t)g * 1024 * 128;
    unsigned char* ul = lds + SSM_UL; bf16_t* ktl = (bf16_t*)(lds + SSM_KT); float* sloc = (float*)(lds + SSM_SLOC); bf16_t* cbt = (bf16_t*)(lds + SSM_CBT);
    { const u32x4* src = (const u32x4*)((const bf16_t*)(ws + WS_KT) + (size_t)g * 65 * 256); u32x4* dstv = (u32x4*)ktl; for (int i = tid; i < 65 * 256 * 2 / 16; i += 512) dstv[i] = src[i]; }
    float sre = 0.f, sim = 0.f; f32x2 lam = {0.f, 0.f};
    if (wave == 0) lam = ((const f32x2*)(ws + WS_LAM64))[g * 64 + lane];
    f32x4 dsk = *(const f32x4*)(p.in[I_SSMD] + 16 * g + 4 * q4);
    for (int cg = 0; cg < SSM_NCG; ++cg) {
        const size_t tokbase = (size_t)b * T_ + (size_t)cg * 2048;
#pragma unroll
        for (int i = 0; i < 8; ++i) { const int idx = tid + 512 * i, tok = idx >> 1, hf = idx & 1;
            *(u32x4*)(ul + (tok >> 6) * UL_CH + (tok & 63) * 32 + hf * 16) = *(const u32x4*)(U + (tokbase + tok) * 512 + 16 * g + 8 * hf); }
        __syncthreads();
        {
            f32x4 a1[2] = {(f32x4){0.f, 0.f, 0.f, 0.f}, (f32x4){0.f, 0.f, 0.f, 0.f}};
            const bf16_t* ap = WST + ((size_t)wave * 32 * 64 + lane) * 8;
            const unsigned char* bp = ul + l16 * UL_CH + (q4 >> 1) * 32 + (q4 & 1) * 16;
            bf16x8 aa[2][4];
#pragma unroll
            for (int q = 0; q < 4; ++q) aa[0][q] = ld8(ap + 512 * q);
#pragma unroll
            for (int kb = 0; kb < 8; ++kb) {
                if (kb < 7) {
#pragma unroll
                    for (int q = 0; q < 4; ++q) aa[(kb + 1) & 1][q] = ld8(ap + 512 * (4 * kb + 4 + q));
                }
                SCHED_FENCE();
#pragma unroll
                for (int q = 0; q < 4; ++q) { const int ks = 4 * kb + q;
                    const bf16x8 b0 = *(const bf16x8*)(bp + ks * 64), b1 = *(const bf16x8*)(bp + 16 * UL_CH + ks * 64);
                    a1[0] = mfma16(aa[kb & 1][q], b0, a1[0]); a1[1] = mfma16(aa[kb & 1][q], b1, a1[1]); }
                SCHED_FENCE();
            }
#pragma unroll
            for (int ct = 0; ct < 2; ++ct)
#pragma unroll
                for (int r = 0; r < 4; ++r) sloc[(16 * wave + 4 * q4 + r) * 32 + 16 * ct + l16] = a1[ct][r];
        }
        __syncthreads();
        if (wave == 0) {
            for (int c = 0; c < 32; ++c) {
                cbt[c * 136 + lane] = (bf16_t)f2bf(sre); cbt[c * 136 + 64 + lane] = (bf16_t)f2bf(sim);
                const float lr = sloc[lane * 32 + c], li = sloc[(64 + lane) * 32 + c];
                const float nr = lam.x * sre - lam.y * sim + lr, ni = lam.x * sim + lam.y * sre + li; sre = nr; sim = ni;
            }
        }
        __syncthreads();
        for (int i = 0; i < 8; ++i) {
            const int t = wave + 8 * i;
            f32x4 a3[2] = {(f32x4){0.f, 0.f, 0.f, 0.f}, (f32x4){0.f, 0.f, 0.f, 0.f}};
            const unsigned char* bp = ul + l16 * UL_CH + (q4 >> 1) * 32 + (q4 & 1) * 16;
            const bf16_t* kp = ktl + (t - (q4 >> 1) + 1) * 256 + l16 * 16 + 8 * (q4 & 1);
            const int nks = (t >> 1) + 1;
            const bf16_t* wp = WO + ((size_t)t * 4 * 64 + lane) * 8;
            bf16x8 wa[4];
#pragma unroll
            for (int ks = 0; ks < 4; ++ks) wa[ks] = ld8(wp + 512 * ks);
            {
                bf16x8 an = ld8(kp), b0n = *(const bf16x8*)(bp), b1n = *(const bf16x8*)(bp + 16 * UL_CH);
                for (int ks = 0; ks < nks; ++ks) {
                    const bf16x8 a = an, b0 = b0n, b1 = b1n;
                    const int kn = (ks + 1 < nks) ? ks + 1 : ks;
                    an = ld8(kp - kn * 512); b0n = *(const bf16x8*)(bp + kn * 64); b1n = *(const bf16x8*)(bp + 16 * UL_CH + kn * 64);
                    a3[0] = mfma16(a, b0, a3[0]); a3[1] = mfma16(a, b1, a3[1]);
                }
            }
#pragma unroll
            for (int ks = 0; ks < 4; ++ks) {
                const bf16x8 b0 = ld8(cbt + l16 * 136 + 32 * ks + 8 * q4), b1 = ld8(cbt + (16 + l16) * 136 + 32 * ks + 8 * q4);
                a3[0] = mfma16(wa[ks], b0, a3[0]); a3[1] = mfma16(wa[ks], b1, a3[1]);
            }
#pragma unroll
            for (int ct = 0; ct < 2; ++ct) {
                const int chunk = 16 * ct + l16; const size_t tok = tokbase + (size_t)chunk * 64 + t;
                const u32x2 uv = *(const u32x2*)(ul + chunk * UL_CH + t * 32 + 8 * q4);
                float y[4];
#pragma unroll
                for (int r = 0; r < 4; ++r) { const unsigned w = uv[r >> 1]; const float uu = bf2f((r & 1) ? (w >> 16) : (w & 0xffffu)); y[r] = gelu_tanh_f(a3[ct][r] + dsk[r] * uu); }
                *(u32x2*)(YG + tok * 512 + 16 * g + 4 * q4) = (u32x2){pk2(y[0], y[1]), pk2(y[2], y[3])};
            }
        }
        __syncthreads();
    }
}

constexpr int CMP_TOK = 0, CMP_H = 528 * 128, CMP_OUT = CMP_H + 32 * 528, CMP_END = CMP_OUT + 32 * 64 * 4;
static_assert(CMP_END <= RING_BYTES, "cmp lds");
constexpr int CMP_UNITS = 2 * B_ * NGRP * (NCP / 32);
DEV void compress_unit(const Params& p, unsigned char* lds, int unit, int tid, int wave, int lane) {
    int r = unit; const int nb = r % (NCP / 32); r /= (NCP / 32); const int g = r % NGRP; r /= NGRP; const int b = r % B_; const int kv = r / B_;
    const int l16 = lane & 15, q4 = lane >> 4; unsigned char* ws = p.ws;
    const bf16_t* CR = (const bf16_t*)(ws + WS_CR); const bf16_t* w1t = (const bf16_t*)(ws + (kv ? WS_W1V : WS_W1K)); const bf16_t* w2t = (const bf16_t*)(ws + (kv ? WS_W2V : WS_W2K));
    const float* cpos = (const float*)(ws + WS_CPOS) + kv * 256;
    unsigned char* tokl = lds + CMP_TOK; bf16_t* hl = (bf16_t*)(lds + CMP_H); float* outl = (float*)(lds + CMP_OUT);
    const int n0 = 32 * nb, tk0 = 16 * n0;
    for (int idx = tid; idx < 528 * 8; idx += 512) {
        const int tl = idx >> 3, ch = idx & 7; const int tok = tk0 + tl;
        u32x4 v = (u32x4){0u, 0u, 0u, 0u};
        if (tok < T_) v = *(const u32x4*)(CR + ((size_t)b * T_ + tok) * 256 + kv * 128 + g * 64 + 8 * ch);
        *(u32x4*)(tokl + (tl * 8 + (ch ^ ((tl >> 4) & 7))) * 16) = v;
    }
    __syncthreads();
    f32x4 acc[2][2];
#pragma unroll
    for (int a = 0; a < 2; ++a)
#pragma unroll
        for (int c = 0; c < 2; ++c) acc[a][c] = (f32x4){0.f, 0.f, 0.f, 0.f};
    const bf16_t* bp0 = w1t + ((size_t)(2 * wave) * 64 * 64 + lane) * 8; const bf16_t* bp1 = bp0 + (size_t)64 * 64 * 8;
    bf16x8 bb[2][4][2];
#pragma unroll
    for (int q = 0; q < 4; ++q) { bb[0][q][0] = ld8(bp0 + 512 * q); bb[0][q][1] = ld8(bp1 + 512 * q); }
#pragma unroll
    for (int kb = 0; kb < 16; ++kb) {
        if (kb < 15) {
#pragma unroll
            for (int q = 0; q < 4; ++q) { bb[(kb + 1) & 1][q][0] = ld8(bp0 + 512 * (4 * kb + 4 + q)); bb[(kb + 1) & 1][q][1] = ld8(bp1 + 512 * (4 * kb + 4 + q)); }
        }
        SCHED_FENCE();
#pragma unroll
        for (int q = 0; q < 4; ++q) { const int ks = 4 * kb + q;
            const int l = ks >> 1, chunk = 4 * (ks & 1) + q4;
            const int tl0 = 16 * l16 + l, tl1 = 16 * (16 + l16) + l;
            const bf16x8 a0 = *(const bf16x8*)(tokl + (tl0 * 8 + (chunk ^ ((tl0 >> 4) & 7))) * 16), a1 = *(const bf16x8*)(tokl + (tl1 * 8 + (chunk ^ ((tl1 >> 4) & 7))) * 16);
            const bf16x8 b0 = bb[kb & 1][q][0], b1 = bb[kb & 1][q][1];
            acc[0][0] = mfma16(a0, b0, acc[0][0]); acc[0][1] = mfma16(a0, b1, acc[0][1]); acc[1][0] = mfma16(a1, b0, acc[1][0]); acc[1][1] = mfma16(a1, b1, acc[1][1]); }
        SCHED_FENCE();
    }
#pragma unroll
    for (int rt = 0; rt < 2; ++rt)
#pragma unroll
        for (int ct = 0; ct < 2; ++ct) { const int j = 32 * wave + 16 * ct + l16; const float cp = (float)((const int*)cpos)[j] * (1.0f / 16777216.0f);
#pragma unroll
            for (int rr = 0; rr < 4; ++rr) hl[(16 * rt + 4 * q4 + rr) * 264 + j] = (bf16_t)f2bf(gelu_tanh_f(acc[rt][ct][rr] + cp)); }
    __syncthreads();
    {
        const int rt = wave >> 2, ct = wave & 3; f32x4 a2 = (f32x4){0.f, 0.f, 0.f, 0.f};
#pragma unroll
        for (int ks = 0; ks < 8; ++ks) { const bf16x8 a = ld8(hl + (16 * rt + l16) * 264 + 32 * ks + 8 * q4), bq = ld8(w2t + (size_t)(16 * ct + l16) * 256 + 32 * ks + 8 * q4); a2 = mfma16(a, bq, a2); }
#pragma unroll
        for (int rr = 0; rr < 4; ++rr) outl[(16 * rt + 4 * q4 + rr) * 64 + 16 * ct + l16] = a2[rr];
    }
    __syncthreads();
    {
        const int row = tid >> 4, c4 = tid & 15; f32x4 v = *(const f32x4*)(outl + row * 64 + 4 * c4);
        if (kv == 0) {
            float ss = v.x * v.x + v.y * v.y + v.z * v.z + v.w * v.w;
            ss += __shfl_xor(ss, 1); ss += __shfl_xor(ss, 2); ss += __shfl_xor(ss, 4); ss += __shfl_xor(ss, 8);
            const float rinv = rsqrtf(ss * (1.0f / 64.0f) + EPS_); const f32x4 gk = *(const f32x4*)(p.in[I_KCNG] + 4 * c4);
            v = v * rinv * gk;
        }
        const int n = n0 + row; if (n >= NCMP) v = (f32x4){0.f, 0.f, 0.f, 0.f};
        bf16_t* dst = (bf16_t*)(ws + (kv ? WS_VC : WS_KC)) + (((size_t)b * NCP + n) * NGRP + g) * 64 + 4 * c4;
        *(u32x2*)dst = (u32x2){pk2(v.x, v.y), pk2(v.z, v.w)};
    }
    __syncthreads();
}

constexpr int VT_UNITS = B_ * NGRP * (T_ / 64);
struct VtPre { u32x4 v, k; };
DEV void vt_fetch(const Params& p, int unit, int tid, VtPre& r) {
    const int tb = unit % (T_ / 64), bg = unit / (T_ / 64), b = bg / NGRP, g = bg % NGRP;
    const bf16_t* SLk = (const bf16_t*)(p.ws + WS_SL) + ((size_t)b * T_ + 64 * tb) * 256 + g * 64; const bf16_t* SLv = SLk + 128;
    { const int tok = tid >> 3, ch = tid & 7; r.v = *(const u32x4*)(SLv + (size_t)tok * 256 + 8 * ch); }
    {
      const int kt = tid >> 8, ks = (tid >> 6) & 3, h = (tid >> 5) & 1, r32 = tid & 31, kr = (r32 & ~12) | ((r32 & 8) >> 1) | ((r32 & 4) << 1);
      r.k = *(const u32x4*)(SLk + (size_t)(32 * kt + kr) * 256 + 16 * ks + 8 * h); }
}
DEV void vt_unit(const Params& p, unsigned char* lds, int unit, int tid, const VtPre& r) {
    const int tb = unit % (T_ / 64), bg = unit / (T_ / 64);
    bf16_t* VF = (bf16_t*)(p.ws + WS_VT) + ((size_t)bg * (T_ / 64) + tb) * 4096; bf16_t* KF = (bf16_t*)(p.ws + WS_KF) + ((size_t)bg * (T_ / 64) + tb) * 4096;
    bf16_t* tile = (bf16_t*)lds;
    { const int tok = tid >> 3, ch = tid & 7; *(u32x4*)(tile + tok * 72 + 8 * ch) = r.v; }
    *(u32x4*)(KF + tid * 8) = r.k;
    __syncthreads();
    { const int dim = tid >> 3, c8 = tid & 7; unsigned short e[8];
#pragma unroll
      for (int i = 0; i < 8; ++i) e[i] = tile[(8 * c8 + i) * 72 + dim];
      *(u32x4*)(VF + (((dim >> 5) * 4 + (c8 >> 1)) * 64 + 32 * (c8 & 1) + (dim & 31)) * 8) = (u32x4){(unsigned)e[0] | ((unsigned)e[1] << 16), (unsigned)e[2] | ((unsigned)e[3] << 16), (unsigned)e[4] | ((unsigned)e[5] << 16), (unsigned)e[6] | ((unsigned)e[7] << 16)}; }
    __syncthreads();
}

constexpr int AT_KB = 0, AT_VOFF = 128 * 160, AT_STAGE = 2 * AT_VOFF, AT_IA = 2 * AT_STAGE, AT_IB = AT_IA + 64 * 128 * 4, AT_SEL = AT_IB + 64 * 128 * 4, AT_TM = AT_SEL + 64 * 16, AT_END = AT_TM + 128 * 8;
constexpr int EN_QL = 0, EN_OL = 40960, EN_LL = EN_OL + 256 * 65 * 4, EN_END = EN_LL + 1024;
static_assert(EN_END + 16 * 512 * 4 <= AT_SEL && 256 * 72 * 2 <= EN_OL, "engine lds");
static_assert(AT_END <= MISC_OFF, "attn lds");
constexpr int AT_UNITS = B_ * NGRP * NSB;

#ifdef CPU_EMU
DEV int row16_sum(int v) { v += __shfl_xor(v, 8); v += __shfl_xor(v, 4); v += __shfl_xor(v, 2); v += __shfl_xor(v, 1); return v; }
DEV int row16_shr(int v, int n) { const int l = threadIdx.x & 63; const int r = __shfl(v, (l & 15) >= n ? l - n : l); return (l & 15) >= n ? r : 0; }
DEV float quad_sum(float v) { v += __shfl_xor(v, 1); v += __shfl_xor(v, 2); return v; }
DEV u32x2 lds_tr16(const bf16_t* p) {
    const int w = threadIdx.x >> 6, l = threadIdx.x & 63; const unsigned long long a = (unsigned long long)(uintptr_t)p;
    emu_xbuf[w][l][0] = (unsigned)a; emu_xbuf[w][l][1] = (unsigned)(a >> 32); emu_wave_sync();
    const int g = l >> 4, i = l & 15; unsigned short e[4];
    for (int q = 0; q < 4; ++q) { const int src = 16 * g + 4 * q + (i >> 2); const unsigned long long sa = (unsigned long long)emu_xbuf[w][src][0] | ((unsigned long long)emu_xbuf[w][src][1] << 32); e[q] = ((const unsigned short*)(uintptr_t)sa)[i & 3]; }
    emu_wave_sync();
    return (u32x2){(unsigned)e[0] | ((unsigned)e[1] << 16), (unsigned)e[2] | ((unsigned)e[3] << 16)};
}
#else
DEV int row16_sum(int v) {
    v += __builtin_amdgcn_update_dpp(0, v, 0x128, 0xF, 0xF, false); v += __builtin_amdgcn_update_dpp(0, v, 0x124, 0xF, 0xF, false);
    v += __builtin_amdgcn_update_dpp(0, v, 0x122, 0xF, 0xF, false); v += __builtin_amdgcn_update_dpp(0, v, 0x121, 0xF, 0xF, false); return v;
}
#define row16_shr(v, n) __builtin_amdgcn_update_dpp(0, (v), 0x110 + (n), 0xF, 0xF, true)
DEV float quad_sum(float v) {
    v += __builtin_bit_cast(float, __builtin_amdgcn_mov_dpp(__builtin_bit_cast(int, v), 0xB1, 0xF, 0xF, true));
    v += __builtin_bit_cast(float, __builtin_amdgcn_mov_dpp(__builtin_bit_cast(int, v), 0x4E, 0xF, 0xF, true));
    return v;
}
typedef short v4i16_t __attribute__((ext_vector_type(4)));
DEV u32x2 lds_tr16(const bf16_t* p) { return __builtin_bit_cast(u32x2, __builtin_amdgcn_ds_read_tr16_b64_v4i16((__attribute__((address_space(3))) v4i16_t*)p)); }
#endif

#ifdef PROBE_TIMING
#define TSTAMP(v) do { __builtin_amdgcn_sched_barrier(0); v = __builtin_amdgcn_s_memtime(); __builtin_amdgcn_s_waitcnt(0xC07F); __builtin_amdgcn_sched_barrier(0); } while (0)
#else
#define TSTAMP(v) do { } while (0)
#endif
#ifndef PROBE_MODE
#define PROBE_MODE -1
#endif
constexpr int ATS = 80;
template <int MODE>
DEV void attn_tile(const bf16_t* kb, const bf16_t* vb, int jt, const bf16x8 (&qf)[4], f32x16 (&oacc)[2], float& lsum, float linv, const f32x16& negm, int ttok,
                   unsigned long long slo, unsigned long long shi, int t0, int qb, float* impA, float* impB, int wave, int lane) {
    const float NINF = -INFINITY;
    const int c32 = lane & 31, h = lane >> 5, hg = lane & 3, tau = c32 >> 2;
    bool nm;
    if (MODE <= 1) nm = (16 * (64 * jt + 63) + 31 > t0);
    else if (MODE == 2) nm = (jt == qb);
    else nm = (jt == qb) || (jt + 8 == qb);
    f32x16 s[2];
    if (nm) {
        const float nm0 = negm[0];
        if (MODE == 3 && jt != qb) {
            const int d2 = ttok - 512 - 64 * jt - 4 * h;
#pragma unroll
            for (int kt = 0; kt < 2; ++kt) {
                f32x16 cm;
#pragma unroll
                for (int i = 0; i < 16; ++i) cm[i] = (32 * kt + (i & 3) + 8 * (i >> 2) > d2) ? nm0 : NINF;
                s[kt] = mfma32(ld8(kb + (32 * kt + c32) * ATS + 8 * h), qf[0], cm);
            }
        } else {
            const int d = ((MODE <= 1) ? ((ttok - 31) >> 4) : ttok) - 64 * jt - 4 * h;
#pragma unroll
            for (int kt = 0; kt < 2; ++kt) {
                f32x16 cm;
#pragma unroll
                for (int i = 0; i < 16; ++i) cm[i] = (32 * kt + (i & 3) + 8 * (i >> 2) <= d) ? nm0 : NINF;
                s[kt] = mfma32(ld8(kb + (32 * kt + c32) * ATS + 8 * h), qf[0], cm);
            }
        }
    } else {
#pragma unroll
        for (int kt = 0; kt < 2; ++kt) s[kt] = mfma32(ld8(kb + (32 * kt + c32) * ATS + 8 * h), qf[0], negm);
    }
#pragma unroll
    for (int kt = 0; kt < 2; ++kt)
#pragma unroll
        for (int ks = 1; ks < 4; ++ks) { const bf16x8 a = ld8(kb + (32 * kt + c32) * ATS + 16 * ks + 8 * h); s[kt] = mfma32(a, qf[ks], s[kt]); }
    float psum = 0.f;
#pragma unroll
    for (int kt = 0; kt < 2; ++kt)
#pragma unroll
        for (int i = 0; i < 16; ++i) { const float pv = exp2_fast(s[kt][i]); s[kt][i] = pv; psum += pv; }
    if (MODE != 1) lsum += psum;
    if (MODE == 1) {
#pragma unroll
        for (int kt = 0; kt < 2; ++kt)
#pragma unroll
            for (int gq = 0; gq < 4; ++gq) {
                const float a = quad_sum(2.0f * (s[kt][4 * gq] + s[kt][4 * gq + 1] + s[kt][4 * gq + 2]) + s[kt][4 * gq + 3]), bq = quad_sum(s[kt][4 * gq + 3]);
                if (hg == 0) { const int j = 16 * jt + 8 * kt + 2 * gq + h; const int tl = 8 * wave + tau; impA[tl * 128 + j] = a; impB[tl * 128 + j] = bq; }
            }
    }
    if (MODE != 0) {
        const int l15 = lane & 15, g1 = (lane >> 4) & 1;
#pragma unroll
        for (int kt = 0; kt < 2; ++kt)
#pragma unroll
            for (int sp = 0; sp < 2; ++sp) {
                u32x4 pw = (u32x4){pk2(s[kt][8 * sp], s[kt][8 * sp + 1]), pk2(s[kt][8 * sp + 2], s[kt][8 * sp + 3]), pk2(s[kt][8 * sp + 4], s[kt][8 * sp + 5]), pk2(s[kt][8 * sp + 6], s[kt][8 * sp + 7])};
                const bf16x8 pf = __builtin_bit_cast(bf16x8, pw);
                const bf16_t* vr = vb + (32 * kt + 16 * sp + 4 * h + (l15 >> 2)) * ATS + 16 * g1 + 4 * (l15 & 3);
#pragma unroll
                for (int dt = 0; dt < 2; ++dt) {
                    const u32x2 lo = lds_tr16(vr + 32 * dt), hi = lds_tr16(vr + 8 * ATS + 32 * dt);
                    oacc[dt] = mfma32(__builtin_bit_cast(bf16x8, (u32x4){lo.x, lo.y, hi.x, hi.y}), pf, oacc[dt]);
                }
            }
    }
}

DEV void at_preload(const bf16_t* Kg, const bf16_t* Vg, int pitch, int jlo, int jhi, int tid, u32x4 (&pk)[2], u32x4 (&pv)[2]) {
    const int key = tid >> 3, ch = tid & 7;
#pragma unroll
    for (int u = 0; u < 2; ++u) { const int jt = jlo + u; pk[u] = (u32x4){0u, 0u, 0u, 0u}; pv[u] = pk[u];
        if (jt <= jhi) { pk[u] = *(const u32x4*)(Kg + (size_t)(64 * jt + key) * pitch + 8 * ch); pv[u] = *(const u32x4*)(Vg + (size_t)(64 * jt + key) * pitch + 8 * ch); } }
}

template <int MODE, bool PRE = false>
DEV void attn_pass(const bf16_t* Kg, const bf16_t* Vg, int pitch, int jlo, int jhi, unsigned char* lds, const bf16x8 (&qf)[4], f32x16 (&oacc)[2], float& lsum, float linv,
                   float m0l, int ttok, unsigned long long slo, unsigned long long shi, int t0, int qb, int tid, int wave, int lane_, unsigned long long& tcomp, unsigned long long& tpass,
                   const u32x4* pk = nullptr, const u32x4* pv = nullptr) {
    unsigned long long tc0_ = 0, tc1_ = 0, tp0_ = 0, tp1_ = 0; TSTAMP(tp0_);
    LAUNDER_V(tid); const int lane = tid & 63; (void)lane_;
    const int key = tid >> 3, ch = tid & 7;
    float* impA = (float*)(lds + AT_IA); float* impB = (float*)(lds + AT_IB);
    const int nsteps = (jhi - jlo + 2) >> 1;
    const u32x4 Z4 = (u32x4){0u, 0u, 0u, 0u};
    f32x16 negm;
    float nm0_ = (MODE == 1) ? (log2_fast(linv) - m0l) : -m0l;
    LAUNDER_V(nm0_);
#pragma unroll
    for (int i = 0; i < 16; ++i) negm[i] = nm0_;
    u32x4 rk[2][2], rv[2][2];
#define AT_LOAD(set, st) do { _Pragma("unroll") for (int u_ = 0; u_ < 2; ++u_) { const int jt_ = jlo + 2 * (st) + u_; rk[set][u_] = Z4; rv[set][u_] = Z4; \
        if (jt_ <= jhi) { rk[set][u_] = *(const u32x4*)(Kg + (size_t)(64 * jt_ + key) * pitch + 8 * ch); if (MODE != 0) rv[set][u_] = *(const u32x4*)(Vg + (size_t)(64 * jt_ + key) * pitch + 8 * ch); } } } while (0)
#define AT_WRITE(set, stage) do { _Pragma("unroll") for (int u_ = 0; u_ < 2; ++u_) { *(u32x4*)(lds + AT_KB + (stage) * AT_STAGE + ((64 * u_ + key) * ATS + 8 * ch) * 2) = rk[set][u_]; \
        if (MODE != 0) *(u32x4*)(lds + AT_KB + (stage) * AT_STAGE + AT_VOFF + ((64 * u_ + key) * ATS + 8 * ch) * 2) = rv[set][u_]; } } while (0)
    if (PRE) { rk[0][0] = pk[0]; rk[0][1] = pk[1]; rv[0][0] = pv[0]; rv[0][1] = pv[1]; } else AT_LOAD(0, 0);
    AT_WRITE(0, 0);
    if (MODE != 2 && nsteps > 1) AT_LOAD(1, 1); else { rk[1][0] = Z4; rk[1][1] = Z4; rv[1][0] = Z4; rv[1][1] = Z4; }
    __syncthreads();
#define AT_COMPUTE(st) do { const int stage_ = (st) & 1; TSTAMP(tc0_); \
        _Pragma("unroll") for (int u = 0; u < 2; ++u) { const int jt = jlo + 2 * (st) + u; if (jt > jhi) break; \
            const bf16_t* kb = (const bf16_t*)(lds + AT_KB + stage_ * AT_STAGE) + 64 * ATS * u; const bf16_t* vb = (const bf16_t*)(lds + AT_KB + stage_ * AT_STAGE + AT_VOFF) + 64 * ATS * u; \
            attn_tile<MODE>(kb, vb, jt, qf, oacc, lsum, linv, negm, ttok, slo, shi, t0, qb, impA, impB, wave, lane); } TSTAMP(tc1_); if (MODE == PROBE_MODE) tcomp += tc1_ - tc0_; } while (0)
    for (int st = 0; st < nsteps; st += 2) {
        if (MODE != 2 && st + 2 < nsteps) AT_LOAD(0, st + 2);
        AT_COMPUTE(st);
        if (MODE != 2 && st + 1 < nsteps) AT_WRITE(1, 1);
        LDS_BARRIER();
        if (MODE == 2 || st + 1 >= nsteps) break;
        if (st + 3 < nsteps) AT_LOAD(1, st + 3);
        AT_COMPUTE(st + 1);
        if (st + 2 < nsteps) AT_WRITE(0, 0);
        LDS_BARRIER();
    }
#undef AT_LOAD
#undef AT_WRITE
#undef AT_COMPUTE
    TSTAMP(tp1_); if (MODE == PROBE_MODE) tpass += tp1_ - tp0_;
}

DEV unsigned char* en_tl(unsigned char* lds, int j) { return j <= 124 ? lds + AT_SEL + 64 * (j - 1) : lds + MISC_OFF + 160; }
static_assert(AT_SEL + 64 * 124 <= MISC_OFF, "token lists");

#ifndef SEL_KSH
#define SEL_KSH 12
#endif
DEV void attn_unit(const Params& p, unsigned char* lds, int b, int g, int qb, float m0c, float m0s, float m0w, int tid, int wave, int lane_) {
    LAUNDER_V(tid); const int lane = tid & 63; (void)lane_;
    unsigned char* ws = p.ws;
    const int c32 = lane & 31, h = lane >> 5, hg = lane & 3, tau = c32 >> 2; const int t0 = 64 * qb;
    const bf16_t* Q = (const bf16_t*)(ws + WS_Q); const bf16_t* QR = (const bf16_t*)(ws + WS_QR);
    const bf16_t* KC = (const bf16_t*)(ws + WS_KC) + (size_t)b * NCP * 128 + g * 64; const bf16_t* VC = (const bf16_t*)(ws + WS_VC) + (size_t)b * NCP * 128 + g * 64;
    const bf16_t* SL = (const bf16_t*)(ws + WS_SL) + (size_t)b * T_ * 256 + g * 64; const bf16_t* WN = (const bf16_t*)(ws + WS_WN) + (size_t)b * T_ * 256 + g * 64;
    const float* G = (const float*)(ws + WS_G);
    constexpr float LOG2E = 1.4426950408889634f;
    const int ttok = t0 + 8 * wave + tau; const size_t rowg = (size_t)b * T_ + ttok;
    const int hd = 4 * g + hg;
    bf16x8 qf[4]; f32x16 oacc[2], outa[2]; float lsum = 0.f, linv = 0.f; unsigned long long tcomp = 0, tpass = 0;
    unsigned long long slo = 0ull, shi = 0ull;
#pragma unroll
    for (int dt = 0; dt < 2; ++dt)
#pragma unroll
        for (int i = 0; i < 16; ++i) { oacc[dt][i] = 0.f; outa[dt][i] = 0.f; }
#pragma unroll
    for (int ks = 0; ks < 4; ++ks) qf[ks] = ld8(Q + rowg * 512 + hd * 64 + 16 * ks + 8 * h);
    const int ncmp = 4 * qb + 3;
    const int jhc = (ncmp - 1) >> 6;
#ifndef REP_CMP
#define REP_CMP 1
#endif
    for (int rep_ = 0; rep_ < REP_CMP; ++rep_) { lsum = 0.f;
    attn_pass<0>(KC, VC, 128, 0, jhc, lds, qf, oacc, lsum, linv, m0c * LOG2E, ttok, slo, shi, t0, qb, tid, wave, lane, tcomp, tpass); }
    { float L = lsum; L += __shfl_xor(L, 32); linv = L > 0.f ? 1.0f / L : 0.f; lsum = 0.f; }
    attn_pass<1>(KC, VC, 128, 0, jhc, lds, qf, oacc, lsum, linv, m0c * LOG2E, ttok, slo, shi, t0, qb, tid, wave, lane, tcomp, tpass);
    { const float gt = G[rowg * 32 + 3 * hd + 0];
#pragma unroll
        for (int dt = 0; dt < 2; ++dt)
#pragma unroll
            for (int i = 0; i < 16; ++i) { outa[dt][i] = oacc[dt][i] * gt; oacc[dt][i] = 0.f; } }
    {
        const float* impA = (const float*)(lds + AT_IA); const float* impB = (const float*)(lds + AT_IB); unsigned long long* sel = (unsigned long long*)(lds + AT_SEL);
        unsigned char* sel8 = (unsigned char*)sel;
        const int row16 = lane >> 4, i16 = lane & 15;
        {
            unsigned k[2][8], th[2] = {0u, 0u};
#pragma unroll
            for (int rnd = 0; rnd < 2; ++rnd) {
                const int tl = 8 * wave + 4 * rnd + row16; const float* ia = impA + tl * 128; const float* ib = impB + tl * 128;
                const f32x4 a0 = *(const f32x4*)(ia + 8 * i16), a1 = *(const f32x4*)(ia + 8 * i16 + 4), b0 = *(const f32x4*)(ib + 8 * i16), b1 = *(const f32x4*)(ib + 8 * i16 + 4);
                const float bm1 = ib[8 * i16 - 1];
#pragma unroll
                for (int c = 0; c < 8; ++c) { const int j = 8 * i16 + c;
                    const float av = c < 4 ? a0[c & 3] : a1[c & 3], bv = (c == 0) ? bm1 : (c <= 4 ? b0[(c - 1) & 3] : b1[(c - 5) & 3]);
                    const unsigned kv = (__builtin_bit_cast(unsigned, av + bv) >> SEL_KSH) + 1u;
                    k[rnd][c] = (j > qb) ? 0u : ((j == 0 || j == qb || j == qb - 1) ? (0x7f800000u >> SEL_KSH) + 1u : kv); }
            }
#pragma unroll 1
            for (int bit = 30 - SEL_KSH; bit >= 0; --bit) {
                const unsigned bm = 1u << bit;
#pragma unroll
                for (int rnd = 0; rnd < 2; ++rnd) {
                    const unsigned cand = th[rnd] | bm;
                    const int c01 = ((k[rnd][0] >= cand) ? 1 : 0) + ((k[rnd][1] >= cand) ? 1 : 0), c23 = ((k[rnd][2] >= cand) ? 1 : 0) + ((k[rnd][3] >= cand) ? 1 : 0);
                    const int c45 = ((k[rnd][4] >= cand) ? 1 : 0) + ((k[rnd][5] >= cand) ? 1 : 0), c67 = ((k[rnd][6] >= cand) ? 1 : 0) + ((k[rnd][7] >= cand) ? 1 : 0);
                    const int cnt = row16_sum((c01 + c23) + (c45 + c67));
                    th[rnd] = (cnt >= 16) ? cand : th[rnd];
                }
            }
#pragma unroll
            for (int rnd = 0; rnd < 2; ++rnd) {
                const int tl = 8 * wave + 4 * rnd + row16;
                int gt = 0, eq = 0;
#pragma unroll
                for (int c = 0; c < 8; ++c) { gt += (k[rnd][c] > th[rnd]) ? 1 : 0; eq += (k[rnd][c] == th[rnd]) ? 1 : 0; }
                const int need = (th[rnd] == 0u) ? 0 : 16 - row16_sum(gt);
                int pre = eq;
                { int t_ = row16_shr(pre, 1); pre += t_; t_ = row16_shr(pre, 2); pre += t_; t_ = row16_shr(pre, 4); pre += t_; t_ = row16_shr(pre, 8); pre += t_; }
                int run = pre - eq; unsigned bits = 0u;
#pragma unroll
                for (int c = 0; c < 8; ++c) {
                    if (k[rnd][c] > th[rnd]) bits |= 1u << c;
                    else if (k[rnd][c] == th[rnd]) { if (run < need) bits |= 1u << c; ++run; }
                }
                sel8[tl * 16 + i16] = (unsigned char)bits;
            }
        }
    }
    __syncthreads();
    {
        const unsigned long long* sel = (const unsigned long long*)(lds + AT_SEL);
        const unsigned long long mylo = sel[lane * 2], myhi = sel[lane * 2 + 1];
        __syncthreads();
        for (int jj = 0; jj < 16; ++jj) { const int j = 16 * wave + jj; if (j < 1 || j > 125) continue;
            const int bit = (int)(((j < 64) ? (mylo >> j) : (myhi >> (j - 64))) & 1ull); const unsigned long long m = __ballot(bit);
            unsigned char* tl = en_tl(lds, j);
            const int pos = __builtin_popcountll(m & ((1ull << lane) - 1ull)), cnt = __builtin_popcountll(m);
            if (bit) tl[pos] = (unsigned char)lane;
            if (lane < 16 && cnt + lane < 64) tl[cnt + lane] = 0xFFu; }
    }
    float* outl = (float*)(lds + AT_IA) + tid;
#pragma unroll
    for (int dt = 0; dt < 2; ++dt)
#pragma unroll
        for (int i = 0; i < 16; ++i) outl[(dt * 16 + i) * 512] = outa[dt][i];
#pragma unroll
    for (int ks = 0; ks < 4; ++ks) qf[ks] = ld8(QR + rowg * 512 + hd * 64 + 16 * ks + 8 * h);
#ifndef REP_WIN
#define REP_WIN 1
#endif
    for (int rep_ = 0; rep_ < REP_WIN; ++rep_)
    attn_pass<3>(WN, WN + 128, 256, qb >= 8 ? qb - 8 : 0, qb, lds, qf, oacc, lsum, linv, m0w * LOG2E, ttok, slo, shi, t0, qb, tid, wave, lane, tcomp, tpass);
    { float L = lsum; L += __shfl_xor(L, 32); const float sc = (L > 0.f ? 1.0f / L : 0.f) * G[rowg * 32 + 3 * hd + 2]; lsum = 0.f;
#pragma unroll
        for (int dt = 0; dt < 2; ++dt)
#pragma unroll
            for (int i = 0; i < 16; ++i) { outa[dt][i] = outl[(dt * 16 + i) * 512] + oacc[dt][i] * sc; oacc[dt][i] = 0.f; } }
    __syncthreads();
    {
        bf16_t* QL = (bf16_t*)(lds + EN_QL); float* OL = (float*)(lds + EN_OL); float* LL = (float*)(lds + EN_LL);
        float* outp = (float*)(lds + EN_END) + tid;
#pragma unroll
        for (int i = 0; i < 16; ++i) outp[i * 512] = outa[1][i];
        for (int i = tid; i < (EN_LL + 1024 - EN_OL) / 16; i += 512) ((u32x4*)(lds + EN_OL))[i] = (u32x4){0u, 0u, 0u, 0u};
        unsigned* qcnt = (unsigned*)(lds + MISC_OFF + 128);
        if (tid == 0) *qcnt = 0u;
#pragma unroll
        for (int k = 0; k < 4; ++k) { const int idx = tid + 512 * k, tok = idx >> 5, c = idx & 31;
            *(u32x4*)(QL + (tok * 4 + (c >> 3)) * 72 + (c & 7) * 8) = *(const u32x4*)(QR + ((size_t)b * T_ + t0 + tok) * 512 + g * 256 + c * 8); }
        __syncthreads();
        const bf16_t* VT = (const bf16_t*)(ws + WS_VT) + (size_t)(b * NGRP + g) * (T_ / 64) * 4096; const bf16_t* KF = (const bf16_t*)(ws + WS_KF) + (size_t)(b * NGRP + g) * (T_ / 64) * 4096;
        const int r32 = lane & 31, kr = (r32 & ~12) | ((r32 & 8) >> 1) | ((r32 & 4) << 1);
        const float cs0 = 17.0f - m0s * LOG2E;
#ifndef REP_SLC
#define REP_SLC 1
#endif
        for (;;) {
            unsigned tk_ = 0u; if (lane == 0) tk_ = atomicAdd(qcnt, 1u);
            tk_ = (unsigned)__shfl((int)tk_, 0);
#ifndef CPU_EMU
            tk_ = (unsigned)__builtin_amdgcn_readfirstlane((int)tk_);
#endif
            const int j = 1 + (int)tk_; if (j > qb - 2) break;
            const unsigned char* tl = en_tl(lds, j);
            int first = tl[0];
#ifndef CPU_EMU
            first = __builtin_amdgcn_readfirstlane(first);
#endif
            if (first == 0xFF) continue;
            bf16x8 kfr[2][4], vfr[2][4];
#pragma unroll
            for (int kt = 0; kt < 2; ++kt)
#pragma unroll
                for (int ks = 0; ks < 4; ++ks) kfr[kt][ks] = ld8(KF + (size_t)j * 4096 + ((kt * 4 + ks) * 64 + lane) * 8);
#pragma unroll
            for (int dt = 0; dt < 2; ++dt)
#pragma unroll
                for (int q = 0; q < 4; ++q) vfr[dt][q] = ld8(VT + (size_t)j * 4096 + ((dt * 4 + q) * 64 + lane) * 8);
            for (int gi = 0; gi < 8; ++gi) {
                const int tokidx = tl[8 * gi + tau];
                const bool valid = tokidx != 0xFF;
                if (!__any(valid)) break;
                const int ti = valid ? tokidx : 0; const int row = ti * 4 + hg;
                bf16x8 qg[4];
#pragma unroll
                for (int ks = 0; ks < 4; ++ks) qg[ks] = ld8(QL + row * 72 + 16 * ks + 8 * h);
                f32x16 s2[2];
#pragma unroll
                for (int kt = 0; kt < 2; ++kt) {
#pragma unroll
                    for (int i = 0; i < 16; ++i) s2[kt][i] = cs0;
#pragma unroll
                    for (int ks = 0; ks < 4; ++ks) s2[kt] = mfma32(kfr[kt][ks], qg[ks], s2[kt]);
                }
                float psum = 0.f;
#pragma unroll
                for (int kt = 0; kt < 2; ++kt)
#pragma unroll
                    for (int i = 0; i < 16; ++i) { const float pv = exp2_fast(s2[kt][i]); s2[kt][i] = pv; psum += pv; }
                u32x4 pw[4];
#pragma unroll
                for (int q = 0; q < 4; ++q) { const int kt = q >> 1, sp = q & 1;
                    pw[q] = (u32x4){pk2(s2[kt][8 * sp], s2[kt][8 * sp + 1]), pk2(s2[kt][8 * sp + 2], s2[kt][8 * sp + 3]), pk2(s2[kt][8 * sp + 4], s2[kt][8 * sp + 5]), pk2(s2[kt][8 * sp + 6], s2[kt][8 * sp + 7])}; }
                if (!__all(valid)) {
                    const unsigned pm = valid ? 0xffffffffu : 0u;
#pragma unroll
                    for (int q = 0; q < 4; ++q) { pw[q].x &= pm; pw[q].y &= pm; pw[q].z &= pm; pw[q].w &= pm; }
                }
                f32x16 o2[2];
#pragma unroll
                for (int dt = 0; dt < 2; ++dt) {
#pragma unroll
                    for (int i = 0; i < 16; ++i) o2[dt][i] = 0.f;
#pragma unroll
                    for (int q = 0; q < 4; ++q) o2[dt] = mfma32(vfr[dt][q], __builtin_bit_cast(bf16x8, pw[q]), o2[dt]);
                }
                psum += __shfl_xor(psum, 32);
                if (valid) {
                    unsigned* orow = (unsigned*)(OL + row * 65 + 4 * h);
#pragma unroll
                    for (int dt = 0; dt < 2; ++dt)
#pragma unroll
                        for (int i = 0; i < 16; ++i) atomicAdd(orow + 32 * dt + (i & 3) + 8 * (i >> 2), (unsigned)f2i_rn(o2[dt][i]));
                    if (h == 0) atomicAdd((unsigned*)(LL + row), (unsigned)f2i_rn(psum));
                }
            }
        }
        {
            const int key = tid >> 3, ch = tid & 7;
            const int nft = qb >= 2 ? 3 : qb + 1;
            u32x4 fk[3], fv[3];
#pragma unroll
            for (int u = 0; u < 3; ++u) { const int jt = (u == 0) ? 0 : (qb >= 2 ? qb - 2 + u : u); fk[u] = (u32x4){0u, 0u, 0u, 0u}; fv[u] = fk[u];
                if (u < nft) { fk[u] = *(const u32x4*)(SL + (size_t)(64 * jt + key) * 256 + 8 * ch); fv[u] = *(const u32x4*)(SL + 128 + (size_t)(64 * jt + key) * 256 + 8 * ch); } }
#pragma unroll
            for (int ks = 0; ks < 4; ++ks) qf[ks] = ld8(QR + rowg * 512 + hd * 64 + 16 * ks + 8 * h);
            __syncthreads();
            const int row = (8 * wave + tau) * 4 + hg;
            float Lf = (h == 0) ? (float)((const int*)LL)[row] : 0.f;
            f32x16 of[2];
            { const int* orow = (const int*)(OL + row * 65 + 4 * h);
#pragma unroll
              for (int dt = 0; dt < 2; ++dt)
#pragma unroll
                  for (int i = 0; i < 16; ++i) of[dt][i] = (float)orow[32 * dt + (i & 3) + 8 * (i >> 2)]; }
            __syncthreads();
#pragma unroll
            for (int u = 0; u < 3; ++u) { unsigned char* slot = lds + AT_KB + (u >> 1) * AT_STAGE + ((64 * (u & 1) + key) * ATS + 8 * ch) * 2;
                *(u32x4*)slot = fk[u]; *(u32x4*)(slot + AT_VOFF) = fv[u]; }
            f32x16 negm; float nm0_ = 17.0f - m0s * LOG2E; LAUNDER_V(nm0_);
#pragma unroll
            for (int i = 0; i < 16; ++i) negm[i] = nm0_;
            __syncthreads();
#pragma unroll 1
            for (int u = 0; u < nft; ++u) { const int jt = (u == 0) ? 0 : (qb >= 2 ? qb - 2 + u : u);
                const bf16_t* kb = (const bf16_t*)(lds + AT_KB + (u >> 1) * AT_STAGE) + 64 * ATS * (u & 1);
                attn_tile<2>(kb, kb + AT_VOFF / 2, jt, qf, of, Lf, linv, negm, ttok, 0ull, 0ull, t0, qb, (float*)(lds + AT_IA), (float*)(lds + AT_IB), wave, lane); }
            Lf += __shfl_xor(Lf, 32);
            const float sc = (Lf > 0.f ? 1.0f / Lf : 0.f) * G[rowg * 32 + 3 * hd + 1];
#pragma unroll
            for (int dt = 0; dt < 2; ++dt)
#pragma unroll
                for (int i = 0; i < 16; ++i) outa[dt][i] = (dt == 1 ? outp[i * 512] : outa[dt][i]) + of[dt][i] * sc;
        }
    }
    {
        const bf16_t* ZA = (const bf16_t*)(ws + WS_ZA); bf16_t* MIX = (bf16_t*)(ws + WS_MIX);
        unsigned char* stg = lds + EN_END + wave * 256;
        const int rr = lane >> 3, pc = lane & 7;
        u32x4 zr[4];
#pragma unroll
        for (int j = 0; j < 4; ++j) { const int r = 8 * j + rr; const size_t grow = (size_t)b * T_ + t0 + 8 * wave + (r >> 2);
            zr[j] = *(const u32x4*)(ZA + grow * 512 + (4 * g + (r & 3)) * 64 + 8 * pc); }
        WAVE_SYNC();
#pragma unroll
        for (int j = 0; j < 4; ++j) { const int r = 8 * j + rr; *(u32x4*)(stg + (r >> 1) * 2048 + (r & 1) * 128 + 16 * pc) = zr[j]; }
        WAVE_SYNC();
        unsigned char* myrow = stg + (c32 >> 1) * 2048 + (c32 & 1) * 128;
#pragma unroll
        for (int dt = 0; dt < 2; ++dt)
#pragma unroll
            for (int gq = 0; gq < 4; ++gq) {
                u32x2* slot = (u32x2*)(myrow + (32 * dt + 8 * gq + 4 * h) * 2); const u32x2 zv = *slot;
                float o[4];
#pragma unroll
                for (int r = 0; r < 4; ++r) { const unsigned w = zv[r >> 1]; o[r] = outa[dt][4 * gq + r] * bf2f((r & 1) ? (w >> 16) : (w & 0xffffu)); }
                *slot = (u32x2){pk2(o[0], o[1]), pk2(o[2], o[3])};
            }
        WAVE_SYNC();
#pragma unroll
        for (int j = 0; j < 4; ++j) { const int r = 8 * j + rr; const size_t grow = (size_t)b * T_ + t0 + 8 * wave + (r >> 2);
            *(u32x4*)(MIX + grow * 1024 + (4 * g + (r & 3)) * 64 + 8 * pc) = *(const u32x4*)(stg + (r >> 1) * 2048 + (r & 1) * 128 + 16 * pc); }
    }
    __syncthreads();
#ifdef PROBE_TIMING
    if (b == PROBE_B && g == 0 && qb == PROBE_QB && tid == PROBE_TID) { float* tr = (float*)(ws + WS_CTL + 32768); tr[0] = (float)tcomp; tr[1] = (float)tpass; }
#endif
}

DEV void p4_attention(const Params& p, unsigned char* lds, int vcu, int G, int tid, int wave, int lane) {
    const float gq = wave_max(fabsf(p.in[I_QNG][lane])), gc = wave_max(fabsf(p.in[I_KCNG][lane])), gs = wave_max(fabsf(p.in[I_KSNG][lane])), gw = wave_max(fabsf(p.in[I_KWNG][lane]));
    const float m0c = 8.2f * gq * gc, m0s = 8.2f * gq * gs, m0w = 8.2f * gq * gw;
    for (int i = 0;; ++i) {
        const long L = (long)i * G + vcu; if (L >= AT_UNITS) break;
        int bg, qb;
        if (G == 256 && B_ * NGRP == 16 && NSB == 128) {
            const int xcd = vcu >> 5, c = vcu & 31, r = i & 3;
            bg = 2 * xcd + (i >> 2); qb = (r == 0) ? c : (r == 1) ? 63 - c : (r == 2) ? 64 + c : 127 - c;
        } else {
            const int per = B_ * NGRP * 16;
            const int k = (int)(L / per), v = (int)(L % per), s = v & 15;
            bg = v >> 4; qb = 32 * (k >> 1) + ((k & 1) ? 31 - s : s);
        }
        attn_unit(p, lds, bg / NGRP, bg % NGRP, qb, m0c, m0s, m0w, tid, wave, lane);
    }
}

#ifndef CPU_EMU
#define GAS __attribute__((address_space(1)))
#define LAS __attribute__((address_space(3)))
#define XB_TMO      128
#define XB_XCNT(j)  (256  + 64 * (j))
#define XB_XSUB(j)  (1280 + 64 * (j))
#define XB_XGEN(j)  (2304 + 64 * (j))
#define XB_TOP      3328
#define XB_TOPGEN   3392
#define XCD_BAR_WORDS 3456
#define XB_SPIN_CAP (1u << 20)
__device__ __forceinline__ unsigned xb_ld(unsigned* p)              { return __hip_atomic_load(p, __ATOMIC_RELAXED, __HIP_MEMORY_SCOPE_AGENT); }
__device__ __forceinline__ unsigned xb_add(unsigned* p, unsigned v) { return __hip_atomic_fetch_add(p, v, __ATOMIC_RELAXED, __HIP_MEMORY_SCOPE_AGENT); }
__device__ __forceinline__ unsigned xb_xcc_id() { return (unsigned)__builtin_amdgcn_s_getreg((3 << 11) | 20) & 0xFu; }
#define XB_SPIN(cond, bar) do { unsigned _sp = 0; while (cond) { __builtin_amdgcn_s_sleep(1); \
    if ((++_sp & 255u) == 0u) { if (xb_ld(&(bar)[XB_TMO])) break; if (_sp > XB_SPIN_CAP) { atomicAdd(&(bar)[XB_TMO], 1u); break; } } } } while (0)
struct XcdBarrier { unsigned* bar; unsigned x; volatile LAS unsigned* st; };
__device__ __forceinline__ XcdBarrier xcd_barrier_post(unsigned* bar, volatile LAS unsigned* st) {
    XcdBarrier b; b.bar = bar; b.x = xb_xcc_id(); b.st = st;
    if (threadIdx.x == 0) (void)xb_add(&bar[XB_XCNT(b.x)], 1u);
    return b;
}
__device__ __forceinline__ void xcd_barrier_complete(unsigned* bar, unsigned x, unsigned& nloc, unsigned& nx) {
    const unsigned G = gridDim.x * gridDim.y * gridDim.z;
    unsigned sum, cnt, mine, sp = 0u;
    for (;;) {
        sum = 0u; cnt = 0u; mine = 0u;
#pragma unroll
        for (unsigned j = 0; j < 16; ++j) { const unsigned c = xb_ld(&bar[XB_XCNT(j)]); sum += c; cnt += (c > 0u) ? 1u : 0u; mine = (j == x) ? c : mine; }
        if (sum == G) break;
        __builtin_amdgcn_s_sleep(1);
        if ((++sp & 255u) == 0u) { if (xb_ld(&bar[XB_TMO])) break; if (sp > XB_SPIN_CAP) { atomicAdd(&bar[XB_TMO], 1u); break; } }
    }
    nloc = mine > 0u ? mine : 1u; nx = cnt > 0u ? cnt : 1u;
}
__device__ __forceinline__ void xcd_barrier(const XcdBarrier& b) {
    asm volatile("s_waitcnt vmcnt(0)" ::: "memory");
    __syncthreads();
    if (threadIdx.x == 0) {
        unsigned* bar = b.bar;
        __builtin_amdgcn_s_waitcnt(0);
        unsigned nloc = b.st[0], nx = b.st[1];
        if (nloc == 0u) { xcd_barrier_complete(bar, b.x, nloc, nx); b.st[0] = nloc; b.st[1] = nx; }
        const unsigned old = xb_add(&bar[XB_XSUB(b.x)], 1u);
        const unsigned gen = old / nloc;
        if (old + 1u == (gen + 1u) * nloc) {
            __builtin_amdgcn_fence(__ATOMIC_RELEASE, "agent");
            asm volatile("s_waitcnt vmcnt(0)" ::: "memory");
            const unsigned og = xb_add(&bar[XB_TOP], 1u);
            const unsigned tg = og / nx;
            if (og + 1u == (tg + 1u) * nx) xb_add(&bar[XB_TOPGEN], 1u);
            else XB_SPIN(xb_ld(&bar[XB_TOPGEN]) == tg, bar);
            __builtin_amdgcn_fence(__ATOMIC_ACQUIRE, "agent");
            xb_add(&bar[XB_XGEN(b.x)], 1u);
            asm volatile("s_waitcnt vmcnt(0)" ::: "memory");
        } else {
            XB_SPIN(xb_ld(&bar[XB_XGEN(b.x)]) == gen, bar);
            __builtin_amdgcn_fence(__ATOMIC_ACQUIRE, "agent");
            asm volatile("s_waitcnt vmcnt(0)" ::: "memory");
        }
    }
    __syncthreads();
}
#endif

#ifndef CPU_EMU
__device__ __forceinline__ void group_barrier(unsigned* cnt, unsigned target) {
    asm volatile("s_waitcnt vmcnt(0)" ::: "memory");
    __syncthreads();
    if (threadIdx.x == 0) {
        __builtin_amdgcn_fence(__ATOMIC_RELEASE, "agent");
        asm volatile("s_waitcnt vmcnt(0)" ::: "memory");
        (void)xb_add(cnt, 1u);
        unsigned sp = 0u;
        while (xb_ld(cnt) < target) { __builtin_amdgcn_s_sleep(1); if (++sp > (XB_SPIN_CAP << 4)) break; }
        __builtin_amdgcn_fence(__ATOMIC_ACQUIRE, "agent");
        asm volatile("s_waitcnt vmcnt(0)" ::: "memory");
    }
    __syncthreads();
}
constexpr size_t WS_GBAR = WS_CTL + 20480;
static_assert(WS_CTL + 4096 + XCD_BAR_WORDS * 4 <= WS_GBAR && WS_GBAR + 8 * 256 <= WS_CPOS, "group barrier words");
static_assert(WS_CTL + 4096 + XCD_BAR_WORDS * 4 <= WS_CPOS && WS_CPOS + 2048 <= WS_CTL + 32768 && 32768 + 64 <= CTL_ZERO_BYTES, "barrier words vs cpos");
#endif
constexpr int N_PHASES = 6;
__global__ void __launch_bounds__(512, 2) fwd_kernel(Params p) {
#ifdef CPU_EMU
    unsigned char* lds = emu_smem;
#else
    extern __shared__ __attribute__((aligned(16))) unsigned char lds[];
#endif
    const int tid = threadIdx.x, lane = tid & 63, wave = WAVE_ID();
    const int G = gridDim.x; const int bx = blockIdx.x; const int vcu = (G % 8 == 0) ? (bx % 8) * (G / 8) + bx / 8 : bx;
#ifndef CPU_EMU
    for (int u = tid; u < 64; u += 512) ((LAS unsigned*)(lds + MISC_OFF))[u] = 0u;
    __syncthreads();
    XcdBarrier bar; bar.bar = (unsigned*)(p.ws + WS_CTL) + 1024 + p.li * XCD_BAR_WORDS; bar.x = 0; bar.st = nullptr;
    if (p.ph_hi - p.ph_lo > 1) bar = xcd_barrier_post(bar.bar, (volatile LAS unsigned*)(lds + MISC_OFF) + 8);
#define GRID_BAR() xcd_barrier(bar)
    const bool grp_ok = (G == 256 && B_ == 8 && T_ == 8192);
    unsigned* gcnt = (unsigned*)(p.ws + WS_GBAR) + 64 * (bx & 7); unsigned gtgt = 0u;
#define GROUP_BAR() do { if (grp_ok) { gtgt += 32u; group_barrier(gcnt, gtgt); } else { xcd_barrier(bar); } } while (0)
#else
#define GRID_BAR() do { } while (0)
#define GROUP_BAR() do { } while (0)
#endif
    const int lo = p.ph_lo, hi = p.ph_hi;
#ifndef PHASE_MASK
#define PHASE_MASK 63
#endif
#define IN(k) (((PHASE_MASK >> (k)) & 1) && lo <= (k) && (k) < hi)
#define BOTH(k) (IN(k) && IN((k) + 1))
#ifndef REP_PHASE
#define REP_PHASE -1
#endif
#define REPS(k) for (int rep_ = 0; rep_ < ((k) == REP_PHASE ? 2 : 1); ++rep_)
    if (IN(0)) { REPS(0) { p0_prologue(p, lds, vcu, G, tid, wave, lane); __syncthreads(); } if (BOTH(0)) GRID_BAR(); }
    if (IN(1)) { REPS(1) p1_norm(p, vcu, G, wave, lane); if (BOTH(1)) GROUP_BAR(); }
    if (IN(2)) {
        constexpr int INGEMM = 2816;
#ifdef REP_INPROJ
        struct RepOrder { pg8::StaticOrder S; int cnt; __device__ bool next(int i, pg8::Unit& u) const { return S.next(i < cnt ? i : i - cnt, u) && i < 2 * cnt; } __device__ void a_ready(const pg8::Unit&) const {} __device__ void done(const pg8::Unit&) const {} };
        pg8::Gemm g{(const bf16_t*)(p.ws + WS_HN), (const bf16_t*)(p.ws + WS_WIN), M_, INGEMM, 1024}; RepOrder S; S.S.init(M_, INGEMM, G, bx); S.cnt = (S.S.nwg - bx + G - 1) / G;
#define INPROJ_ORDER RepOrder
#else
        pg8::Gemm g{(const bf16_t*)(p.ws + WS_HN), (const bf16_t*)(p.ws + WS_WIN), M_, INGEMM, 1024}; pg8::StaticOrder S; S.init(M_, INGEMM, G, bx);
#define INPROJ_ORDER pg8::StaticOrder
#endif
        EpiInProj E{p.ws, p.in[I_QNG], p.in[I_KSNG], p.in[I_KWNG]};
        pg8::gemm_phase<EpiInProj, INPROJ_ORDER, true, true>(PG8_PTR(lds), g, S, E);
        if (BOTH(2)) GROUP_BAR();
    }
    if (IN(3)) {
        REPS(3) for (int u = vcu; u < B_ * SSM_NG; u += G) ssm_unit(p, lds, u, tid, wave, lane);
        REPS(6) for (int u = vcu; u < CMP_UNITS; u += G) compress_unit(p, lds, u, tid, wave, lane);
        {
            const bool local = (G == 256 && B_ == 8);
            auto vt_of = [&](int k) -> int { if (local) { if (k >= VT_UNITS / 256) return -1; const int loc = (vcu & 31) + 32 * k; return ((vcu >> 5) * NGRP + (loc >> 7)) * (T_ / 64) + (loc & 127); }
                                               const int u = vcu + k * G; return u < VT_UNITS ? u : -1; };
            VtPre cur, nxt; int u = vt_of(0);
            if (u >= 0) vt_fetch(p, u, tid, cur);
            for (int k = 0; u >= 0; ++k) {
                const int un = vt_of(k + 1); nxt = cur;
                if (un >= 0) vt_fetch(p, un, tid, nxt);
                vt_unit(p, lds, u, tid, cur);
                cur = nxt; u = un;
            }
        }
        if (BOTH(3)) GROUP_BAR();
    }
    if (IN(4)) {
        REPS(4) p4_attention(p, lds, vcu, G, tid, wave, lane);
        pg8::Gemm g{(const bf16_t*)(p.ws + WS_YG), (const bf16_t*)(p.ws + WS_WGLU), M_, 512, 512}; pg8::StaticOrder S; S.init(M_, 512, G, bx);
        EpiGlu E{(const bf16_t*)(p.ws + WS_YG), (const bf16_t*)(p.ws + WS_ZS), (bf16_t*)(p.ws + WS_MIX), p.in[I_GLUB]};
        REPS(7) pg8::gemm_phase<EpiGlu, pg8::StaticOrder, true, true>(PG8_PTR(lds), g, S, E);
        if (BOTH(4)) GROUP_BAR();
    }
    if (IN(5)) {
        pg8::Gemm g{(const bf16_t*)(p.ws + WS_MIX), (const bf16_t*)(p.ws + WS_WO), M_, 1024, 1024}; pg8::StaticOrder S; S.init(M_, 1024, G, bx);
        EpiOut E{p.in[I_X], p.out, (const float*)(p.ws + WS_MOD)};
        REPS(5) pg8::gemm_phase<EpiOut, pg8::StaticOrder, true, true>(PG8_PTR(lds), g, S, E);
#ifdef PROBE_TIMING
        GRID_BAR();
        if (bx == 0 && tid == 0) { const float* tr = (const float*)(p.ws + WS_CTL + 32768); p.out[0] += tr[PROBE_WHICH] * 1e-3f; }
#endif
    }
#undef IN
#undef BOTH
}

extern "C" void kernel_launch(void* const* d_in, const int* in_sizes, int n_in, void* d_out, int out_size, void* d_ws, size_t ws_size, hipStream_t stream) {
    static int grid = 0;
    if (grid == 0) {
        if (n_in != N_IN || out_size != M_ * D_ || ws_size < WS_END) { fprintf(stderr, "kernel_launch: unexpected shapes (n_in %d out %d ws %zu need %zu)\n", n_in, out_size, ws_size, (size_t)WS_END); grid = -1; return; }
#ifdef CPU_EMU
        grid = EMU_GRID;
#else
        int dev = 0, cus = 0, per_cu = 0;
        if (hipGetDevice(&dev) != hipSuccess || hipDeviceGetAttribute(&cus, hipDeviceAttributeMultiprocessorCount, dev) != hipSuccess) { grid = -1; return; }
        if (hipFuncSetAttribute((const void*)fwd_kernel, hipFuncAttributeMaxDynamicSharedMemorySize, LDS_BYTES) != hipSuccess) { fprintf(stderr, "kernel_launch: hipFuncSetAttribute failed\n"); grid = -1; return; }
        if (hipOccupancyMaxActiveBlocksPerMultiprocessor(&per_cu, (const void*)fwd_kernel, 512, LDS_BYTES) != hipSuccess || per_cu < 1) { fprintf(stderr, "kernel_launch: occupancy query says %d blocks per CU\n", per_cu); per_cu = 1; }
        (void)hipGetLastError();
        grid = cus;
#endif
    }
    if (grid < 0) return;
    (void)hipMemsetAsync((char*)d_ws + WS_CTL, 0, CTL_ZERO_BYTES, stream);
    Params a{};
    for (int i = 0; i < N_IN; ++i) a.in[i] = (const float*)d_in[i];
    a.out = (float*)d_out; a.ws = (unsigned char*)d_ws;
    for (int li = 0; li < N_LAUNCH; ++li) {
        a.ph_lo = (N_LAUNCH == 1) ? 0 : li; a.ph_hi = (N_LAUNCH == 1) ? N_PHASES : li + 1; a.li = 0;
#ifdef CPU_EMU
        emu_launch((unsigned)grid, 512u, [&]() { fwd_kernel(a); });
#else
        hipLaunchKernelGGL(fwd_kernel, dim3(grid), dim3(512), LDS_BYTES, stream, a);
#endif
    }
}
```

```cpp
#ifndef CPU_EMU
#include <hip/hip_runtime.h>
#endif
#include <cstdio>
#include <cstdint>
#include <cmath>

#ifndef BATCH_N
#define BATCH_N 8
#endif
#ifndef SEQ_LEN
#define SEQ_LEN 8192
#endif
#ifndef N_LAUNCH
#define N_LAUNCH 1
#endif
#define DEV __device__ __forceinline__

typedef unsigned short bf16_t;
typedef short bf16x8 __attribute__((ext_vector_type(8)));
typedef float f32x4 __attribute__((ext_vector_type(4)));
typedef float f32x16 __attribute__((ext_vector_type(16)));
typedef float f32x2 __attribute__((ext_vector_type(2)));
typedef unsigned u32x4 __attribute__((ext_vector_type(4)));
typedef unsigned u32x2 __attribute__((ext_vector_type(2)));

constexpr int B_ = BATCH_N, T_ = SEQ_LEN, D_ = 1024, M_ = B_ * T_;
constexpr int NH = 8, HD = 64, NGRP = 2;
constexpr int NCMP = (T_ - 32) / 16 + 1;
constexpr int NCP = T_ / 16;
constexpr int NSB = T_ / 64;
constexpr int INW = 2840, INP = 3072;
constexpr int SSM_NG = 32, SSM_P = 64, SSM_C = 16, SSM_W = 512;
constexpr int SSM_L = 64;
constexpr int SSM_CG = 32;
constexpr int SSM_NCG = T_ / (SSM_L * SSM_CG);
constexpr float EPS_ = 1e-6f;
static_assert(T_ % 2048 == 0 && NSB <= 128, "shape assumptions");

enum { I_X = 0, I_C, I_WADA, I_BADA, I_NORMG, I_WIN, I_QNG, I_KCNG, I_KSNG, I_KWNG, I_POSK, I_POSV, I_W1K, I_W2K, I_W1V, I_W2V,
       I_ARE, I_AIM, I_LOGDT, I_BRE, I_BIM, I_CRE, I_CIM, I_SSMD, I_GLUW, I_GLUB, I_WOUT, N_IN };

constexpr size_t MiB = 1u << 20;
constexpr size_t al(size_t x) { return (x + MiB - 1) / MiB * MiB; }
constexpr size_t WS_CTL = 0, CTL_ZERO_BYTES = 64 * 1024;
constexpr size_t WS_MOD = 1 * MiB;
constexpr size_t WS_ROPE = WS_MOD + al((size_t)B_ * 3072 * 4);
constexpr size_t WS_CPOS = WS_CTL + 24576;
constexpr size_t WS_LAM64 = WS_ROPE + al((size_t)T_ * 64 * 4);
constexpr size_t WS_KT = WS_LAM64 + MiB;
constexpr size_t WS_WST = WS_KT + al((size_t)32 * 65 * 256 * 2);
constexpr size_t WS_WOUTS = WS_WST + al((size_t)32 * 128 * 1024 * 2);
constexpr size_t WS_WIN = WS_WOUTS + al((size_t)32 * 1024 * 128 * 2);
constexpr size_t WS_WO = WS_WIN + al((size_t)INP * 1024 * 2);
constexpr size_t WS_WGLU = WS_WO + al((size_t)1024 * 1024 * 2);
constexpr size_t WS_W1K = WS_WGLU + MiB, WS_W1V = WS_W1K + MiB;
constexpr size_t WS_W2K = WS_W1V + MiB, WS_W2V = WS_W2K + 64 * 1024;
constexpr size_t WS_KC = WS_W2K + MiB;
constexpr size_t WS_VC = WS_KC + al((size_t)B_ * NCP * 128 * 2);
constexpr size_t WS_G = WS_VC + al((size_t)B_ * NCP * 128 * 2);
constexpr size_t WS_HN = WS_G + al((size_t)M_ * 32 * 4);
constexpr size_t WS_Q = WS_HN + al((size_t)M_ * 1024 * 2);
constexpr size_t WS_QR = WS_Q + al((size_t)M_ * 512 * 2);
constexpr size_t WS_CR = WS_QR + al((size_t)M_ * 512 * 2);
constexpr size_t WS_SL = WS_CR + al((size_t)M_ * 256 * 2);
constexpr size_t WS_WN = WS_SL + al((size_t)M_ * 256 * 2);
constexpr size_t WS_ZA = WS_WN + al((size_t)M_ * 256 * 2);
constexpr size_t WS_U = WS_ZA + al((size_t)M_ * 512 * 2);
constexpr size_t WS_ZS = WS_U + al((size_t)M_ * 512 * 2);
constexpr size_t WS_YG = WS_ZS + al((size_t)M_ * 512 * 2);
constexpr size_t WS_MIX = WS_YG + al((size_t)M_ * 512 * 2);
constexpr size_t WS_VT = WS_MIX + al((size_t)M_ * 1024 * 2);
constexpr size_t WS_KF = WS_VT + al((size_t)M_ * 128 * 2);
constexpr size_t WS_END = WS_KF + al((size_t)M_ * 128 * 2);

constexpr int RING_BYTES = 131072;
constexpr int LDS_BYTES = 155648;
constexpr int MISC_OFF = LDS_BYTES - 256;

DEV unsigned f2bf(float f) { unsigned u = __builtin_bit_cast(unsigned, f); return (u + 0x7fffu + ((u >> 16) & 1u)) >> 16; }
DEV float bf2f(unsigned h) { return __builtin_bit_cast(float, h << 16); }
#ifdef CPU_EMU
DEV unsigned pk2(float lo, float hi) { return f2bf(lo) | (f2bf(hi) << 16); }
DEV float exp2_fast(float x) { return exp2f(x); }
DEV float rcp_fast(float x) { return 1.0f / x; }
DEV float log2_fast(float x) { return log2f(x); }
DEV int f2i_rn(float x) { return (int)floorf(x + 0.5f); }
DEV f32x4 mfma16(bf16x8 a, bf16x8 b, f32x4 c) { return emu_mfma16(a, b, c); }
DEV f32x16 mfma32(bf16x8 a, bf16x8 b, f32x16 c) { return emu_mfma32(a, b, c); }
#define WAVE_ID() ((int)(threadIdx.x >> 6))
#else
typedef __bf16 bf16x2_t __attribute__((ext_vector_type(2)));
DEV unsigned pk2(float lo, float hi) { f32x2 v = {lo, hi}; bf16x2_t b = __builtin_convertvector(v, bf16x2_t); return __builtin_bit_cast(unsigned, b); }
DEV float exp2_fast(float x) { return __builtin_amdgcn_exp2f(x); }
DEV float rcp_fast(float x) { return __builtin_amdgcn_rcpf(x); }
DEV float log2_fast(float x) { return __builtin_amdgcn_logf(x); }
DEV int f2i_rn(float x) { int r; asm("v_cvt_rpi_i32_f32 %0, %1" : "=v"(r) : "v"(x)); return r; }
DEV f32x4 mfma16(bf16x8 a, bf16x8 b, f32x4 c) { return __builtin_amdgcn_mfma_f32_16x16x32_bf16(a, b, c, 0, 0, 0); }
DEV f32x16 mfma32(bf16x8 a, bf16x8 b, f32x16 c) { return __builtin_amdgcn_mfma_f32_32x32x16_bf16(a, b, c, 0, 0, 0); }
#define WAVE_ID() (__builtin_amdgcn_readfirstlane((int)(threadIdx.x >> 6)))
#endif
#ifdef CPU_EMU
#define EXPF(x) expf(x)
#else
#define EXPF(x) __expf(x)
#endif
DEV float silu_f(float v) { return v * rcp_fast(1.0f + EXPF(-v)); }
DEV float sigmoid_f(float v) { return rcp_fast(1.0f + EXPF(-v)); }
DEV float gelu_tanh_f(float v) { const float u = 0.7978845608028654f * (v + 0.044715f * v * v * v); const float e = EXPF(2.0f * u); return v * (1.0f - rcp_fast(e + 1.0f)); }
DEV float wave_sum(float v) {
#ifdef CPU_EMU
#pragma unroll
    for (int o = 1; o < 64; o <<= 1) v += __shfl_xor(v, o);
    return v;
#else
#define WS_ROR(n) v += __builtin_bit_cast(float, __builtin_amdgcn_update_dpp(0, __builtin_bit_cast(int, v), 0x120 + (n), 0xf, 0xf, false))
    WS_ROR(8); WS_ROR(4); WS_ROR(2); WS_ROR(1);
#undef WS_ROR
    unsigned a_ = __builtin_bit_cast(unsigned, v), b_ = a_;
    asm volatile("s_nop 1\n\tv_permlane16_swap_b32 %0, %1" : "+v"(a_), "+v"(b_));
    v = __builtin_bit_cast(float, a_) + __builtin_bit_cast(float, b_);
    a_ = __builtin_bit_cast(unsigned, v); b_ = a_;
    asm volatile("s_nop 1\n\tv_permlane32_swap_b32 %0, %1" : "+v"(a_), "+v"(b_));
    return __builtin_bit_cast(float, a_) + __builtin_bit_cast(float, b_);
#endif
}
DEV float wave_max(float v) {
#pragma unroll
    for (int o = 1; o < 64; o <<= 1) v = fmaxf(v, __shfl_xor(v, o));
    return v;
}
DEV bf16x8 ld8(const bf16_t* p) { return *(const bf16x8*)p; }
namespace pg8 {
#define PG8_LAS __attribute__((address_space(3)))
typedef unsigned short bf16_t;
typedef short bf16x8 __attribute__((ext_vector_type(8)));
typedef float f32x4 __attribute__((ext_vector_type(4)));
typedef unsigned u32x4 __attribute__((ext_vector_type(4)));
constexpr int BM = 256, BK = 64, HALF = 128, HTB = HALF * BK * 2  , STAGE_BYTES = 8 * HTB, NXCD = 8, WGM = 8;

__host__ __device__ __forceinline__ int lds_byte(int r, int c) { const int st = (r >> 4) * 2 + (c >> 5), rr = r & 15, cc = c & 31, ob = rr * 64 + cc * 2; return st * 1024 + (ob ^ (((ob >> 9) & 1) << 5)); }
__host__ __device__ __forceinline__ void stage_rc(int b, int& R, int& C) { const int st = b / 1024, sb = b % 1024, swz = sb ^ (((sb >> 9) & 1) << 5); R = (st >> 1) * 16 + swz / 64; C = (st & 1) * 32 + (swz % 64) / 2; }
__host__ __device__ __forceinline__ int perm32(int rho) { const int n = rho >> 4, i = rho & 15; return 8 * (i >> 2) + 4 * n + (i & 3); }

struct Unit { int pm, pn; };
struct Gemm { const bf16_t* A; const bf16_t* Bt; int M, N, K; };

struct StaticOrder {
    int nM, nN, nwg, G, c;
    __host__ __device__ void init(int M, int N, int G_, int c_) { nM = M / BM; nN = N / BM; nwg = nM * nN; G = G_; c = c_; }
    __host__ __device__ bool next(int i, Unit& u) const {
        const long L = (long)i * G + c; if (L >= nwg) return false;
        int wgid = (int)L; { const int q = nwg / NXCD, r = nwg % NXCD, xcd = wgid % NXCD, off = wgid / NXCD; wgid = (xcd < r ? xcd * (q + 1) : r * (q + 1) + (xcd - r) * q) + off; }
        const int nig = WGM * nN, gid = wgid / nig, fm = gid * WGM, gsz = (nM - fm) < WGM ? (nM - fm) : WGM;
        u.pm = fm + ((wgid % nig) % gsz); u.pn = (wgid % nig) / gsz; return true;
    }
    __device__ __forceinline__ void a_ready(const Unit&) const {}
    __device__ __forceinline__ void done(const Unit&) const {}
};

#ifndef CPU_EMU
__device__ __forceinline__ unsigned cvt_pk_bf16(float lo, float hi) { unsigned r; asm volatile("v_cvt_pk_bf16_f32 %0, %1, %2" : "=v"(r) : "v"(lo), "v"(hi)); return r; }
template <class Epi, class Sched, bool ALIGN_EPI = false, bool SP2 = false>
__device__ __forceinline__ void gemm_phase(PG8_LAS unsigned char* lds, const Gemm g, const Sched& S, const Epi& E) {
    const int tid = threadIdx.x, wid = __builtin_amdgcn_readfirstlane(tid >> 6), lane = tid & 63, wr = wid >> 2, wc = wid & 3, fr = lane & 15, fq = lane >> 4;
    const int K = g.K, nt = K / BK;
    unsigned voffA[2], voffB[2];
#pragma unroll
    for (int i = 0; i < 2; ++i) { int R, C; stage_rc(tid * 16 + i * 8192, R, C); const int Rb = Epi::PERM ? ((R & ~31) + perm32(R & 31)) : R;
        voffA[i] = (unsigned)(R * K + C) * 2u; voffB[i] = (unsigned)(Rb * K + C) * 2u; }
    const size_t kstep = (size_t)(BK * 2);
    const size_t hstep = (size_t)HALF * K * 2;
    const size_t tstep = 2 * hstep;
    const unsigned ldsw = (unsigned)wid * 1024u;
    const int aoff = lds_byte(wr * 64 + fr, fq * 8), boff = lds_byte(wc * 32 + fr, fq * 8);
#define PG8_SA(b, h) (((b) * 2 + (h)) * HTB)
#define PG8_SB(b, h) ((4 + (b) * 2 + (h)) * HTB)
#define PG8_STAGE(bufoff, gbase, voff) do { _Pragma("unroll") for (int _i = 0; _i < 2; ++_i) \
        __builtin_amdgcn_global_load_lds((const unsigned*)((const char*)(gbase) + (voff)[_i]), (PG8_LAS unsigned*)(lds + (bufoff) + ldsw + _i * 8192), 16, 0, 0); } while (0)
#define PG8_LDA(dst, b, h) do { _Pragma("unroll") for (int m = 0; m < 4; ++m) _Pragma("unroll") for (int k = 0; k < 2; ++k) dst[m][k] = *(const PG8_LAS bf16x8*)(lds + PG8_SA(b, h) + aoff + m * 2048 + k * 1024); } while (0)
#define PG8_LDB(dst, b, h) do { _Pragma("unroll") for (int n = 0; n < 2; ++n) _Pragma("unroll") for (int k = 0; k < 2; ++k) dst[n][k] = *(const PG8_LAS bf16x8*)(lds + PG8_SB(b, h) + boff + n * 2048 + k * 1024); } while (0)
#define PG8_MMA(ai, bj, At, Bt) do { __builtin_amdgcn_s_setprio(1); _Pragma("unroll") for (int m = 0; m < 4; ++m) _Pragma("unroll") for (int n = 0; n < 2; ++n) _Pragma("unroll") for (int k = 0; k < 2; ++k) \
        acc[ai][bj][m][n] = __builtin_amdgcn_mfma_f32_16x16x32_bf16(Bt[n][k], At[m][k], acc[ai][bj][m][n], 0, 0, 0); __builtin_amdgcn_s_setprio(0); } while (0)
#define PG8_WAIT_V(n) asm volatile("s_waitcnt vmcnt(" #n ")" ::: "memory")
#define PG8_WAIT_L(n) asm volatile("s_waitcnt lgkmcnt(" #n ")" ::: "memory")
#define PG8_BAR __builtin_amdgcn_s_barrier()
#define PG8_SCHED __builtin_amdgcn_sched_barrier(0)
    Unit cur, nxt; int ui = 0;
    if (!S.next(0, cur)) return;
    f32x4 acc[2][2][4][2];
#pragma unroll
    for (int a = 0; a < 2; ++a)
#pragma unroll
        for (int b = 0; b < 2; ++b)
#pragma unroll
            for (int m = 0; m < 4; ++m)
#pragma unroll
                for (int n = 0; n < 2; ++n) acc[a][b][m][n] = (f32x4){0.f, 0.f, 0.f, 0.f};
    bf16x8 At[4][2], B0[2][2], B1[2][2];
    const char* cA = (const char*)g.A + (size_t)cur.pm * tstep; const char* cB = (const char*)g.Bt + (size_t)cur.pn * tstep;
    S.a_ready(cur);
    if constexpr (SP2) {
        PG8_STAGE(PG8_SB(0, 0), cB, voffB); PG8_STAGE(PG8_SB(0, 1), cB + hstep, voffB); PG8_STAGE(PG8_SA(0, 0), cA, voffA); PG8_STAGE(PG8_SA(0, 1), cA + hstep, voffA);
        if (wr == 1) PG8_BAR;
        PG8_WAIT_V(2); PG8_BAR;
        PG8_STAGE(PG8_SB(1, 0), cB + kstep, voffB); PG8_STAGE(PG8_SA(1, 0), cA + kstep, voffA); PG8_STAGE(PG8_SB(1, 1), cB + hstep + kstep, voffB);
        PG8_WAIT_V(6); PG8_BAR;
    } else {
        PG8_STAGE(PG8_SB(0, 0), cB, voffB); PG8_STAGE(PG8_SA(0, 0), cA, voffA); PG8_STAGE(PG8_SB(0, 1), cB + hstep, voffB); PG8_STAGE(PG8_SA(0, 1), cA + hstep, voffA);
        if (wr == 1) PG8_BAR;
        PG8_WAIT_V(4); PG8_BAR;
        PG8_STAGE(PG8_SB(1, 0), cB + kstep, voffB); PG8_STAGE(PG8_SA(1, 0), cA + kstep, voffA); PG8_STAGE(PG8_SB(1, 1), cB + hstep + kstep, voffB);
        PG8_WAIT_V(6); PG8_BAR;
    }
    for (;;) {
        const bool has_next = S.next(ui + 1, nxt);
        const char* nA = has_next ? (const char*)g.A + (size_t)nxt.pm * tstep : cA; const char* nB = has_next ? (const char*)g.Bt + (size_t)nxt.pn * tstep : cB;
        for (int t = 0; t < nt; t += 2) {
            const bool last = (t == nt - 2);
            const char* a1 = cA + (size_t)(t + 1) * kstep;
            const char* a2 = last ? nA : cA + (size_t)(t + 2) * kstep; const char* b2 = last ? nB : cB + (size_t)(t + 2) * kstep;
            const char* a3 = a2 + kstep; const char* b3 = b2 + kstep;
            if (last && has_next) S.a_ready(nxt);
            if constexpr (SP2) {
            PG8_LDB(B0, 0, 0); PG8_LDB(B1, 0, 1); PG8_SCHED; PG8_LDA(At, 0, 0); PG8_STAGE(PG8_SA(1, 1), a1 + hstep, voffA);
            PG8_WAIT_V(8); PG8_WAIT_L(0); PG8_BAR; PG8_MMA(0, 0, At, B0); PG8_MMA(0, 1, At, B1); PG8_BAR; PG8_SCHED;
            PG8_LDA(At, 0, 1); PG8_STAGE(PG8_SB(0, 0), b2, voffB); PG8_STAGE(PG8_SB(0, 1), b2 + hstep, voffB); PG8_STAGE(PG8_SA(0, 0), a2, voffA);
            PG8_WAIT_V(8); PG8_WAIT_L(0); PG8_BAR; PG8_MMA(1, 0, At, B0); PG8_MMA(1, 1, At, B1); PG8_BAR; PG8_SCHED;
            PG8_LDB(B0, 1, 0); PG8_LDB(B1, 1, 1); PG8_SCHED; PG8_LDA(At, 1, 0); PG8_STAGE(PG8_SA(0, 1), a2 + hstep, voffA);
            PG8_WAIT_V(8); PG8_WAIT_L(0); PG8_BAR; PG8_MMA(0, 0, At, B0); PG8_MMA(0, 1, At, B1); PG8_BAR; PG8_SCHED;
            PG8_LDA(At, 1, 1); PG8_STAGE(PG8_SB(1, 0), b3, voffB); PG8_STAGE(PG8_SB(1, 1), b3 + hstep, voffB); PG8_STAGE(PG8_SA(1, 0), a3, voffA);
            PG8_WAIT_V(8); PG8_WAIT_L(0); PG8_BAR; PG8_MMA(1, 0, At, B0); PG8_MMA(1, 1, At, B1); PG8_BAR; PG8_SCHED;
            } else {
            PG8_LDB(B0, 0, 0); PG8_SCHED; PG8_LDA(At, 0, 0); PG8_STAGE(PG8_SA(1, 1), a1 + hstep, voffA);
            PG8_WAIT_L(8); PG8_BAR; PG8_WAIT_L(0); PG8_MMA(0, 0, At, B0); PG8_BAR; PG8_SCHED;
            PG8_LDB(B1, 0, 1); PG8_STAGE(PG8_SB(0, 0), b2, voffB);
            PG8_BAR; PG8_WAIT_L(0); PG8_MMA(0, 1, At, B1); PG8_BAR;
            PG8_LDA(At, 0, 1); PG8_STAGE(PG8_SA(0, 0), a2, voffA);
            PG8_BAR; PG8_WAIT_L(0); PG8_MMA(1, 0, At, B0); PG8_BAR; PG8_SCHED;
            PG8_STAGE(PG8_SB(0, 1), b2 + hstep, voffB);
            PG8_WAIT_V(6); PG8_BAR; PG8_MMA(1, 1, At, B1); PG8_BAR;
            PG8_LDB(B0, 1, 0); PG8_SCHED; PG8_LDA(At, 1, 0); PG8_STAGE(PG8_SA(0, 1), a2 + hstep, voffA);
            PG8_WAIT_L(8); PG8_BAR; PG8_WAIT_L(0); PG8_MMA(0, 0, At, B0); PG8_BAR; PG8_SCHED;
            PG8_LDB(B1, 1, 1); PG8_STAGE(PG8_SB(1, 0), b3, voffB);
            PG8_BAR; PG8_WAIT_L(0); PG8_MMA(0, 1, At, B1); PG8_BAR;
            PG8_LDA(At, 1, 1); PG8_STAGE(PG8_SA(1, 0), a3, voffA);
            PG8_BAR; PG8_WAIT_L(0); PG8_MMA(1, 0, At, B0); PG8_BAR; PG8_SCHED;
            PG8_STAGE(PG8_SB(1, 1), b3 + hstep, voffB);
            PG8_WAIT_V(6); PG8_BAR; PG8_MMA(1, 1, At, B1); PG8_BAR;
            }
        }
        if constexpr (ALIGN_EPI) { if (wr == 0) PG8_BAR; }
        if constexpr (!Epi::AFTER_DRAIN) { E(acc, cur, wr, wc, fr, fq); S.done(cur); }
        if (!has_next) break;
#pragma unroll
        for (int a = 0; a < 2; ++a)
#pragma unroll
            for (int b = 0; b < 2; ++b)
#pragma unroll
                for (int m = 0; m < 4; ++m)
#pragma unroll
                    for (int n = 0; n < 2; ++n) acc[a][b][m][n] = (f32x4){0.f, 0.f, 0.f, 0.f};
        cur = nxt; cA = nA; cB = nB; ++ui;
        if constexpr (ALIGN_EPI) { if (wr == 1) PG8_BAR; }
    }
    PG8_WAIT_V(0);
    if constexpr (!ALIGN_EPI) { if (wr == 0) PG8_BAR; }
    PG8_BAR;
    if constexpr (Epi::AFTER_DRAIN) { E.fused(acc, cur, wr, wc, fr, fq, lds, wid, lane); S.done(cur); }
#undef PG8_SA
#undef PG8_SB
#undef PG8_STAGE
#undef PG8_LDA
#undef PG8_LDB
#undef PG8_MMA
#undef PG8_WAIT_V
#undef PG8_WAIT_L
#undef PG8_BAR
#undef PG8_SCHED
}
}
#define PG8_PTR(x) ((__attribute__((address_space(3))) unsigned char*)(x))
#else
template <class Epi, class Sched, bool ALIGN_EPI = false, bool SP2 = false>
inline void gemm_phase(unsigned char* lds, const Gemm g, const Sched& S, const Epi& E) {
    const int tid = threadIdx.x, wid = tid >> 6, lane = tid & 63, wr = wid >> 2, wc = wid & 3, fr = lane & 15, fq = lane >> 4;
    Unit cur;
    for (int ui = 0; S.next(ui, cur); ++ui) {
        f32x4 acc[2][2][4][2];
        for (int ai = 0; ai < 2; ++ai) for (int bj = 0; bj < 2; ++bj) for (int m = 0; m < 4; ++m) for (int n = 0; n < 2; ++n) for (int i = 0; i < 4; ++i) {
            const int row = 256 * cur.pm + 128 * ai + 64 * wr + 16 * m + fr;
            const int col = 256 * cur.pn + 128 * bj + 32 * wc + (Epi::PERM ? 8 * fq + 4 * n + i : 16 * n + 4 * fq + i);
            const bf16_t* a = g.A + (size_t)row * g.K; const bf16_t* b = g.Bt + (size_t)col * g.K; float s = 0.f;
            for (int k = 0; k < g.K; ++k) s += emu_bf2f(a[k]) * emu_bf2f(b[k]);
            acc[ai][bj][m][n][i] = s; }
        E(acc, cur, wr, wc, fr, fq);
    }
}
}
#define PG8_PTR(x) (x)
#endif
#ifdef CPU_EMU
#define WAVE_SYNC() emu_wave_sync()
#define SCHED_FENCE() do { } while (0)
#define LAUNDER_V(x) do { } while (0)
#define LDS_BARRIER() __syncthreads()
#else
#define LDS_BARRIER() do { asm volatile("s_waitcnt lgkmcnt(0)" ::: "memory"); __builtin_amdgcn_s_barrier(); asm volatile("" ::: "memory"); } while (0)
#define LAUNDER_V(x) asm volatile("" : "+v"(x))
#define WAVE_SYNC() asm volatile("s_waitcnt lgkmcnt(0)" ::: "memory")
#define SCHED_FENCE() __builtin_amdgcn_sched_barrier(0)
#endif

struct Params { const float* in[N_IN]; float* out; unsigned char* ws; int ph_lo, ph_hi, li, pad; };

constexpr float QSCALE = 0.125f * 1.4426950408889634f;
DEV void gates_rows(unsigned char* ws, size_t row0, int lane) {
    const int r = lane & 15, kq = lane >> 4;
    const bf16_t* HN = (const bf16_t*)(ws + WS_HN) + (row0 + r) * 1024 + 8 * kq;
    const bf16_t* WG = (const bf16_t*)(ws + WS_WIN) + (size_t)(2816 + r) * 1024 + 8 * kq;
    f32x4 acc[2][2];
#pragma unroll
    for (int rb = 0; rb < 2; ++rb)
#pragma unroll
        for (int cb = 0; cb < 2; ++cb) acc[rb][cb] = (f32x4){0.f, 0.f, 0.f, 0.f};
    bf16x8 hb[2][4][2], wb[2][4][2];
#define GU_LOAD(bt) do { _Pragma("unroll") for (int q = 0; q < 4; ++q) { const int s_ = 4 * (bt) + q; hb[(bt) & 1][q][0] = ld8(HN + 32 * s_); hb[(bt) & 1][q][1] = ld8(HN + 16 * 1024 + 32 * s_); \
        wb[(bt) & 1][q][0] = ld8(WG + 32 * s_); wb[(bt) & 1][q][1] = ld8(WG + 16 * 1024 + 32 * s_); } } while (0)
    GU_LOAD(0);
#pragma unroll
    for (int bt = 0; bt < 8; ++bt) {
        if (bt < 7) GU_LOAD(bt + 1);
        SCHED_FENCE();
#pragma unroll
        for (int q = 0; q < 4; ++q) {
            const bf16x8 h0 = hb[bt & 1][q][0], h1 = hb[bt & 1][q][1], w0 = wb[bt & 1][q][0], w1 = wb[bt & 1][q][1];
            acc[0][0] = mfma16(w0, h0, acc[0][0]); acc[0][1] = mfma16(w1, h0, acc[0][1]);
            acc[1][0] = mfma16(w0, h1, acc[1][0]); acc[1][1] = mfma16(w1, h1, acc[1][1]);
        }
        SCHED_FENCE();
    }
#undef GU_LOAD
    float* Gp = (float*)(ws + WS_G);
#pragma unroll
    for (int rb = 0; rb < 2; ++rb)
#pragma unroll
        for (int cb = 0; cb < 2; ++cb) { f32x4 o;
#pragma unroll
            for (int i = 0; i < 4; ++i) o[i] = sigmoid_f(acc[rb][cb][i]);
            *(f32x4*)(Gp + (row0 + 16 * rb + r) * 32 + 16 * cb + 4 * kq) = o; }
}

struct EpiInProj {
    static constexpr bool PERM = true, AFTER_DRAIN = false;
    unsigned char* ws; const float* qng; const float* ksng; const float* kwng;
    DEV void operator()(const f32x4 (&acc)[2][2][4][2], const pg8::Unit& u, int wr, int wc, int fr, int fq) const {
        const int pn = u.pn; const int row0 = u.pm * 256 + wr * 64 + fr;
        int kind; bf16_t* dst = nullptr; bf16_t* dst2 = nullptr; int pitch = 512, colb = 0; const float* gv = nullptr;
        if (pn < 2) { kind = 2; dst = (bf16_t*)(ws + WS_Q); dst2 = (bf16_t*)(ws + WS_QR); colb = (4 * pn + wc) * 64; gv = qng; }
        else if (pn == 2) { kind = 0; dst = (bf16_t*)(ws + WS_CR); pitch = 256; colb = wc * 64; }
        else if (pn == 3) { kind = wc < 2 ? 1 : 0; dst = (bf16_t*)(ws + WS_SL); pitch = 256; colb = wc * 64; gv = ksng; }
        else if (pn == 4) { kind = wc < 2 ? 1 : 0; dst = (bf16_t*)(ws + WS_WN); pitch = 256; colb = wc * 64; gv = kwng; }
        else if (pn < 7) { kind = 3; dst = (bf16_t*)(ws + WS_ZA); colb = (4 * (pn - 5) + wc) * 64; }
        else if (pn < 9) { kind = 0; dst = (bf16_t*)(ws + WS_U); colb = (4 * (pn - 7) + wc) * 64; }
        else if (pn < 11) { kind = 3; dst = (bf16_t*)(ws + WS_ZS); colb = (4 * (pn - 9) + wc) * 64; }
        else { kind = (wc == 0) ? 4 : 5; }
        if (kind == 5) return;
        float g1[8], g2[8];
        if (kind == 1 || kind == 2) {
#pragma unroll
            for (int i = 0; i < 8; ++i) { const float qs = (kind == 2) ? QSCALE : 1.0f; g1[i] = gv[8 * fq + i] * qs; g2[i] = gv[32 + 8 * fq + i] * qs; }
        }
        const float* rope = (const float*)(ws + WS_ROPE);
#pragma unroll
        for (int ai = 0; ai < 2; ++ai)
#pragma unroll
            for (int m = 0; m < 4; ++m) {
                const int row = row0 + ai * 128 + m * 16;
                float x1[8], x2[8];
#pragma unroll
                for (int i = 0; i < 4; ++i) { x1[i] = acc[ai][0][m][0][i]; x1[4 + i] = acc[ai][0][m][1][i]; x2[i] = acc[ai][1][m][0][i]; x2[4 + i] = acc[ai][1][m][1][i]; }
                if (kind == 4) {
                    float* G = (float*)(ws + WS_G) + (size_t)row * 32 + 8 * fq;
                    f32x4 o0, o1;
#pragma unroll
                    for (int i = 0; i < 4; ++i) { o0[i] = sigmoid_f(x1[i]); o1[i] = sigmoid_f(x1[4 + i]); }
                    *(f32x4*)G = o0; *(f32x4*)(G + 4) = o1;
                    continue;
                }
                if (kind == 1 || kind == 2) {
                    float ss = 0.f;
#pragma unroll
                    for (int i = 0; i < 8; ++i) ss += x1[i] * x1[i] + x2[i] * x2[i];
                    ss += __shfl_xor(ss, 16); ss += __shfl_xor(ss, 32);
                    const float rinv = rsqrtf(ss * (1.0f / 64.0f) + EPS_);
#pragma unroll
                    for (int i = 0; i < 8; ++i) { x1[i] = x1[i] * rinv * g1[i]; x2[i] = x2[i] * rinv * g2[i]; }
                    if (kind == 2) {
                        bf16_t* o = dst + (size_t)row * pitch + colb + 8 * fq;
                        *(u32x4*)o = (u32x4){pk2(x1[0], x1[1]), pk2(x1[2], x1[3]), pk2(x1[4], x1[5]), pk2(x1[6], x1[7])};
                        *(u32x4*)(o + 32) = (u32x4){pk2(x2[0], x2[1]), pk2(x2[2], x2[3]), pk2(x2[4], x2[5]), pk2(x2[6], x2[7])};
                    }
                    const int t = row % T_;
                    const float* cs = rope + (size_t)t * 32 + 8 * fq; const float* sn = cs + (size_t)T_ * 32;
                    const f32x4 c0 = *(const f32x4*)cs, c1 = *(const f32x4*)(cs + 4), s0 = *(const f32x4*)sn, s1 = *(const f32x4*)(sn + 4);
#pragma unroll
                    for (int i = 0; i < 8; ++i) { const float c = i < 4 ? c0[i & 3] : c1[i & 3], s = i < 4 ? s0[i & 3] : s1[i & 3]; const float a = x1[i], b = x2[i]; x1[i] = a * c - b * s; x2[i] = b * c + a * s; }
                } else if (kind == 3) {
#pragma unroll
                    for (int i = 0; i < 8; ++i) { x1[i] = silu_f(x1[i]); x2[i] = silu_f(x2[i]); }
                }
                bf16_t* o = (kind == 2 ? dst2 : dst) + (size_t)row * pitch + colb + 8 * fq;
                *(u32x4*)o = (u32x4){pk2(x1[0], x1[1]), pk2(x1[2], x1[3]), pk2(x1[4], x1[5]), pk2(x1[6], x1[7])};
                *(u32x4*)(o + 32) = (u32x4){pk2(x2[0], x2[1]), pk2(x2[2], x2[3]), pk2(x2[4], x2[5]), pk2(x2[6], x2[7])};
            }
    }
};

struct EpiGlu {
    static constexpr bool PERM = true, AFTER_DRAIN = false;
    const bf16_t* YG; const bf16_t* ZS; bf16_t* MIX; const float* glub;
    DEV void operator()(const f32x4 (&acc)[2][2][4][2], const pg8::Unit& u, int wr, int wc, int fr, int fq) const {
        const int row0 = u.pm * 256 + wr * 64 + fr, col0 = u.pn * 256 + wc * 32 + 8 * fq;
        f32x4 bv[2][2]; u32x4 ya[2][2], za[2][2];
#pragma unroll
        for (int bj = 0; bj < 2; ++bj) { bv[bj][0] = *(const f32x4*)(glub + col0 + bj * 128); bv[bj][1] = *(const f32x4*)(glub + col0 + bj * 128 + 4); }
#define EG_ROW(grp, mm) (row0 + (((grp) >> 1) & 1) * 128 + (2 * ((grp) & 1) + (mm)) * 16)
#define EG_COL(grp) (col0 + ((grp) >> 2) * 128)
#define EG_LOAD(grp) do { _Pragma("unroll") for (int mm = 0; mm < 2; ++mm) { ya[(grp) & 1][mm] = *(const u32x4*)(YG + (size_t)EG_ROW(grp, mm) * 512 + EG_COL(grp)); za[(grp) & 1][mm] = *(const u32x4*)(ZS + (size_t)EG_ROW(grp, mm) * 512 + EG_COL(grp)); } } while (0)
        EG_LOAD(0);
#pragma unroll
        for (int grp = 0; grp < 8; ++grp) {
            const int bj = grp >> 2, ai = (grp >> 1) & 1;
            if (grp < 7) EG_LOAD(grp + 1);
            SCHED_FENCE();
#pragma unroll
            for (int mm = 0; mm < 2; ++mm) {
                const int m = 2 * (grp & 1) + mm; const u32x4 yv = ya[grp & 1][mm], zv = za[grp & 1][mm];
                float o[8];
#pragma unroll
                for (int i = 0; i < 8; ++i) {
                    const float a = (i < 4 ? acc[ai][bj][m][0][i & 3] : acc[ai][bj][m][1][i & 3]) + (i < 4 ? bv[bj][0][i & 3] : bv[bj][1][i & 3]);
                    const unsigned yw = yv[i >> 1], zw = zv[i >> 1];
                    const float y = bf2f((i & 1) ? (yw >> 16) : (yw & 0xffffu)), z = bf2f((i & 1) ? (zw >> 16) : (zw & 0xffffu));
                    o[i] = y * sigmoid_f(a) * z;
                }
                *(u32x4*)(MIX + (size_t)EG_ROW(grp, mm) * 1024 + 512 + EG_COL(grp)) = (u32x4){pk2(o[0], o[1]), pk2(o[2], o[3]), pk2(o[4], o[5]), pk2(o[6], o[7])};
            }
            SCHED_FENCE();
        }
#undef EG_ROW
#undef EG_COL
#undef EG_LOAD
    }
};

struct EpiOut {
    static constexpr bool PERM = false, AFTER_DRAIN = false;
    const float* x; float* out; const float* mod;
    DEV void operator()(const f32x4 (&acc)[2][2][4][2], const pg8::Unit& u, int wr, int wc, int fr, int fq) const {
        const int row0 = u.pm * 256 + wr * 64 + fr, col0 = u.pn * 256 + wc * 32 + 4 * fq; const int b = (u.pm * 256) / T_;
        f32x4 gv[2][2], xa[2][2][2];
#pragma unroll
        for (int bj = 0; bj < 2; ++bj) { gv[bj][0] = *(const f32x4*)(mod + (size_t)b * 3072 + 2048 + col0 + bj * 128); gv[bj][1] = *(const f32x4*)(mod + (size_t)b * 3072 + 2048 + col0 + bj * 128 + 16); }
#define EO_OFF(grp, mm) ((size_t)(row0 + (((grp) >> 1) & 1) * 128 + (2 * ((grp) & 1) + (mm)) * 16) * 1024 + col0 + ((grp) >> 2) * 128)
#define EO_LOAD(grp) do { _Pragma("unroll") for (int mm = 0; mm < 2; ++mm) { xa[(grp) & 1][mm][0] = *(const f32x4*)(x + EO_OFF(grp, mm)); xa[(grp) & 1][mm][1] = *(const f32x4*)(x + EO_OFF(grp, mm) + 16); } } while (0)
        EO_LOAD(0);
#pragma unroll
        for (int grp = 0; grp < 8; ++grp) {
            const int bj = grp >> 2, ai = (grp >> 1) & 1;
            if (grp < 7) EO_LOAD(grp + 1);
            SCHED_FENCE();
#pragma unroll
            for (int mm = 0; mm < 2; ++mm) {
                const int m = 2 * (grp & 1) + mm;
                *(f32x4*)(out + EO_OFF(grp, mm)) = xa[grp & 1][mm][0] + gv[bj][0] * acc[ai][bj][m][0];
                *(f32x4*)(out + EO_OFF(grp, mm) + 16) = xa[grp & 1][mm][1] + gv[bj][1] * acc[ai][bj][m][1];
            }
            SCHED_FENCE();
        }
#undef EO_OFF
#undef EO_LOAD
    }
};

DEV size_t frag_idx(int row, int k, int K) { return ((size_t)((row >> 4) * (K >> 5) + (k >> 5)) * 64 + 16 * ((k >> 3) & 3) + (row & 15)) * 8 + (k & 7); }
DEV void tr_item(const float* W, int Nsrc, int K, int k0, int col0, int nvalid, bf16_t* WT, int drow0, float* scr, int lane, bool frag = false) {
    const int c = lane & 31;
    float v[32];
#pragma unroll
    for (int i = 0; i < 32; ++i) { const int kk = 2 * i + (lane >> 5); v[i] = (c < nvalid) ? W[(size_t)(k0 + kk) * Nsrc + col0 + c] : 0.f; }
#pragma unroll
    for (int i = 0; i < 32; ++i) { const int kk = 2 * i + (lane >> 5); scr[kk * 33 + c] = v[i]; }
    WAVE_SYNC();
    const int c8 = lane & 7;
#pragma unroll
    for (int j = 0; j < 4; ++j) { const int n = (lane >> 3) + 8 * j; const float* s = scr + (8 * c8) * 33 + n;
        u32x4 o; o.x = pk2(s[0 * 33], s[1 * 33]); o.y = pk2(s[2 * 33], s[3 * 33]); o.z = pk2(s[4 * 33], s[5 * 33]); o.w = pk2(s[6 * 33], s[7 * 33]);
        const int row = drow0 + n, k8 = (k0 >> 3) + c8;
        *(u32x4*)(WT + (frag ? ((size_t)((row >> 4) * (K >> 5) + (k8 >> 2)) * 64 + 16 * (k8 & 3) + (row & 15)) * 8 : (size_t)row * K + k0 + 8 * c8)) = o; }
    WAVE_SYNC();
}

DEV void p0_prologue(const Params& p, unsigned char* lds, int vcu, int G, int tid, int wave, int lane) {
    unsigned char* ws = p.ws;
    {
        const float* c = p.in[I_C]; const float* w = p.in[I_WADA]; const float* ba = p.in[I_BADA]; float* mod = (float*)(ws + WS_MOD);
        for (int cb = vcu; cb < 256; cb += G)
            for (int b = wave; b < B_; b += 8) {
                float a[12];
#pragma unroll
                for (int j = 0; j < 12; ++j) a[j] = 0.f;
#pragma unroll 8
                for (int i = 0; i < 16; ++i) {
                    const int k = lane + 64 * i; const float s = silu_f(c[b * 1024 + k]);
                    const f32x4* wp = (const f32x4*)(w + (size_t)k * 3072 + 12 * cb); const f32x4 w0 = wp[0], w1 = wp[1], w2 = wp[2];
#pragma unroll
                    for (int j = 0; j < 4; ++j) { a[j] += s * w0[j]; a[4 + j] += s * w1[j]; a[8 + j] += s * w2[j]; }
                }
#pragma unroll
                for (int j = 0; j < 12; ++j) a[j] = wave_sum(a[j]);
                if (lane == 0) {
#pragma unroll
                    for (int j = 0; j < 12; ++j) mod[b * 3072 + 12 * cb + j] = a[j] + ba[12 * cb + j];
                }
            }
    }
    {
        float* scr = (float*)(lds + wave * 16384);
        const int NGW = G * 8, gw = NGW - 1 - (vcu * 8 + wave);
        constexpr int I_IN = 96 * 16, I_O = 32 * 16, I_GL = 16 * 8, I_W1 = 8 * 32, I_W2 = 2 * 4;
        constexpr int NIT = I_IN + I_O + I_GL + 2 * I_W1 + 2 * I_W2;
        for (int it = gw; it < NIT; it += NGW) {
            int r = it;
            if (r < I_IN) {
                const int ci = r / 16, kb = r % 16, n0 = 32 * ci, pn = n0 >> 8, bj = (n0 >> 7) & 1, wc = (n0 >> 5) & 3, L0 = 256 * pn + 64 * wc + 32 * bj;
                int oc, nv; if (L0 < 1792) { oc = L0; nv = 32; } else if (L0 < 2816) { oc = L0 + 24; nv = 32; } else if (L0 == 2816) { oc = 1792; nv = 24; } else { oc = 0; nv = 0; }
                tr_item(p.in[I_WIN], INW, 1024, 64 * kb, oc, nv, (bf16_t*)(ws + WS_WIN), n0, scr, lane); continue; }
            r -= I_IN;
            if (r < I_O) { tr_item(p.in[I_WOUT], 1024, 1024, 64 * (r % 16), 32 * (r / 16), 32, (bf16_t*)(ws + WS_WO), 32 * (r / 16), scr, lane); continue; }
            r -= I_O;
            if (r < I_GL) { tr_item(p.in[I_GLUW], 512, 512, 64 * (r % 8), 32 * (r / 8), 32, (bf16_t*)(ws + WS_WGLU), 32 * (r / 8), scr, lane); continue; }
            r -= I_GL;
            if (r < I_W1) { tr_item(p.in[I_W1K], 256, 2048, 64 * (r % 32), 32 * (r / 32), 32, (bf16_t*)(ws + WS_W1K), 32 * (r / 32), scr, lane, true); continue; }
            r -= I_W1;
            if (r < I_W1) { tr_item(p.in[I_W1V], 256, 2048, 64 * (r % 32), 32 * (r / 32), 32, (bf16_t*)(ws + WS_W1V), 32 * (r / 32), scr, lane, true); continue; }
            r -= I_W1;
            if (r < I_W2) { tr_item(p.in[I_W2K], 64, 256, 64 * (r % 4), 32 * (r / 4), 32, (bf16_t*)(ws + WS_W2K), 32 * (r / 4), scr, lane); continue; }
            r -= I_W2;
            tr_item(p.in[I_W2V], 64, 256, 64 * (r % 4), 32 * (r / 4), 32, (bf16_t*)(ws + WS_W2V), 32 * (r / 4), scr, lane);
        }
    }
    {
        const float H1[32] = {2.037182617e+01f, 1.527673340e+01f, 1.145593262e+01f, 8.590698242e+00f, 6.442138672e+00f, 4.830932617e+00f, 3.622680664e+00f, 2.716613770e+00f, 2.037170410e+00f, 1.527679443e+00f, 1.145599365e+00f, 8.590698242e-01f, 6.442108154e-01f, 4.830932617e-01f, 3.622665405e-01f, 2.716636658e-01f, 2.037181854e-01f, 1.527671814e-01f, 1.145591736e-01f, 8.590698242e-02f, 6.442165375e-02f, 4.830932617e-02f, 3.622674942e-02f, 2.716636658e-02f, 2.037191391e-02f, 1.527667046e-02f, 1.145589352e-02f, 8.590698242e-03f, 6.442129612e-03f, 4.830896854e-03f, 3.622680902e-03f, 2.716630697e-03f};
        const float L1[32] = {6.543887594e-06f, -1.416575378e-05f, -9.063650396e-06f, 3.259562436e-05f, 4.341966076e-07f, -9.333384696e-06f, 3.694024997e-07f, 1.383195467e-05f, 1.289177635e-05f, -7.611160072e-06f, -7.100949915e-06f, 3.214027856e-06f, 3.140712124e-06f, -1.001640385e-06f, 1.570408244e-06f, -8.980337611e-07f, 1.371793559e-07f, 1.700163388e-08f, 6.043357104e-08f, 3.195055172e-07f, -2.581333831e-07f, -9.542085166e-08f, 6.167339706e-08f, -9.075201035e-08f, -8.022654185e-08f, 4.843524337e-08f, 2.941089683e-08f, 3.325492770e-08f, 9.949448376e-09f, 2.627999152e-08f, 1.475850692e-10f, -2.996157100e-09f};
        const float H2[32] = {1.591548920e-01f, 1.193494797e-01f, 8.949947357e-02f, 6.711483002e-02f, 5.032920837e-02f, 3.774166107e-02f, 2.830219269e-02f, 2.122354507e-02f, 1.591539383e-02f, 1.193499565e-02f, 8.949995041e-03f, 6.711483002e-03f, 5.032896996e-03f, 3.774166107e-03f, 2.830207348e-03f, 2.122372389e-03f, 1.591548324e-03f, 1.193493605e-03f, 8.949935436e-04f, 6.711483002e-04f, 5.032941699e-04f, 3.774166107e-04f, 2.830214798e-04f, 2.122372389e-04f, 1.591555774e-04f, 1.193489879e-04f, 8.949916810e-05f, 6.711483002e-05f, 5.032913759e-05f, 3.774138168e-05f, 2.830219455e-05f, 2.122367732e-05f};
        const float L2[32] = {5.112412182e-08f, -1.106699514e-07f, -7.080976872e-08f, 2.546533153e-07f, 3.392160997e-09f, -7.291706794e-08f, 2.885957029e-09f, 1.080621459e-07f, 1.007170027e-07f, -5.946218806e-08f, -5.547617121e-08f, 2.510959263e-08f, 2.453681347e-08f, -7.825315507e-09f, 1.226881441e-08f, -7.015888759e-09f, 1.071713718e-09f, 1.328252647e-10f, 4.721372737e-10f, 2.496136853e-09f, -2.016667056e-09f, -7.454754036e-10f, 4.818234145e-10f, -7.090000809e-10f, -6.267698582e-10f, 3.784003388e-10f, 2.297726315e-10f, 2.598041227e-10f, 7.773006544e-11f, 2.053124337e-10f, 1.153008353e-12f, -2.340747735e-11f};
        float* rc = (float*)(ws + WS_ROPE); float* rs = rc + (size_t)T_ * 32;
        for (int i = vcu * 512 + tid; i < T_ * 32; i += G * 512) {
            const int t = i >> 5, d = i & 31; const float th = (float)(t >> 7), tl = (float)(t & 127);
            const float a = th * H1[d], c = tl * H2[d];
            float rev = (a - floorf(a)) + (c - floorf(c)) + (th * L1[d] + tl * L2[d]);
            rev -= floorf(rev);
#ifdef CPU_EMU
            rc[i] = cosf(6.283185307179586f * rev); rs[i] = sinf(6.283185307179586f * rev);
#else
            rc[i] = __builtin_amdgcn_cosf(rev); rs[i] = __builtin_amdgcn_sinf(rev);
#endif
        }
    }
    __syncthreads();
    {
        f32x2* lp = (f32x2*)lds;
        f32x2* bb = lp + 5 * 64;
        f32x2* cc = bb + 1024;
        f32x2* ee = cc + 1024;
        for (int it = vcu; it < 32 * 13 + 32; it += G) {
            if (it >= 32 * 13) {
                const int r = it - 32 * 13, kv = r >> 4, ks = r & 15; const float* pos = p.in[kv ? I_POSV : I_POSK]; const float* w1 = p.in[kv ? I_W1V : I_W1K];
                const int j = tid & 255, i0 = 128 * ks + 64 * (tid >> 8); float a = 0.f;
#pragma unroll 32
                for (int i = i0; i < i0 + 64; ++i) a += pos[i] * w1[(size_t)i * 256 + j];
                atomicAdd((unsigned*)(ws + WS_CPOS) + kv * 256 + j, (unsigned)(int)__builtin_rintf(a * 16777216.0f));
                continue;
            }
            const int g = it / 13, nb = it % 13;
            const float dt = expf(p.in[I_LOGDT][g]);
            for (int e = tid; e < 1024; e += 512) {
                const int pp = e >> 4, ci = e & 15;
                const float ar = p.in[I_ARE][g * 64 + pp], ai = p.in[I_AIM][g * 64 + pp], x = ar * dt, y = ai * dt;
                const float em1 = expm1f(x), ex = em1 + 1.0f, cy = cosf(y), sy = sinf(y), sh = sinf(0.5f * y);
                const float lr = em1 * cy - 2.0f * sh * sh, li = ex * sy;
                const float den = ar * ar + ai * ai, fr_ = (lr * ar + li * ai) / den, fi_ = (li * ar - lr * ai) / den;
                const float br = p.in[I_BRE][(g * 64 + pp) * 16 + ci], bi = p.in[I_BIM][(g * 64 + pp) * 16 + ci];
                bb[e] = (f32x2){fr_ * br - fi_ * bi, fr_ * bi + fi_ * br};
                const int co = e >> 6, p2 = e & 63;
                cc[e] = (f32x2){p.in[I_CRE][(g * 16 + co) * 64 + p2], p.in[I_CIM][(g * 16 + co) * 64 + p2]};
            }
            if (tid < 5 * 64) {
                const int q = tid >> 6, pp = tid & 63, n = 5 * nb + q;
                const float ar = p.in[I_ARE][g * 64 + pp], ai = p.in[I_AIM][g * 64 + pp];
                const float mag = expf(ar * dt * (float)n), ang = ai * dt * (float)n;
                lp[tid] = (f32x2){mag * cosf(ang), mag * sinf(ang)};
            }
            __syncthreads();
            for (int idx = tid; idx < 5 * 1024; idx += 512) { const int q = idx >> 10, e = idx & 1023; const f32x2 l = lp[q * 64 + (e >> 4)], b = bb[e]; ee[idx] = (f32x2){l.x * b.x - l.y * b.y, l.x * b.y + l.y * b.x}; }
            __syncthreads();
            {
                bf16_t* KT = (bf16_t*)(ws + WS_KT) + (size_t)g * 65 * 256;
                for (int task = tid; task < 5 * 256; task += 512) {
                    const int q = task >> 8, t256 = task & 255, n = 5 * nb + q;
                    if (n < 64) {
                        const int co = t256 >> 4, ci = t256 & 15; float a = 0.f;
                        for (int pp = 0; pp < 64; ++pp) { const f32x2 c = cc[co * 64 + pp], e = ee[q * 1024 + pp * 16 + ci]; a += c.x * e.x - c.y * e.y; }
                        KT[(n + 1) * 256 + t256] = (bf16_t)f2bf(a);
                        if (n == 0) KT[t256] = 0;
                    }
                }
                bf16_t* WST = (bf16_t*)(ws + WS_WST) + (size_t)g * 128 * 1024; bf16_t* WO = (bf16_t*)(ws + WS_WOUTS) + (size_t)g * 1024 * 128;
                for (int idx = tid; idx < 5 * 1024; idx += 512) {
                    const int q = idx >> 10, e = idx & 1023, n = 5 * nb + q;
                    if (n < 64) { const int sidx = 63 - n, pp = e >> 4, ci = e & 15; const f32x2 v = ee[idx];
                        WST[frag_idx(pp, sidx * 16 + ci, 1024)] = (bf16_t)f2bf(v.x); WST[frag_idx(64 + pp, sidx * 16 + ci, 1024)] = (bf16_t)f2bf(v.y); }
                    if (n >= 1) { const int t = n - 1, co = e >> 6, pp = e & 63; const f32x2 c = cc[e], l = lp[q * 64 + pp];
                        WO[frag_idx(t * 16 + co, pp, 128)] = (bf16_t)f2bf(c.x * l.x - c.y * l.y); WO[frag_idx(t * 16 + co, 64 + pp, 128)] = (bf16_t)f2bf(-(c.x * l.y + c.y * l.x)); }
                }
                if (nb == 12 && tid < 64) ((f32x2*)(ws + WS_LAM64))[g * 64 + tid] = lp[4 * 64 + tid];
            }
            __syncthreads();
        }
    }
}

DEV void p1_norm(const Params& p, int vcu, int G, int wave, int lane) {
    const float* x = p.in[I_X]; const float* ng = p.in[I_NORMG]; const float* mod = (const float*)(p.ws + WS_MOD); bf16_t* HN = (bf16_t*)(p.ws + WS_HN);
    const int gw = vcu * 8 + wave, NGW = G * 8;
    constexpr int RB = 32;
    for (int it = gw; it < M_ / RB; it += NGW) {
        const int r0 = it * RB, b = r0 / T_;
        f32x4 cs[4], sh[4];
#pragma unroll
        for (int j = 0; j < 4; ++j) { const int k = 4 * lane + 256 * j; const f32x4 g = *(const f32x4*)(ng + k), sc = *(const f32x4*)(mod + (size_t)b * 3072 + 1024 + k);
            cs[j] = g * (sc + 1.0f); sh[j] = *(const f32x4*)(mod + (size_t)b * 3072 + k); }
        for (int r = r0; r < r0 + RB; ++r) {
            const f32x4* xr = (const f32x4*)(x + (size_t)r * 1024) + lane; f32x4 v[4]; float s = 0.f;
#pragma unroll
            for (int j = 0; j < 4; ++j) { v[j] = xr[64 * j]; s += (v[j].x * v[j].x + v[j].y * v[j].y) + (v[j].z * v[j].z + v[j].w * v[j].w); }
            const float rinv = rsqrtf(wave_sum(s) * (1.0f / 1024.0f) + EPS_);
            u32x2* o = (u32x2*)(HN + (size_t)r * 1024) + lane;
#pragma unroll
            for (int j = 0; j < 4; ++j) { const f32x4 h = v[j] * rinv * cs[j] + sh[j]; o[64 * j] = (u32x2){pk2(h.x, h.y), pk2(h.z, h.w)}; }
        }
#ifndef CPU_EMU
        asm volatile("s_waitcnt vmcnt(0)" ::: "memory");
#else
        emu_wave_sync();
#endif
        gates_rows(p.ws, (size_t)r0, lane);
    }
}

constexpr int UL_CH = 2064;
constexpr int SSM_UL = 0, SSM_KT = 32 * UL_CH, SSM_SLOC = SSM_KT + 65 * 256 * 2, SSM_CBT = SSM_SLOC + 128 * 32 * 4, SSM_END = SSM_CBT + 32 * 272;
static_assert(SSM_END <= RING_BYTES, "ssm lds");
DEV void ssm_unit(const Params& p, unsigned char* lds, int unit, int tid, int wave, int lane) {
    const int b = unit / SSM_NG, g = unit % SSM_NG; const int l16 = lane & 15, q4 = lane >> 4;
    unsigned char* ws = p.ws;
    const bf16_t* U = (const bf16_t*)(ws + WS_U); bf16_t* YG = (bf16_t*)(ws + WS_YG);
    const bf16_t* WST = (const bf16_t*)(ws + WS_WST) + (size_t)g * 128 * 1024; const bf16_t* WO = (const bf16_t*)(ws + WS_WOUTS) + (size_t)g * 1024 * 128;
    unsigned char* ul = lds + SSM_UL; bf16_t* ktl = (bf16_t*)(lds + SSM_KT); float* sloc = (float*)(lds + SSM_SLOC); bf16_t* cbt = (bf16_t*)(lds + SSM_CBT);
    { const u32x4* src = (const u32x4*)((const bf16_t*)(ws + WS_KT) + (size_t)g * 65 * 256); u32x4* dstv = (u32x4*)ktl; for (int i = tid; i < 65 * 256 * 2 / 16; i += 512) dstv[i] = src[i]; }
    float sre = 0.f, sim = 0.f; f32x2 lam = {0.f, 0.f};
    if (wave == 0) lam = ((const f32x2*)(ws + WS_LAM64))[g * 64 + lane];
    f32x4 dsk = *(const f32x4*)(p.in[I_SSMD] + 16 * g + 4 * q4);
    for (int cg = 0; cg < SSM_NCG; ++cg) {
        const size_t tokbase = (size_t)b * T_ + (size_t)cg * 2048;
#pragma unroll
        for (int i = 0; i < 8; ++i) { const int idx = tid + 512 * i, tok = idx >> 1, hf = idx & 1;
            *(u32x4*)(ul + (tok >> 6) * UL_CH + (tok & 63) * 32 + hf * 16) = *(const u32x4*)(U + (tokbase + tok) * 512 + 16 * g + 8 * hf); }
        __syncthreads();
        {
            f32x4 a1[2] = {(f32x4){0.f, 0.f, 0.f, 0.f}, (f32x4){0.f, 0.f, 0.f, 0.f}};
            const bf16_t* ap = WST + ((size_t)wave * 32 * 64 + lane) * 8;
            const unsigned char* bp = ul + l16 * UL_CH + (q4 >> 1) * 32 + (q4 & 1) * 16;
            bf16x8 aa[2][4];
#pragma unroll
            for (int q = 0; q < 4; ++q) aa[0][q] = ld8(ap + 512 * q);
#pragma unroll
            for (int kb = 0; kb < 8; ++kb) {
                if (kb < 7) {
#pragma unroll
                    for (int q = 0; q < 4; ++q) aa[(kb + 1) & 1][q] = ld8(ap + 512 * (4 * kb + 4 + q));
                }
                SCHED_FENCE();
#pragma unroll
                for (int q = 0; q < 4; ++q) { const int ks = 4 * kb + q;
                    const bf16x8 b0 = *(const bf16x8*)(bp + ks * 64), b1 = *(const bf16x8*)(bp + 16 * UL_CH + ks * 64);
                    a1[0] = mfma16(aa[kb & 1][q], b0, a1[0]); a1[1] = mfma16(aa[kb & 1][q], b1, a1[1]); }
                SCHED_FENCE();
            }
#pragma unroll
            for (int ct = 0; ct < 2; ++ct)
#pragma unroll
                for (int r = 0; r < 4; ++r) sloc[(16 * wave + 4 * q4 + r) * 32 + 16 * ct + l16] = a1[ct][r];
        }
        __syncthreads();
        if (wave == 0) {
            f32x4 lr4[8], li4[8];
#pragma unroll
            for (int q = 0; q < 8; ++q) { lr4[q] = *(const f32x4*)(sloc + lane * 32 + 4 * q); li4[q] = *(const f32x4*)(sloc + (64 + lane) * 32 + 4 * q); }
#pragma unroll
            for (int c = 0; c < 32; ++c) {
                cbt[c * 136 + lane] = (bf16_t)f2bf(sre); cbt[c * 136 + 64 + lane] = (bf16_t)f2bf(sim);
                const float lr = lr4[c >> 2][c & 3], li = li4[c >> 2][c & 3];
                const float nr = lam.x * sre - lam.y * sim + lr, ni = lam.x * sim + lam.y * sre + li; sre = nr; sim = ni;
            }
        }
        __syncthreads();
#pragma unroll 1
        for (int pi = 0; pi < 4; ++pi) {
            const int t1 = wave + 16 * pi, t2 = t1 + 8;
            f32x4 a3[2][2];
#pragma unroll
            for (int q = 0; q < 2; ++q) { a3[q][0] = (f32x4){0.f, 0.f, 0.f, 0.f}; a3[q][1] = a3[q][0]; }
            const unsigned char* bp = ul + l16 * UL_CH + (q4 >> 1) * 32 + (q4 & 1) * 16;
            const bf16_t* kp1 = ktl + (t1 - (q4 >> 1) + 1) * 256 + l16 * 16 + 8 * (q4 & 1); const bf16_t* kp2 = kp1 + 8 * 256;
            const int nks1 = (t1 >> 1) + 1;
            bf16x8 wa[2][4];
#pragma unroll
            for (int ks = 0; ks < 4; ++ks) wa[0][ks] = ld8(WO + ((size_t)t1 * 4 * 64 + lane) * 8 + 512 * ks);
            for (int ks = 0; ks < nks1; ++ks) {
                const bf16x8 x1 = ld8(kp1 - ks * 512), x2 = ld8(kp2 - ks * 512), b0 = *(const bf16x8*)(bp + ks * 64), b1 = *(const bf16x8*)(bp + 16 * UL_CH + ks * 64);
                a3[0][0] = mfma16(x1, b0, a3[0][0]); a3[0][1] = mfma16(x1, b1, a3[0][1]); a3[1][0] = mfma16(x2, b0, a3[1][0]); a3[1][1] = mfma16(x2, b1, a3[1][1]);
            }
#pragma unroll
            for (int ks = 0; ks < 4; ++ks) wa[1][ks] = ld8(WO + ((size_t)t2 * 4 * 64 + lane) * 8 + 512 * ks);
#pragma unroll
            for (int k4 = 0; k4 < 4; ++k4) { const int ks = nks1 + k4;
                const bf16x8 x2 = ld8(kp2 - ks * 512), b0 = *(const bf16x8*)(bp + ks * 64), b1 = *(const bf16x8*)(bp + 16 * UL_CH + ks * 64);
                a3[1][0] = mfma16(x2, b0, a3[1][0]); a3[1][1] = mfma16(x2, b1, a3[1][1]); }
#pragma unroll
            for (int ks = 0; ks < 4; ++ks) {
                const bf16x8 b0 = ld8(cbt + l16 * 136 + 32 * ks + 8 * q4), b1 = ld8(cbt + (16 + l16) * 136 + 32 * ks + 8 * q4);
                a3[0][0] = mfma16(wa[0][ks], b0, a3[0][0]); a3[0][1] = mfma16(wa[0][ks], b1, a3[0][1]); a3[1][0] = mfma16(wa[1][ks], b0, a3[1][0]); a3[1][1] = mfma16(wa[1][ks], b1, a3[1][1]);
            }
#pragma unroll
            for (int q = 0; q < 2; ++q) { const int t = q ? t2 : t1;
#pragma unroll
                for (int ct = 0; ct < 2; ++ct) {
                    const int chunk = 16 * ct + l16; const size_t tok = tokbase + (size_t)chunk * 64 + t;
                    const u32x2 uv = *(const u32x2*)(ul + chunk * UL_CH + t * 32 + 8 * q4);
                    float y[4];
#pragma unroll
                    for (int r = 0; r < 4; ++r) { const unsigned w = uv[r >> 1]; const float uu = bf2f((r & 1) ? (w >> 16) : (w & 0xffffu)); y[r] = gelu_tanh_f(a3[q][ct][r] + dsk[r] * uu); }
                    *(u32x2*)(YG + tok * 512 + 16 * g + 4 * q4) = (u32x2){pk2(y[0], y[1]), pk2(y[2], y[3])};
                }
            }
        }
        __syncthreads();
    }
}

constexpr int CMP_NTOK = 16 * 63 + 32, CMP_TOK = 0, CMP_H = 0, CMP_OUT = 64 * 264 * 2, CMP_END = CMP_NTOK * 128;
static_assert(CMP_END <= MISC_OFF && CMP_OUT + 64 * 64 * 4 <= CMP_END, "cmp lds");
constexpr int CMP_UNITS = 2 * B_ * NGRP * (NCP / 64);
DEV void compress_unit(const Params& p, unsigned char* lds, int unit, int tid, int wave, int lane) {
    int r = unit; const int nb = r % (NCP / 64); r /= (NCP / 64); const int g = r % NGRP; r /= NGRP; const int b = r % B_; const int kv = r / B_;
    const int l16 = lane & 15, q4 = lane >> 4; unsigned char* ws = p.ws;
    const bf16_t* CR = (const bf16_t*)(ws + WS_CR); const bf16_t* w1t = (const bf16_t*)(ws + (kv ? WS_W1V : WS_W1K)); const bf16_t* w2t = (const bf16_t*)(ws + (kv ? WS_W2V : WS_W2K));
    const float* cpos = (const float*)(ws + WS_CPOS) + kv * 256;
    unsigned char* tokl = lds + CMP_TOK; bf16_t* hl = (bf16_t*)(lds + CMP_H); float* outl = (float*)(lds + CMP_OUT);
    const int n0 = 64 * nb, tk0 = 16 * n0;
    const bf16_t* bp0 = w1t + ((size_t)(2 * wave) * 64 * 64 + lane) * 8; const bf16_t* bp1 = bp0 + (size_t)64 * 64 * 8;
    for (int idx = tid; idx < CMP_NTOK * 8; idx += 512) {
        const int tl = idx >> 3, ch = idx & 7; const int tok = tk0 + tl;
        u32x4 v = (u32x4){0u, 0u, 0u, 0u};
        if (tok < T_) v = *(const u32x4*)(CR + ((size_t)b * T_ + tok) * 256 + kv * 128 + g * 64 + 8 * ch);
        *(u32x4*)(tokl + (tl * 8 + (ch ^ ((tl >> 4) & 7))) * 16) = v;
    }
    __syncthreads();
    f32x4 acc[4][2];
#pragma unroll
    for (int a = 0; a < 4; ++a)
#pragma unroll
        for (int c = 0; c < 2; ++c) acc[a][c] = (f32x4){0.f, 0.f, 0.f, 0.f};
    bf16x8 bb[2][4][2];
#pragma unroll
    for (int q = 0; q < 4; ++q) { bb[0][q][0] = ld8(bp0 + 512 * q); bb[0][q][1] = ld8(bp1 + 512 * q); }
#pragma unroll
    for (int kb = 0; kb < 16; ++kb) {
        if (kb < 15) {
#pragma unroll
            for (int q = 0; q < 4; ++q) { bb[(kb + 1) & 1][q][0] = ld8(bp0 + 512 * (4 * kb + 4 + q)); bb[(kb + 1) & 1][q][1] = ld8(bp1 + 512 * (4 * kb + 4 + q)); }
        }
        SCHED_FENCE();
#pragma unroll
        for (int q = 0; q < 4; ++q) { const int ks = 4 * kb + q;
            const int l = ks >> 1, chunk = 4 * (ks & 1) + q4;
            const bf16x8 b0 = bb[kb & 1][q][0], b1 = bb[kb & 1][q][1];
#pragma unroll
            for (int rt = 0; rt < 4; ++rt) { const int tl = 16 * (16 * rt + l16) + l;
                const bf16x8 a = *(const bf16x8*)(tokl + (tl * 8 + (chunk ^ ((tl >> 4) & 7))) * 16);
                acc[rt][0] = mfma16(a, b0, acc[rt][0]); acc[rt][1] = mfma16(a, b1, acc[rt][1]); } }
        SCHED_FENCE();
    }
    __syncthreads();
#pragma unroll
    for (int rt = 0; rt < 4; ++rt)
#pragma unroll
        for (int ct = 0; ct < 2; ++ct) { const int j = 32 * wave + 16 * ct + l16; const float cp = (float)((const int*)cpos)[j] * (1.0f / 16777216.0f);
#pragma unroll
            for (int rr = 0; rr < 4; ++rr) hl[(16 * rt + 4 * q4 + rr) * 264 + j] = (bf16_t)f2bf(gelu_tanh_f(acc[rt][ct][rr] + cp)); }
    __syncthreads();
    {
        const int rt = wave >> 1; f32x4 a2[2] = {(f32x4){0.f, 0.f, 0.f, 0.f}, (f32x4){0.f, 0.f, 0.f, 0.f}};
#pragma unroll
        for (int ks = 0; ks < 8; ++ks) { const bf16x8 a = ld8(hl + (16 * rt + l16) * 264 + 32 * ks + 8 * q4);
#pragma unroll
            for (int c2 = 0; c2 < 2; ++c2) { const int ct = 2 * (wave & 1) + c2; const bf16x8 bq = ld8(w2t + (size_t)(16 * ct + l16) * 256 + 32 * ks + 8 * q4); a2[c2] = mfma16(a, bq, a2[c2]); } }
#pragma unroll
        for (int c2 = 0; c2 < 2; ++c2) { const int ct = 2 * (wave & 1) + c2;
#pragma unroll
            for (int rr = 0; rr < 4; ++rr) outl[(16 * rt + 4 * q4 + rr) * 64 + 16 * ct + l16] = a2[c2][rr]; }
    }
    __syncthreads();
    {
        const int row = tid >> 3, c8 = tid & 7; f32x4 v0 = *(const f32x4*)(outl + row * 64 + 8 * c8), v1 = *(const f32x4*)(outl + row * 64 + 8 * c8 + 4);
        if (kv == 0) {
            float ss = (v0.x * v0.x + v0.y * v0.y + v0.z * v0.z + v0.w * v0.w) + (v1.x * v1.x + v1.y * v1.y + v1.z * v1.z + v1.w * v1.w);
            ss += __shfl_xor(ss, 1); ss += __shfl_xor(ss, 2); ss += __shfl_xor(ss, 4);
            const float rinv = rsqrtf(ss * (1.0f / 64.0f) + EPS_); const f32x4 g0 = *(const f32x4*)(p.in[I_KCNG] + 8 * c8), g1 = *(const f32x4*)(p.in[I_KCNG] + 8 * c8 + 4);
            v0 = v0 * rinv * g0; v1 = v1 * rinv * g1;
        }
        const int n = n0 + row; if (n >= NCMP) { v0 = (f32x4){0.f, 0.f, 0.f, 0.f}; v1 = v0; }
        bf16_t* dst = (bf16_t*)(ws + (kv ? WS_VC : WS_KC)) + (((size_t)b * NCP + n) * NGRP + g) * 64 + 8 * c8;
        *(u32x4*)dst = (u32x4){pk2(v0.x, v0.y), pk2(v0.z, v0.w), pk2(v1.x, v1.y), pk2(v1.z, v1.w)};
    }
    __syncthreads();
}

constexpr int VT_UNITS = B_ * NGRP * (T_ / 64);
struct VtPre { u32x4 v, k; };
DEV void vt_fetch(const Params& p, int unit, int tid, VtPre& r) {
    const int tb = unit % (T_ / 64), bg = unit / (T_ / 64), b = bg / NGRP, g = bg % NGRP;
    const bf16_t* SLk = (const bf16_t*)(p.ws + WS_SL) + ((size_t)b * T_ + 64 * tb) * 256 + g * 64; const bf16_t* SLv = SLk + 128;
    { const int tok = tid >> 3, ch = tid & 7; r.v = *(const u32x4*)(SLv + (size_t)tok * 256 + 8 * ch); }
    {
      const int kt = tid >> 8, ks = (tid >> 6) & 3, h = (tid >> 5) & 1, r32 = tid & 31, kr = (r32 & ~12) | ((r32 & 8) >> 1) | ((r32 & 4) << 1);
      r.k = *(const u32x4*)(SLk + (size_t)(32 * kt + kr) * 256 + 16 * ks + 8 * h); }
}
DEV void vt_unit(const Params& p, unsigned char* lds, int unit, int tid, const VtPre& r) {
    const int tb = unit % (T_ / 64), bg = unit / (T_ / 64);
    bf16_t* VF = (bf16_t*)(p.ws + WS_VT) + ((size_t)bg * (T_ / 64) + tb) * 4096; bf16_t* KF = (bf16_t*)(p.ws + WS_KF) + ((size_t)bg * (T_ / 64) + tb) * 4096;
    bf16_t* tile = (bf16_t*)lds;
    { const int tok = tid >> 3, ch = tid & 7; *(u32x4*)(tile + tok * 72 + 8 * ch) = r.v; }
    *(u32x4*)(KF + tid * 8) = r.k;
    __syncthreads();
    { const int dim = tid >> 3, c8 = tid & 7; unsigned short e[8];
#pragma unroll
      for (int i = 0; i < 8; ++i) e[i] = tile[(8 * c8 + i) * 72 + dim];
      *(u32x4*)(VF + (((dim >> 5) * 4 + (c8 >> 1)) * 64 + 32 * (c8 & 1) + (dim & 31)) * 8) = (u32x4){(unsigned)e[0] | ((unsigned)e[1] << 16), (unsigned)e[2] | ((unsigned)e[3] << 16), (unsigned)e[4] | ((unsigned)e[5] << 16), (unsigned)e[6] | ((unsigned)e[7] << 16)}; }
    __syncthreads();
}

constexpr int AT_KB = 0, AT_VOFF = 128 * 160, AT_STAGE = 2 * AT_VOFF, AT_IA = 2 * AT_STAGE, AT_IB = AT_IA + 64 * 128 * 4, AT_SEL = AT_IB + 64 * 128 * 4, AT_TM = AT_SEL + 64 * 16, AT_END = AT_TM + 128 * 8;
constexpr int EN_QL = 0, EN_OL = 40960, EN_LL = EN_OL + 256 * 65 * 4, EN_END = EN_LL + 1024;
static_assert(EN_END + 16 * 512 * 4 <= AT_SEL && 256 * 72 * 2 <= EN_OL, "engine lds");
static_assert(AT_END <= MISC_OFF, "attn lds");
constexpr int AT_UNITS = B_ * NGRP * NSB;

#ifdef CPU_EMU
DEV int row16_sum(int v) { v += __shfl_xor(v, 8); v += __shfl_xor(v, 4); v += __shfl_xor(v, 2); v += __shfl_xor(v, 1); return v; }
DEV int row16_shr(int v, int n) { const int l = threadIdx.x & 63; const int r = __shfl(v, (l & 15) >= n ? l - n : l); return (l & 15) >= n ? r : 0; }
DEV float quad_sum(float v) { v += __shfl_xor(v, 1); v += __shfl_xor(v, 2); return v; }
DEV u32x2 lds_tr16(const bf16_t* p) {
    const int w = threadIdx.x >> 6, l = threadIdx.x & 63; const unsigned long long a = (unsigned long long)(uintptr_t)p;
    emu_xbuf[w][l][0] = (unsigned)a; emu_xbuf[w][l][1] = (unsigned)(a >> 32); emu_wave_sync();
    const int g = l >> 4, i = l & 15; unsigned short e[4];
    for (int q = 0; q < 4; ++q) { const int src = 16 * g + 4 * q + (i >> 2); const unsigned long long sa = (unsigned long long)emu_xbuf[w][src][0] | ((unsigned long long)emu_xbuf[w][src][1] << 32); e[q] = ((const unsigned short*)(uintptr_t)sa)[i & 3]; }
    emu_wave_sync();
    return (u32x2){(unsigned)e[0] | ((unsigned)e[1] << 16), (unsigned)e[2] | ((unsigned)e[3] << 16)};
}
#else
DEV int row16_sum(int v) {
    v += __builtin_amdgcn_update_dpp(0, v, 0x128, 0xF, 0xF, false); v += __builtin_amdgcn_update_dpp(0, v, 0x124, 0xF, 0xF, false);
    v += __builtin_amdgcn_update_dpp(0, v, 0x122, 0xF, 0xF, false); v += __builtin_amdgcn_update_dpp(0, v, 0x121, 0xF, 0xF, false); return v;
}
#define row16_shr(v, n) __builtin_amdgcn_update_dpp(0, (v), 0x110 + (n), 0xF, 0xF, true)
DEV float quad_sum(float v) {
    v += __builtin_bit_cast(float, __builtin_amdgcn_mov_dpp(__builtin_bit_cast(int, v), 0xB1, 0xF, 0xF, true));
    v += __builtin_bit_cast(float, __builtin_amdgcn_mov_dpp(__builtin_bit_cast(int, v), 0x4E, 0xF, 0xF, true));
    return v;
}
typedef short v4i16_t __attribute__((ext_vector_type(4)));
DEV u32x2 lds_tr16(const bf16_t* p) { return __builtin_bit_cast(u32x2, __builtin_amdgcn_ds_read_tr16_b64_v4i16((__attribute__((address_space(3))) v4i16_t*)p)); }
#endif

#ifdef PROBE_TIMING
#define TSTAMP(v) do { __builtin_amdgcn_sched_barrier(0); v = __builtin_amdgcn_s_memtime(); __builtin_amdgcn_s_waitcnt(0xC07F); __builtin_amdgcn_sched_barrier(0); } while (0)
#else
#define TSTAMP(v) do { } while (0)
#endif
#ifndef PROBE_MODE
#define PROBE_MODE -1
#endif
constexpr int ATS = 80;
template <int MODE>
DEV void attn_tile(const bf16_t* kb, const bf16_t* vb, int jt, const bf16x8 (&qf)[4], f32x16 (&oacc)[2], float& lsum, float& icarry, const f32x16& negm, int ttok,
                   unsigned long long slo, unsigned long long shi, int t0, int qb, float* impA, float* impB, int wave, int lane) {
    const float NINF = -INFINITY;
    const int c32 = lane & 31, h = lane >> 5, hg = lane & 3, tau = c32 >> 2;
    bool nm;
    if (MODE <= 1) nm = (16 * (64 * jt + 63) + 31 > t0);
    else if (MODE == 2) nm = (jt == qb);
    else nm = (jt == qb) || (jt + 8 == qb);
    f32x16 s[2];
    if (nm) {
        const float nm0 = negm[0];
        if (MODE == 3 && jt != qb) {
            const int d2 = ttok - 512 - 64 * jt - 4 * h;
#pragma unroll
            for (int kt = 0; kt < 2; ++kt) {
                f32x16 cm;
#pragma unroll
                for (int i = 0; i < 16; ++i) cm[i] = (32 * kt + (i & 3) + 8 * (i >> 2) > d2) ? nm0 : NINF;
                s[kt] = mfma32(ld8(kb + (32 * kt + c32) * ATS + 8 * h), qf[0], cm);
            }
        } else {
            const int d = ((MODE <= 1) ? ((ttok - 31) >> 4) : ttok) - 64 * jt - 4 * h;
#pragma unroll
            for (int kt = 0; kt < 2; ++kt) {
                f32x16 cm;
#pragma unroll
                for (int i = 0; i < 16; ++i) cm[i] = (32 * kt + (i & 3) + 8 * (i >> 2) <= d) ? nm0 : NINF;
                s[kt] = mfma32(ld8(kb + (32 * kt + c32) * ATS + 8 * h), qf[0], cm);
            }
        }
    } else {
#pragma unroll
        for (int kt = 0; kt < 2; ++kt) s[kt] = mfma32(ld8(kb + (32 * kt + c32) * ATS + 8 * h), qf[0], negm);
    }
#pragma unroll
    for (int kt = 0; kt < 2; ++kt)
#pragma unroll
        for (int ks = 1; ks < 4; ++ks) { const bf16x8 a = ld8(kb + (32 * kt + c32) * ATS + 16 * ks + 8 * h); s[kt] = mfma32(a, qf[ks], s[kt]); }
    float psum = 0.f;
#pragma unroll
    for (int kt = 0; kt < 2; ++kt)
#pragma unroll
        for (int i = 0; i < 16; ++i) { const float pv = exp2_fast(s[kt][i]); s[kt][i] = pv; psum += pv; }
    lsum += psum;
    if (MODE == 1) {
        unsigned short* impH = (unsigned short*)impA;
        const int tl = 8 * wave + tau, xs = 8 * (tl & 7);
#pragma unroll
        for (int kt = 0; kt < 2; ++kt) {
            float lo_from[4], up_from[4];
#ifdef CPU_EMU
#pragma unroll
            for (int gq = 0; gq < 4; ++gq) { const float sw = __shfl_xor(s[kt][4 * gq + 3], 32); lo_from[gq] = sw; up_from[gq] = sw; }
#else
#pragma unroll
            for (int pr = 0; pr < 2; ++pr) {
                const float pa_ = s[kt][4 * (2 * pr) + 3], pb_ = s[kt][4 * (2 * pr + 1) + 3];
                unsigned a0 = __builtin_bit_cast(unsigned, pa_), b0 = __builtin_bit_cast(unsigned, pb_), a1 = b0, b1 = a0;
                asm volatile("s_nop 1\n\tv_permlane32_swap_b32 %0, %1" : "+v"(a0), "+v"(b0));
                asm volatile("s_nop 1\n\tv_permlane32_swap_b32 %0, %1" : "+v"(a1), "+v"(b1));
                lo_from[2 * pr + 1] = __builtin_bit_cast(float, a0); up_from[2 * pr] = __builtin_bit_cast(float, b0);
                lo_from[2 * pr] = __builtin_bit_cast(float, a1); up_from[2 * pr + 1] = __builtin_bit_cast(float, b1);
            }
#endif
#pragma unroll
            for (int gq = 0; gq < 4; ++gq) {
                const float p3 = s[kt][4 * gq + 3];
                const float prev = h ? lo_from[gq] : (gq == 0 ? icarry : up_from[gq - 1]);
                const float M = 2.0f * (s[kt][4 * gq] + s[kt][4 * gq + 1] + s[kt][4 * gq + 2]) + p3 + prev;
                const int j = 16 * jt + 8 * kt + 2 * gq + h;
                impH[(tl * 128 + (j ^ xs)) * 4 + hg] = __builtin_bit_cast(unsigned short, (_Float16)(M * 256.0f));
            }
            icarry = up_from[3];
        }
    }
    if (MODE != 0) {
        const int l15 = lane & 15, g1 = (lane >> 4) & 1;
#pragma unroll
        for (int kt = 0; kt < 2; ++kt)
#pragma unroll
            for (int sp = 0; sp < 2; ++sp) {
                u32x4 pw = (u32x4){pk2(s[kt][8 * sp], s[kt][8 * sp + 1]), pk2(s[kt][8 * sp + 2], s[kt][8 * sp + 3]), pk2(s[kt][8 * sp + 4], s[kt][8 * sp + 5]), pk2(s[kt][8 * sp + 6], s[kt][8 * sp + 7])};
                const bf16x8 pf = __builtin_bit_cast(bf16x8, pw);
                const bf16_t* vr = vb + (32 * kt + 16 * sp + 4 * h + (l15 >> 2)) * ATS + 16 * g1 + 4 * (l15 & 3);
#pragma unroll
                for (int dt = 0; dt < 2; ++dt) {
                    const u32x2 lo = lds_tr16(vr + 32 * dt), hi = lds_tr16(vr + 8 * ATS + 32 * dt);
                    oacc[dt] = mfma32(__builtin_bit_cast(bf16x8, (u32x4){lo.x, lo.y, hi.x, hi.y}), pf, oacc[dt]);
                }
            }
    }
}

DEV void at_preload(const bf16_t* Kg, const bf16_t* Vg, int pitch, int jlo, int jhi, int tid, u32x4 (&pk)[2], u32x4 (&pv)[2]) {
    const int key = tid >> 3, ch = tid & 7;
#pragma unroll
    for (int u = 0; u < 2; ++u) { const int jt = jlo + u; pk[u] = (u32x4){0u, 0u, 0u, 0u}; pv[u] = pk[u];
        if (jt <= jhi) { pk[u] = *(const u32x4*)(Kg + (size_t)(64 * jt + key) * pitch + 8 * ch); pv[u] = *(const u32x4*)(Vg + (size_t)(64 * jt + key) * pitch + 8 * ch); } }
}

template <int MODE, bool PRE = false>
DEV void attn_pass(const bf16_t* Kg, const bf16_t* Vg, int pitch, int jlo, int jhi, unsigned char* lds, const bf16x8 (&qf)[4], f32x16 (&oacc)[2], float& lsum, float& icarry,
                   float m0l, int ttok, unsigned long long slo, unsigned long long shi, int t0, int qb, int tid, int wave, int lane_, unsigned long long& tcomp, unsigned long long& tpass,
                   const u32x4* pk = nullptr, const u32x4* pv = nullptr) {
    unsigned long long tc0_ = 0, tc1_ = 0, tp0_ = 0, tp1_ = 0; TSTAMP(tp0_);
    LAUNDER_V(tid); const int lane = tid & 63; (void)lane_;
    const int key = tid >> 3, ch = tid & 7;
    float* impA = (float*)(lds + AT_IA); float* impB = (float*)(lds + AT_IB);
    const int nsteps = (jhi - jlo + 2) >> 1;
    const u32x4 Z4 = (u32x4){0u, 0u, 0u, 0u};
    f32x16 negm;
    float nm0_ = -m0l;
    LAUNDER_V(nm0_);
#pragma unroll
    for (int i = 0; i < 16; ++i) negm[i] = nm0_;
    u32x4 rk[2][2], rv[2][2];
#define AT_LOAD(set, st) do { _Pragma("unroll") for (int u_ = 0; u_ < 2; ++u_) { const int jt_ = jlo + 2 * (st) + u_; rk[set][u_] = Z4; rv[set][u_] = Z4; \
        if (jt_ <= jhi) { rk[set][u_] = *(const u32x4*)(Kg + (size_t)(64 * jt_ + key) * pitch + 8 * ch); if (MODE != 0) rv[set][u_] = *(const u32x4*)(Vg + (size_t)(64 * jt_ + key) * pitch + 8 * ch); } } } while (0)
#define AT_WRITE(set, stage) do { _Pragma("unroll") for (int u_ = 0; u_ < 2; ++u_) { *(u32x4*)(lds + AT_KB + (stage) * AT_STAGE + ((64 * u_ + key) * ATS + 8 * ch) * 2) = rk[set][u_]; \
        if (MODE != 0) *(u32x4*)(lds + AT_KB + (stage) * AT_STAGE + AT_VOFF + ((64 * u_ + key) * ATS + 8 * ch) * 2) = rv[set][u_]; } } while (0)
    if (PRE) { rk[0][0] = pk[0]; rk[0][1] = pk[1]; rv[0][0] = pv[0]; rv[0][1] = pv[1]; } else AT_LOAD(0, 0);
    AT_WRITE(0, 0);
    if (MODE != 2 && nsteps > 1) AT_LOAD(1, 1); else { rk[1][0] = Z4; rk[1][1] = Z4; rv[1][0] = Z4; rv[1][1] = Z4; }
    __syncthreads();
#define AT_COMPUTE(st) do { const int stage_ = (st) & 1; TSTAMP(tc0_); \
        _Pragma("unroll") for (int u = 0; u < 2; ++u) { const int jt = jlo + 2 * (st) + u; if (jt > jhi) break; \
            const bf16_t* kb = (const bf16_t*)(lds + AT_KB + stage_ * AT_STAGE) + 64 * ATS * u; const bf16_t* vb = (const bf16_t*)(lds + AT_KB + stage_ * AT_STAGE + AT_VOFF) + 64 * ATS * u; \
            attn_tile<MODE>(kb, vb, jt, qf, oacc, lsum, icarry, negm, ttok, slo, shi, t0, qb, impA, impB, wave, lane); } TSTAMP(tc1_); if (MODE == PROBE_MODE) tcomp += tc1_ - tc0_; } while (0)
    for (int st = 0; st < nsteps; st += 2) {
        if (MODE != 2 && st + 2 < nsteps) AT_LOAD(0, st + 2);
        AT_COMPUTE(st);
        if (MODE != 2 && st + 1 < nsteps) AT_WRITE(1, 1);
        LDS_BARRIER();
        if (MODE == 2 || st + 1 >= nsteps) break;
        if (st + 3 < nsteps) AT_LOAD(1, st + 3);
        AT_COMPUTE(st + 1);
        if (st + 2 < nsteps) AT_WRITE(0, 0);
        LDS_BARRIER();
    }
#undef AT_LOAD
#undef AT_WRITE
#undef AT_COMPUTE
    TSTAMP(tp1_); if (MODE == PROBE_MODE) tpass += tp1_ - tp0_;
}

DEV unsigned char* en_tl(unsigned char* lds, int j) { return j <= 124 ? lds + AT_SEL + 64 * (j - 1) : lds + MISC_OFF + 160; }
static_assert(AT_SEL + 64 * 124 <= MISC_OFF, "token lists");

#ifndef SEL_KSH
#define SEL_KSH 12
#endif
DEV void attn_unit(const Params& p, unsigned char* lds, int b, int g, int qb, float m0c, float m0s, float m0w, int tid, int wave, int lane_) {
    LAUNDER_V(tid); const int lane = tid & 63; (void)lane_;
    unsigned char* ws = p.ws;
    const int c32 = lane & 31, h = lane >> 5, hg = lane & 3, tau = c32 >> 2; const int t0 = 64 * qb;
    const bf16_t* Q = (const bf16_t*)(ws + WS_Q); const bf16_t* QR = (const bf16_t*)(ws + WS_QR);
    const bf16_t* KC = (const bf16_t*)(ws + WS_KC) + (size_t)b * NCP * 128 + g * 64; const bf16_t* VC = (const bf16_t*)(ws + WS_VC) + (size_t)b * NCP * 128 + g * 64;
    const bf16_t* SL = (const bf16_t*)(ws + WS_SL) + (size_t)b * T_ * 256 + g * 64; const bf16_t* WN = (const bf16_t*)(ws + WS_WN) + (size_t)b * T_ * 256 + g * 64;
    const float* G = (const float*)(ws + WS_G);
    constexpr float LOG2E = 1.4426950408889634f;
    const int ttok = t0 + 8 * wave + tau; const size_t rowg = (size_t)b * T_ + ttok;
    const int hd = 4 * g + hg;
    bf16x8 qf[4]; f32x16 oacc[2], outa[2]; float lsum = 0.f, linv = 0.f; unsigned long long tcomp = 0, tpass = 0;
    unsigned long long slo = 0ull, shi = 0ull;
#pragma unroll
    for (int dt = 0; dt < 2; ++dt)
#pragma unroll
        for (int i = 0; i < 16; ++i) { oacc[dt][i] = 0.f; outa[dt][i] = 0.f; }
#pragma unroll
    for (int ks = 0; ks < 4; ++ks) qf[ks] = ld8(Q + rowg * 512 + hd * 64 + 16 * ks + 8 * h);
    const int ncmp = 4 * qb + 3;
    const int jhc = (ncmp - 1) >> 6;
#ifndef REP_CMP
#define REP_CMP 1
#endif
    float icarry = 0.f; lsum = 0.f;
    attn_pass<1>(KC, VC, 128, 0, jhc, lds, qf, oacc, lsum, icarry, m0c * LOG2E, ttok, slo, shi, t0, qb, tid, wave, lane, tcomp, tpass);
    { float L = lsum; L += __shfl_xor(L, 32); linv = L > 0.f ? 1.0f / L : 0.f; lsum = 0.f; }
    if (h == 0) ((float*)(lds + AT_TM))[(8 * wave + tau) * 4 + hg] = linv;
    { const float gt = G[rowg * 32 + 3 * hd + 0] * linv;
#pragma unroll
        for (int dt = 0; dt < 2; ++dt)
#pragma unroll
            for (int i = 0; i < 16; ++i) { outa[dt][i] = oacc[dt][i] * gt; oacc[dt][i] = 0.f; } }
    WAVE_SYNC();
    {
        const float* impA = (const float*)(lds + AT_IA); const float* impB = (const float*)(lds + AT_IB); unsigned long long* sel = (unsigned long long*)(lds + AT_SEL);
        unsigned char* sel8 = (unsigned char*)sel;
        const int row16 = lane >> 4, i16 = lane & 15;
        {
            unsigned k[2][8], th[2] = {0u, 0u};
#pragma unroll
            for (int rnd = 0; rnd < 2; ++rnd) {
                const int tl = 8 * wave + 4 * rnd + row16;
                const u32x4* mrow = (const u32x4*)((const unsigned short*)impA + (tl * 128 + 8 * (i16 ^ (tl & 7))) * 4);
                const u32x4 m0 = mrow[0], m1 = mrow[1], m2 = mrow[2], m3 = mrow[3];
                const f32x4 li = *(const f32x4*)((const float*)(lds + AT_TM) + tl * 4);
#pragma unroll
                for (int c = 0; c < 8; ++c) { const int j = 8 * i16 + c;
                    const u32x4 mv = (c >> 1) == 0 ? m0 : ((c >> 1) == 1 ? m1 : ((c >> 1) == 2 ? m2 : m3));
                    const unsigned w0 = (c & 1) ? mv.z : mv.x, w1 = (c & 1) ? mv.w : mv.y;
                    const float imp = (float)__builtin_bit_cast(_Float16, (unsigned short)(w0 & 0xffffu)) * li.x + (float)__builtin_bit_cast(_Float16, (unsigned short)(w0 >> 16)) * li.y
                                    + (float)__builtin_bit_cast(_Float16, (unsigned short)(w1 & 0xffffu)) * li.z + (float)__builtin_bit_cast(_Float16, (unsigned short)(w1 >> 16)) * li.w;
                    const unsigned kv = (__builtin_bit_cast(unsigned, imp) >> SEL_KSH) + 1u;
                    k[rnd][c] = (j > qb) ? 0u : ((j == 0 || j == qb || j == qb - 1) ? (0x7f800000u >> SEL_KSH) + 1u : kv); }
            }
#pragma unroll 1
            for (int bit = 30 - SEL_KSH; bit >= 0; --bit) {
                const unsigned bm = 1u << bit;
#pragma unroll
                for (int rnd = 0; rnd < 2; ++rnd) {
                    const unsigned cand = th[rnd] | bm;
                    const int c01 = ((k[rnd][0] >= cand) ? 1 : 0) + ((k[rnd][1] >= cand) ? 1 : 0), c23 = ((k[rnd][2] >= cand) ? 1 : 0) + ((k[rnd][3] >= cand) ? 1 : 0);
                    const int c45 = ((k[rnd][4] >= cand) ? 1 : 0) + ((k[rnd][5] >= cand) ? 1 : 0), c67 = ((k[rnd][6] >= cand) ? 1 : 0) + ((k[rnd][7] >= cand) ? 1 : 0);
                    const int cnt = row16_sum((c01 + c23) + (c45 + c67));
                    th[rnd] = (cnt >= 16) ? cand : th[rnd];
                }
            }
#pragma unroll
            for (int rnd = 0; rnd < 2; ++rnd) {
                const int tl = 8 * wave + 4 * rnd + row16;
                int gt = 0, eq = 0;
#pragma unroll
                for (int c = 0; c < 8; ++c) { gt += (k[rnd][c] > th[rnd]) ? 1 : 0; eq += (k[rnd][c] == th[rnd]) ? 1 : 0; }
                const int need = (th[rnd] == 0u) ? 0 : 16 - row16_sum(gt);
                int pre = eq;
                { int t_ = row16_shr(pre, 1); pre += t_; t_ = row16_shr(pre, 2); pre += t_; t_ = row16_shr(pre, 4); pre += t_; t_ = row16_shr(pre, 8); pre += t_; }
                int run = pre - eq; unsigned bits = 0u;
#pragma unroll
                for (int c = 0; c < 8; ++c) {
                    if (k[rnd][c] > th[rnd]) bits |= 1u << c;
                    else if (k[rnd][c] == th[rnd]) { if (run < need) bits |= 1u << c; ++run; }
                }
                sel8[tl * 16 + i16] = (unsigned char)bits;
            }
        }
    }
    __syncthreads();
    {
        const unsigned long long* sel = (const unsigned long long*)(lds + AT_SEL);
        const unsigned long long mylo = sel[lane * 2], myhi = sel[lane * 2 + 1];
        __syncthreads();
        for (int jj = 0; jj < 16; ++jj) { const int j = 16 * wave + jj; if (j < 1 || j > 125) continue;
            const int bit = (int)(((j < 64) ? (mylo >> j) : (myhi >> (j - 64))) & 1ull); const unsigned long long m = __ballot(bit);
            unsigned char* tl = en_tl(lds, j);
            const int pos = __builtin_popcountll(m & ((1ull << lane) - 1ull)), cnt = __builtin_popcountll(m);
            if (bit) tl[pos] = (unsigned char)lane;
            if (lane < 16 && cnt + lane < 64) tl[cnt + lane] = 0xFFu; }
    }
    float* outl = (float*)(lds + AT_IA) + tid;
#pragma unroll
    for (int dt = 0; dt < 2; ++dt)
#pragma unroll
        for (int i = 0; i < 16; ++i) outl[(dt * 16 + i) * 512] = outa[dt][i];
#pragma unroll
    for (int ks = 0; ks < 4; ++ks) qf[ks] = ld8(QR + rowg * 512 + hd * 64 + 16 * ks + 8 * h);
#ifndef REP_WIN
#define REP_WIN 1
#endif
    for (int rep_ = 0; rep_ < REP_WIN; ++rep_)
    attn_pass<3>(WN, WN + 128, 256, qb >= 8 ? qb - 8 : 0, qb, lds, qf, oacc, lsum, icarry, m0w * LOG2E, ttok, slo, shi, t0, qb, tid, wave, lane, tcomp, tpass);
    { float L = lsum; L += __shfl_xor(L, 32); const float sc = (L > 0.f ? 1.0f / L : 0.f) * G[rowg * 32 + 3 * hd + 2]; lsum = 0.f;
#pragma unroll
        for (int dt = 0; dt < 2; ++dt)
#pragma unroll
            for (int i = 0; i < 16; ++i) { outa[dt][i] = outl[(dt * 16 + i) * 512] + oacc[dt][i] * sc; oacc[dt][i] = 0.f; } }
    __syncthreads();
    {
        bf16_t* QL = (bf16_t*)(lds + EN_QL); float* OL = (float*)(lds + EN_OL); float* LL = (float*)(lds + EN_LL);
        float* outp = (float*)(lds + EN_END) + tid;
#pragma unroll
        for (int i = 0; i < 16; ++i) outp[i * 512] = outa[1][i];
        for (int i = tid; i < (EN_LL + 1024 - EN_OL) / 16; i += 512) ((u32x4*)(lds + EN_OL))[i] = (u32x4){0u, 0u, 0u, 0u};
        unsigned* qcnt = (unsigned*)(lds + MISC_OFF + 128);
        if (tid == 0) *qcnt = 0u;
#pragma unroll
        for (int k = 0; k < 4; ++k) { const int idx = tid + 512 * k, tok = idx >> 5, c = idx & 31;
            *(u32x4*)(QL + (tok * 4 + (c >> 3)) * 72 + (c & 7) * 8) = *(const u32x4*)(QR + ((size_t)b * T_ + t0 + tok) * 512 + g * 256 + c * 8); }
        __syncthreads();
        const bf16_t* VT = (const bf16_t*)(ws + WS_VT) + (size_t)(b * NGRP + g) * (T_ / 64) * 4096; const bf16_t* KF = (const bf16_t*)(ws + WS_KF) + (size_t)(b * NGRP + g) * (T_ / 64) * 4096;
        const int r32 = lane & 31, kr = (r32 & ~12) | ((r32 & 8) >> 1) | ((r32 & 4) << 1);
        const float cs0 = 17.0f - m0s * LOG2E;
#ifndef REP_SLC
#define REP_SLC 1
#endif
        for (;;) {
            unsigned tk_ = 0u; if (lane == 0) tk_ = atomicAdd(qcnt, 1u);
            tk_ = (unsigned)__shfl((int)tk_, 0);
#ifndef CPU_EMU
            tk_ = (unsigned)__builtin_amdgcn_readfirstlane((int)tk_);
#endif
            const int j = 1 + (int)tk_; if (j > qb - 2) break;
            const unsigned char* tl = en_tl(lds, j);
            int first = tl[0];
#ifndef CPU_EMU
            first = __builtin_amdgcn_readfirstlane(first);
#endif
            if (first == 0xFF) continue;
            bf16x8 kfr[2][4], vfr[2][4];
#pragma unroll
            for (int kt = 0; kt < 2; ++kt)
#pragma unroll
                for (int ks = 0; ks < 4; ++ks) kfr[kt][ks] = ld8(KF + (size_t)j * 4096 + ((kt * 4 + ks) * 64 + lane) * 8);
#pragma unroll
            for (int dt = 0; dt < 2; ++dt)
#pragma unroll
                for (int q = 0; q < 4; ++q) vfr[dt][q] = ld8(VT + (size_t)j * 4096 + ((dt * 4 + q) * 64 + lane) * 8);
            for (int gi = 0; gi < 8; ++gi) {
                const int tokidx = tl[8 * gi + tau];
                const bool valid = tokidx != 0xFF;
                if (!__any(valid)) break;
                const int ti = valid ? tokidx : 0; const int row = ti * 4 + hg;
                bf16x8 qg[4];
#pragma unroll
                for (int ks = 0; ks < 4; ++ks) qg[ks] = ld8(QL + row * 72 + 16 * ks + 8 * h);
                f32x16 s2[2];
#pragma unroll
                for (int kt = 0; kt < 2; ++kt) {
#pragma unroll
                    for (int i = 0; i < 16; ++i) s2[kt][i] = cs0;
#pragma unroll
                    for (int ks = 0; ks < 4; ++ks) s2[kt] = mfma32(kfr[kt][ks], qg[ks], s2[kt]);
                }
                float psum = 0.f;
#pragma unroll
                for (int kt = 0; kt < 2; ++kt)
#pragma unroll
                    for (int i = 0; i < 16; ++i) { const float pv = exp2_fast(s2[kt][i]); s2[kt][i] = pv; psum += pv; }
                u32x4 pw[4];
#pragma unroll
                for (int q = 0; q < 4; ++q) { const int kt = q >> 1, sp = q & 1;
                    pw[q] = (u32x4){pk2(s2[kt][8 * sp], s2[kt][8 * sp + 1]), pk2(s2[kt][8 * sp + 2], s2[kt][8 * sp + 3]), pk2(s2[kt][8 * sp + 4], s2[kt][8 * sp + 5]), pk2(s2[kt][8 * sp + 6], s2[kt][8 * sp + 7])}; }
                if (!__all(valid)) {
                    const unsigned pm = valid ? 0xffffffffu : 0u;
#pragma unroll
                    for (int q = 0; q < 4; ++q) { pw[q].x &= pm; pw[q].y &= pm; pw[q].z &= pm; pw[q].w &= pm; }
                }
                f32x16 o2[2];
#pragma unroll
                for (int dt = 0; dt < 2; ++dt) {
#pragma unroll
                    for (int i = 0; i < 16; ++i) o2[dt][i] = 0.f;
#pragma unroll
                    for (int q = 0; q < 4; ++q) o2[dt] = mfma32(vfr[dt][q], __builtin_bit_cast(bf16x8, pw[q]), o2[dt]);
                }
#ifdef CPU_EMU
                psum += __shfl_xor(psum, 32);
#else
                { unsigned pa_ = __builtin_bit_cast(unsigned, psum), pb_ = pa_;
                  asm volatile("s_nop 1\n\tv_permlane32_swap_b32 %0, %1" : "+v"(pa_), "+v"(pb_));
                  psum += __builtin_bit_cast(float, pb_); }
#endif
                if (valid) {
                    unsigned* orow = (unsigned*)(OL + row * 65 + 4 * h);
#pragma unroll
                    for (int dt = 0; dt < 2; ++dt)
#pragma unroll
                        for (int i = 0; i < 16; ++i) atomicAdd(orow + 32 * dt + (i & 3) + 8 * (i >> 2), (unsigned)f2i_rn(o2[dt][i]));
                    if (h == 0) atomicAdd((unsigned*)(LL + row), (unsigned)f2i_rn(psum));
                }
            }
        }
        {
            const int key = tid >> 3, ch = tid & 7;
            const int nft = qb >= 2 ? 3 : qb + 1;
            u32x4 fk[3], fv[3];
#pragma unroll
            for (int u = 0; u < 3; ++u) { const int jt = (u == 0) ? 0 : (qb >= 2 ? qb - 2 + u : u); fk[u] = (u32x4){0u, 0u, 0u, 0u}; fv[u] = fk[u];
                if (u < nft) { fk[u] = *(const u32x4*)(SL + (size_t)(64 * jt + key) * 256 + 8 * ch); fv[u] = *(const u32x4*)(SL + 128 + (size_t)(64 * jt + key) * 256 + 8 * ch); } }
#pragma unroll
            for (int ks = 0; ks < 4; ++ks) qf[ks] = ld8(QR + rowg * 512 + hd * 64 + 16 * ks + 8 * h);
            __syncthreads();
            const int row = (8 * wave + tau) * 4 + hg;
            float Lf = (h == 0) ? (float)((const int*)LL)[row] : 0.f;
            f32x16 of[2];
            { const int* orow = (const int*)(OL + row * 65 + 4 * h);
#pragma unroll
              for (int dt = 0; dt < 2; ++dt)
#pragma unroll
                  for (int i = 0; i < 16; ++i) of[dt][i] = (float)orow[32 * dt + (i & 3) + 8 * (i >> 2)]; }
            __syncthreads();
#pragma unroll
            for (int u = 0; u < 3; ++u) { unsigned char* slot = lds + AT_KB + (u >> 1) * AT_STAGE + ((64 * (u & 1) + key) * ATS + 8 * ch) * 2;
                *(u32x4*)slot = fk[u]; *(u32x4*)(slot + AT_VOFF) = fv[u]; }
            f32x16 negm; float nm0_ = 17.0f - m0s * LOG2E; LAUNDER_V(nm0_);
#pragma unroll
            for (int i = 0; i < 16; ++i) negm[i] = nm0_;
            __syncthreads();
#pragma unroll 1
            for (int u = 0; u < nft; ++u) { const int jt = (u == 0) ? 0 : (qb >= 2 ? qb - 2 + u : u);
                const bf16_t* kb = (const bf16_t*)(lds + AT_KB + (u >> 1) * AT_STAGE) + 64 * ATS * (u & 1);
                attn_tile<2>(kb, kb + AT_VOFF / 2, jt, qf, of, Lf, icarry, negm, ttok, 0ull, 0ull, t0, qb, (float*)(lds + AT_IA), (float*)(lds + AT_IB), wave, lane); }
            Lf += __shfl_xor(Lf, 32);
            const float sc = (Lf > 0.f ? 1.0f / Lf : 0.f) * G[rowg * 32 + 3 * hd + 1];
#pragma unroll
            for (int dt = 0; dt < 2; ++dt)
#pragma unroll
                for (int i = 0; i < 16; ++i) outa[dt][i] = (dt == 1 ? outp[i * 512] : outa[dt][i]) + of[dt][i] * sc;
        }
    }
    {
        const bf16_t* ZA = (const bf16_t*)(ws + WS_ZA); bf16_t* MIX = (bf16_t*)(ws + WS_MIX);
        unsigned char* stg = lds + EN_END + wave * 256;
        const int rr = lane >> 3, pc = lane & 7;
        u32x4 zr[4];
#pragma unroll
        for (int j = 0; j < 4; ++j) { const int r = 8 * j + rr; const size_t grow = (size_t)b * T_ + t0 + 8 * wave + (r >> 2);
            zr[j] = *(const u32x4*)(ZA + grow * 512 + (4 * g + (r & 3)) * 64 + 8 * pc); }
        WAVE_SYNC();
#pragma unroll
        for (int j = 0; j < 4; ++j) { const int r = 8 * j + rr; *(u32x4*)(stg + (r >> 1) * 2048 + (r & 1) * 128 + 16 * pc) = zr[j]; }
        WAVE_SYNC();
        unsigned char* myrow = stg + (c32 >> 1) * 2048 + (c32 & 1) * 128;
#pragma unroll
        for (int dt = 0; dt < 2; ++dt)
#pragma unroll
            for (int gq = 0; gq < 4; ++gq) {
                u32x2* slot = (u32x2*)(myrow + (32 * dt + 8 * gq + 4 * h) * 2); const u32x2 zv = *slot;
                float o[4];
#pragma unroll
                for (int r = 0; r < 4; ++r) { const unsigned w = zv[r >> 1]; o[r] = outa[dt][4 * gq + r] * bf2f((r & 1) ? (w >> 16) : (w & 0xffffu)); }
                *slot = (u32x2){pk2(o[0], o[1]), pk2(o[2], o[3])};
            }
        WAVE_SYNC();
#pragma unroll
        for (int j = 0; j < 4; ++j) { const int r = 8 * j + rr; const size_t grow = (size_t)b * T_ + t0 + 8 * wave + (r >> 2);
            *(u32x4*)(MIX + grow * 1024 + (4 * g + (r & 3)) * 64 + 8 * pc) = *(const u32x4*)(stg + (r >> 1) * 2048 + (r & 1) * 128 + 16 * pc); }
    }
    __syncthreads();
#ifdef PROBE_TIMING
    if (b == PROBE_B && g == 0 && qb == PROBE_QB && tid == PROBE_TID) { float* tr = (float*)(ws + WS_CTL + 32768); tr[0] = (float)tcomp; tr[1] = (float)tpass; }
#endif
}

DEV void p4_attention(const Params& p, unsigned char* lds, int vcu, int G, int tid, int wave, int lane) {
    const float gq = wave_max(fabsf(p.in[I_QNG][lane])), gc = wave_max(fabsf(p.in[I_KCNG][lane])), gs = wave_max(fabsf(p.in[I_KSNG][lane])), gw = wave_max(fabsf(p.in[I_KWNG][lane]));
    const float m0c = 8.2f * gq * gc, m0s = 8.2f * gq * gs, m0w = 8.2f * gq * gw;
    for (int i = 0;; ++i) {
        const long L = (long)i * G + vcu; if (L >= AT_UNITS) break;
        int bg, qb;
        if (G == 256 && B_ * NGRP == 16 && NSB == 128) {
            const int xcd = vcu >> 5, c = vcu & 31, r = i & 3;
            bg = 2 * xcd + (i >> 2); qb = (r == 0) ? c : (r == 1) ? 63 - c : (r == 2) ? 64 + c : 127 - c;
        } else {
            const int per = B_ * NGRP * 16;
            const int k = (int)(L / per), v = (int)(L % per), s = v & 15;
            bg = v >> 4; qb = 32 * (k >> 1) + ((k & 1) ? 31 - s : s);
        }
        attn_unit(p, lds, bg / NGRP, bg % NGRP, qb, m0c, m0s, m0w, tid, wave, lane);
    }
}

#ifndef CPU_EMU
#define GAS __attribute__((address_space(1)))
#define LAS __attribute__((address_space(3)))
#define XB_TMO      128
#define XB_XCNT(j)  (256  + 64 * (j))
#define XB_XSUB(j)  (1280 + 64 * (j))
#define XB_XGEN(j)  (2304 + 64 * (j))
#define XB_TOP      3328
#define XB_TOPGEN   3392
#define XCD_BAR_WORDS 3456
#define XB_SPIN_CAP (1u << 20)
__device__ __forceinline__ unsigned xb_ld(unsigned* p)              { return __hip_atomic_load(p, __ATOMIC_RELAXED, __HIP_MEMORY_SCOPE_AGENT); }
__device__ __forceinline__ unsigned xb_add(unsigned* p, unsigned v) { return __hip_atomic_fetch_add(p, v, __ATOMIC_RELAXED, __HIP_MEMORY_SCOPE_AGENT); }
__device__ __forceinline__ unsigned xb_xcc_id() { return (unsigned)__builtin_amdgcn_s_getreg((3 << 11) | 20) & 0xFu; }
#define XB_SPIN(cond, bar) do { unsigned _sp = 0; while (cond) { __builtin_amdgcn_s_sleep(1); \
    if ((++_sp & 255u) == 0u) { if (xb_ld(&(bar)[XB_TMO])) break; if (_sp > XB_SPIN_CAP) { atomicAdd(&(bar)[XB_TMO], 1u); break; } } } } while (0)
struct XcdBarrier { unsigned* bar; unsigned x; volatile LAS unsigned* st; };
__device__ __forceinline__ XcdBarrier xcd_barrier_post(unsigned* bar, volatile LAS unsigned* st) {
    XcdBarrier b; b.bar = bar; b.x = xb_xcc_id(); b.st = st;
    if (threadIdx.x == 0) (void)xb_add(&bar[XB_XCNT(b.x)], 1u);
    return b;
}
__device__ __forceinline__ void xcd_barrier_complete(unsigned* bar, unsigned x, unsigned& nloc, unsigned& nx) {
    const unsigned G = gridDim.x * gridDim.y * gridDim.z;
    unsigned sum, cnt, mine, sp = 0u;
    for (;;) {
        sum = 0u; cnt = 0u; mine = 0u;
#pragma unroll
        for (unsigned j = 0; j < 16; ++j) { const unsigned c = xb_ld(&bar[XB_XCNT(j)]); sum += c; cnt += (c > 0u) ? 1u : 0u; mine = (j == x) ? c : mine; }
        if (sum == G) break;
        __builtin_amdgcn_s_sleep(1);
        if ((++sp & 255u) == 0u) { if (xb_ld(&bar[XB_TMO])) break; if (sp > XB_SPIN_CAP) { atomicAdd(&bar[XB_TMO], 1u); break; } }
    }
    nloc = mine > 0u ? mine : 1u; nx = cnt > 0u ? cnt : 1u;
}
__device__ __forceinline__ void xcd_barrier(const XcdBarrier& b) {
    asm volatile("s_waitcnt vmcnt(0)" ::: "memory");
    __syncthreads();
    if (threadIdx.x == 0) {
        unsigned* bar = b.bar;
        __builtin_amdgcn_s_waitcnt(0);
        unsigned nloc = b.st[0], nx = b.st[1];
        if (nloc == 0u) { xcd_barrier_complete(bar, b.x, nloc, nx); b.st[0] = nloc; b.st[1] = nx; }
        const unsigned old = xb_add(&bar[XB_XSUB(b.x)], 1u);
        const unsigned gen = old / nloc;
        if (old + 1u == (gen + 1u) * nloc) {
            __builtin_amdgcn_fence(__ATOMIC_RELEASE, "agent");
            asm volatile("s_waitcnt vmcnt(0)" ::: "memory");
            const unsigned og = xb_add(&bar[XB_TOP], 1u);
            const unsigned tg = og / nx;
            if (og + 1u == (tg + 1u) * nx) xb_add(&bar[XB_TOPGEN], 1u);
            else XB_SPIN(xb_ld(&bar[XB_TOPGEN]) == tg, bar);
            __builtin_amdgcn_fence(__ATOMIC_ACQUIRE, "agent");
            xb_add(&bar[XB_XGEN(b.x)], 1u);
            asm volatile("s_waitcnt vmcnt(0)" ::: "memory");
        } else {
            XB_SPIN(xb_ld(&bar[XB_XGEN(b.x)]) == gen, bar);
            __builtin_amdgcn_fence(__ATOMIC_ACQUIRE, "agent");
            asm volatile("s_waitcnt vmcnt(0)" ::: "memory");
        }
    }
    __syncthreads();
}
#endif

#ifndef CPU_EMU
__device__ __forceinline__ void group_barrier(unsigned* cnt, unsigned target, bool same_xcc) {
    asm volatile("s_waitcnt vmcnt(0)" ::: "memory");
    __syncthreads();
    if (threadIdx.x == 0) {
        if (!same_xcc) __builtin_amdgcn_fence(__ATOMIC_RELEASE, "agent");
        asm volatile("s_waitcnt vmcnt(0)" ::: "memory");
        (void)xb_add(cnt, 1u);
        unsigned sp = 0u;
        while (xb_ld(cnt) < target) { __builtin_amdgcn_s_sleep(1); if (++sp > (XB_SPIN_CAP << 4)) break; }
        __builtin_amdgcn_fence(__ATOMIC_ACQUIRE, "agent");
        asm volatile("s_waitcnt vmcnt(0)" ::: "memory");
    }
    __syncthreads();
}
constexpr size_t WS_GBAR = WS_CTL + 20480;
static_assert(WS_CTL + 4096 + XCD_BAR_WORDS * 4 <= WS_GBAR && WS_GBAR + 8 * 256 <= WS_CPOS, "group barrier words");
constexpr size_t WS_XID = WS_CTL + 28672;
static_assert(WS_CPOS + 2048 <= WS_XID && WS_XID + 1024 <= WS_CTL + 32768, "xcc id words");
static_assert(WS_CTL + 4096 + XCD_BAR_WORDS * 4 <= WS_CPOS && WS_CPOS + 2048 <= WS_CTL + 32768 && 32768 + 64 <= CTL_ZERO_BYTES, "barrier words vs cpos");
#endif
constexpr int N_PHASES = 6;
__global__ void __launch_bounds__(512, 2) fwd_kernel(Params p) {
#ifdef CPU_EMU
    unsigned char* lds = emu_smem;
#else
    extern __shared__ __attribute__((aligned(16))) unsigned char lds[];
#endif
    const int tid = threadIdx.x, lane = tid & 63, wave = WAVE_ID();
    const int G = gridDim.x; const int bx = blockIdx.x; const int vcu = (G % 8 == 0) ? (bx % 8) * (G / 8) + bx / 8 : bx;
#ifndef CPU_EMU
    for (int u = tid; u < 64; u += 512) ((LAS unsigned*)(lds + MISC_OFF))[u] = 0u;
    __syncthreads();
    XcdBarrier bar; bar.bar = (unsigned*)(p.ws + WS_CTL) + 1024 + p.li * XCD_BAR_WORDS; bar.x = 0; bar.st = nullptr;
    if (p.ph_hi - p.ph_lo > 1) bar = xcd_barrier_post(bar.bar, (volatile LAS unsigned*)(lds + MISC_OFF) + 8);
    const bool grp_ok = (G == 256 && B_ == 8 && T_ == 8192);
    unsigned* gcnt = (unsigned*)(p.ws + WS_GBAR) + 64 * (bx & 7); unsigned gtgt = 0u;
    bool grp_same_xcc = false;
    if (grp_ok && p.ph_hi - p.ph_lo > 1 && tid == 0) __hip_atomic_store((unsigned*)(p.ws + WS_XID) + bx, xb_xcc_id() + 1u, __ATOMIC_RELAXED, __HIP_MEMORY_SCOPE_AGENT);
#define GRID_BAR() do { xcd_barrier(bar); if (grp_ok) { \
        if (tid == 0) { const unsigned me_ = xb_xcc_id() + 1u; unsigned same_ = 1u; for (int k_ = 0; k_ < 32; ++k_) same_ &= (xb_ld((unsigned*)(p.ws + WS_XID) + (bx & 7) + 8 * k_) == me_) ? 1u : 0u; \
                        ((volatile LAS unsigned*)(lds + MISC_OFF))[12] = same_; } \
        __syncthreads(); grp_same_xcc = ((volatile LAS unsigned*)(lds + MISC_OFF))[12] != 0u; } } while (0)
#define GROUP_BAR() do { if (grp_ok) { gtgt += 32u; group_barrier(gcnt, gtgt, grp_same_xcc); } else { xcd_barrier(bar); } } while (0)
#else
#define GRID_BAR() do { } while (0)
#define GROUP_BAR() do { } while (0)
#endif
    const int lo = p.ph_lo, hi = p.ph_hi;
#ifndef PHASE_MASK
#define PHASE_MASK 63
#endif
#define IN(k) (((PHASE_MASK >> (k)) & 1) && lo <= (k) && (k) < hi)
#define BOTH(k) (IN(k) && IN((k) + 1))
#ifndef REP_PHASE
#define REP_PHASE -1
#endif
#define REPS(k) for (int rep_ = 0; rep_ < ((k) == REP_PHASE ? 2 : 1); ++rep_)
    if (IN(0)) { REPS(0) { p0_prologue(p, lds, vcu, G, tid, wave, lane); __syncthreads(); } if (BOTH(0)) GRID_BAR(); }
    if (IN(1)) { REPS(1) p1_norm(p, vcu, G, wave, lane); if (BOTH(1)) GROUP_BAR(); }
    if (IN(2)) {
        constexpr int INGEMM = 2816;
#ifdef REP_INPROJ
        struct RepOrder { pg8::StaticOrder S; int cnt; __device__ bool next(int i, pg8::Unit& u) const { return S.next(i < cnt ? i : i - cnt, u) && i < 2 * cnt; } __device__ void a_ready(const pg8::Unit&) const {} __device__ void done(const pg8::Unit&) const {} };
        pg8::Gemm g{(const bf16_t*)(p.ws + WS_HN), (const bf16_t*)(p.ws + WS_WIN), M_, INGEMM, 1024}; RepOrder S; S.S.init(M_, INGEMM, G, bx); S.cnt = (S.S.nwg - bx + G - 1) / G;
#define INPROJ_ORDER RepOrder
#else
        pg8::Gemm g{(const bf16_t*)(p.ws + WS_HN), (const bf16_t*)(p.ws + WS_WIN), M_, INGEMM, 1024}; pg8::StaticOrder S; S.init(M_, INGEMM, G, bx);
#define INPROJ_ORDER pg8::StaticOrder
#endif
        EpiInProj E{p.ws, p.in[I_QNG], p.in[I_KSNG], p.in[I_KWNG]};
        pg8::gemm_phase<EpiInProj, INPROJ_ORDER, true, true>(PG8_PTR(lds), g, S, E);
        if (BOTH(2)) GROUP_BAR();
    }
    if (IN(3)) {
        REPS(3) for (int u = vcu; u < B_ * SSM_NG; u += G) ssm_unit(p, lds, u, tid, wave, lane);
        REPS(6) for (int u = vcu; u < CMP_UNITS; u += G) compress_unit(p, lds, u, tid, wave, lane);
        {
            const bool local = (G == 256 && B_ == 8);
            auto vt_of = [&](int k) -> int { if (local) { if (k >= VT_UNITS / 256) return -1; const int loc = (vcu & 31) + 32 * k; return ((vcu >> 5) * NGRP + (loc >> 7)) * (T_ / 64) + (loc & 127); }
                                               const int u = vcu + k * G; return u < VT_UNITS ? u : -1; };
            VtPre cur, nxt; int u = vt_of(0);
            if (u >= 0) vt_fetch(p, u, tid, cur);
            for (int k = 0; u >= 0; ++k) {
                const int un = vt_of(k + 1); nxt = cur;
                if (un >= 0) vt_fetch(p, un, tid, nxt);
                vt_unit(p, lds, u, tid, cur);
                cur = nxt; u = un;
            }
        }
        if (BOTH(3)) GROUP_BAR();
    }
    if (IN(4)) {
        REPS(4) p4_attention(p, lds, vcu, G, tid, wave, lane);
        pg8::Gemm g{(const bf16_t*)(p.ws + WS_YG), (const bf16_t*)(p.ws + WS_WGLU), M_, 512, 512}; pg8::StaticOrder S; S.init(M_, 512, G, bx);
        EpiGlu E{(const bf16_t*)(p.ws + WS_YG), (const bf16_t*)(p.ws + WS_ZS), (bf16_t*)(p.ws + WS_MIX), p.in[I_GLUB]};
        REPS(7) pg8::gemm_phase<EpiGlu, pg8::StaticOrder, true, true>(PG8_PTR(lds), g, S, E);
        if (BOTH(4)) GROUP_BAR();
    }
    if (IN(5)) {
        pg8::Gemm g{(const bf16_t*)(p.ws + WS_MIX), (const bf16_t*)(p.ws + WS_WO), M_, 1024, 1024}; pg8::StaticOrder S; S.init(M_, 1024, G, bx);
        EpiOut E{p.in[I_X], p.out, (const float*)(p.ws + WS_MOD)};
        REPS(5) pg8::gemm_phase<EpiOut, pg8::StaticOrder, true, true>(PG8_PTR(lds), g, S, E);
#ifdef PROBE_TIMING
        GRID_BAR();
        if (bx == 0 && tid == 0) { const float* tr = (const float*)(p.ws + WS_CTL + 32768); p.out[0] += tr[PROBE_WHICH] * 1e-3f; }
#endif
    }
#undef IN
#undef BOTH
}

extern "C" void kernel_launch(void* const* d_in, const int* in_sizes, int n_in, void* d_out, int out_size, void* d_ws, size_t ws_size, hipStream_t stream) {
    static int grid = 0;
    if (grid == 0) {
        if (n_in != N_IN || out_size != M_ * D_ || ws_size < WS_END) { fprintf(stderr, "kernel_launch: unexpected shapes (n_in %d out %d ws %zu need %zu)\n", n_in, out_size, ws_size, (size_t)WS_END); grid = -1; return; }
#ifdef CPU_EMU
        grid = EMU_GRID;
#else
        int dev = 0, cus = 0, per_cu = 0;
        if (hipGetDevice(&dev) != hipSuccess || hipDeviceGetAttribute(&cus, hipDeviceAttributeMultiprocessorCount, dev) != hipSuccess) { grid = -1; return; }
        if (hipFuncSetAttribute((const void*)fwd_kernel, hipFuncAttributeMaxDynamicSharedMemorySize, LDS_BYTES) != hipSuccess) { fprintf(stderr, "kernel_launch: hipFuncSetAttribute failed\n"); grid = -1; return; }
        if (hipOccupancyMaxActiveBlocksPerMultiprocessor(&per_cu, (const void*)fwd_kernel, 512, LDS_BYTES) != hipSuccess || per_cu < 1) { fprintf(stderr, "kernel_launch: occupancy query says %d blocks per CU\n", per_cu); per_cu = 1; }
        (void)hipGetLastError();
        grid = cus;
#endif
    }
    if (grid < 0) return;
    (void)hipMemsetAsync((char*)d_ws + WS_CTL, 0, CTL_ZERO_BYTES, stream);
    Params a{};
    for (int i = 0; i < N_IN; ++i) a.in[i] = (const float*)d_in[i];
    a.out = (float*)d_out; a.ws = (unsigned char*)d_ws;
    for (int li = 0; li < N_LAUNCH; ++li) {
        a.ph_lo = (N_LAUNCH == 1) ? 0 : li; a.ph_hi = (N_LAUNCH == 1) ? N_PHASES : li + 1; a.li = 0;
#ifdef CPU_EMU
        emu_launch((unsigned)grid, 512u, [&]() { fwd_kernel(a); });
#else
        hipLaunchKernelGGL(fwd_kernel, dim3(grid), dim3(512), LDS_BYTES, stream, a);
#endif
    }
}
```
